# Optimizing an MI355X kernel written in HIP

```python
import math
import jax
import jax.numpy as jnp
from jax import lax
import numpy as np

D_MODEL = 1024
BATCH = 8
SEQ = 4096
DEPTH = 2

GRID_W = 64
CTX_LEN = 256
EPS = 1e-6
N_MOD = 9
FFN_HIDDEN = 2816

DA_HEADS = 4
DA_DH = 64
DA_DV = 2 * DA_DH
DA_WIDTH = DA_HEADS * DA_DV
Q_BLOCK = 128
ROPE_BASE = 10000.0
ROPE_PAIRS = DA_DH // 4

HY_WIDTH = 256
HY_ORDER = 2
HY_EMB = 33
HY_BANDS = (HY_EMB - 1) // 2
HY_FILTER_HIDDEN = 64
HY_FAST_DECAY = 0.3
HY_SLOW_DECAY = 1.5
HY_TARGET = 1e-2

SG_WIDTH = 256
SG_GROUPS = 4
SG_CHUNK = 128

N_BRANCH = 3
MIX_WIDTH = DA_WIDTH + HY_WIDTH + SG_WIDTH
HY_OFF = 3 * DA_WIDTH
SG_OFF = HY_OFF + (HY_ORDER + 1) * HY_WIDTH
IN_WIDTH = SG_OFF + 2 * SG_WIDTH

kernel_name = 'hybrid_diffattn_hyena_gmlp_macaron_dit'


def rms_norm(x, gain):
    xf = x.astype(jnp.float32)
    y = xf * lax.rsqrt(jnp.mean(xf * xf, axis=-1, keepdims=True) + EPS)
    return (y * gain.astype(jnp.float32)).astype(x.dtype)


def layer_norm(x, gain, bias):
    xf = x.astype(jnp.float32)
    mu = jnp.mean(xf, axis=-1, keepdims=True)
    var = jnp.mean(jnp.square(xf - mu), axis=-1, keepdims=True)
    y = (xf - mu) * lax.rsqrt(var + EPS)
    return (y * gain.astype(jnp.float32) + bias.astype(jnp.float32)).astype(x.dtype)


def adaln_input(x, mod, i, gain):
    shift = mod[:, 3 * i][:, None]
    scale = mod[:, 3 * i + 1][:, None]
    return rms_norm(x, gain) * (1.0 + scale) + shift


def adaln_gate(mod, i):
    return mod[:, 3 * i + 2][:, None]


def macaron_ffn(xs, mod, i, gain, w_up, w_down):
    h = adaln_input(xs, mod, i, gain)
    a, b = jnp.split(h @ w_up, 2, axis=-1)
    return xs + 0.5 * adaln_gate(mod, i) * ((jax.nn.silu(a) * b) @ w_down)


def axial_rope_tables(n_tokens):
    rows = n_tokens // GRID_W
    row = jnp.repeat(jnp.arange(rows), GRID_W)
    col = jnp.tile(jnp.arange(GRID_W), rows)
    inv = ROPE_BASE ** (-jnp.arange(ROPE_PAIRS, dtype=jnp.float32) / ROPE_PAIRS)
    ang = jnp.stack([row, col], axis=-1).astype(jnp.float32)[:, :, None] * inv
    return jnp.cos(ang), jnp.sin(ang)


def apply_rope(x, cos, sin):
    shp = x.shape
    xr = x.reshape(shp[:-1] + (2, 2, ROPE_PAIRS))
    x1, x2 = xr[..., 0, :], xr[..., 1, :]
    c = cos[None, :, None, None].astype(x.dtype)
    s = sin[None, :, None, None].astype(x.dtype)
    out = jnp.stack([x1 * c - x2 * s, x1 * s + x2 * c], axis=-2)
    return out.reshape(shp)


def split_qkv(proj, qk_gain):
    b, n = proj.shape[:2]
    q = proj[..., :DA_WIDTH].reshape(b, n, DA_HEADS, 2, DA_DH)
    k = proj[..., DA_WIDTH:2 * DA_WIDTH].reshape(b, n, DA_HEADS, 2, DA_DH)
    v = proj[..., 2 * DA_WIDTH:3 * DA_WIDTH].reshape(b, n, DA_HEADS, DA_DV)
    return rms_norm(q, qk_gain[0]), rms_norm(k, qk_gain[1]), v


def diff_softmax_attend(q, k, v, lam):
    s = jnp.einsum('bqhcd,bkhcd->bhcqk', q, k).astype(jnp.float32) * (DA_DH ** -0.5)
    p = jax.nn.softmax(s, axis=-1)
    a = (p[:, :, 0] - lam * p[:, :, 1]).astype(v.dtype)
    return jnp.einsum('bhqk,bkhe->bqhe', a, v)


def diff_attention(pl, pc, cos, sin, qk_gain, lam_vecs, subln, layer_idx, with_ctx):
    lam_init = 0.8 - 0.6 * math.exp(-0.3 * layer_idx)
    lv = lam_vecs.astype(jnp.float32)
    lam = jnp.exp(jnp.sum(lv[0] * lv[1])) - jnp.exp(jnp.sum(lv[2] * lv[3])) + lam_init
    ql, kl, vl = split_qkv(pl, qk_gain)
    qc, kc, vc = split_qkv(pc, qk_gain)
    ql = apply_rope(ql, cos, sin)
    kl = apply_rope(kl, cos, sin)
    k_all = jnp.concatenate([kc, kl], axis=1)
    v_all = jnp.concatenate([vc, vl], axis=1)
    b, n = pl.shape[:2]
    nb = n // Q_BLOCK
    qb = ql.reshape(b, nb, Q_BLOCK, DA_HEADS, 2, DA_DH).swapaxes(0, 1)
    ol = lax.map(lambda qi: diff_softmax_attend(qi, k_all, v_all, lam), qb)
    ol = ol.swapaxes(0, 1).reshape(b, n, DA_HEADS, DA_DV)

    def head_out(o):
        return (rms_norm(o, subln) * (1.0 - lam_init)).reshape(o.shape[0], o.shape[1], DA_WIDTH)

    yl = head_out(ol)
    yc = head_out(diff_softmax_attend(qc, kc, vc, lam)) if with_ctx else None
    return yl, yc


def short_conv(u, w, b):
    up = jnp.pad(u, ((0, 0), (1, 1), (0, 0)))
    return up[:, :-2] * w[0] + up[:, 1:-1] * w[1] + up[:, 2:] * w[2] + b


def hyena_filters(n, w1, b1, w2, b2, freq, w3):
    f32 = jnp.float32
    t = jnp.linspace(0.0, 1.0, n, dtype=f32)[:, None]
    w = (2.0 * math.pi / n) * jnp.arange(n, dtype=f32)[:, None]
    bands = jnp.linspace(1e-4, HY_BANDS - 1, HY_BANDS, dtype=f32)
    z = jnp.concatenate([t, jnp.cos(bands * w), -jnp.sin(bands * w)], axis=-1)
    h = jnp.sin(freq * (z @ w1 + b1))
    h = jnp.sin(freq * (h @ w2 + b2))
    h = (h @ w3).astype(f32).reshape(n, 2, HY_ORDER, HY_WIDTH)
    max_decay = math.log(HY_TARGET) / HY_FAST_DECAY
    min_decay = math.log(HY_TARGET) / HY_SLOW_DECAY
    deltas = jnp.linspace(min_decay, max_decay, HY_ORDER * HY_WIDTH, dtype=f32).reshape(HY_ORDER, HY_WIDTH)
    h = h * jnp.exp(-t[:, :, None] * jnp.abs(deltas))[:, None]
    filt = jnp.concatenate([h[:, 0], jnp.zeros((1, HY_ORDER, HY_WIDTH), f32), jnp.flip(h[1:, 1], axis=0)], axis=0)
    return filt / jnp.sum(jnp.abs(filt), axis=0, keepdims=True)


def bidir_fftconv(u, filt, bias):
    n = u.shape[1]
    uf = jnp.fft.rfft(u.astype(jnp.float32), n=2 * n, axis=1)
    ff = jnp.fft.rfft(filt, n=2 * n, axis=0)
    y = jnp.fft.irfft(uf * ff[None], n=2 * n, axis=1)[:, :n]
    return (y + u.astype(jnp.float32) * bias).astype(u.dtype)


def hyena_branch(proj, conv_w, conv_b, filt_params, skip):
    n = proj.shape[1]
    u = short_conv(proj, conv_w, conv_b)
    v, x1, x2 = jnp.split(u, 3, axis=-1)
    filt = hyena_filters(n, *filt_params)
    z = x1 * bidir_fftconv(v, filt[:, 0], skip[0])
    return x2 * bidir_fftconv(z, filt[:, 1], skip[1])


def sgu_branch(proj, ln_g, ln_b, w_s, b_s):
    b, n = proj.shape[:2]
    u, v = jnp.split(jax.nn.gelu(proj, approximate=False), 2, axis=-1)
    v = layer_norm(v, ln_g, ln_b)
    v = v.reshape(b, n // SG_CHUNK, SG_CHUNK, SG_GROUPS, SG_WIDTH // SG_GROUPS)
    v = jnp.einsum('gij,bnjgc->bnigc', w_s, v) + jnp.transpose(b_s)[None, None, :, :, None]
    return u * v.reshape(b, n, SG_WIDTH)


def merge_branches(h, ya, yb, yc, gate_w, gate_b, w_br, w_o):
    ga, gb, gc = jnp.split(jax.nn.sigmoid(h @ gate_w + gate_b), N_BRANCH, axis=-1)
    m = (ga * (ya @ w_br[:DA_WIDTH])
         + gb * (yb @ w_br[DA_WIDTH:DA_WIDTH + HY_WIDTH])
         + gc * (yc @ w_br[DA_WIDTH + HY_WIDTH:]))
    return m @ w_o


def setup_inputs(seed: int = 0) -> dict:
    key = jax.random.key(seed)
    ks = iter(jax.random.split(key, 32))
    f32 = jnp.float32

    def nrm(shape, scale):
        return jax.random.normal(next(ks), shape, f32) * scale

    L = DEPTH
    return {
        'x': nrm((BATCH, SEQ, D_MODEL), 1.0),
        'c': nrm((BATCH, D_MODEL), 1.0),
        'ctx': nrm((BATCH, CTX_LEN, D_MODEL), 1.0),
        'c_ctx': nrm((D_MODEL,), 1.0),
        'ada_w': nrm((L, D_MODEL, N_MOD * D_MODEL), D_MODEL ** -0.5),
        'ada_b': nrm((L, N_MOD * D_MODEL), 0.02),
        'norm_g': 1.0 + nrm((L, 3, D_MODEL), 0.02),
        'ffn_up': nrm((L, 2, D_MODEL, 2 * FFN_HIDDEN), D_MODEL ** -0.5),
        'ffn_down': nrm((L, 2, FFN_HIDDEN, D_MODEL), FFN_HIDDEN ** -0.5),
        'w_in': nrm((L, D_MODEL, IN_WIDTH), D_MODEL ** -0.5),
        'da_qk_gain': 1.0 + nrm((L, 2, DA_DH), 0.02),
        'da_lambda': nrm((L, 4, DA_DH), 0.1),
        'da_subln': 1.0 + nrm((L, DA_DV), 0.02),
        'hy_conv_w': nrm((L, 3, (HY_ORDER + 1) * HY_WIDTH), 0.5),
        'hy_conv_b': nrm((L, (HY_ORDER + 1) * HY_WIDTH), 0.02),
        'hy_f_w1': nrm((L, HY_EMB, HY_FILTER_HIDDEN), HY_EMB ** -0.5),
        'hy_f_b1': nrm((L, HY_FILTER_HIDDEN), 0.1),
        'hy_f_w2': nrm((L, HY_FILTER_HIDDEN, HY_FILTER_HIDDEN), HY_FILTER_HIDDEN ** -0.5),
        'hy_f_b2': nrm((L, HY_FILTER_HIDDEN), 0.1),
        'hy_f_freq': 1.0 + nrm((L, HY_FILTER_HIDDEN), 0.05),
        'hy_f_w3': nrm((L, HY_FILTER_HIDDEN, 2 * HY_ORDER * HY_WIDTH), HY_FILTER_HIDDEN ** -0.5),
        'hy_skip': nrm((L, HY_ORDER, HY_WIDTH), 0.5),
        'sg_ln_g': 1.0 + nrm((L, SG_WIDTH), 0.02),
        'sg_ln_b': nrm((L, SG_WIDTH), 0.02),
        'sg_w': nrm((L, SG_GROUPS, SG_CHUNK, SG_CHUNK), SG_CHUNK ** -0.5),
        'sg_b': 1.0 + nrm((L, SG_GROUPS, SG_CHUNK), 0.02),
        'gate_w': nrm((L, D_MODEL, N_BRANCH * D_MODEL), D_MODEL ** -0.5),
        'gate_b': nrm((L, N_BRANCH * D_MODEL), 0.02),
        'w_br': nrm((L, MIX_WIDTH, D_MODEL), DA_WIDTH ** -0.5),
        'w_o': nrm((L, D_MODEL, D_MODEL), D_MODEL ** -0.5),
    }


def reference(x, c, ctx, c_ctx, ada_w, ada_b, norm_g, ffn_up, ffn_down, w_in, da_qk_gain, da_lambda, da_subln,
              hy_conv_w, hy_conv_b, hy_f_w1, hy_f_b1, hy_f_w2, hy_f_b2, hy_f_freq, hy_f_w3, hy_skip,
              sg_ln_g, sg_ln_b, sg_w, sg_b, gate_w, gate_b, w_br, w_o):
    cos, sin = axial_rope_tables(x.shape[1])
    s_lat = jax.nn.silu(c)
    s_ctx = jax.nn.silu(c_ctx)[None]
    xl, xc = x, ctx
    for l in range(DEPTH):
        last = l == DEPTH - 1
        mod_l = (s_lat @ ada_w[l] + ada_b[l]).reshape(-1, N_MOD, D_MODEL)
        mod_c = (s_ctx @ ada_w[l] + ada_b[l]).reshape(1, N_MOD, D_MODEL)

        xl = macaron_ffn(xl, mod_l, 0, norm_g[l, 0], ffn_up[l, 0], ffn_down[l, 0])
        xc = macaron_ffn(xc, mod_c, 0, norm_g[l, 0], ffn_up[l, 0], ffn_down[l, 0])

        hl = adaln_input(xl, mod_l, 1, norm_g[l, 1])
        hc = adaln_input(xc, mod_c, 1, norm_g[l, 1])
        pl = hl @ w_in[l]
        pc = hc @ w_in[l]
        filt_params = (hy_f_w1[l], hy_f_b1[l], hy_f_w2[l], hy_f_b2[l], hy_f_freq[l], hy_f_w3[l])
        ya_l, ya_c = diff_attention(pl, pc, cos, sin, da_qk_gain[l], da_lambda[l], da_subln[l], l, not last)
        yb_l = hyena_branch(pl[..., HY_OFF:SG_OFF], hy_conv_w[l], hy_conv_b[l], filt_params, hy_skip[l])
        yc_l = sgu_branch(pl[..., SG_OFF:], sg_ln_g[l], sg_ln_b[l], sg_w[l], sg_b[l])
        xl = xl + adaln_gate(mod_l, 1) * merge_branches(hl, ya_l, yb_l, yc_l, gate_w[l], gate_b[l], w_br[l], w_o[l])

        xl = macaron_ffn(xl, mod_l, 2, norm_g[l, 2], ffn_up[l, 1], ffn_down[l, 1])

        if not last:
            yb_c = hyena_branch(pc[..., HY_OFF:SG_OFF], hy_conv_w[l], hy_conv_b[l], filt_params, hy_skip[l])
            yc_c = sgu_branch(pc[..., SG_OFF:], sg_ln_g[l], sg_ln_b[l], sg_w[l], sg_b[l])
            xc = xc + adaln_gate(mod_c, 1) * merge_branches(hc, ya_c, yb_c, yc_c, gate_w[l], gate_b[l], w_br[l], w_o[l])
            xc = macaron_ffn(xc, mod_c, 2, norm_g[l, 2], ffn_up[l, 1], ffn_down[l, 1])
    return xl
```

```cpp
#include <hip/hip_runtime.h>
#include <hip/hip_cooperative_groups.h>
#include <cstdio>
namespace cg = cooperative_groups;

#define LAS __attribute__((address_space(3)))
typedef unsigned short bf16_t;
typedef short bf16x8 __attribute__((ext_vector_type(8)));
typedef float f32x2 __attribute__((ext_vector_type(2)));
typedef float f32x4 __attribute__((ext_vector_type(4)));
typedef float f32x16 __attribute__((ext_vector_type(16)));
typedef unsigned u32x2 __attribute__((ext_vector_type(2)));
typedef unsigned u32x4 __attribute__((ext_vector_type(4)));
typedef __bf16 bf16v2 __attribute__((ext_vector_type(2)));

constexpr int NT = 512;
#ifndef REP_ATT
#define REP_ATT 1
#endif
#ifndef REP_HY
#define REP_HY 1
#endif
#ifndef REP_AUX
#define REP_AUX 1
#endif
#ifndef REP_MISC
#define REP_MISC 1
#endif
#ifndef REP_PREP
#define REP_PREP 1
#endif
#ifndef REP_UP
#define REP_UP 1
#endif
#ifndef REP_DN
#define REP_DN 1
#endif
#ifndef REP_G3
#define REP_G3 1
#endif
#ifndef REP_P9
#define REP_P9 1
#endif
#ifndef REP_QK
#define REP_QK 1
#endif
#ifndef REP_NORM
#define REP_NORM 1
#endif
#ifndef REP_SGU
#define REP_SGU 1
#endif
constexpr int TL = 32768, TCX = 2048, TT = 34816, DM = 1024, FFH = 2816, SEQ = 4096, CTXL = 256, NK = 4352;
constexpr int LDS_BYTES = 147456;

constexpr size_t AL(size_t x) { return (x + 255) & ~(size_t)255; }
constexpr size_t O_WUP0 = 0;
constexpr size_t O_WUP1 = O_WUP0 + (size_t)5632 * 1024 * 2;
constexpr size_t O_WDN0 = O_WUP1 + (size_t)5632 * 1024 * 2;
constexpr size_t O_WDN1 = O_WDN0 + (size_t)1024 * 2816 * 2;
constexpr size_t O_WIN = O_WDN1 + (size_t)1024 * 2816 * 2;
constexpr size_t O_WG = O_WIN + (size_t)2816 * 1024 * 2;
constexpr size_t O_WBR = O_WG + (size_t)3072 * 1024 * 2;
constexpr size_t O_WO = O_WBR + (size_t)1024 * 1024 * 2;
constexpr size_t O_XC = O_WO + (size_t)1024 * 1024 * 2;
constexpr size_t O_MOD = O_XC + (size_t)TCX * 1024 * 4;
constexpr size_t O_L1P = O_MOD + AL((size_t)2 * 9 * 9216 * 4);
constexpr size_t O_L1PC = O_L1P + (size_t)256 * 1024 * 4;
constexpr size_t O_FILTC = O_L1PC + (size_t)16 * 1024 * 4;
constexpr size_t O_BAR = O_FILTC + (size_t)2 * 256 * 512 * 4;
constexpr size_t O_H = O_BAR + 16384;
constexpr size_t O_AR = O_H + (size_t)TT * 1024 * 2;
constexpr size_t O_GH = O_AR;
constexpr size_t O_VRAW = O_AR;
constexpr size_t O_HYRAW = O_VRAW + (size_t)TT * 512 * 2;
constexpr size_t O_SGRAW = O_HYRAW + (size_t)TT * 768 * 2;
constexpr size_t O_XALT = O_AR + (size_t)TT * 2816 * 2;
constexpr size_t O_PART = O_XALT;
constexpr size_t O_OC = O_AR;
constexpr size_t O_YBT = O_OC + (size_t)TT * 1024 * 2;
constexpr size_t O_YBTC = O_YBT + (size_t)8 * 256 * 4096 * 2;
static_assert(O_YBTC + (size_t)8 * 256 * 256 * 2 <= O_SGRAW, "OC/YBT must not touch SGRAW (read in the post phase)");
constexpr size_t O_G3 = O_AR;
constexpr size_t O_YCAT = O_G3 + (size_t)TT * 3072 * 2;
constexpr size_t O_MB = O_YCAT + (size_t)TT * 1024 * 2;
constexpr size_t SZ_B = (size_t)TT * 1024 * 4 + (size_t)8 * 256 * 4096 * 2 + (size_t)8 * 256 * 256 * 2;
constexpr size_t O_QN = O_AR + AL(SZ_B);
constexpr size_t O_KN = O_QN + (size_t)64 * NK * 64 * 2;
constexpr size_t O_VT = O_KN + (size_t)64 * NK * 64 * 2;
constexpr size_t O_HV = O_VT + (size_t)32 * 128 * NK * 2;
constexpr size_t O_HVC = O_HV + (size_t)8 * 768 * 4096 * 2;
constexpr size_t O_FH = O_HVC + (size_t)8 * 768 * 256 * 2;
constexpr size_t O_FILT = O_HV;
constexpr size_t SZ_C1 = (size_t)8 * 768 * 4096 * 2 + (size_t)8 * 768 * 256 * 2 + (size_t)2 * 256 * 8192 * 8;
constexpr size_t END1 = O_HV + SZ_C1, END2 = O_MB + (size_t)TT * 1024 * 2;
static_assert(O_YCAT >= O_SGRAW + (size_t)TT * 512 * 2, "YCAT is written while OC/YBT/SGRAW are read");
constexpr size_t WS_NEED = AL(END1 > END2 ? END1 : END2);
static_assert(O_GH + (size_t)TT * 2816 * 2 <= O_HV, "Gh must stay inside regions B'+A");
static_assert(O_XALT + (size_t)TL * 1024 * 2 <= O_MB, "X_alt is written while MB is read");
static_assert(O_PART + (size_t)4 * 2048 * 1024 * 4 <= O_HV, "partials must not touch FILT/FH");
static_assert(O_SGRAW + (size_t)TT * 512 * 2 <= O_QN, "raws fit region B'");

struct Params {
    const float *x, *c, *ctx, *c_ctx, *ada_w, *ada_b, *norm_g, *ffn_up, *ffn_down, *w_in, *qk_gain, *da_lambda, *da_subln,
        *hy_conv_w, *hy_conv_b, *hy_w1, *hy_b1, *hy_w2, *hy_b2, *hy_freq, *hy_w3, *hy_skip, *sg_ln_g, *sg_ln_b, *sg_w, *sg_b,
        *gate_w, *gate_b, *w_br, *w_o;
    float* out;
    unsigned char* ws;
};


__device__ __forceinline__ int TID() { int t = threadIdx.x; asm volatile("" : "+v"(t)); return t; }
constexpr int POFF = 147456 - 512;
__device__ __forceinline__ const float* ldp(const unsigned char* smem, int idx) {
    const volatile unsigned* w = (const volatile unsigned*)(smem + POFF + idx * 8);
    const unsigned lo = __builtin_amdgcn_readfirstlane(w[0]), hi = __builtin_amdgcn_readfirstlane(w[1]);
    typedef __attribute__((address_space(1))) const float* gptr_t;
    return (const float*)(gptr_t)(((unsigned long long)hi << 32) | lo);
}
__device__ __forceinline__ Params opq(const unsigned char* smem) {
    Params q;
    q.x = ldp(smem, 0); q.c = ldp(smem, 1); q.ctx = ldp(smem, 2); q.c_ctx = ldp(smem, 3); q.ada_w = ldp(smem, 4); q.ada_b = ldp(smem, 5); q.norm_g = ldp(smem, 6);
    q.ffn_up = ldp(smem, 7); q.ffn_down = ldp(smem, 8); q.w_in = ldp(smem, 9); q.qk_gain = ldp(smem, 10); q.da_lambda = ldp(smem, 11); q.da_subln = ldp(smem, 12);
    q.hy_conv_w = ldp(smem, 13); q.hy_conv_b = ldp(smem, 14); q.hy_w1 = ldp(smem, 15); q.hy_b1 = ldp(smem, 16); q.hy_w2 = ldp(smem, 17); q.hy_b2 = ldp(smem, 18);
    q.hy_freq = ldp(smem, 19); q.hy_w3 = ldp(smem, 20); q.hy_skip = ldp(smem, 21); q.sg_ln_g = ldp(smem, 22); q.sg_ln_b = ldp(smem, 23); q.sg_w = ldp(smem, 24);
    q.sg_b = ldp(smem, 25); q.gate_w = ldp(smem, 26); q.gate_b = ldp(smem, 27); q.w_br = ldp(smem, 28); q.w_o = ldp(smem, 29);
    q.out = (float*)ldp(smem, 30); q.ws = (unsigned char*)ldp(smem, 31);
    return q;
}


#define XB_TMO      128
#define XB_XCNT(j)  (256  + 64 * (j))
#define XB_XSUB(j)  (1280 + 64 * (j))
#define XB_XGEN(j)  (2304 + 64 * (j))
#define XB_TOP      3328
#define XB_TOPGEN   3392
#define XCD_BAR_WORDS 3456
#define XB_SPIN_CAP (1u << 22)
__device__ __forceinline__ unsigned xb_ld(unsigned* p)              { return __hip_atomic_load(p, __ATOMIC_RELAXED, __HIP_MEMORY_SCOPE_AGENT); }
__device__ __forceinline__ unsigned xb_add(unsigned* p, unsigned v) { return __hip_atomic_fetch_add(p, v, __ATOMIC_RELAXED, __HIP_MEMORY_SCOPE_AGENT); }
__device__ __forceinline__ unsigned xb_xcc_id() { return (unsigned)__builtin_amdgcn_s_getreg((3 << 11) | 20) & 0xFu; }
#define XB_SPIN(cond, bar) do { unsigned _sp = 0; while (cond) { __builtin_amdgcn_s_sleep(1); \
    if ((++_sp & 255u) == 0u) { if (xb_ld(&(bar)[XB_TMO])) break; if (_sp > XB_SPIN_CAP) { atomicAdd(&(bar)[XB_TMO], 1u); break; } } } } while (0)
__device__ __forceinline__ void xcd_barrier_complete(unsigned* bar, unsigned x, unsigned& nloc, unsigned& nx) {
    const unsigned G = gridDim.x * gridDim.y * gridDim.z;
    unsigned sum, cnt, mine, sp = 0u;
    for (;;) {
        sum = 0u; cnt = 0u; mine = 0u;
#pragma unroll
        for (unsigned j = 0; j < 16; ++j) { const unsigned c = xb_ld(&bar[XB_XCNT(j)]); sum += c; cnt += (c > 0u) ? 1u : 0u; mine = (j == x) ? c : mine; }
        if (sum == G) break;
        __builtin_amdgcn_s_sleep(1);
        if ((++sp & 255u) == 0u) { if (xb_ld(&bar[XB_TMO])) break; if (sp > XB_SPIN_CAP) { atomicAdd(&bar[XB_TMO], 1u); break; } }
    }
    nloc = mine > 0u ? mine : 1u; nx = cnt > 0u ? cnt : 1u;
}
__device__ __forceinline__ void gsync(unsigned char* smem) {
    asm volatile("s_waitcnt vmcnt(0)" ::: "memory");
    __syncthreads();
    if (threadIdx.x == 0) {
        unsigned* bar = (unsigned*)((unsigned char*)ldp(smem, 31) + O_BAR);
        volatile unsigned* st = (volatile unsigned*)(smem + POFF + 256);
        const unsigned x = xb_xcc_id();
        __builtin_amdgcn_s_waitcnt(0);
        unsigned nloc = st[0], nx = st[1];
        if (nloc == 0u) { xcd_barrier_complete(bar, x, nloc, nx); st[0] = nloc; st[1] = nx; }
        const unsigned old = xb_add(&bar[XB_XSUB(x)], 1u);
        const unsigned gen = old / nloc;
        if (old + 1u == (gen + 1u) * nloc) {
            __builtin_amdgcn_fence(__ATOMIC_RELEASE, "agent");
            asm volatile("s_waitcnt vmcnt(0)" ::: "memory");
            const unsigned og = xb_add(&bar[XB_TOP], 1u);
            const unsigned tg = og / nx;
            if (og + 1u == (tg + 1u) * nx) xb_add(&bar[XB_TOPGEN], 1u);
            else XB_SPIN(xb_ld(&bar[XB_TOPGEN]) == tg, bar);
            __builtin_amdgcn_fence(__ATOMIC_ACQUIRE, "agent");
            xb_add(&bar[XB_XGEN(x)], 1u);
            asm volatile("s_waitcnt vmcnt(0)" ::: "memory");
        } else {
            XB_SPIN(xb_ld(&bar[XB_XGEN(x)]) == gen, bar);
            __builtin_amdgcn_fence(__ATOMIC_ACQUIRE, "agent");
            asm volatile("s_waitcnt vmcnt(0)" ::: "memory");
        }
    }
    __syncthreads();
}

__device__ __forceinline__ unsigned pk2(float a, float b) { f32x2 v = {a, b}; bf16v2 r = __builtin_convertvector(v, bf16v2); return __builtin_bit_cast(unsigned, r); }
__device__ __forceinline__ bf16_t f2bf(float a) { return (bf16_t)(pk2(a, 0.f) & 0xffffu); }
__device__ __forceinline__ float bf2f(bf16_t h) { return __uint_as_float((unsigned)h << 16); }
__device__ __forceinline__ float bflo(unsigned w) { return __uint_as_float(w << 16); }
__device__ __forceinline__ float bfhi(unsigned w) { return __uint_as_float(w & 0xffff0000u); }
__device__ __forceinline__ void row_bk(int r, int& b, int& kidx) { if (r < TL) { b = r >> 12; kidx = 256 + (r & 4095); } else { const int rc = r - TL; b = rc >> 8; kidx = rc & 255; } }
__device__ __forceinline__ float wave_sum(float v) {
#pragma unroll
    for (int o = 32; o > 0; o >>= 1) v += __shfl_xor(v, o);
    return v;
}
__device__ __forceinline__ float sigmoidf_(float v) { return __builtin_amdgcn_rcpf(1.0f + __builtin_amdgcn_exp2f(v * -1.4426950408889634f)); }

namespace pg8 {
constexpr int BM = 256, BK = 64, HALF = 128, HTB = HALF * BK * 2, STAGE_BYTES = 8 * HTB, NXCD = 8, WGM = 8;
__device__ __forceinline__ int lds_byte(int r, int c) { const int st = (r >> 4) * 2 + (c >> 5), rr = r & 15, cc = c & 31, ob = rr * 64 + cc * 2; return st * 1024 + (ob ^ (((ob >> 9) & 1) << 5)); }
__device__ __forceinline__ void stage_rc(int b, int& R, int& C) { const int st = b / 1024, sb = b % 1024, swz = sb ^ (((sb >> 9) & 1) << 5); R = (st >> 1) * 16 + swz / 64; C = (st & 1) * 32 + (swz % 64) / 2; }
__device__ __forceinline__ int perm32(int rho) { const int n = rho >> 4, i = rho & 15; return 8 * (i >> 2) + 4 * n + (i & 3); }
struct Unit { int pm, pn, k0, nt, split; };
struct Gemm { const bf16_t* A; const bf16_t* Bt; int M, N, K; };
struct StaticOrder {
    int nM, nN, nwg, G, c, ntk, ntail;
    __device__ void init(int M, int N, int K, int G_, int c_, bool split_tail) {
        nM = M / BM; nN = N / BM; G = G_; c = c_; ntk = K / BK; ntail = 0;
        if (split_tail) { nM -= 8; ntail = 128; }
        nwg = nM * nN;
    }
    __device__ __forceinline__ bool next(int i, Unit& u) const {
        const long L = (long)i * G + c; if (L >= nwg + ntail) return false;
        int pm, pn, k0 = 0, nt = ntk, split = 0;
        if (L >= nwg) {
            const int j = (int)L - nwg, cu = j >> 2, part = j & 3;
            pm = nM + (cu >> 2); pn = cu & 3; split = 1 + part;
            const int q = (ntk / 4) & ~1, big = (ntk - 4 * q) / 2;
            nt = q + ((part < big) ? 2 : 0);
            k0 = part * q + 2 * (part < big ? part : big);
        } else {
            int wgid = (int)L; { const int q = nwg / NXCD, r = nwg % NXCD, xcd = wgid % NXCD, off = wgid / NXCD; wgid = (xcd < r ? xcd * (q + 1) : r * (q + 1) + (xcd - r) * q) + off; }
            const int nig = WGM * nN, gid = wgid / nig, fm = gid * WGM, gsz = (nM - fm) < WGM ? (nM - fm) : WGM;
            pm = fm + ((wgid % nig) % gsz); pn = (wgid % nig) / gsz;
        }
        u.pm = pm; u.pn = pn; u.k0 = k0; u.nt = nt; u.split = split;
        return true;
    }
};

template <class Epi>
__device__ __forceinline__ void gemm_phase(LAS unsigned char* lds, const Gemm g, const StaticOrder& S, const Epi& E) {
    const int tid = TID(), wid = __builtin_amdgcn_readfirstlane(tid >> 6), lane = tid & 63, wr = wid >> 2, wc = wid & 3, fr = lane & 15, fq = lane >> 4;
    const int K = g.K;
    unsigned voffA[2], voffB[2];
#pragma unroll
    for (int i = 0; i < 2; ++i) { int R, C; stage_rc(tid * 16 + i * 8192, R, C); const int Rb = Epi::PERM ? ((R & ~31) + perm32(R & 31)) : R;
        voffA[i] = (unsigned)(R * K + C) * 2u; voffB[i] = (unsigned)(Rb * K + C) * 2u; }
    const size_t kstep = (size_t)(BK * 2);
    const size_t hstep = (size_t)HALF * K * 2;
    const size_t tstep = 2 * hstep;
    const unsigned ldsw = (unsigned)wid * 1024u;
    const int aoff = lds_byte(wr * 64 + fr, fq * 8), boff = lds_byte(wc * 32 + fr, fq * 8);
#define PG8_SA(b, h) (((b) * 2 + (h)) * HTB)
#define PG8_SB(b, h) ((4 + (b) * 2 + (h)) * HTB)
#define PG8_STAGE(bufoff, gbase, voff) do { _Pragma("unroll") for (int _i = 0; _i < 2; ++_i) \
        __builtin_amdgcn_global_load_lds((const unsigned*)((const char*)(gbase) + (voff)[_i]), (LAS unsigned*)(lds + (bufoff) + ldsw + _i * 8192), 16, 0, 0); } while (0)
#define PG8_LDA(dst, b, h) do { _Pragma("unroll") for (int m = 0; m < 4; ++m) _Pragma("unroll") for (int k = 0; k < 2; ++k) dst[m][k] = *(const LAS bf16x8*)(lds + PG8_SA(b, h) + aoff + m * 2048 + k * 1024); } while (0)
#define PG8_LDB(dst, b, h) do { _Pragma("unroll") for (int n = 0; n < 2; ++n) _Pragma("unroll") for (int k = 0; k < 2; ++k) dst[n][k] = *(const LAS bf16x8*)(lds + PG8_SB(b, h) + boff + n * 2048 + k * 1024); } while (0)
#define PG8_MMA(ai, bj, At, Bt) do { __builtin_amdgcn_s_setprio(1); _Pragma("unroll") for (int m = 0; m < 4; ++m) _Pragma("unroll") for (int n = 0; n < 2; ++n) _Pragma("unroll") for (int k = 0; k < 2; ++k) \
        acc[ai][bj][m][n] = __builtin_amdgcn_mfma_f32_16x16x32_bf16(Bt[n][k], At[m][k], acc[ai][bj][m][n], 0, 0, 0); __builtin_amdgcn_s_setprio(0); } while (0)
#define PG8_WAIT_V(n) asm volatile("s_waitcnt vmcnt(" #n ")" ::: "memory")
#define PG8_WAIT_L(n) asm volatile("s_waitcnt lgkmcnt(" #n ")" ::: "memory")
#define PG8_BAR __builtin_amdgcn_s_barrier()
#define PG8_SCHED __builtin_amdgcn_sched_barrier(0)
    Unit cur, nxt; int ui = 0;
    if (!S.next(0, cur)) return;
    f32x4 acc[2][2][4][2];
#pragma unroll
    for (int a = 0; a < 2; ++a)
#pragma unroll
        for (int b = 0; b < 2; ++b)
#pragma unroll
            for (int m = 0; m < 4; ++m)
#pragma unroll
                for (int n = 0; n < 2; ++n) acc[a][b][m][n] = (f32x4){0.f, 0.f, 0.f, 0.f};
    bf16x8 At[4][2], B0[2][2], B1[2][2];
    const char* cA = (const char*)g.A + (size_t)cur.pm * tstep + (size_t)cur.k0 * kstep; const char* cB = (const char*)g.Bt + (size_t)cur.pn * tstep + (size_t)cur.k0 * kstep;
    PG8_STAGE(PG8_SB(0, 0), cB, voffB); PG8_STAGE(PG8_SA(0, 0), cA, voffA); PG8_STAGE(PG8_SB(0, 1), cB + hstep, voffB); PG8_STAGE(PG8_SA(0, 1), cA + hstep, voffA);
    if (wr == 1) PG8_BAR;
    PG8_WAIT_V(4); PG8_BAR;
    PG8_STAGE(PG8_SB(1, 0), cB + kstep, voffB); PG8_STAGE(PG8_SA(1, 0), cA + kstep, voffA); PG8_STAGE(PG8_SB(1, 1), cB + hstep + kstep, voffB);
    PG8_WAIT_V(6); PG8_BAR;
    for (;;) {
        const bool has_next = S.next(ui + 1, nxt);
        const char* nA = has_next ? (const char*)g.A + (size_t)nxt.pm * tstep + (size_t)nxt.k0 * kstep : cA; const char* nB = has_next ? (const char*)g.Bt + (size_t)nxt.pn * tstep + (size_t)nxt.k0 * kstep : cB;
        const int nt = cur.nt;
        for (int t = 0; t < nt; t += 2) {
            const bool last = (t == nt - 2);
            const char* a1 = cA + (size_t)(t + 1) * kstep;
            const char* a2 = last ? nA : cA + (size_t)(t + 2) * kstep; const char* b2 = last ? nB : cB + (size_t)(t + 2) * kstep;
            const char* a3 = a2 + kstep; const char* b3 = b2 + kstep;
            if constexpr (Epi::RESCALE) { if (t == 8 || t == 12) E.rescale(acc, cur, t == 8 ? 0 : 1, wr, wc, fr, fq); }
            PG8_LDB(B0, 0, 0); PG8_SCHED; PG8_LDA(At, 0, 0); PG8_STAGE(PG8_SA(1, 1), a1 + hstep, voffA);
            PG8_WAIT_L(8); PG8_BAR; PG8_WAIT_L(0); PG8_MMA(0, 0, At, B0); PG8_BAR; PG8_SCHED;
            PG8_LDB(B1, 0, 1); PG8_STAGE(PG8_SB(0, 0), b2, voffB);
            PG8_BAR; PG8_WAIT_L(0); PG8_MMA(0, 1, At, B1); PG8_BAR;
            PG8_LDA(At, 0, 1); PG8_STAGE(PG8_SA(0, 0), a2, voffA);
            PG8_BAR; PG8_WAIT_L(0); PG8_MMA(1, 0, At, B0); PG8_BAR; PG8_SCHED;
            PG8_STAGE(PG8_SB(0, 1), b2 + hstep, voffB);
            PG8_WAIT_V(6); PG8_BAR; PG8_MMA(1, 1, At, B1); PG8_BAR;
            PG8_LDB(B0, 1, 0); PG8_SCHED; PG8_LDA(At, 1, 0); PG8_STAGE(PG8_SA(0, 1), a2 + hstep, voffA);
            PG8_WAIT_L(8); PG8_BAR; PG8_WAIT_L(0); PG8_MMA(0, 0, At, B0); PG8_BAR; PG8_SCHED;
            PG8_LDB(B1, 1, 1); PG8_STAGE(PG8_SB(1, 0), b3, voffB);
            PG8_BAR; PG8_WAIT_L(0); PG8_MMA(0, 1, At, B1); PG8_BAR;
            PG8_LDA(At, 1, 1); PG8_STAGE(PG8_SA(1, 0), a3, voffA);
            PG8_BAR; PG8_WAIT_L(0); PG8_MMA(1, 0, At, B0); PG8_BAR; PG8_SCHED;
            PG8_STAGE(PG8_SB(1, 1), b3 + hstep, voffB);
            PG8_WAIT_V(6); PG8_BAR; PG8_MMA(1, 1, At, B1); PG8_BAR;
        }
        E(acc, cur, wr, wc, fr, fq);
        if (!has_next) break;
#pragma unroll
        for (int a = 0; a < 2; ++a)
#pragma unroll
            for (int b = 0; b < 2; ++b)
#pragma unroll
                for (int m = 0; m < 4; ++m)
#pragma unroll
                    for (int n = 0; n < 2; ++n) acc[a][b][m][n] = (f32x4){0.f, 0.f, 0.f, 0.f};
        cur = nxt; cA = nA; cB = nB; ++ui;
    }
    PG8_WAIT_V(0);
    if (wr == 0) PG8_BAR;
    PG8_BAR;
#undef PG8_SA
#undef PG8_SB
#undef PG8_STAGE
#undef PG8_LDA
#undef PG8_LDB
#undef PG8_MMA
#undef PG8_WAIT_V
#undef PG8_WAIT_L
#undef PG8_BAR
#undef PG8_SCHED
}
}
using pg8::Unit;
typedef f32x4 AccT[2][2][4][2];

struct EpiSwiglu {
    static constexpr bool PERM = true, RESCALE = false;
    bf16_t* G;
    __device__ __forceinline__ void operator()(const AccT& acc, const Unit& u, int wr, int wc, int fr, int fq) const {
        const int row0 = u.pm * 256 + wr * 64 + fr, col0 = u.pn * 128 + wc * 32 + 8 * fq;
#pragma unroll
        for (int ai = 0; ai < 2; ++ai)
#pragma unroll
            for (int m = 0; m < 4; ++m) {
                float gv[8];
#pragma unroll
                for (int n = 0; n < 2; ++n)
#pragma unroll
                    for (int j = 0; j < 4; ++j) { const float a = acc[ai][0][m][n][j], b = acc[ai][1][m][n][j]; gv[n * 4 + j] = a * b * __builtin_amdgcn_rcpf(1.0f + __builtin_amdgcn_exp2f(a * -1.4426950408889634f)); }
                u32x4 w; w.x = pk2(gv[0], gv[1]); w.y = pk2(gv[2], gv[3]); w.z = pk2(gv[4], gv[5]); w.w = pk2(gv[6], gv[7]);
                *(u32x4*)(G + (size_t)(row0 + ai * 128 + m * 16) * FFH + col0) = w;
            }
    }
};
struct EpiResid {
    static constexpr bool PERM = true, RESCALE = false;
    const bf16_t* xin; bf16_t* xout; float* fout; float* xc; float* part; const float* mod; int gofs; float coef;
    __device__ __forceinline__ void operator()(const AccT& acc, const Unit& u, int wr, int wc, int fr, int fq) const {
        const int row0 = u.pm * 256 + wr * 64 + fr, col0 = u.pn * 256 + wc * 32 + 8 * fq;
        const bool lat = u.pm < 128;
        const int mr = lat ? (u.pm >> 4) : 8;
        const float* gp = mod + (size_t)mr * 9216 + gofs + col0;
#pragma unroll
        for (int bj = 0; bj < 2; ++bj) {
            const f32x4 g0 = *(const f32x4*)(gp + bj * 128) * coef, g1 = *(const f32x4*)(gp + bj * 128 + 4) * coef;
            if (lat) {
                u32x4 xw[8];
#pragma unroll
                for (int am = 0; am < 8; ++am) xw[am] = *(const u32x4*)(xin + (size_t)(row0 + (am >> 2) * 128 + (am & 3) * 16) * 1024 + col0 + bj * 128);
#pragma unroll
                for (int am = 0; am < 8; ++am) {
                    const int ai = am >> 2, m = am & 3;
                    const size_t o = (size_t)(row0 + ai * 128 + m * 16) * 1024 + col0 + bj * 128;
                    f32x4 v0 = {bflo(xw[am].x), bfhi(xw[am].x), bflo(xw[am].y), bfhi(xw[am].y)}, v1 = {bflo(xw[am].z), bfhi(xw[am].z), bflo(xw[am].w), bfhi(xw[am].w)};
                    v0 += g0 * acc[ai][bj][m][0]; v1 += g1 * acc[ai][bj][m][1];
                    if (fout) { *(f32x4*)(fout + o) = v0; *(f32x4*)(fout + o + 4) = v1; }
                    else { u32x4 w; w.x = pk2(v0[0], v0[1]); w.y = pk2(v0[2], v0[3]); w.z = pk2(v1[0], v1[1]); w.w = pk2(v1[2], v1[3]); *(u32x4*)(xout + o) = w; }
                }
            } else {
#pragma unroll
                for (int am = 0; am < 8; ++am) {
                    const int ai = am >> 2, m = am & 3;
                    const size_t o = (size_t)(row0 + ai * 128 + m * 16 - TL) * 1024 + col0 + bj * 128;
                    const f32x4 d0 = g0 * acc[ai][bj][m][0], d1 = g1 * acc[ai][bj][m][1];
                    if (u.split) { float* pp = part + (size_t)(u.split - 1) * 2048 * 1024 + o; *(f32x4*)pp = d0; *(f32x4*)(pp + 4) = d1; }
                    else { float* xp = xc + o; *(f32x4*)xp = *(const f32x4*)xp + d0; *(f32x4*)(xp + 4) = *(const f32x4*)(xp + 4) + d1; }
                }
            }
        }
    }
};
struct EpiIn {
    static constexpr bool PERM = true, RESCALE = false;
    bf16_t *qn, *kn, *vraw, *hyraw, *sgraw;
    __device__ __forceinline__ void operator()(const AccT& acc, const Unit& u, int wr, int wc, int fr, int fq) const {
        const int row0 = u.pm * 256 + wr * 64 + fr, pn = u.pn;
#pragma unroll
        for (int ai = 0; ai < 2; ++ai)
#pragma unroll
            for (int m = 0; m < 4; ++m) {
                const int r = row0 + ai * 128 + m * 16;
#pragma unroll
                for (int bj = 0; bj < 2; ++bj) {
                    const f32x4 v0 = acc[ai][bj][m][0], v1 = acc[ai][bj][m][1];
                    u32x4 w; w.x = pk2(v0[0], v0[1]); w.y = pk2(v0[2], v0[3]); w.z = pk2(v1[0], v1[1]); w.w = pk2(v1[2], v1[3]);
                    const int cl = bj * 128 + wc * 32 + 8 * fq;
                    bf16_t* dst;
                    if (pn < 4) {
                        int b, kidx; row_bk(r, b, kidx);
                        const int cc = (pn & 1) * 256 + cl, head = cc >> 7, comp = (cc >> 6) & 1, d = cc & 63;
                        dst = (pn < 2 ? qn : kn) + ((size_t)((b * 4 + head) * 2 + comp) * NK + kidx) * 64 + d;
                    } else if (pn < 6) dst = vraw + (size_t)r * 512 + (pn - 4) * 256 + cl;
                    else if (pn < 9) dst = hyraw + (size_t)r * 768 + (pn - 6) * 256 + cl;
                    else dst = sgraw + (size_t)r * 512 + (pn - 9) * 256 + cl;
                    *(u32x4*)dst = w;
                }
            }
    }
};
struct EpiGate3 {
    static constexpr bool PERM = true, RESCALE = false;
    bf16_t* g3; const float* bias;
    __device__ __forceinline__ void operator()(const AccT& acc, const Unit& u, int wr, int wc, int fr, int fq) const {
        const int row0 = u.pm * 256 + wr * 64 + fr, col0 = u.pn * 256 + wc * 32 + 8 * fq;
#pragma unroll
        for (int bj = 0; bj < 2; ++bj) {
            const f32x4 b0 = *(const f32x4*)(bias + col0 + bj * 128), b1 = *(const f32x4*)(bias + col0 + bj * 128 + 4);
#pragma unroll
            for (int ai = 0; ai < 2; ++ai)
#pragma unroll
                for (int m = 0; m < 4; ++m) {
                    const f32x4 v0 = acc[ai][bj][m][0] + b0, v1 = acc[ai][bj][m][1] + b1;
                    float gv[8];
#pragma unroll
                    for (int j = 0; j < 4; ++j) { gv[j] = fmaxf(sigmoidf_(v0[j]), 1e-5f); gv[4 + j] = fmaxf(sigmoidf_(v1[j]), 1e-5f); }
                    u32x4 w; w.x = pk2(gv[0], gv[1]); w.y = pk2(gv[2], gv[3]); w.z = pk2(gv[4], gv[5]); w.w = pk2(gv[6], gv[7]);
                    *(u32x4*)(g3 + (size_t)(row0 + ai * 128 + m * 16) * 3072 + col0 + bj * 128) = w;
                }
        }
    }
};
struct EpiMergeR {
    static constexpr bool PERM = true, RESCALE = true;
    const bf16_t* g3; bf16_t* mb;
    __device__ __forceinline__ void rescale(AccT& acc, const Unit& u, int which, int wr, int wc, int fr, int fq) const {
        const int row0 = u.pm * 256 + wr * 64 + fr, col0 = u.pn * 256 + wc * 32 + 8 * fq;
        const bf16_t* gb = g3 + (size_t)row0 * 3072 + which * 1024 + col0;
#pragma unroll
        for (int ai = 0; ai < 2; ++ai)
#pragma unroll
            for (int mh = 0; mh < 2; ++mh) {
                u32x4 nw[2][2], dw[2][2];
#pragma unroll
                for (int mm = 0; mm < 2; ++mm)
#pragma unroll
                    for (int bj = 0; bj < 2; ++bj) { const bf16_t* gp = gb + (size_t)(ai * 128 + (mh * 2 + mm) * 16) * 3072 + bj * 128; nw[mm][bj] = *(const u32x4*)gp; dw[mm][bj] = *(const u32x4*)(gp + 1024); }
#pragma unroll
                for (int mm = 0; mm < 2; ++mm)
#pragma unroll
                    for (int bj = 0; bj < 2; ++bj) {
                        const u32x4 n4 = nw[mm][bj], d4 = dw[mm][bj];
                        const f32x4 r0 = {bflo(n4.x) * __builtin_amdgcn_rcpf(bflo(d4.x)), bfhi(n4.x) * __builtin_amdgcn_rcpf(bfhi(d4.x)), bflo(n4.y) * __builtin_amdgcn_rcpf(bflo(d4.y)), bfhi(n4.y) * __builtin_amdgcn_rcpf(bfhi(d4.y))};
                        const f32x4 r1 = {bflo(n4.z) * __builtin_amdgcn_rcpf(bflo(d4.z)), bfhi(n4.z) * __builtin_amdgcn_rcpf(bfhi(d4.z)), bflo(n4.w) * __builtin_amdgcn_rcpf(bflo(d4.w)), bfhi(n4.w) * __builtin_amdgcn_rcpf(bfhi(d4.w))};
                        acc[ai][bj][mh * 2 + mm][0] *= r0; acc[ai][bj][mh * 2 + mm][1] *= r1;
                    }
                __builtin_amdgcn_sched_barrier(0);
            }
    }
    __device__ __forceinline__ void operator()(const AccT& acc, const Unit& u, int wr, int wc, int fr, int fq) const {
        const int row0 = u.pm * 256 + wr * 64 + fr, col0 = u.pn * 256 + wc * 32 + 8 * fq;
#pragma unroll
        for (int bj = 0; bj < 2; ++bj) {
            u32x4 gw[8];
#pragma unroll
            for (int am = 0; am < 8; ++am) gw[am] = *(const u32x4*)(g3 + (size_t)(row0 + (am >> 2) * 128 + (am & 3) * 16) * 3072 + 2048 + col0 + bj * 128);
#pragma unroll
            for (int am = 0; am < 8; ++am) {
                const int ai = am >> 2, m = am & 3;
                const f32x4 v0 = acc[ai][bj][m][0], v1 = acc[ai][bj][m][1];
                u32x4 w; w.x = pk2(v0[0] * bflo(gw[am].x), v0[1] * bfhi(gw[am].x)); w.y = pk2(v0[2] * bflo(gw[am].y), v0[3] * bfhi(gw[am].y));
                w.z = pk2(v1[0] * bflo(gw[am].z), v1[1] * bfhi(gw[am].z)); w.w = pk2(v1[2] * bflo(gw[am].w), v1[3] * bfhi(gw[am].w));
                *(u32x4*)(mb + (size_t)(row0 + ai * 128 + m * 16) * 1024 + col0 + bj * 128) = w;
            }
        }
    }
};

template <class Epi>
__device__ __forceinline__ void run_gemm(unsigned char* smem, const bf16_t* A, const bf16_t* Bt, int M, int N, int K, const Epi& E, bool split_tail = false) {
    asm volatile("" : "+s"(M), "+s"(N), "+s"(K));
    pg8::Gemm g; g.A = A; g.Bt = Bt; g.M = M; g.N = N; g.K = K;
    pg8::StaticOrder S; S.init(M, N, K, gridDim.x, blockIdx.x, split_tail);
    pg8::gemm_phase<Epi>((LAS unsigned char*)smem, g, S, E);
}

__device__ __forceinline__ void mod_item(const Params& p, unsigned char* smem, int m) {
    float* s = (float*)smem;
    float* red = s + 9 * 1024;
    const int tid = TID(), l = m / 144, cb = m % 144;
    __syncthreads();
    for (int i = tid; i < 9216; i += NT) { const float v = (i < 8192) ? p.c[i] : p.c_ctx[i - 8192]; s[i] = v / (1.0f + __expf(-v)); }
    __syncthreads();
    const int kg = tid >> 6, cn = tid & 63, col = cb * 64 + cn;
    const float* w = p.ada_w + (size_t)l * 1024 * 9216 + col;
    float a0 = 0, a1 = 0, a2 = 0, a3 = 0, a4 = 0, a5 = 0, a6 = 0, a7 = 0, a8 = 0;
    for (int k = kg * 128; k < kg * 128 + 128; ++k) {
        const float wv = w[(size_t)k * 9216];
        a0 += s[k] * wv; a1 += s[1024 + k] * wv; a2 += s[2048 + k] * wv; a3 += s[3072 + k] * wv; a4 += s[4096 + k] * wv;
        a5 += s[5120 + k] * wv; a6 += s[6144 + k] * wv; a7 += s[7168 + k] * wv; a8 += s[8192 + k] * wv;
    }
    float* rp = red + kg * 576 + cn;
    rp[0] = a0; rp[64] = a1; rp[128] = a2; rp[192] = a3; rp[256] = a4; rp[320] = a5; rp[384] = a6; rp[448] = a7; rp[512] = a8;
    __syncthreads();
    float* MOD = (float*)(p.ws + O_MOD);
    for (int i = tid; i < 576; i += NT) {
        float v = 0; for (int q = 0; q < 8; ++q) v += red[q * 576 + i];
        const int r = i >> 6, c2 = cb * 64 + (i & 63);
        MOD[((size_t)l * 9 + r) * 9216 + c2] = v + p.ada_b[(size_t)l * 9216 + c2];
    }
}

__device__ __forceinline__ void filt_item(const Params& p, unsigned char* smem, int l, int n, int item, float* filt, float* l1p) {
    float* z = (float*)smem;
    float* h1 = z + 16 * 36;
    float* h2 = h1 + 16 * 64;
    const int tid = TID(), t0 = item * 16;
    __syncthreads();
    for (int i = tid; i < 16 * 33; i += NT) {
        const int tt = i / 33, e = i % 33, t = t0 + tt; float v;
        if (e == 0) v = (float)t / (float)(n - 1);
        else { const int bi = (e - 1) & 15; const float band = 1e-4f + (float)bi * ((15.0f - 1e-4f) / 15.0f); const float wv = (6.283185307179586f / (float)n) * (float)t;
            v = (e <= 16) ? cosf(band * wv) : -sinf(band * wv); }
        z[tt * 36 + e] = v;
    }
    __syncthreads();
    for (int i = tid; i < 16 * 64; i += NT) {
        const int tt = i >> 6, j = i & 63; float a = p.hy_b1[l * 64 + j];
        for (int e = 0; e < 33; ++e) a += z[tt * 36 + e] * p.hy_w1[((size_t)l * 33 + e) * 64 + j];
        h1[i] = sinf(p.hy_freq[l * 64 + j] * a);
    }
    __syncthreads();
    for (int i = tid; i < 16 * 64; i += NT) {
        const int tt = i >> 6, j = i & 63; float a = p.hy_b2[l * 64 + j];
        for (int e = 0; e < 64; ++e) a += h1[tt * 64 + e] * p.hy_w2[((size_t)l * 64 + e) * 64 + j];
        h2[i] = sinf(p.hy_freq[l * 64 + j] * a);
    }
    __syncthreads();
    const float min_decay = -3.0701134573253945f, max_decay = -15.350567286626973f;
#pragma unroll 1
    for (int cc = 0; cc < 2; ++cc) {
        const int col = tid + cc * 512;
        float acc[16];
#pragma unroll
        for (int tt = 0; tt < 16; ++tt) acc[tt] = 0.f;
        for (int e = 0; e < 64; ++e) {
            const float wv = p.hy_w3[((size_t)l * 64 + e) * 1024 + col];
#pragma unroll
            for (int tt = 0; tt < 16; ++tt) acc[tt] += h2[tt * 64 + e] * wv;
        }
        const int dir = col >> 9, oc = col & 511;
        const float ad = fabsf(min_decay + (float)oc * ((max_decay - min_decay) / 511.0f));
        float* dst = filt + (size_t)oc * (2 * n);
        float l1 = 0.f;
#pragma unroll
        for (int tt = 0; tt < 16; ++tt) {
            const int t = t0 + tt; const float tn = (float)t / (float)(n - 1);
            float v = acc[tt] * __expf(-tn * ad);
            if (dir == 0) dst[t] = v;
            else if (t == 0) { dst[n] = 0.f; v = 0.f; }
            else dst[2 * n - t] = v;
            l1 += fabsf(v);
        }
        l1p[(size_t)item * 1024 + col] = l1;
    }
}

struct WDesc { const float* src; bf16_t* dst; int ld, K; };
__device__ __forceinline__ WDesc wdesc(const Params& p, int l, int ti) {
    WDesc d; int K, nrb, mapsw = 0; const float* src; bf16_t* dst; int ld;
    const size_t L = (size_t)l;
    if (ti < 1408) { src = p.ffn_up + (L * 2 + 0) * 1024 * 5632; ld = 5632; K = 1024; dst = (bf16_t*)(p.ws + O_WUP0); mapsw = 1; }
    else if ((ti -= 1408) < 1408) { src = p.ffn_up + (L * 2 + 1) * 1024 * 5632; ld = 5632; K = 1024; dst = (bf16_t*)(p.ws + O_WUP1); mapsw = 1; }
    else if ((ti -= 1408) < 704) { src = p.ffn_down + (L * 2 + 0) * 2816 * 1024; ld = 1024; K = 2816; dst = (bf16_t*)(p.ws + O_WDN0); }
    else if ((ti -= 704) < 704) { src = p.ffn_down + (L * 2 + 1) * 2816 * 1024; ld = 1024; K = 2816; dst = (bf16_t*)(p.ws + O_WDN1); }
    else if ((ti -= 704) < 704) { src = p.w_in + L * 1024 * 2816; ld = 2816; K = 1024; dst = (bf16_t*)(p.ws + O_WIN); }
    else if ((ti -= 704) < 768) { src = p.gate_w + L * 1024 * 3072; ld = 3072; K = 1024; dst = (bf16_t*)(p.ws + O_WG); }
    else if ((ti -= 768) < 256) { src = p.w_br + L * 1024 * 1024; ld = 1024; K = 1024; dst = (bf16_t*)(p.ws + O_WBR); }
    else { ti -= 256; src = p.w_o + L * 1024 * 1024; ld = 1024; K = 1024; dst = (bf16_t*)(p.ws + O_WO); }
    nrb = K / 64;
    const int nb = ti / nrb, kb = ti % nrb, n0 = nb * 64, k0 = kb * 64;
    int scol = n0;
    if (mapsw) { const int pn = n0 >> 8, half = (n0 >> 7) & 1; scol = half * 2816 + pn * 128 + (n0 & 127); }
    d.src = src + (size_t)k0 * ld + scol; d.dst = dst + (size_t)n0 * K + k0; d.ld = ld; d.K = K;
    return d;
}
__device__ __forceinline__ void wconv_tiles(const Params& p, unsigned char* smem, int l, int nw) {
    float* tile = (float*)smem;
    const int tid = TID(), kk0 = tid >> 6, nn0 = tid & 63, nn = tid >> 3, ks = tid & 7;
    int ti = blockIdx.x;
    if (ti >= nw) return;
    WDesc d = wdesc(p, l, ti);
    float v[8];
#pragma unroll
    for (int i = 0; i < 8; ++i) v[i] = d.src[(size_t)(kk0 + 8 * i) * d.ld + nn0];
    for (;;) {
        const int tn = ti + gridDim.x; const bool more = tn < nw;
        WDesc dn = d; float vn[8];
        if (more) { dn = wdesc(p, l, tn);
#pragma unroll
            for (int i = 0; i < 8; ++i) vn[i] = dn.src[(size_t)(kk0 + 8 * i) * dn.ld + nn0]; }
        __syncthreads();
#pragma unroll
        for (int i = 0; i < 8; ++i) tile[(kk0 + 8 * i) * 65 + nn0] = v[i];
        __syncthreads();
        float o[8];
#pragma unroll
        for (int j = 0; j < 8; ++j) o[j] = tile[(ks * 8 + j) * 65 + nn];
        u32x4 w; w.x = pk2(o[0], o[1]); w.y = pk2(o[2], o[3]); w.z = pk2(o[4], o[5]); w.w = pk2(o[6], o[7]);
        *(u32x4*)(d.dst + (size_t)nn * d.K + ks * 8) = w;
        if (!more) break;
        d = dn; ti = tn;
#pragma unroll
        for (int i = 0; i < 8; ++i) v[i] = vn[i];
    }
}

__device__ __forceinline__ void aux_phase(const Params& p, unsigned char* smem, int l) {
    const int nmod = (l == 0) ? 288 : 0, nf = 256, nfc = (l == 0) ? 16 : 0, nw = 6208;
    const int total = nmod + nf + nfc;
    for (int rep = 0; rep < REP_AUX; ++rep) {
        for (int it = blockIdx.x; it < total; it += gridDim.x) {
            int i = it;
            if (i < nmod) { mod_item(p, smem, i); continue; }
            i -= nmod;
            if (i < nf) { filt_item(p, smem, l, 4096, i, (float*)(p.ws + O_FILT), (float*)(p.ws + O_L1P)); continue; }
            i -= nf;
            filt_item(p, smem, l, 256, i, (float*)(p.ws + O_FILTC), (float*)(p.ws + O_L1PC));
        }
        wconv_tiles(p, smem, l, nw);
    }
}

__device__ __forceinline__ void norm_phase(const Params& p, int l, int sub, int M, bool first, const bf16_t* xl) {
    const float* PART = (const float*)(p.ws + O_PART);
    const int tid = TID(), lane = tid & 63, wv = tid >> 6;
    const float* MOD = (const float*)(p.ws + O_MOD) + (size_t)l * 9 * 9216;
    const float* gn = p.norm_g + ((size_t)l * 3 + sub) * 1024;
    float* XC = (float*)(p.ws + O_XC);
    bf16_t* H = (bf16_t*)(p.ws + O_H);
    const int rstep = gridDim.x * 8;
    for (int rep = 0; rep < REP_NORM; ++rep)
    for (int r0 = blockIdx.x * 8 + wv; r0 < M; r0 += 4 * rstep) {
        f32x4 v[4][4]; float ss[4];
#pragma unroll
        for (int k = 0; k < 4; ++k) {
            const int r = r0 + k * rstep; ss[k] = 0.f;
            if (r >= M) { continue; }
            if (r >= TL) {
                const float* src = (first ? p.ctx : XC) + (size_t)(r - TL) * 1024;
#pragma unroll
                for (int i = 0; i < 4; ++i) { const size_t o = (size_t)(r - TL) * 1024 + i * 256 + lane * 4; v[k][i] = *(const f32x4*)(src + i * 256 + lane * 4);
                    if (!first) { v[k][i] += *(const f32x4*)(PART + o); v[k][i] += *(const f32x4*)(PART + 2048 * 1024 + o); v[k][i] += *(const f32x4*)(PART + 2 * 2048 * 1024 + o); v[k][i] += *(const f32x4*)(PART + 3 * 2048 * 1024 + o); } }
            } else if (first) {
                const float* src = p.x + (size_t)r * 1024;
#pragma unroll
                for (int i = 0; i < 4; ++i) v[k][i] = *(const f32x4*)(src + i * 256 + lane * 4);
            } else {
                const bf16_t* src = xl + (size_t)r * 1024;
#pragma unroll
                for (int i = 0; i < 4; ++i) { const u32x2 w = *(const u32x2*)(src + i * 256 + lane * 4); v[k][i] = (f32x4){bflo(w.x), bfhi(w.x), bflo(w.y), bfhi(w.y)}; }
            }
        }
#pragma unroll
        for (int k = 0; k < 4; ++k) {
            const int r = r0 + k * rstep;
            if (r >= M) continue;
            if (r >= TL) {
#pragma unroll
                for (int i = 0; i < 4; ++i) *(f32x4*)(XC + (size_t)(r - TL) * 1024 + i * 256 + lane * 4) = v[k][i];
            } else if (first) {
                bf16_t* dstx = (bf16_t*)p.out + (size_t)r * 1024;
#pragma unroll
                for (int i = 0; i < 4; ++i) { u32x2 w; w.x = pk2(v[k][i][0], v[k][i][1]); w.y = pk2(v[k][i][2], v[k][i][3]); *(u32x2*)(dstx + i * 256 + lane * 4) = w; v[k][i] = (f32x4){bflo(w.x), bfhi(w.x), bflo(w.y), bfhi(w.y)}; }
            }
            float s2 = 0.f;
#pragma unroll
            for (int i = 0; i < 4; ++i) s2 += v[k][i][0] * v[k][i][0] + v[k][i][1] * v[k][i][1] + v[k][i][2] * v[k][i][2] + v[k][i][3] * v[k][i][3];
            s2 = wave_sum(s2);
            const float rinv = rsqrtf(s2 * (1.0f / 1024.0f) + 1e-6f);
            const int mr = r < TL ? (r >> 12) : 8;
            const float* sh = MOD + (size_t)mr * 9216 + (3 * sub) * 1024;
            const float* sc = sh + 1024;
#pragma unroll
            for (int i = 0; i < 4; ++i) {
                const int c = i * 256 + lane * 4;
                const f32x4 g4 = *(const f32x4*)(gn + c), s4 = *(const f32x4*)(sc + c), h4 = *(const f32x4*)(sh + c);
                const f32x4 y = v[k][i] * rinv * g4 * (s4 + 1.0f) + h4;
                u32x2 w; w.x = pk2(y[0], y[1]); w.y = pk2(y[2], y[3]);
                *(u32x2*)(H + (size_t)r * 1024 + c) = w;
            }
        }
    }
}

#define ZI(i) ((i) + ((i) >> 4))
__device__ __forceinline__ f32x2 cmul(f32x2 a, f32x2 b) { return (f32x2){a.x * b.x - a.y * b.y, a.x * b.y + a.y * b.x}; }
__device__ __forceinline__ f32x2 cmulc(f32x2 a, f32x2 b) { return (f32x2){a.x * b.x + a.y * b.y, a.y * b.x - a.x * b.y}; }
__device__ __forceinline__ void dif8(f32x2 (&x)[8]) {
    const float C = 0.70710678118654752f;
    { f32x2 t;
      t = x[0] - x[4]; x[0] += x[4]; x[4] = t;
      t = x[1] - x[5]; x[1] += x[5]; x[5] = (f32x2){C * (t.x + t.y), C * (t.y - t.x)};
      t = x[2] - x[6]; x[2] += x[6]; x[6] = (f32x2){t.y, -t.x};
      t = x[3] - x[7]; x[3] += x[7]; x[7] = (f32x2){C * (t.y - t.x), -C * (t.x + t.y)}; }
#pragma unroll
    for (int b = 0; b < 8; b += 4) { f32x2 t;
      t = x[b] - x[b + 2]; x[b] += x[b + 2]; x[b + 2] = t;
      t = x[b + 1] - x[b + 3]; x[b + 1] += x[b + 3]; x[b + 3] = (f32x2){t.y, -t.x}; }
#pragma unroll
    for (int b = 0; b < 8; b += 2) { const f32x2 t = x[b] - x[b + 1]; x[b] += x[b + 1]; x[b + 1] = t; }
}
__device__ __forceinline__ void idif8(f32x2 (&x)[8]) {
    const float C = 0.70710678118654752f;
#pragma unroll
    for (int b = 0; b < 8; b += 2) { const f32x2 t = x[b] - x[b + 1]; x[b] += x[b + 1]; x[b + 1] = t; }
#pragma unroll
    for (int b = 0; b < 8; b += 4) { f32x2 v, u;
      v = x[b + 2]; u = x[b]; x[b] = u + v; x[b + 2] = u - v;
      v = (f32x2){-x[b + 3].y, x[b + 3].x}; u = x[b + 1]; x[b + 1] = u + v; x[b + 3] = u - v; }
    { f32x2 v, u, t;
      v = x[4]; u = x[0]; x[0] = u + v; x[4] = u - v;
      t = x[5]; v = (f32x2){C * (t.x - t.y), C * (t.x + t.y)}; u = x[1]; x[1] = u + v; x[5] = u - v;
      t = x[6]; v = (f32x2){-t.y, t.x}; u = x[2]; x[2] = u + v; x[6] = u - v;
      t = x[7]; v = (f32x2){-C * (t.x + t.y), C * (t.x - t.y)}; u = x[3]; x[3] = u + v; x[7] = u - v; }
}
__device__ __forceinline__ void twid8(f32x2 (&x)[8], int pidx, int L, bool conj) {
    const float rev = -(float)pidx / (float)L;
    const float s = __builtin_amdgcn_sinf(rev), c = __builtin_amdgcn_cosf(rev);
    const f32x2 w1 = {c, s}; const f32x2 w2 = cmul(w1, w1), w3 = cmul(w2, w1), w4 = cmul(w2, w2), w5 = cmul(w4, w1), w6 = cmul(w3, w3), w7 = cmul(w4, w3);
    if (!conj) { x[1] = cmul(x[1], w4); x[2] = cmul(x[2], w2); x[3] = cmul(x[3], w6); x[4] = cmul(x[4], w1); x[5] = cmul(x[5], w5); x[6] = cmul(x[6], w3); x[7] = cmul(x[7], w7); }
    else { x[1] = cmulc(x[1], w4); x[2] = cmulc(x[2], w2); x[3] = cmulc(x[3], w6); x[4] = cmulc(x[4], w1); x[5] = cmulc(x[5], w5); x[6] = cmulc(x[6], w3); x[7] = cmulc(x[7], w7); }
}
__device__ __forceinline__ void fft_fwd(f32x2* z) {
    const int tid = TID();
#pragma unroll 1
    for (int L = 8192; L >= 16; L >>= 3) {
        const int S = L >> 3;
#pragma unroll
        for (int qq = 0; qq < 2; ++qq) { const int q = tid + qq * NT;
            const int pidx = q & (S - 1), B = (q / S) * L + pidx;
            f32x2 x[8];
#pragma unroll
            for (int j = 0; j < 8; ++j) x[j] = z[ZI(B + j * S)];
            dif8(x); twid8(x, pidx, L, false);
#pragma unroll
            for (int j = 0; j < 8; ++j) z[ZI(B + j * S)] = x[j];
        }
        __syncthreads();
    }
#pragma unroll 4
    for (int q = tid; q < 4096; q += NT) { const f32x2 a = z[ZI(2 * q)], b = z[ZI(2 * q + 1)]; z[ZI(2 * q)] = a + b; z[ZI(2 * q + 1)] = a - b; }
    __syncthreads();
}
__device__ __forceinline__ void fft_inv(f32x2* z) {
    const int tid = TID();
#pragma unroll 4
    for (int q = tid; q < 4096; q += NT) { const f32x2 a = z[ZI(2 * q)], b = z[ZI(2 * q + 1)]; z[ZI(2 * q)] = a + b; z[ZI(2 * q + 1)] = a - b; }
    __syncthreads();
#pragma unroll 1
    for (int L = 16; L <= 8192; L <<= 3) {
        const int S = L >> 3;
#pragma unroll
        for (int qq = 0; qq < 2; ++qq) { const int q = tid + qq * NT;
            const int pidx = q & (S - 1), B = (q / S) * L + pidx;
            f32x2 x[8];
#pragma unroll
            for (int j = 0; j < 8; ++j) x[j] = z[ZI(B + j * S)];
            twid8(x, pidx, L, true); idif8(x);
#pragma unroll
            for (int j = 0; j < 8; ++j) z[ZI(B + j * S)] = x[j];
        }
        __syncthreads();
    }
}

__device__ __forceinline__ void filtfft_item(const Params& p, unsigned char* smem, int oc) {
    f32x2* z = (f32x2*)smem;
    float* red = (float*)(smem + 8704 * 8);
    const int tid = TID();
    const float* filt = (const float*)(p.ws + O_FILT) + (size_t)oc * 8192;
    const float* l1p = (const float*)(p.ws + O_L1P);
    __syncthreads();
#pragma unroll 4
    for (int i = tid; i < 8192; i += NT) z[ZI(i)] = (f32x2){filt[i], 0.f};
    if (tid < 256) red[tid] = l1p[(size_t)tid * 1024 + oc] + l1p[(size_t)tid * 1024 + 512 + oc];
    __syncthreads();
    if (tid < 64) { float v = red[tid] + red[tid + 64] + red[tid + 128] + red[tid + 192]; v = wave_sum(v); if (tid == 0) red[256] = v; }
    fft_fwd(z);
    const float sc = 1.0f / (red[256] * 8192.0f);
    f32x2* fh = (f32x2*)(p.ws + O_FH) + (size_t)oc * 8192;
#pragma unroll 4
    for (int i = tid; i < 8192; i += NT) fh[i] = z[ZI(i)] * sc;
}

__device__ __forceinline__ void hyfft_item(const Params& p, unsigned char* smem, int l, int ch, int bp) {
    f32x2* z = (f32x2*)smem;
    f32x2* zz = (f32x2*)(smem + 8704 * 8);
    const int tid = TID();
    const bf16_t* HV = (const bf16_t*)(p.ws + O_HV);
    const bf16_t* v0 = HV + ((size_t)(2 * bp) * 768 + ch) * 4096; const bf16_t* v1 = v0 + (size_t)768 * 4096;
    const f32x2* fh0 = (const f32x2*)(p.ws + O_FH) + (size_t)ch * 8192; const f32x2* fh1 = fh0 + (size_t)256 * 8192;
    const float sk0 = p.hy_skip[(size_t)l * 512 + ch], sk1 = p.hy_skip[(size_t)l * 512 + 256 + ch];
    bf16_t a0[8], a1[8];
#pragma unroll
    for (int k = 0; k < 8; ++k) { a0[k] = v0[tid + k * NT]; a1[k] = v1[tid + k * NT]; }
    f32x2 fr[16];
#pragma unroll
    for (int k = 0; k < 16; ++k) fr[k] = fh0[tid + k * NT];
    __syncthreads();
#pragma unroll
    for (int k = 0; k < 8; ++k) { const int t = tid + k * NT; z[ZI(t)] = (f32x2){bf2f(a0[k]), bf2f(a1[k])}; z[ZI(4096 + t)] = (f32x2){0.f, 0.f}; }
    __syncthreads();
    fft_fwd(z);
#pragma unroll
    for (int k = 0; k < 16; ++k) { const int i = tid + k * NT; z[ZI(i)] = cmul(z[ZI(i)], fr[k]); }
    bf16_t x0[8], x1[8];
#pragma unroll
    for (int k = 0; k < 8; ++k) { x0[k] = v0[(size_t)256 * 4096 + tid + k * NT]; x1[k] = v1[(size_t)256 * 4096 + tid + k * NT]; }
#pragma unroll
    for (int k = 0; k < 16; ++k) fr[k] = fh1[tid + k * NT];
    __syncthreads();
    fft_inv(z);
#pragma unroll
    for (int k = 0; k < 8; ++k) {
        const int t = tid + k * NT;
        f32x2 y = z[ZI(t)];
        y.x += bf2f(a0[k]) * sk0; y.y += bf2f(a1[k]) * sk0;
        const f32x2 zv = {bf2f(x0[k]) * y.x, bf2f(x1[k]) * y.y};
        zz[t] = zv; z[ZI(t)] = zv; z[ZI(4096 + t)] = (f32x2){0.f, 0.f};
    }
    __syncthreads();
    fft_fwd(z);
#pragma unroll
    for (int k = 0; k < 16; ++k) { const int i = tid + k * NT; z[ZI(i)] = cmul(z[ZI(i)], fr[k]); }
#pragma unroll
    for (int k = 0; k < 8; ++k) { x0[k] = v0[(size_t)512 * 4096 + tid + k * NT]; x1[k] = v1[(size_t)512 * 4096 + tid + k * NT]; }
    __syncthreads();
    fft_inv(z);
    bf16_t* YBT = (bf16_t*)(p.ws + O_YBT);
    bf16_t* o0 = YBT + ((size_t)(2 * bp) * 256 + ch) * 4096; bf16_t* o1 = o0 + (size_t)256 * 4096;
#pragma unroll
    for (int k = 0; k < 8; ++k) {
        const int t = tid + k * NT;
        const f32x2 y = z[ZI(t)] + zz[t] * sk1;
        o0[t] = f2bf(bf2f(x0[k]) * y.x); o1[t] = f2bf(bf2f(x1[k]) * y.y);
    }
}

__device__ __forceinline__ void hyctx_item(const Params& p, unsigned char* smem, int l, int b, int cp) {
    float* f1 = (float*)smem;
    float* f2 = f1 + 1024;
    float* vv = f2 + 1024;
    float* zc = vv + 512;
    float* red = zc + 512;
    const int tid = TID(), hf = tid >> 8, t = tid & 255, ch = cp * 2 + hf;
    const float* FC = (const float*)(p.ws + O_FILTC); const float* l1p = (const float*)(p.ws + O_L1PC);
    const bf16_t* HVC = (const bf16_t*)(p.ws + O_HVC) + ((size_t)b * 768 + ch) * 256;
    __syncthreads();
    f1[hf * 512 + t] = FC[(size_t)ch * 512 + t]; f1[hf * 512 + 256 + t] = FC[(size_t)ch * 512 + 256 + t];
    f2[hf * 512 + t] = FC[(size_t)(256 + ch) * 512 + t]; f2[hf * 512 + 256 + t] = FC[(size_t)(256 + ch) * 512 + 256 + t];
    const float vt = bf2f(HVC[t]); vv[hf * 256 + t] = vt;
    if (t < 2) { float s = 0.f; for (int it = 0; it < 16; ++it) s += l1p[(size_t)it * 1024 + t * 256 + ch] + l1p[(size_t)it * 1024 + 512 + t * 256 + ch]; red[hf * 2 + t] = s; }
    __syncthreads();
    float a = 0.f;
    for (int s = 0; s < 256; ++s) a += f1[hf * 512 + ((t - s) & 511)] * vv[hf * 256 + s];
    const float y1 = a / red[hf * 2 + 0] + vt * p.hy_skip[(size_t)l * 512 + ch];
    const float zt = bf2f(HVC[(size_t)256 * 256 + t]) * y1; zc[hf * 256 + t] = zt;
    __syncthreads();
    float a2 = 0.f;
    for (int s = 0; s < 256; ++s) a2 += f2[hf * 512 + ((t - s) & 511)] * zc[hf * 256 + s];
    const float y2 = a2 / red[hf * 2 + 1] + zt * p.hy_skip[(size_t)l * 512 + 256 + ch];
    bf16_t* YBTC = (bf16_t*)(p.ws + O_YBTC);
    YBTC[((size_t)b * 256 + ch) * 256 + t] = f2bf(bf2f(HVC[(size_t)512 * 256 + t]) * y2);
}

__device__ __forceinline__ void qk_item(const Params& p, int l, int item, bool dry = false) {
    unsigned zmask = 0u; asm volatile("" : "+v"(zmask));
    const int vi = item * NT + TID();
    const int per = 64 * NK;
    const int which = vi / per, rem = vi % per, kidx = rem % NK;
    bf16_t* ptr = (bf16_t*)(p.ws + (which ? O_KN : O_QN)) + (size_t)rem * 64;
    u32x4 raw[8];
#pragma unroll
    for (int i = 0; i < 8; ++i) raw[i] = *(const u32x4*)(ptr + i * 8);
    float ss = 0.f;
#pragma unroll
    for (int i = 0; i < 8; ++i) { const u32x4 w = raw[i];
        const float a0 = bflo(w.x), a1 = bfhi(w.x), a2 = bflo(w.y), a3 = bfhi(w.y), a4 = bflo(w.z), a5 = bfhi(w.z), a6 = bflo(w.w), a7 = bfhi(w.w);
        ss += a0 * a0 + a1 * a1 + a2 * a2 + a3 * a3 + a4 * a4 + a5 * a5 + a6 * a6 + a7 * a7; }
    const float qs = which ? 1.0f : (0.125f * 1.4426950408889634f);
    const float rinv = rsqrtf(ss * (1.0f / 64.0f) + 1e-6f) * qs;
    const float* gain = p.qk_gain + (size_t)l * 128 + (which ? 64 : 0);
    const bool rope = kidx >= 256;
    const int t = kidx - 256;
#pragma unroll
    for (int a1 = 0; a1 < 2; ++a1) {
        float v[32];
#pragma unroll
        for (int i = 0; i < 4; ++i) { const u32x4 w = raw[a1 * 4 + i];
            v[i * 8 + 0] = bflo(w.x); v[i * 8 + 1] = bfhi(w.x); v[i * 8 + 2] = bflo(w.y); v[i * 8 + 3] = bfhi(w.y);
            v[i * 8 + 4] = bflo(w.z); v[i * 8 + 5] = bfhi(w.z); v[i * 8 + 6] = bflo(w.w); v[i * 8 + 7] = bfhi(w.w); }
#pragma unroll
        for (int i = 0; i < 32; ++i) v[i] = v[i] * rinv * gain[a1 * 32 + i];
        if (rope) {
            const float pos = (float)(a1 ? (t & 63) : (t >> 6));
#pragma unroll
            for (int q = 0; q < 16; ++q) {
                const float inv = exp2f(-(float)q * (13.287712379549449f / 16.0f));
                float sn, cs; __sincosf(pos * inv, &sn, &cs);
                const float x1 = v[q], x2 = v[16 + q];
                v[q] = x1 * cs - x2 * sn; v[16 + q] = x1 * sn + x2 * cs;
            }
        }
#pragma unroll
        for (int i = 0; i < 4; ++i) { u32x4 w; w.x = pk2(v[i * 8], v[i * 8 + 1]); w.y = pk2(v[i * 8 + 2], v[i * 8 + 3]);
            w.z = pk2(v[i * 8 + 4], v[i * 8 + 5]); w.w = pk2(v[i * 8 + 6], v[i * 8 + 7]);
            if (dry) { const u32x4 o = raw[a1 * 4 + i]; w = (u32x4){o.x ^ (w.x & zmask), o.y ^ (w.y & zmask), o.z ^ (w.z & zmask), o.w ^ (w.w & zmask)}; }
            *(u32x4*)(ptr + a1 * 32 + i * 8) = w; }
    }
}

__device__ __forceinline__ void vt_item(const Params& p, unsigned char* smem, int tb) {
    bf16_t* tile = (bf16_t*)smem;
    const int tid = TID(), r0 = tb * 64;
    const bf16_t* src = (const bf16_t*)(p.ws + O_VRAW) + (size_t)r0 * 512;
    __syncthreads();
#pragma unroll
    for (int i = 0; i < 8; ++i) { const int e = tid + i * NT, rr = e >> 6, sg = e & 63; *(u32x4*)(tile + rr * 520 + sg * 8) = *(const u32x4*)(src + (size_t)rr * 512 + sg * 8); }
    __syncthreads();
    int b, kidx0; row_bk(r0, b, kidx0);
    bf16_t* dst = (bf16_t*)(p.ws + O_VT) + ((size_t)b * 512 + tid) * NK + kidx0;
#pragma unroll
    for (int s = 0; s < 8; ++s) {
        unsigned w[4];
#pragma unroll
        for (int j = 0; j < 4; ++j) w[j] = (unsigned)tile[(s * 8 + 2 * j) * 520 + tid] | ((unsigned)tile[(s * 8 + 2 * j + 1) * 520 + tid] << 16);
        *(u32x4*)(dst + s * 8) = (u32x4){w[0], w[1], w[2], w[3]};
    }
}

__device__ __forceinline__ void hyconv_item(const Params& p, unsigned char* smem, int l, int tb) {
    bf16_t* tile = (bf16_t*)smem;
    const int tid = TID(), r0 = tb * 64;
    const bool lat = r0 < TL;
    const int n = lat ? 4096 : 256, rb = lat ? r0 : r0 - TL, b = rb / n, t0 = rb % n;
    const bf16_t* src = (const bf16_t*)(p.ws + O_HYRAW);
    __syncthreads();
    for (int e = tid; e < 66 * 96; e += NT) {
        const int rr = e / 96, sg = e % 96, t = t0 - 1 + rr;
        u32x4 w = {0u, 0u, 0u, 0u};
        if (t >= 0 && t < n) w = *(const u32x4*)(src + (size_t)(r0 - 1 + rr) * 768 + sg * 8);
        *(u32x4*)(tile + rr * 776 + sg * 8) = w;
    }
    __syncthreads();
    const float* cw = p.hy_conv_w + (size_t)l * 3 * 768; const float* cb = p.hy_conv_b + (size_t)l * 768;
    for (int c = tid; c < 768; c += NT) {
        const float w0 = cw[c], w1 = cw[768 + c], w2 = cw[1536 + c], bb = cb[c];
        bf16_t* dst = lat ? (bf16_t*)(p.ws + O_HV) + ((size_t)b * 768 + c) * 4096 + t0 : (bf16_t*)(p.ws + O_HVC) + ((size_t)b * 768 + c) * 256 + t0;
        float pm = bf2f(tile[c]), pc = bf2f(tile[776 + c]);
#pragma unroll
        for (int s = 0; s < 8; ++s) {
            float o[8];
#pragma unroll
            for (int j = 0; j < 8; ++j) { const float pn = bf2f(tile[(s * 8 + j + 2) * 776 + c]); o[j] = pm * w0 + pc * w1 + pn * w2 + bb; pm = pc; pc = pn; }
            *(u32x4*)(dst + s * 8) = (u32x4){pk2(o[0], o[1]), pk2(o[2], o[3]), pk2(o[4], o[5]), pk2(o[6], o[7])};
        }
    }
}

__device__ __forceinline__ float gelu_exact(float v) { return 0.5f * v * (1.0f + erff(v * 0.70710678118654752f)); }
__device__ __forceinline__ void sgu_item(const Params& p, unsigned char* smem, int l, int ci) {
    bf16_t* vt = (bf16_t*)smem;
    const int tid = TID(), lane = tid & 63, wv = __builtin_amdgcn_readfirstlane(tid >> 6), r0 = ci * 128;
    const bf16_t* src = (const bf16_t*)(p.ws + O_SGRAW) + (size_t)r0 * 512;
    const float* lg = p.sg_ln_g + (size_t)l * 256; const float* lb = p.sg_ln_b + (size_t)l * 256;
    __syncthreads();
    {
        const f32x4 g4 = *(const f32x4*)(lg + lane * 4), b4 = *(const f32x4*)(lb + lane * 4);
        u32x2 wr_[16];
#pragma unroll
        for (int k = 0; k < 16; ++k) wr_[k] = *(const u32x2*)(src + (size_t)(wv + 8 * k) * 512 + 256 + lane * 4);
#pragma unroll
        for (int k = 0; k < 16; ++k) {
            const int rr = wv + 8 * k; const u32x2 w = wr_[k];
            float a[4] = {gelu_exact(bflo(w.x)), gelu_exact(bfhi(w.x)), gelu_exact(bflo(w.y)), gelu_exact(bfhi(w.y))};
            const float mu = wave_sum(a[0] + a[1] + a[2] + a[3]) * (1.0f / 256.0f);
            float d[4]; float sq = 0.f;
#pragma unroll
            for (int j = 0; j < 4; ++j) { d[j] = a[j] - mu; sq += d[j] * d[j]; }
            const float rstd = rsqrtf(wave_sum(sq) * (1.0f / 256.0f) + 1e-6f);
#pragma unroll
            for (int j = 0; j < 4; ++j) vt[(lane * 4 + j) * 136 + rr] = f2bf(d[j] * rstd * g4[j] + b4[j]);
        }
    }
    __syncthreads();
    const int g = wv & 3, ih = wv >> 2, l32 = lane & 31, kg = lane >> 5;
    const float* wsb = p.sg_w + ((size_t)l * 4 + g) * 128 * 128;
    const float* bsb = p.sg_b + ((size_t)l * 4 + g) * 128;
    bf16_t* yc = (bf16_t*)(p.ws + O_YCAT) + 768;
#pragma unroll 1
    for (int ib = 0; ib < 2; ++ib) {
        const int i0 = ih * 64 + ib * 32;
        f32x16 acc0, acc1;
#pragma unroll
        for (int r = 0; r < 16; ++r) { acc0[r] = 0.f; acc1[r] = 0.f; }
        const float* wrow = wsb + (size_t)(i0 + l32) * 128 + 8 * kg;
#pragma unroll
        for (int ks = 0; ks < 8; ++ks) {
            const f32x4 w0 = *(const f32x4*)(wrow + 16 * ks), w1 = *(const f32x4*)(wrow + 16 * ks + 4);
            const u32x4 aw = {pk2(w0[0], w0[1]), pk2(w0[2], w0[3]), pk2(w1[0], w1[1]), pk2(w1[2], w1[3])};
            const bf16x8 af = __builtin_bit_cast(bf16x8, aw);
            const bf16x8 b0 = *(const bf16x8*)(vt + (g * 64 + l32) * 136 + 16 * ks + 8 * kg);
            const bf16x8 b1 = *(const bf16x8*)(vt + (g * 64 + 32 + l32) * 136 + 16 * ks + 8 * kg);
            acc0 = __builtin_amdgcn_mfma_f32_32x32x16_bf16(af, b0, acc0, 0, 0, 0);
            acc1 = __builtin_amdgcn_mfma_f32_32x32x16_bf16(af, b1, acc1, 0, 0, 0);
        }
#pragma unroll
        for (int r = 0; r < 16; ++r) {
            const int i = i0 + 8 * (r >> 2) + 4 * kg + (r & 3);
            const float bi = bsb[i];
            const int c0 = g * 64 + l32, c1 = c0 + 32;
            const float u0 = gelu_exact(bf2f(src[(size_t)i * 512 + c0])), u1 = gelu_exact(bf2f(src[(size_t)i * 512 + c1]));
            yc[(size_t)(r0 + i) * 1024 + c0] = f2bf(u0 * (acc0[r] + bi));
            yc[(size_t)(r0 + i) * 1024 + c1] = f2bf(u1 * (acc1[r] + bi));
        }
    }
}

__device__ __forceinline__ void prep_phase(const Params& p, unsigned char* smem, int l) {
    const int n_sg = 0, n_hy = 544, n_vt = 544, n_qk = 1088;
    const int total = n_sg + n_hy + n_vt + n_qk;
    for (int it = blockIdx.x; it < total; it += gridDim.x) {
        int i = it;
        if (i < n_sg) { for (int rep = 0; rep < REP_SGU; ++rep) sgu_item(p, smem, l, i); continue; }
        i -= n_sg;
        if (i < n_hy) { for (int rep = 0; rep < REP_PREP; ++rep) hyconv_item(p, smem, l, i); continue; }
        i -= n_hy;
        if (i < n_vt) { for (int rep = 0; rep < REP_PREP; ++rep) vt_item(p, smem, i); continue; }
        i -= n_vt;
#if REP_QK > 1
        qk_item(p, l, i, true);
#endif
        qk_item(p, l, i);
    }
}

__device__ __forceinline__ void attn_item(const Params& p, unsigned char* smem, int b, int h, int comp, int q0, int rowbase, int nkt) {
    constexpr int ABUF = 64 * 72 + 128 * 72;
    bf16_t* Ks = (bf16_t*)smem;
    bf16_t* Vs = Ks + 64 * 72;
    const int tid = TID(), lane = tid & 63, w = tid >> 6, l32 = lane & 31, g = lane >> 5;
    const size_t hc = (size_t)((b * 4 + h) * 2 + comp);
    const bf16_t* Qb = (const bf16_t*)(p.ws + O_QN) + (hc * NK + q0 + 32 * w + l32) * 64;
    const bf16_t* Kb = (const bf16_t*)(p.ws + O_KN) + hc * NK * 64;
    const bf16_t* Vb = (const bf16_t*)(p.ws + O_VT) + (size_t)((b * 4 + h) * 128) * NK;
    bf16x8 qf[4];
#pragma unroll
    for (int ks = 0; ks < 4; ++ks) qf[ks] = *(const bf16x8*)(Qb + 16 * ks + 8 * g);
    f32x16 O[4];
#pragma unroll
    for (int d = 0; d < 4; ++d)
#pragma unroll
        for (int i = 0; i < 16; ++i) O[d][i] = 0.f;
    float lsum = 0.f;
    const int kkey = tid >> 3, kseg = tid & 7, vdv = tid >> 2, vseg = tid & 3;
    const bf16_t* kg = Kb + (size_t)kkey * 64 + kseg * 8;
    const bf16_t* vg = Vb + (size_t)vdv * NK + vseg * 16;
    u32x4 kreg = *(const u32x4*)kg, vr0 = *(const u32x4*)vg, vr1 = *(const u32x4*)(vg + 8);
    const int pr = (l32 & ~12) | ((l32 & 4) << 1) | ((l32 & 8) >> 1);
    __syncthreads();
    *(u32x4*)(Ks + kkey * 72 + kseg * 8) = kreg; *(u32x4*)(Vs + vdv * 72 + vseg * 16) = vr0; *(u32x4*)(Vs + vdv * 72 + vseg * 16 + 8) = vr1;
    if (nkt > 1) { kreg = *(const u32x4*)(kg + (size_t)64 * 64); vr0 = *(const u32x4*)(vg + 64); vr1 = *(const u32x4*)(vg + 64 + 8); }
    __syncthreads();
    for (int kt = 0; kt < nkt; ++kt) {
        const bf16_t* Kc = Ks + (kt & 1) * ABUF; const bf16_t* Vc = Vs + (kt & 1) * ABUF;
        if (kt + 1 < nkt) {
            bf16_t* Kn = Ks + ((kt + 1) & 1) * ABUF; bf16_t* Vn = Vs + ((kt + 1) & 1) * ABUF;
            *(u32x4*)(Kn + kkey * 72 + kseg * 8) = kreg; *(u32x4*)(Vn + vdv * 72 + vseg * 16) = vr0; *(u32x4*)(Vn + vdv * 72 + vseg * 16 + 8) = vr1;
            if (kt + 2 < nkt) { kreg = *(const u32x4*)(kg + (size_t)(kt + 2) * 64 * 64); vr0 = *(const u32x4*)(vg + (kt + 2) * 64); vr1 = *(const u32x4*)(vg + (kt + 2) * 64 + 8); }
        }
        f32x16 S0, S1;
#pragma unroll
        for (int i = 0; i < 16; ++i) { S0[i] = 0.f; S1[i] = 0.f; }
#pragma unroll
        for (int ks = 0; ks < 4; ++ks) {
            const bf16x8 ka = *(const bf16x8*)(Kc + pr * 72 + 16 * ks + 8 * g);
            const bf16x8 kb = *(const bf16x8*)(Kc + (32 + pr) * 72 + 16 * ks + 8 * g);
            S0 = __builtin_amdgcn_mfma_f32_32x32x16_bf16(ka, qf[ks], S0, 0, 0, 0);
            S1 = __builtin_amdgcn_mfma_f32_32x32x16_bf16(kb, qf[ks], S1, 0, 0, 0);
        }
#pragma unroll
        for (int i = 0; i < 16; ++i) { S0[i] = __builtin_amdgcn_exp2f(S0[i]); S1[i] = __builtin_amdgcn_exp2f(S1[i]); lsum += S0[i] + S1[i]; }
#pragma unroll
        for (int kb2 = 0; kb2 < 2; ++kb2)
#pragma unroll
            for (int s = 0; s < 2; ++s) {
                u32x4 pw;
                if (kb2 == 0) { pw.x = pk2(S0[8 * s], S0[8 * s + 1]); pw.y = pk2(S0[8 * s + 2], S0[8 * s + 3]); pw.z = pk2(S0[8 * s + 4], S0[8 * s + 5]); pw.w = pk2(S0[8 * s + 6], S0[8 * s + 7]); }
                else { pw.x = pk2(S1[8 * s], S1[8 * s + 1]); pw.y = pk2(S1[8 * s + 2], S1[8 * s + 3]); pw.z = pk2(S1[8 * s + 4], S1[8 * s + 5]); pw.w = pk2(S1[8 * s + 6], S1[8 * s + 7]); }
                const bf16x8 pf = __builtin_bit_cast(bf16x8, pw);
#pragma unroll
                for (int d = 0; d < 4; ++d) {
                    const bf16x8 va = *(const bf16x8*)(Vc + (d * 32 + l32) * 72 + kb2 * 32 + 16 * s + 8 * g);
                    O[d] = __builtin_amdgcn_mfma_f32_32x32x16_bf16(va, pf, O[d], 0, 0, 0);
                }
            }
        __syncthreads();
    }
    lsum += __shfl_xor(lsum, 32);
    const float inv = 1.0f / lsum;
    bf16_t* ob = (bf16_t*)(p.ws + O_OC) + ((size_t)(rowbase + 32 * w + l32) * 8 + h * 2 + comp) * 128;
#pragma unroll
    for (int d = 0; d < 4; ++d)
#pragma unroll
        for (int i4 = 0; i4 < 4; ++i4) {
            u32x2 o; o.x = pk2(O[d][4 * i4] * inv, O[d][4 * i4 + 1] * inv); o.y = pk2(O[d][4 * i4 + 2] * inv, O[d][4 * i4 + 3] * inv);
            *(u32x2*)(ob + d * 32 + 8 * i4 + 4 * g) = o;
        }
}

__device__ __forceinline__ void mix_phase(const Params& p, unsigned char* smem, int l) {
    const int n_al = 1024, n_ac = (l == 0) ? 64 : 0, n_hf = 1024, n_hc = (l == 0) ? 1024 : 0;
    const int total = n_al + n_ac + n_hf + n_hc;
    for (int it = blockIdx.x; it < total; it += gridDim.x) {
        int i = it;
        if (i < n_al) { const int comp = i & 1, h = (i >> 1) & 3, qt = (i >> 3) & 15, b = i >> 7; for (int rep = 0; rep < REP_ATT; ++rep) attn_item(p, smem, b, h, comp, 256 + qt * 256, b * 4096 + qt * 256, 68); continue; }
        i -= n_al;
        if (i < n_ac) { const int comp = i & 1, h = (i >> 1) & 3, b = i >> 3; attn_item(p, smem, b, h, comp, 0, TL + b * 256, 4); continue; }
        i -= n_ac;
        if (i < n_hf) { for (int rep = 0; rep < REP_HY; ++rep) hyfft_item(p, smem, l, i >> 2, i & 3); continue; }
        i -= n_hf;
        for (int rep = 0; rep < REP_MISC; ++rep) hyctx_item(p, smem, l, i >> 7, i & 127);
    }
}

__device__ __forceinline__ void ybt_item(const Params& p, unsigned char* smem, int tb) {
    bf16_t* tile = (bf16_t*)smem;
    const int tid = TID(), r0 = tb * 64;
    const bool lat = r0 < TL;
    const int n = lat ? 4096 : 256, rb = lat ? r0 : r0 - TL, b = rb / n, t0 = rb % n;
    const bf16_t* src = (lat ? (const bf16_t*)(p.ws + O_YBT) : (const bf16_t*)(p.ws + O_YBTC)) + (size_t)b * 256 * n + t0;
    __syncthreads();
#pragma unroll
    for (int i = 0; i < 4; ++i) { const int e = tid + i * NT, ch = e >> 3, sg = e & 7; *(u32x4*)(tile + ch * 72 + sg * 8) = *(const u32x4*)(src + (size_t)ch * n + sg * 8); }
    __syncthreads();
    bf16_t* yb = (bf16_t*)(p.ws + O_YCAT) + 512;
#pragma unroll
    for (int i = 0; i < 4; ++i) {
        const int e = tid + i * NT, rr = e >> 5, sg = e & 31;
        unsigned w[4];
#pragma unroll
        for (int j = 0; j < 4; ++j) w[j] = (unsigned)tile[(sg * 8 + 2 * j) * 72 + rr] | ((unsigned)tile[(sg * 8 + 2 * j + 1) * 72 + rr] << 16);
        *(u32x4*)(yb + (size_t)(r0 + rr) * 1024 + sg * 8) = (u32x4){w[0], w[1], w[2], w[3]};
    }
}
__device__ __forceinline__ void post_phase(const Params& p, unsigned char* smem, int l, int M) {
    const int n_sg = M / 128, nb = M / 64;
    for (int it = blockIdx.x; it < n_sg + nb; it += gridDim.x) {
        if (it < n_sg) { for (int rep = 0; rep < REP_SGU; ++rep) sgu_item(p, smem, l, it); }
        else ybt_item(p, smem, it - n_sg);
    }
    const int tid = TID(), lane = tid & 63, wv = tid >> 6;
    const float* lv = p.da_lambda + (size_t)l * 256;
    const float d01 = wave_sum(lv[lane] * lv[64 + lane]), d23 = wave_sum(lv[128 + lane] * lv[192 + lane]);
    const float lam_init = 0.8f - 0.6f * expf(-0.3f * (float)l);
    const float lam = expf(d01) - expf(d23) + lam_init;
    const float* sub = p.da_subln + (size_t)l * 128;
    const float s0 = sub[2 * lane] * (1.0f - lam_init), s1 = sub[2 * lane + 1] * (1.0f - lam_init);
    const bf16_t* OC = (const bf16_t*)(p.ws + O_OC);
    bf16_t* YA = (bf16_t*)(p.ws + O_YCAT);
    const int vstep = gridDim.x * 8;
    for (int v0i = blockIdx.x * 8 + wv; v0i < M * 4; v0i += 4 * vstep) {
        unsigned aw[4], bw[4];
#pragma unroll
        for (int k = 0; k < 4; ++k) { const int vi = v0i + k * vstep; aw[k] = 0u; bw[k] = 0u;
            if (vi < M * 4) { const bf16_t* o0 = OC + (size_t)vi * 256; aw[k] = *(const unsigned*)(o0 + 2 * lane); bw[k] = *(const unsigned*)(o0 + 128 + 2 * lane); } }
#pragma unroll
        for (int k = 0; k < 4; ++k) { const int vi = v0i + k * vstep;
            if (vi < M * 4) {
                const float x0 = bflo(aw[k]) - lam * bflo(bw[k]), x1 = bfhi(aw[k]) - lam * bfhi(bw[k]);
                const float rinv = rsqrtf(wave_sum(x0 * x0 + x1 * x1) * (1.0f / 128.0f) + 1e-6f);
                *(unsigned*)(YA + (size_t)(vi >> 2) * 1024 + (vi & 3) * 128 + 2 * lane) = pk2(x0 * rinv * s0, x1 * rinv * s1);
            } }
    }
}

template <int l> __device__ __forceinline__ void layer_body(unsigned char* smem) {
        const int Mfull = TT, Mpost = (l == 0) ? TT : TL;
        { const Params q = opq(smem); norm_phase(q, l, 0, Mfull, l == 0, (const bf16_t*)q.out); if (l == 1) aux_phase(q, smem, 1); }
        gsync(smem);
        for (int rep = 0; rep < REP_UP; ++rep) { const Params q = opq(smem); EpiSwiglu E; E.G = (bf16_t*)(q.ws + O_GH); run_gemm(smem, (const bf16_t*)(q.ws + O_H), (const bf16_t*)(q.ws + O_WUP0), Mfull, 5632, 1024, E); }
        gsync(smem);
        { const Params q = opq(smem); EpiResid E; E.xin = (const bf16_t*)q.out; E.xout = (bf16_t*)q.out; E.fout = nullptr; E.xc = (float*)(q.ws + O_XC); E.part = (float*)(q.ws + O_PART); E.mod = (const float*)(q.ws + O_MOD) + (size_t)l * 9 * 9216; E.gofs = 2 * 1024; E.coef = 0.5f;
          run_gemm(smem, (const bf16_t*)(q.ws + O_GH), (const bf16_t*)(q.ws + O_WDN0), Mfull, 1024, 2816, E, true);
          for (int rep = 1; rep < REP_DN; ++rep) { E.coef = 0.f; run_gemm(smem, (const bf16_t*)(q.ws + O_GH), (const bf16_t*)(q.ws + O_WDN0), Mfull, 1024, 2816, E); } }
        gsync(smem);
        { const Params q = opq(smem); norm_phase(q, l, 1, Mfull, false, (const bf16_t*)q.out); for (int rep = 0; rep < REP_MISC; ++rep) for (int it = blockIdx.x; it < 512; it += gridDim.x) filtfft_item(q, smem, it); }
        gsync(smem);
        for (int rep = 0; rep < REP_G3; ++rep) { const Params q = opq(smem); EpiIn E; E.qn = (bf16_t*)(q.ws + O_QN); E.kn = (bf16_t*)(q.ws + O_KN); E.vraw = (bf16_t*)(q.ws + O_VRAW); E.hyraw = (bf16_t*)(q.ws + O_HYRAW); E.sgraw = (bf16_t*)(q.ws + O_SGRAW);
          run_gemm(smem, (const bf16_t*)(q.ws + O_H), (const bf16_t*)(q.ws + O_WIN), Mfull, 2816, 1024, E); }
        gsync(smem);
        { const Params q = opq(smem); prep_phase(q, smem, l); }
        gsync(smem);
        { const Params q = opq(smem); mix_phase(q, smem, l); }
        gsync(smem);
        for (int rep = 0; rep < REP_MISC; ++rep) { const Params q = opq(smem); post_phase(q, smem, l, Mpost); }
        gsync(smem);
#pragma unroll 1
        for (int rep9 = 0; rep9 < REP_P9; ++rep9) {
            { const Params q = opq(smem); EpiGate3 E; E.g3 = (bf16_t*)(q.ws + O_G3); E.bias = q.gate_b + (size_t)l * 3072;
              run_gemm(smem, (const bf16_t*)(q.ws + O_H), (const bf16_t*)(q.ws + O_WG), Mpost, 3072, 1024, E); }
            gsync(smem);
            { const Params q = opq(smem); EpiMergeR E; E.g3 = (const bf16_t*)(q.ws + O_G3); E.mb = (bf16_t*)(q.ws + O_MB);
              run_gemm(smem, (const bf16_t*)(q.ws + O_YCAT), (const bf16_t*)(q.ws + O_WBR), Mpost, 1024, 1024, E); }
        }
        gsync(smem);
        { const Params q = opq(smem); EpiResid E; E.xin = (const bf16_t*)q.out; E.xout = (l == 1) ? (bf16_t*)(q.ws + O_XALT) : (bf16_t*)q.out; E.fout = nullptr; E.xc = (float*)(q.ws + O_XC); E.part = (float*)(q.ws + O_PART); E.mod = (const float*)(q.ws + O_MOD) + (size_t)l * 9 * 9216; E.gofs = 5 * 1024; E.coef = 1.0f;
          run_gemm(smem, (const bf16_t*)(q.ws + O_MB), (const bf16_t*)(q.ws + O_WO), Mpost, 1024, 1024, E, l == 0);
          for (int rep = 1; rep < REP_G3; ++rep) { E.coef = 0.f; run_gemm(smem, (const bf16_t*)(q.ws + O_MB), (const bf16_t*)(q.ws + O_WO), Mpost, 1024, 1024, E); } }
        gsync(smem);
        { const Params q = opq(smem); norm_phase(q, l, 2, Mpost, false, (l == 1) ? (const bf16_t*)(q.ws + O_XALT) : (const bf16_t*)q.out); }
        gsync(smem);
        for (int rep = 0; rep < REP_UP; ++rep) { const Params q = opq(smem); EpiSwiglu E; E.G = (bf16_t*)(q.ws + O_GH); run_gemm(smem, (const bf16_t*)(q.ws + O_H), (const bf16_t*)(q.ws + O_WUP1), Mpost, 5632, 1024, E); }
        gsync(smem);
        { const Params q = opq(smem); EpiResid E; E.xin = (l == 1) ? (const bf16_t*)(q.ws + O_XALT) : (const bf16_t*)q.out; E.xout = (bf16_t*)q.out; E.fout = (l == 1) ? q.out : nullptr; E.xc = (float*)(q.ws + O_XC); E.part = (float*)(q.ws + O_PART); E.mod = (const float*)(q.ws + O_MOD) + (size_t)l * 9 * 9216; E.gofs = 8 * 1024; E.coef = 0.5f;
          run_gemm(smem, (const bf16_t*)(q.ws + O_GH), (const bf16_t*)(q.ws + O_WDN1), Mpost, 1024, 2816, E, l == 0); }
}

__global__ void __launch_bounds__(512, 2) fwd_megakernel(Params p) {
    extern __shared__ __attribute__((aligned(16))) unsigned char smem[];
    cg::grid_group grid = cg::this_grid();
    if (threadIdx.x == 0) {
        *(Params*)(smem + POFF) = p;
        volatile unsigned* st = (volatile unsigned*)(smem + POFF + 256); st[0] = 0u; st[1] = 0u;
        xb_add(&((unsigned*)(p.ws + O_BAR))[XB_XCNT(xb_xcc_id())], 1u);
    }
    __syncthreads();
    { const Params q = opq(smem); aux_phase(q, smem, 0); }
    grid.sync();
    layer_body<0>(smem);
    gsync(smem);
    layer_body<1>(smem);
}

extern "C" void kernel_launch(void* const* d_in, const int* in_sizes, int n_in, void* d_out, int out_size, void* d_ws, size_t ws_size, hipStream_t stream) {
    if (ws_size < WS_NEED) { fprintf(stderr, "workspace too small: need %zu have %zu\n", (size_t)WS_NEED, ws_size); return; }
    static int grid_blocks = 0;
    if (!grid_blocks) {
        hipFuncSetAttribute((const void*)fwd_megakernel, hipFuncAttributeMaxDynamicSharedMemorySize, LDS_BYTES);
        int dev = 0, cus = 0, per_cu = 0;
        hipGetDevice(&dev);
        hipDeviceGetAttribute(&cus, hipDeviceAttributeMultiprocessorCount, dev);
        hipOccupancyMaxActiveBlocksPerMultiprocessor(&per_cu, fwd_megakernel, NT, LDS_BYTES);
        if (per_cu < 1) per_cu = 1;
        grid_blocks = cus;
    }
    Params p{};
    const float** pp = (const float**)&p;
    for (int i = 0; i < 30; ++i) pp[i] = (const float*)d_in[i];
    p.out = (float*)d_out;
    p.ws = (unsigned char*)d_ws;
    hipMemsetAsync((unsigned char*)d_ws + O_BAR, 0, 16384, stream);
    void* args[] = {&p};
    hipError_t e = hipLaunchCooperativeKernel((void*)fwd_megakernel, dim3(grid_blocks), dim3(NT), args, LDS_BYTES, stream);
    if (e != hipSuccess) fprintf(stderr, "cooperative launch failed: %s (grid %d)\n", hipGetErrorString(e), grid_blocks);
}
```

```cpp
#include <hip/hip_runtime.h>
#include <hip/hip_cooperative_groups.h>
#include <cstdio>
namespace cg = cooperative_groups;

#define LAS __attribute__((address_space(3)))
typedef unsigned short bf16_t;
typedef short bf16x8 __attribute__((ext_vector_type(8)));
typedef float f32x2 __attribute__((ext_vector_type(2)));
typedef float f32x4 __attribute__((ext_vector_type(4)));
typedef float f32x16 __attribute__((ext_vector_type(16)));
typedef unsigned u32x2 __attribute__((ext_vector_type(2)));
typedef unsigned u32x4 __attribute__((ext_vector_type(4)));
typedef __bf16 bf16v2 __attribute__((ext_vector_type(2)));

constexpr int NT = 512;
#ifndef REP_ATT
#define REP_ATT 1
#endif
#ifndef REP_HY
#define REP_HY 1
#endif
#ifndef REP_AUX
#define REP_AUX 1
#endif
#ifndef REP_MISC
#define REP_MISC 1
#endif
#ifndef REP_PREP
#define REP_PREP 1
#endif
#ifndef REP_UP
#define REP_UP 1
#endif
#ifndef REP_DN
#define REP_DN 1
#endif
#ifndef REP_G3
#define REP_G3 1
#endif
#ifndef REP_P9
#define REP_P9 1
#endif
#ifndef REP_QK
#define REP_QK 1
#endif
#ifndef REP_NORM
#define REP_NORM 1
#endif
#ifndef REP_SGU
#define REP_SGU 1
#endif
constexpr int TL = 32768, TCX = 2048, TT = 34816, DM = 1024, FFH = 2816, SEQ = 4096, CTXL = 256, NK = 4352;
constexpr int LDS_BYTES = 147456;

constexpr size_t AL(size_t x) { return (x + 255) & ~(size_t)255; }
constexpr size_t O_WUP0 = 0;
constexpr size_t O_WUP1 = O_WUP0 + (size_t)5632 * 1024 * 2;
constexpr size_t O_WDN0 = O_WUP1 + (size_t)5632 * 1024 * 2;
constexpr size_t O_WDN1 = O_WDN0 + (size_t)1024 * 2816 * 2;
constexpr size_t O_WIN = O_WDN1 + (size_t)1024 * 2816 * 2;
constexpr size_t O_WG = O_WIN + (size_t)2816 * 1024 * 2;
constexpr size_t O_WBR = O_WG + (size_t)3072 * 1024 * 2;
constexpr size_t O_WO = O_WBR + (size_t)1024 * 1024 * 2;
constexpr size_t O_XC = O_WO + (size_t)1024 * 1024 * 2;
constexpr size_t O_MOD = O_XC + (size_t)TCX * 1024 * 4;
constexpr size_t O_L1P = O_MOD + AL((size_t)2 * 9 * 9216 * 4);
constexpr size_t O_L1PC = O_L1P + (size_t)256 * 1024 * 4;
constexpr size_t O_FILTC = O_L1PC + (size_t)16 * 1024 * 4;
constexpr size_t O_BAR = O_FILTC + (size_t)2 * 256 * 512 * 4;
constexpr size_t O_H = O_BAR + 16384;
constexpr size_t O_AR = O_H + (size_t)TT * 1024 * 2;
constexpr size_t O_GH = O_AR;
constexpr size_t O_VRAW = O_AR;
constexpr size_t O_HYRAW = O_VRAW + (size_t)TT * 512 * 2;
constexpr size_t O_SGRAW = O_HYRAW + (size_t)TT * 768 * 2;
constexpr size_t O_XALT = O_AR + (size_t)TT * 2816 * 2;
constexpr size_t O_PART = O_XALT;
constexpr size_t O_OC = O_AR;
constexpr size_t O_YBT = O_OC + (size_t)TT * 1024 * 2;
constexpr size_t O_YBTC = O_YBT + (size_t)8 * 256 * 4096 * 2;
static_assert(O_YBTC + (size_t)8 * 256 * 256 * 2 <= O_SGRAW, "OC/YBT must not touch SGRAW (read in the post phase)");
constexpr size_t O_G3 = O_AR;
constexpr size_t O_YCAT = O_G3 + (size_t)TT * 3072 * 2;
constexpr size_t O_MB = O_YCAT + (size_t)TT * 1024 * 2;
constexpr size_t SZ_B = (size_t)TT * 1024 * 4 + (size_t)8 * 256 * 4096 * 2 + (size_t)8 * 256 * 256 * 2;
constexpr size_t O_QN = O_AR + AL(SZ_B);
constexpr size_t O_KN = O_QN + (size_t)64 * NK * 64 * 2;
constexpr size_t O_VT = O_KN + (size_t)64 * NK * 64 * 2;
constexpr size_t O_HV = O_VT + (size_t)32 * 128 * NK * 2;
constexpr size_t O_HVC = O_HV + (size_t)8 * 768 * 4096 * 2;
constexpr size_t O_FH = O_HVC + (size_t)8 * 768 * 256 * 2;
constexpr size_t O_FILT = O_HV;
constexpr size_t SZ_C1 = (size_t)8 * 768 * 4096 * 2 + (size_t)8 * 768 * 256 * 2 + (size_t)2 * 256 * 8192 * 8;
constexpr size_t END1 = O_HV + SZ_C1, END2 = O_MB + (size_t)TT * 1024 * 2;
static_assert(O_YCAT >= O_SGRAW + (size_t)TT * 512 * 2, "YCAT is written while OC/YBT/SGRAW are read");
constexpr size_t WS_NEED = AL(END1 > END2 ? END1 : END2);
static_assert(O_GH + (size_t)TT * 2816 * 2 <= O_HV, "Gh must stay inside regions B'+A");
static_assert(O_XALT + (size_t)TL * 1024 * 2 <= O_MB, "X_alt is written while MB is read");
static_assert(O_PART + (size_t)4 * 2048 * 1024 * 4 <= O_HV, "partials must not touch FILT/FH");
static_assert(O_SGRAW + (size_t)TT * 512 * 2 <= O_QN, "raws fit region B'");

struct Params {
    const float *x, *c, *ctx, *c_ctx, *ada_w, *ada_b, *norm_g, *ffn_up, *ffn_down, *w_in, *qk_gain, *da_lambda, *da_subln,
        *hy_conv_w, *hy_conv_b, *hy_w1, *hy_b1, *hy_w2, *hy_b2, *hy_freq, *hy_w3, *hy_skip, *sg_ln_g, *sg_ln_b, *sg_w, *sg_b,
        *gate_w, *gate_b, *w_br, *w_o;
    float* out;
    unsigned char* ws;
};


__device__ __forceinline__ int TID() { int t = threadIdx.x; asm volatile("" : "+v"(t)); return t; }
constexpr int POFF = 147456 - 512;
__device__ __forceinline__ const float* ldp(const unsigned char* smem, int idx) {
    const volatile unsigned* w = (const volatile unsigned*)(smem + POFF + idx * 8);
    const unsigned lo = __builtin_amdgcn_readfirstlane(w[0]), hi = __builtin_amdgcn_readfirstlane(w[1]);
    typedef __attribute__((address_space(1))) const float* gptr_t;
    return (const float*)(gptr_t)(((unsigned long long)hi << 32) | lo);
}
__device__ __forceinline__ Params opq(const unsigned char* smem) {
    Params q;
    q.x = ldp(smem, 0); q.c = ldp(smem, 1); q.ctx = ldp(smem, 2); q.c_ctx = ldp(smem, 3); q.ada_w = ldp(smem, 4); q.ada_b = ldp(smem, 5); q.norm_g = ldp(smem, 6);
    q.ffn_up = ldp(smem, 7); q.ffn_down = ldp(smem, 8); q.w_in = ldp(smem, 9); q.qk_gain = ldp(smem, 10); q.da_lambda = ldp(smem, 11); q.da_subln = ldp(smem, 12);
    q.hy_conv_w = ldp(smem, 13); q.hy_conv_b = ldp(smem, 14); q.hy_w1 = ldp(smem, 15); q.hy_b1 = ldp(smem, 16); q.hy_w2 = ldp(smem, 17); q.hy_b2 = ldp(smem, 18);
    q.hy_freq = ldp(smem, 19); q.hy_w3 = ldp(smem, 20); q.hy_skip = ldp(smem, 21); q.sg_ln_g = ldp(smem, 22); q.sg_ln_b = ldp(smem, 23); q.sg_w = ldp(smem, 24);
    q.sg_b = ldp(smem, 25); q.gate_w = ldp(smem, 26); q.gate_b = ldp(smem, 27); q.w_br = ldp(smem, 28); q.w_o = ldp(smem, 29);
    q.out = (float*)ldp(smem, 30); q.ws = (unsigned char*)ldp(smem, 31);
    return q;
}


#define XB_TMO      128
#define XB_XCNT(j)  (256  + 64 * (j))
#define XB_XSUB(j)  (1280 + 64 * (j))
#define XB_XGEN(j)  (2304 + 64 * (j))
#define XB_TOP      3328
#define XB_TOPGEN   3392
#define XCD_BAR_WORDS 3456
#define XB_SPIN_CAP (1u << 22)
__device__ __forceinline__ unsigned xb_ld(unsigned* p)              { return __hip_atomic_load(p, __ATOMIC_RELAXED, __HIP_MEMORY_SCOPE_AGENT); }
__device__ __forceinline__ unsigned xb_add(unsigned* p, unsigned v) { return __hip_atomic_fetch_add(p, v, __ATOMIC_RELAXED, __HIP_MEMORY_SCOPE_AGENT); }
__device__ __forceinline__ unsigned xb_xcc_id() { return (unsigned)__builtin_amdgcn_s_getreg((3 << 11) | 20) & 0xFu; }
#define XB_SPIN(cond, bar) do { unsigned _sp = 0; while (cond) { __builtin_amdgcn_s_sleep(1); \
    if ((++_sp & 255u) == 0u) { if (xb_ld(&(bar)[XB_TMO])) break; if (_sp > XB_SPIN_CAP) { atomicAdd(&(bar)[XB_TMO], 1u); break; } } } } while (0)
__device__ __forceinline__ void xcd_barrier_complete(unsigned* bar, unsigned x, unsigned& nloc, unsigned& nx) {
    const unsigned G = gridDim.x * gridDim.y * gridDim.z;
    unsigned sum, cnt, mine, sp = 0u;
    for (;;) {
        sum = 0u; cnt = 0u; mine = 0u;
#pragma unroll
        for (unsigned j = 0; j < 16; ++j) { const unsigned c = xb_ld(&bar[XB_XCNT(j)]); sum += c; cnt += (c > 0u) ? 1u : 0u; mine = (j == x) ? c : mine; }
        if (sum == G) break;
        __builtin_amdgcn_s_sleep(1);
        if ((++sp & 255u) == 0u) { if (xb_ld(&bar[XB_TMO])) break; if (sp > XB_SPIN_CAP) { atomicAdd(&bar[XB_TMO], 1u); break; } }
    }
    nloc = mine > 0u ? mine : 1u; nx = cnt > 0u ? cnt : 1u;
}
__device__ __forceinline__ void gsync(unsigned char* smem) {
    asm volatile("s_waitcnt vmcnt(0)" ::: "memory");
    __syncthreads();
    if (threadIdx.x == 0) {
        unsigned* bar = (unsigned*)((unsigned char*)ldp(smem, 31) + O_BAR);
        volatile unsigned* st = (volatile unsigned*)(smem + POFF + 256);
        const unsigned x = xb_xcc_id();
        __builtin_amdgcn_s_waitcnt(0);
        unsigned nloc = st[0], nx = st[1];
        if (nloc == 0u) { xcd_barrier_complete(bar, x, nloc, nx); st[0] = nloc; st[1] = nx; }
        const unsigned old = xb_add(&bar[XB_XSUB(x)], 1u);
        const unsigned gen = old / nloc;
        if (old + 1u == (gen + 1u) * nloc) {
            __builtin_amdgcn_fence(__ATOMIC_RELEASE, "agent");
            asm volatile("s_waitcnt vmcnt(0)" ::: "memory");
            const unsigned og = xb_add(&bar[XB_TOP], 1u);
            const unsigned tg = og / nx;
            if (og + 1u == (tg + 1u) * nx) xb_add(&bar[XB_TOPGEN], 1u);
            else XB_SPIN(xb_ld(&bar[XB_TOPGEN]) == tg, bar);
            __builtin_amdgcn_fence(__ATOMIC_ACQUIRE, "agent");
            xb_add(&bar[XB_XGEN(x)], 1u);
            asm volatile("s_waitcnt vmcnt(0)" ::: "memory");
        } else {
            XB_SPIN(xb_ld(&bar[XB_XGEN(x)]) == gen, bar);
            __builtin_amdgcn_fence(__ATOMIC_ACQUIRE, "agent");
            asm volatile("s_waitcnt vmcnt(0)" ::: "memory");
        }
    }
    __syncthreads();
}

__device__ __forceinline__ unsigned pk2(float a, float b) { f32x2 v = {a, b}; bf16v2 r = __builtin_convertvector(v, bf16v2); return __builtin_bit_cast(unsigned, r); }
__device__ __forceinline__ bf16_t f2bf(float a) { return (bf16_t)(pk2(a, 0.f) & 0xffffu); }
__device__ __forceinline__ float bf2f(bf16_t h) { return __uint_as_float((unsigned)h << 16); }
__device__ __forceinline__ float bflo(unsigned w) { return __uint_as_float(w << 16); }
__device__ __forceinline__ float bfhi(unsigned w) { return __uint_as_float(w & 0xffff0000u); }
__device__ __forceinline__ void row_bk(int r, int& b, int& kidx) { if (r < TL) { b = r >> 12; kidx = 256 + (r & 4095); } else { const int rc = r - TL; b = rc >> 8; kidx = rc & 255; } }
__device__ __forceinline__ float wave_sum(float v) {
#pragma unroll
    for (int o = 32; o > 0; o >>= 1) v += __shfl_xor(v, o);
    return v;
}
__device__ __forceinline__ float sigmoidf_(float v) { return __builtin_amdgcn_rcpf(1.0f + __builtin_amdgcn_exp2f(v * -1.4426950408889634f)); }

namespace pg8 {
constexpr int BM = 256, BK = 64, HALF = 128, HTB = HALF * BK * 2, STAGE_BYTES = 8 * HTB, NXCD = 8, WGM = 8;
__device__ __forceinline__ int lds_byte(int r, int c) { const int st = (r >> 4) * 2 + (c >> 5), rr = r & 15, cc = c & 31, ob = rr * 64 + cc * 2; return st * 1024 + (ob ^ (((ob >> 9) & 1) << 5)); }
__device__ __forceinline__ void stage_rc(int b, int& R, int& C) { const int st = b / 1024, sb = b % 1024, swz = sb ^ (((sb >> 9) & 1) << 5); R = (st >> 1) * 16 + swz / 64; C = (st & 1) * 32 + (swz % 64) / 2; }
__device__ __forceinline__ int perm32(int rho) { const int n = rho >> 4, i = rho & 15; return 8 * (i >> 2) + 4 * n + (i & 3); }
struct Unit { int pm, pn, k0, nt, split; };
struct Gemm { const bf16_t* A; const bf16_t* Bt; int M, N, K; };
struct StaticOrder {
    int nM, nN, nwg, G, c, ntk, ntail;
    __device__ void init(int M, int N, int K, int G_, int c_, bool split_tail) {
        nM = M / BM; nN = N / BM; G = G_; c = c_; ntk = K / BK; ntail = 0;
        if (split_tail) { nM -= 8; ntail = 128; }
        nwg = nM * nN;
    }
    __device__ __forceinline__ bool next(int i, Unit& u) const {
        const long L = (long)i * G + c; if (L >= nwg + ntail) return false;
        int pm, pn, k0 = 0, nt = ntk, split = 0;
        if (L >= nwg) {
            const int j = (int)L - nwg, cu = j >> 2, part = j & 3;
            pm = nM + (cu >> 2); pn = cu & 3; split = 1 + part;
            const int q = (ntk / 4) & ~1, big = (ntk - 4 * q) / 2;
            nt = q + ((part < big) ? 2 : 0);
            k0 = part * q + 2 * (part < big ? part : big);
        } else {
            int wgid = (int)L; { const int q = nwg / NXCD, r = nwg % NXCD, xcd = wgid % NXCD, off = wgid / NXCD; wgid = (xcd < r ? xcd * (q + 1) : r * (q + 1) + (xcd - r) * q) + off; }
            const int nig = WGM * nN, gid = wgid / nig, fm = gid * WGM, gsz = (nM - fm) < WGM ? (nM - fm) : WGM;
            pm = fm + ((wgid % nig) % gsz); pn = (wgid % nig) / gsz;
        }
        u.pm = pm; u.pn = pn; u.k0 = k0; u.nt = nt; u.split = split;
        return true;
    }
};

template <class Epi>
__device__ __forceinline__ void gemm_phase(LAS unsigned char* lds, const Gemm g, const StaticOrder& S, const Epi& E) {
    const int tid = TID(), wid = __builtin_amdgcn_readfirstlane(tid >> 6), lane = tid & 63, wr = wid >> 2, wc = wid & 3, fr = lane & 15, fq = lane >> 4;
    const int K = g.K;
    unsigned voffA[2], voffB[2];
#pragma unroll
    for (int i = 0; i < 2; ++i) { int R, C; stage_rc(tid * 16 + i * 8192, R, C); const int Rb = Epi::PERM ? ((R & ~31) + perm32(R & 31)) : R;
        voffA[i] = (unsigned)(R * K + C) * 2u; voffB[i] = (unsigned)(Rb * K + C) * 2u; }
    const size_t kstep = (size_t)(BK * 2);
    const size_t hstep = (size_t)HALF * K * 2;
    const size_t tstep = 2 * hstep;
    const unsigned ldsw = (unsigned)wid * 1024u;
    const int aoff = lds_byte(wr * 64 + fr, fq * 8), boff = lds_byte(wc * 32 + fr, fq * 8);
#define PG8_SA(b, h) (((b) * 2 + (h)) * HTB)
#define PG8_SB(b, h) ((4 + (b) * 2 + (h)) * HTB)
#define PG8_STAGE(bufoff, gbase, voff) do { _Pragma("unroll") for (int _i = 0; _i < 2; ++_i) \
        __builtin_amdgcn_global_load_lds((const unsigned*)((const char*)(gbase) + (voff)[_i]), (LAS unsigned*)(lds + (bufoff) + ldsw + _i * 8192), 16, 0, 0); } while (0)
#define PG8_LDA(dst, b, h) do { _Pragma("unroll") for (int m = 0; m < 4; ++m) _Pragma("unroll") for (int k = 0; k < 2; ++k) dst[m][k] = *(const LAS bf16x8*)(lds + PG8_SA(b, h) + aoff + m * 2048 + k * 1024); } while (0)
#define PG8_LDB(dst, b, h) do { _Pragma("unroll") for (int n = 0; n < 2; ++n) _Pragma("unroll") for (int k = 0; k < 2; ++k) dst[n][k] = *(const LAS bf16x8*)(lds + PG8_SB(b, h) + boff + n * 2048 + k * 1024); } while (0)
#define PG8_MMA(ai, bj, At, Bt) do { __builtin_amdgcn_s_setprio(1); _Pragma("unroll") for (int m = 0; m < 4; ++m) _Pragma("unroll") for (int n = 0; n < 2; ++n) _Pragma("unroll") for (int k = 0; k < 2; ++k) \
        acc[ai][bj][m][n] = __builtin_amdgcn_mfma_f32_16x16x32_bf16(Bt[n][k], At[m][k], acc[ai][bj][m][n], 0, 0, 0); __builtin_amdgcn_s_setprio(0); } while (0)
#define PG8_WAIT_V(n) asm volatile("s_waitcnt vmcnt(" #n ")" ::: "memory")
#define PG8_WAIT_L(n) asm volatile("s_waitcnt lgkmcnt(" #n ")" ::: "memory")
#define PG8_BAR __builtin_amdgcn_s_barrier()
#define PG8_SCHED __builtin_amdgcn_sched_barrier(0)
    Unit cur, nxt; int ui = 0;
    if (!S.next(0, cur)) return;
    f32x4 acc[2][2][4][2];
#pragma unroll
    for (int a = 0; a < 2; ++a)
#pragma unroll
        for (int b = 0; b < 2; ++b)
#pragma unroll
            for (int m = 0; m < 4; ++m)
#pragma unroll
                for (int n = 0; n < 2; ++n) acc[a][b][m][n] = (f32x4){0.f, 0.f, 0.f, 0.f};
    bf16x8 At[4][2], B0[2][2], B1[2][2];
    const char* cA = (const char*)g.A + (size_t)cur.pm * tstep + (size_t)cur.k0 * kstep; const char* cB = (const char*)g.Bt + (size_t)cur.pn * tstep + (size_t)cur.k0 * kstep;
    PG8_STAGE(PG8_SB(0, 0), cB, voffB); PG8_STAGE(PG8_SA(0, 0), cA, voffA); PG8_STAGE(PG8_SB(0, 1), cB + hstep, voffB); PG8_STAGE(PG8_SA(0, 1), cA + hstep, voffA);
    if (wr == 1) PG8_BAR;
    PG8_WAIT_V(4); PG8_BAR;
    PG8_STAGE(PG8_SB(1, 0), cB + kstep, voffB); PG8_STAGE(PG8_SA(1, 0), cA + kstep, voffA); PG8_STAGE(PG8_SB(1, 1), cB + hstep + kstep, voffB);
    PG8_WAIT_V(6); PG8_BAR;
    for (;;) {
        const bool has_next = S.next(ui + 1, nxt);
        const char* nA = has_next ? (const char*)g.A + (size_t)nxt.pm * tstep + (size_t)nxt.k0 * kstep : cA; const char* nB = has_next ? (const char*)g.Bt + (size_t)nxt.pn * tstep + (size_t)nxt.k0 * kstep : cB;
        const int nt = cur.nt;
        for (int t = 0; t < nt; t += 2) {
            const bool last = (t == nt - 2);
            const char* a1 = cA + (size_t)(t + 1) * kstep;
            const char* a2 = last ? nA : cA + (size_t)(t + 2) * kstep; const char* b2 = last ? nB : cB + (size_t)(t + 2) * kstep;
            const char* a3 = a2 + kstep; const char* b3 = b2 + kstep;
            if constexpr (Epi::RESCALE) { if (t == 8 || t == 12) E.rescale(acc, cur, t == 8 ? 0 : 1, wr, wc, fr, fq); }
            PG8_LDB(B0, 0, 0); PG8_SCHED; PG8_LDA(At, 0, 0); PG8_STAGE(PG8_SA(1, 1), a1 + hstep, voffA);
            PG8_WAIT_L(8); PG8_BAR; PG8_WAIT_L(0); PG8_MMA(0, 0, At, B0); PG8_BAR; PG8_SCHED;
            PG8_LDB(B1, 0, 1); PG8_STAGE(PG8_SB(0, 0), b2, voffB);
            PG8_BAR; PG8_WAIT_L(0); PG8_MMA(0, 1, At, B1); PG8_BAR;
            PG8_LDA(At, 0, 1); PG8_STAGE(PG8_SA(0, 0), a2, voffA);
            PG8_BAR; PG8_WAIT_L(0); PG8_MMA(1, 0, At, B0); PG8_BAR; PG8_SCHED;
            PG8_STAGE(PG8_SB(0, 1), b2 + hstep, voffB);
            PG8_WAIT_V(6); PG8_BAR; PG8_MMA(1, 1, At, B1); PG8_BAR;
            PG8_LDB(B0, 1, 0); PG8_SCHED; PG8_LDA(At, 1, 0); PG8_STAGE(PG8_SA(0, 1), a2 + hstep, voffA);
            PG8_WAIT_L(8); PG8_BAR; PG8_WAIT_L(0); PG8_MMA(0, 0, At, B0); PG8_BAR; PG8_SCHED;
            PG8_LDB(B1, 1, 1); PG8_STAGE(PG8_SB(1, 0), b3, voffB);
            PG8_BAR; PG8_WAIT_L(0); PG8_MMA(0, 1, At, B1); PG8_BAR;
            PG8_LDA(At, 1, 1); PG8_STAGE(PG8_SA(1, 0), a3, voffA);
            PG8_BAR; PG8_WAIT_L(0); PG8_MMA(1, 0, At, B0); PG8_BAR; PG8_SCHED;
            PG8_STAGE(PG8_SB(1, 1), b3 + hstep, voffB);
            PG8_WAIT_V(6); PG8_BAR; PG8_MMA(1, 1, At, B1); PG8_BAR;
        }
        E(acc, cur, wr, wc, fr, fq);
        if (!has_next) break;
#pragma unroll
        for (int a = 0; a < 2; ++a)
#pragma unroll
            for (int b = 0; b < 2; ++b)
#pragma unroll
                for (int m = 0; m < 4; ++m)
#pragma unroll
                    for (int n = 0; n < 2; ++n) acc[a][b][m][n] = (f32x4){0.f, 0.f, 0.f, 0.f};
        cur = nxt; cA = nA; cB = nB; ++ui;
    }
    PG8_WAIT_V(0);
    if (wr == 0) PG8_BAR;
    PG8_BAR;
#undef PG8_SA
#undef PG8_SB
#undef PG8_STAGE
#undef PG8_LDA
#undef PG8_LDB
#undef PG8_MMA
#undef PG8_WAIT_V
#undef PG8_WAIT_L
#undef PG8_BAR
#undef PG8_SCHED
}
}
using pg8::Unit;
typedef f32x4 AccT[2][2][4][2];

struct EpiSwiglu {
    static constexpr bool PERM = true, RESCALE = false;
    bf16_t* G;
    __device__ __forceinline__ void operator()(const AccT& acc, const Unit& u, int wr, int wc, int fr, int fq) const {
        const int row0 = u.pm * 256 + wr * 64 + fr, col0 = u.pn * 128 + wc * 32 + 8 * fq;
#pragma unroll
        for (int ai = 0; ai < 2; ++ai)
#pragma unroll
            for (int m = 0; m < 4; ++m) {
                float gv[8];
#pragma unroll
                for (int n = 0; n < 2; ++n)
#pragma unroll
                    for (int j = 0; j < 4; ++j) { const float a = acc[ai][0][m][n][j], b = acc[ai][1][m][n][j]; gv[n * 4 + j] = a * b * __builtin_amdgcn_rcpf(1.0f + __builtin_amdgcn_exp2f(a * -1.4426950408889634f)); }
                u32x4 w; w.x = pk2(gv[0], gv[1]); w.y = pk2(gv[2], gv[3]); w.z = pk2(gv[4], gv[5]); w.w = pk2(gv[6], gv[7]);
                *(u32x4*)(G + (size_t)(row0 + ai * 128 + m * 16) * FFH + col0) = w;
            }
    }
};
struct EpiResid {
    static constexpr bool PERM = true, RESCALE = false;
    const bf16_t* xin; bf16_t* xout; float* fout; float* xc; float* part; const float* mod; int gofs; float coef;
    __device__ __forceinline__ void operator()(const AccT& acc, const Unit& u, int wr, int wc, int fr, int fq) const {
        const int row0 = u.pm * 256 + wr * 64 + fr, col0 = u.pn * 256 + wc * 32 + 8 * fq;
        const bool lat = u.pm < 128;
        const int mr = lat ? (u.pm >> 4) : 8;
        const float* gp = mod + (size_t)mr * 9216 + gofs + col0;
#pragma unroll
        for (int bj = 0; bj < 2; ++bj) {
            const f32x4 g0 = *(const f32x4*)(gp + bj * 128) * coef, g1 = *(const f32x4*)(gp + bj * 128 + 4) * coef;
            if (lat) {
                u32x4 xw[8];
#pragma unroll
                for (int am = 0; am < 8; ++am) xw[am] = *(const u32x4*)(xin + (size_t)(row0 + (am >> 2) * 128 + (am & 3) * 16) * 1024 + col0 + bj * 128);
#pragma unroll
                for (int am = 0; am < 8; ++am) {
                    const int ai = am >> 2, m = am & 3;
                    const size_t o = (size_t)(row0 + ai * 128 + m * 16) * 1024 + col0 + bj * 128;
                    f32x4 v0 = {bflo(xw[am].x), bfhi(xw[am].x), bflo(xw[am].y), bfhi(xw[am].y)}, v1 = {bflo(xw[am].z), bfhi(xw[am].z), bflo(xw[am].w), bfhi(xw[am].w)};
                    v0 += g0 * acc[ai][bj][m][0]; v1 += g1 * acc[ai][bj][m][1];
                    if (fout) { *(f32x4*)(fout + o) = v0; *(f32x4*)(fout + o + 4) = v1; }
                    else { u32x4 w; w.x = pk2(v0[0], v0[1]); w.y = pk2(v0[2], v0[3]); w.z = pk2(v1[0], v1[1]); w.w = pk2(v1[2], v1[3]); *(u32x4*)(xout + o) = w; }
                }
            } else {
#pragma unroll
                for (int am = 0; am < 8; ++am) {
                    const int ai = am >> 2, m = am & 3;
                    const size_t o = (size_t)(row0 + ai * 128 + m * 16 - TL) * 1024 + col0 + bj * 128;
                    const f32x4 d0 = g0 * acc[ai][bj][m][0], d1 = g1 * acc[ai][bj][m][1];
                    if (u.split) { float* pp = part + (size_t)(u.split - 1) * 2048 * 1024 + o; *(f32x4*)pp = d0; *(f32x4*)(pp + 4) = d1; }
                    else { float* xp = xc + o; *(f32x4*)xp = *(const f32x4*)xp + d0; *(f32x4*)(xp + 4) = *(const f32x4*)(xp + 4) + d1; }
                }
            }
        }
    }
};
struct EpiIn {
    static constexpr bool PERM = true, RESCALE = false;
    bf16_t *qn, *kn, *vraw, *hyraw, *sgraw;
    __device__ __forceinline__ void operator()(const AccT& acc, const Unit& u, int wr, int wc, int fr, int fq) const {
        const int row0 = u.pm * 256 + wr * 64 + fr, pn = u.pn;
#pragma unroll
        for (int ai = 0; ai < 2; ++ai)
#pragma unroll
            for (int m = 0; m < 4; ++m) {
                const int r = row0 + ai * 128 + m * 16;
#pragma unroll
                for (int bj = 0; bj < 2; ++bj) {
                    const f32x4 v0 = acc[ai][bj][m][0], v1 = acc[ai][bj][m][1];
                    u32x4 w; w.x = pk2(v0[0], v0[1]); w.y = pk2(v0[2], v0[3]); w.z = pk2(v1[0], v1[1]); w.w = pk2(v1[2], v1[3]);
                    const int cl = bj * 128 + wc * 32 + 8 * fq;
                    bf16_t* dst;
                    if (pn < 4) {
                        int b, kidx; row_bk(r, b, kidx);
                        const int cc = (pn & 1) * 256 + cl, head = cc >> 7, comp = (cc >> 6) & 1, d = cc & 63;
                        dst = (pn < 2 ? qn : kn) + ((size_t)((b * 4 + head) * 2 + comp) * NK + kidx) * 64 + d;
                    } else if (pn < 6) dst = vraw + (size_t)r * 512 + (pn - 4) * 256 + cl;
                    else if (pn < 9) dst = hyraw + (size_t)r * 768 + (pn - 6) * 256 + cl;
                    else dst = sgraw + (size_t)r * 512 + (pn - 9) * 256 + cl;
                    *(u32x4*)dst = w;
                }
            }
    }
};
struct EpiGate3 {
    static constexpr bool PERM = true, RESCALE = false;
    bf16_t* g3; const float* bias;
    __device__ __forceinline__ void operator()(const AccT& acc, const Unit& u, int wr, int wc, int fr, int fq) const {
        const int row0 = u.pm * 256 + wr * 64 + fr, col0 = u.pn * 256 + wc * 32 + 8 * fq;
#pragma unroll
        for (int bj = 0; bj < 2; ++bj) {
            const f32x4 b0 = *(const f32x4*)(bias + col0 + bj * 128), b1 = *(const f32x4*)(bias + col0 + bj * 128 + 4);
#pragma unroll
            for (int ai = 0; ai < 2; ++ai)
#pragma unroll
                for (int m = 0; m < 4; ++m) {
                    const f32x4 v0 = acc[ai][bj][m][0] + b0, v1 = acc[ai][bj][m][1] + b1;
                    float gv[8];
#pragma unroll
                    for (int j = 0; j < 4; ++j) { gv[j] = fmaxf(sigmoidf_(v0[j]), 1e-5f); gv[4 + j] = fmaxf(sigmoidf_(v1[j]), 1e-5f); }
                    u32x4 w; w.x = pk2(gv[0], gv[1]); w.y = pk2(gv[2], gv[3]); w.z = pk2(gv[4], gv[5]); w.w = pk2(gv[6], gv[7]);
                    *(u32x4*)(g3 + (size_t)(row0 + ai * 128 + m * 16) * 3072 + col0 + bj * 128) = w;
                }
        }
    }
};
struct EpiMergeR {
    static constexpr bool PERM = true, RESCALE = true;
    const bf16_t* g3; bf16_t* mb;
    __device__ __forceinline__ void rescale(AccT& acc, const Unit& u, int which, int wr, int wc, int fr, int fq) const {
        const int row0 = u.pm * 256 + wr * 64 + fr, col0 = u.pn * 256 + wc * 32 + 8 * fq;
        const bf16_t* gb = g3 + (size_t)row0 * 3072 + which * 1024 + col0;
#pragma unroll
        for (int ai = 0; ai < 2; ++ai)
#pragma unroll
            for (int mh = 0; mh < 2; ++mh) {
                u32x4 nw[2][2], dw[2][2];
#pragma unroll
                for (int mm = 0; mm < 2; ++mm)
#pragma unroll
                    for (int bj = 0; bj < 2; ++bj) { const bf16_t* gp = gb + (size_t)(ai * 128 + (mh * 2 + mm) * 16) * 3072 + bj * 128; nw[mm][bj] = *(const u32x4*)gp; dw[mm][bj] = *(const u32x4*)(gp + 1024); }
#pragma unroll
                for (int mm = 0; mm < 2; ++mm)
#pragma unroll
                    for (int bj = 0; bj < 2; ++bj) {
                        const u32x4 n4 = nw[mm][bj], d4 = dw[mm][bj];
                        const f32x4 r0 = {bflo(n4.x) * __builtin_amdgcn_rcpf(bflo(d4.x)), bfhi(n4.x) * __builtin_amdgcn_rcpf(bfhi(d4.x)), bflo(n4.y) * __builtin_amdgcn_rcpf(bflo(d4.y)), bfhi(n4.y) * __builtin_amdgcn_rcpf(bfhi(d4.y))};
                        const f32x4 r1 = {bflo(n4.z) * __builtin_amdgcn_rcpf(bflo(d4.z)), bfhi(n4.z) * __builtin_amdgcn_rcpf(bfhi(d4.z)), bflo(n4.w) * __builtin_amdgcn_rcpf(bflo(d4.w)), bfhi(n4.w) * __builtin_amdgcn_rcpf(bfhi(d4.w))};
                        acc[ai][bj][mh * 2 + mm][0] *= r0; acc[ai][bj][mh * 2 + mm][1] *= r1;
                    }
                __builtin_amdgcn_sched_barrier(0);
            }
    }
    __device__ __forceinline__ void operator()(const AccT& acc, const Unit& u, int wr, int wc, int fr, int fq) const {
        const int row0 = u.pm * 256 + wr * 64 + fr, col0 = u.pn * 256 + wc * 32 + 8 * fq;
#pragma unroll
        for (int bj = 0; bj < 2; ++bj) {
            u32x4 gw[8];
#pragma unroll
            for (int am = 0; am < 8; ++am) gw[am] = *(const u32x4*)(g3 + (size_t)(row0 + (am >> 2) * 128 + (am & 3) * 16) * 3072 + 2048 + col0 + bj * 128);
#pragma unroll
            for (int am = 0; am < 8; ++am) {
                const int ai = am >> 2, m = am & 3;
                const f32x4 v0 = acc[ai][bj][m][0], v1 = acc[ai][bj][m][1];
                u32x4 w; w.x = pk2(v0[0] * bflo(gw[am].x), v0[1] * bfhi(gw[am].x)); w.y = pk2(v0[2] * bflo(gw[am].y), v0[3] * bfhi(gw[am].y));
                w.z = pk2(v1[0] * bflo(gw[am].z), v1[1] * bfhi(gw[am].z)); w.w = pk2(v1[2] * bflo(gw[am].w), v1[3] * bfhi(gw[am].w));
                *(u32x4*)(mb + (size_t)(row0 + ai * 128 + m * 16) * 1024 + col0 + bj * 128) = w;
            }
        }
    }
};

template <class Epi>
__device__ __forceinline__ void run_gemm(unsigned char* smem, const bf16_t* A, const bf16_t* Bt, int M, int N, int K, const Epi& E, bool split_tail = false) {
    asm volatile("" : "+s"(M), "+s"(N), "+s"(K));
    pg8::Gemm g; g.A = A; g.Bt = Bt; g.M = M; g.N = N; g.K = K;
    pg8::StaticOrder S; S.init(M, N, K, gridDim.x, blockIdx.x, split_tail);
    pg8::gemm_phase<Epi>((LAS unsigned char*)smem, g, S, E);
}

__device__ __forceinline__ void mod_item(const Params& p, unsigned char* smem, int m) {
    float* s = (float*)smem;
    float* red = s + 9 * 1024;
    const int tid = TID(), l = m / 144, cb = m % 144;
    __syncthreads();
    for (int i = tid; i < 9216; i += NT) { const float v = (i < 8192) ? p.c[i] : p.c_ctx[i - 8192]; s[i] = v / (1.0f + __expf(-v)); }
    __syncthreads();
    const int kg = tid >> 6, cn = tid & 63, col = cb * 64 + cn;
    const float* w = p.ada_w + (size_t)l * 1024 * 9216 + col;
    float a0 = 0, a1 = 0, a2 = 0, a3 = 0, a4 = 0, a5 = 0, a6 = 0, a7 = 0, a8 = 0;
    for (int k = kg * 128; k < kg * 128 + 128; ++k) {
        const float wv = w[(size_t)k * 9216];
        a0 += s[k] * wv; a1 += s[1024 + k] * wv; a2 += s[2048 + k] * wv; a3 += s[3072 + k] * wv; a4 += s[4096 + k] * wv;
        a5 += s[5120 + k] * wv; a6 += s[6144 + k] * wv; a7 += s[7168 + k] * wv; a8 += s[8192 + k] * wv;
    }
    float* rp = red + kg * 576 + cn;
    rp[0] = a0; rp[64] = a1; rp[128] = a2; rp[192] = a3; rp[256] = a4; rp[320] = a5; rp[384] = a6; rp[448] = a7; rp[512] = a8;
    __syncthreads();
    float* MOD = (float*)(p.ws + O_MOD);
    for (int i = tid; i < 576; i += NT) {
        float v = 0; for (int q = 0; q < 8; ++q) v += red[q * 576 + i];
        const int r = i >> 6, c2 = cb * 64 + (i & 63);
        MOD[((size_t)l * 9 + r) * 9216 + c2] = v + p.ada_b[(size_t)l * 9216 + c2];
    }
}

__device__ __forceinline__ void filt_item(const Params& p, unsigned char* smem, int l, int n, int item, float* filt, float* l1p) {
    float* z = (float*)smem;
    float* h1 = z + 16 * 36;
    float* h2 = h1 + 16 * 64;
    const int tid = TID(), t0 = item * 16;
    __syncthreads();
    for (int i = tid; i < 16 * 33; i += NT) {
        const int tt = i / 33, e = i % 33, t = t0 + tt; float v;
        if (e == 0) v = (float)t / (float)(n - 1);
        else { const int bi = (e - 1) & 15; const float band = 1e-4f + (float)bi * ((15.0f - 1e-4f) / 15.0f); const float wv = (6.283185307179586f / (float)n) * (float)t;
            v = (e <= 16) ? cosf(band * wv) : -sinf(band * wv); }
        z[tt * 36 + e] = v;
    }
    __syncthreads();
    for (int i = tid; i < 16 * 64; i += NT) {
        const int tt = i >> 6, j = i & 63; float a = p.hy_b1[l * 64 + j];
        for (int e = 0; e < 33; ++e) a += z[tt * 36 + e] * p.hy_w1[((size_t)l * 33 + e) * 64 + j];
        h1[i] = sinf(p.hy_freq[l * 64 + j] * a);
    }
    __syncthreads();
    for (int i = tid; i < 16 * 64; i += NT) {
        const int tt = i >> 6, j = i & 63; float a = p.hy_b2[l * 64 + j];
        for (int e = 0; e < 64; ++e) a += h1[tt * 64 + e] * p.hy_w2[((size_t)l * 64 + e) * 64 + j];
        h2[i] = sinf(p.hy_freq[l * 64 + j] * a);
    }
    __syncthreads();
    const float min_decay = -3.0701134573253945f, max_decay = -15.350567286626973f;
#pragma unroll 1
    for (int cc = 0; cc < 2; ++cc) {
        const int col = tid + cc * 512;
        float acc[16];
#pragma unroll
        for (int tt = 0; tt < 16; ++tt) acc[tt] = 0.f;
        for (int e = 0; e < 64; ++e) {
            const float wv = p.hy_w3[((size_t)l * 64 + e) * 1024 + col];
#pragma unroll
            for (int tt = 0; tt < 16; ++tt) acc[tt] += h2[tt * 64 + e] * wv;
        }
        const int dir = col >> 9, oc = col & 511;
        const float ad = fabsf(min_decay + (float)oc * ((max_decay - min_decay) / 511.0f));
        float* dst = filt + (size_t)oc * (2 * n);
        float l1 = 0.f;
#pragma unroll
        for (int tt = 0; tt < 16; ++tt) {
            const int t = t0 + tt; const float tn = (float)t / (float)(n - 1);
            float v = acc[tt] * __expf(-tn * ad);
            if (dir == 0) dst[t] = v;
            else if (t == 0) { dst[n] = 0.f; v = 0.f; }
            else dst[2 * n - t] = v;
            l1 += fabsf(v);
        }
        l1p[(size_t)item * 1024 + col] = l1;
    }
}

struct WDesc { const float* src; bf16_t* dst; int ld, K; };
__device__ __forceinline__ WDesc wdesc(const Params& p, int l, int ti) {
    WDesc d; int K, nrb, mapsw = 0; const float* src; bf16_t* dst; int ld;
    const size_t L = (size_t)l;
    if (ti < 1408) { src = p.ffn_up + (L * 2 + 0) * 1024 * 5632; ld = 5632; K = 1024; dst = (bf16_t*)(p.ws + O_WUP0); mapsw = 1; }
    else if ((ti -= 1408) < 1408) { src = p.ffn_up + (L * 2 + 1) * 1024 * 5632; ld = 5632; K = 1024; dst = (bf16_t*)(p.ws + O_WUP1); mapsw = 1; }
    else if ((ti -= 1408) < 704) { src = p.ffn_down + (L * 2 + 0) * 2816 * 1024; ld = 1024; K = 2816; dst = (bf16_t*)(p.ws + O_WDN0); }
    else if ((ti -= 704) < 704) { src = p.ffn_down + (L * 2 + 1) * 2816 * 1024; ld = 1024; K = 2816; dst = (bf16_t*)(p.ws + O_WDN1); }
    else if ((ti -= 704) < 704) { src = p.w_in + L * 1024 * 2816; ld = 2816; K = 1024; dst = (bf16_t*)(p.ws + O_WIN); }
    else if ((ti -= 704) < 768) { src = p.gate_w + L * 1024 * 3072; ld = 3072; K = 1024; dst = (bf16_t*)(p.ws + O_WG); }
    else if ((ti -= 768) < 256) { src = p.w_br + L * 1024 * 1024; ld = 1024; K = 1024; dst = (bf16_t*)(p.ws + O_WBR); }
    else { ti -= 256; src = p.w_o + L * 1024 * 1024; ld = 1024; K = 1024; dst = (bf16_t*)(p.ws + O_WO); }
    nrb = K / 64;
    const int nb = ti / nrb, kb = ti % nrb, n0 = nb * 64, k0 = kb * 64;
    int scol = n0;
    if (mapsw) { const int pn = n0 >> 8, half = (n0 >> 7) & 1; scol = half * 2816 + pn * 128 + (n0 & 127); }
    d.src = src + (size_t)k0 * ld + scol; d.dst = dst + (size_t)n0 * K + k0; d.ld = ld; d.K = K;
    return d;
}
__device__ __forceinline__ void wconv_tiles(const Params& p, unsigned char* smem, int l, int nw) {
    float* tile = (float*)smem;
    const int tid = TID(), kk0 = tid >> 6, nn0 = tid & 63, nn = tid >> 3, ks = tid & 7;
    int ti = blockIdx.x;
    if (ti >= nw) return;
    WDesc d = wdesc(p, l, ti);
    float v[8];
#pragma unroll
    for (int i = 0; i < 8; ++i) v[i] = d.src[(size_t)(kk0 + 8 * i) * d.ld + nn0];
    for (;;) {
        const int tn = ti + gridDim.x; const bool more = tn < nw;
        WDesc dn = d; float vn[8];
        if (more) { dn = wdesc(p, l, tn);
#pragma unroll
            for (int i = 0; i < 8; ++i) vn[i] = dn.src[(size_t)(kk0 + 8 * i) * dn.ld + nn0]; }
        __syncthreads();
#pragma unroll
        for (int i = 0; i < 8; ++i) tile[(kk0 + 8 * i) * 65 + nn0] = v[i];
        __syncthreads();
        float o[8];
#pragma unroll
        for (int j = 0; j < 8; ++j) o[j] = tile[(ks * 8 + j) * 65 + nn];
        u32x4 w; w.x = pk2(o[0], o[1]); w.y = pk2(o[2], o[3]); w.z = pk2(o[4], o[5]); w.w = pk2(o[6], o[7]);
        *(u32x4*)(d.dst + (size_t)nn * d.K + ks * 8) = w;
        if (!more) break;
        d = dn; ti = tn;
#pragma unroll
        for (int i = 0; i < 8; ++i) v[i] = vn[i];
    }
}

__device__ __forceinline__ void aux_phase(const Params& p, unsigned char* smem, int l) {
    const int nmod = (l == 0) ? 288 : 0, nf = 256, nfc = (l == 0) ? 16 : 0, nw = 6208;
    const int total = nmod + nf + nfc;
    for (int rep = 0; rep < REP_AUX; ++rep) {
        for (int it = blockIdx.x; it < total; it += gridDim.x) {
            int i = it;
            if (i < nmod) { mod_item(p, smem, i); continue; }
            i -= nmod;
            if (i < nf) { filt_item(p, smem, l, 4096, i, (float*)(p.ws + O_FILT), (float*)(p.ws + O_L1P)); continue; }
            i -= nf;
            filt_item(p, smem, l, 256, i, (float*)(p.ws + O_FILTC), (float*)(p.ws + O_L1PC));
        }
        wconv_tiles(p, smem, l, nw);
    }
}

__device__ __forceinline__ void norm_phase(const Params& p, int l, int sub, int M, bool first, const bf16_t* xl) {
    const float* PART = (const float*)(p.ws + O_PART);
    const int tid = TID(), lane = tid & 63, wv = tid >> 6;
    const float* MOD = (const float*)(p.ws + O_MOD) + (size_t)l * 9 * 9216;
    const float* gn = p.norm_g + ((size_t)l * 3 + sub) * 1024;
    float* XC = (float*)(p.ws + O_XC);
    bf16_t* H = (bf16_t*)(p.ws + O_H);
    const int rstep = gridDim.x * 8;
    for (int rep = 0; rep < REP_NORM; ++rep)
    for (int r0 = blockIdx.x * 8 + wv; r0 < M; r0 += 4 * rstep) {
        f32x4 v[4][4]; float ss[4];
#pragma unroll
        for (int k = 0; k < 4; ++k) {
            const int r = r0 + k * rstep; ss[k] = 0.f;
            if (r >= M) { continue; }
            if (r >= TL) {
                const float* src = (first ? p.ctx : XC) + (size_t)(r - TL) * 1024;
#pragma unroll
                for (int i = 0; i < 4; ++i) { const size_t o = (size_t)(r - TL) * 1024 + i * 256 + lane * 4; v[k][i] = *(const f32x4*)(src + i * 256 + lane * 4);
                    if (!first) { v[k][i] += *(const f32x4*)(PART + o); v[k][i] += *(const f32x4*)(PART + 2048 * 1024 + o); v[k][i] += *(const f32x4*)(PART + 2 * 2048 * 1024 + o); v[k][i] += *(const f32x4*)(PART + 3 * 2048 * 1024 + o); } }
            } else if (first) {
                const float* src = p.x + (size_t)r * 1024;
#pragma unroll
                for (int i = 0; i < 4; ++i) v[k][i] = *(const f32x4*)(src + i * 256 + lane * 4);
            } else {
                const bf16_t* src = xl + (size_t)r * 1024;
#pragma unroll
                for (int i = 0; i < 4; ++i) { const u32x2 w = *(const u32x2*)(src + i * 256 + lane * 4); v[k][i] = (f32x4){bflo(w.x), bfhi(w.x), bflo(w.y), bfhi(w.y)}; }
            }
        }
#pragma unroll
        for (int k = 0; k < 4; ++k) {
            const int r = r0 + k * rstep;
            if (r >= M) continue;
            if (r >= TL) {
#pragma unroll
                for (int i = 0; i < 4; ++i) *(f32x4*)(XC + (size_t)(r - TL) * 1024 + i * 256 + lane * 4) = v[k][i];
            } else if (first) {
                bf16_t* dstx = (bf16_t*)p.out + (size_t)r * 1024;
#pragma unroll
                for (int i = 0; i < 4; ++i) { u32x2 w; w.x = pk2(v[k][i][0], v[k][i][1]); w.y = pk2(v[k][i][2], v[k][i][3]); *(u32x2*)(dstx + i * 256 + lane * 4) = w; v[k][i] = (f32x4){bflo(w.x), bfhi(w.x), bflo(w.y), bfhi(w.y)}; }
            }
            float s2 = 0.f;
#pragma unroll
            for (int i = 0; i < 4; ++i) s2 += v[k][i][0] * v[k][i][0] + v[k][i][1] * v[k][i][1] + v[k][i][2] * v[k][i][2] + v[k][i][3] * v[k][i][3];
            s2 = wave_sum(s2);
            const float rinv = rsqrtf(s2 * (1.0f / 1024.0f) + 1e-6f);
            const int mr = r < TL ? (r >> 12) : 8;
            const float* sh = MOD + (size_t)mr * 9216 + (3 * sub) * 1024;
            const float* sc = sh + 1024;
#pragma unroll
            for (int i = 0; i < 4; ++i) {
                const int c = i * 256 + lane * 4;
                const f32x4 g4 = *(const f32x4*)(gn + c), s4 = *(const f32x4*)(sc + c), h4 = *(const f32x4*)(sh + c);
                const f32x4 y = v[k][i] * rinv * g4 * (s4 + 1.0f) + h4;
                u32x2 w; w.x = pk2(y[0], y[1]); w.y = pk2(y[2], y[3]);
                *(u32x2*)(H + (size_t)r * 1024 + c) = w;
            }
        }
    }
}

#define ZI(i) ((i) + ((i) >> 4))
__device__ __forceinline__ f32x2 cmul(f32x2 a, f32x2 b) { return (f32x2){a.x * b.x - a.y * b.y, a.x * b.y + a.y * b.x}; }
__device__ __forceinline__ f32x2 cmulc(f32x2 a, f32x2 b) { return (f32x2){a.x * b.x + a.y * b.y, a.y * b.x - a.x * b.y}; }
__device__ __forceinline__ void dif8(f32x2 (&x)[8]) {
    const float C = 0.70710678118654752f;
    { f32x2 t;
      t = x[0] - x[4]; x[0] += x[4]; x[4] = t;
      t = x[1] - x[5]; x[1] += x[5]; x[5] = (f32x2){C * (t.x + t.y), C * (t.y - t.x)};
      t = x[2] - x[6]; x[2] += x[6]; x[6] = (f32x2){t.y, -t.x};
      t = x[3] - x[7]; x[3] += x[7]; x[7] = (f32x2){C * (t.y - t.x), -C * (t.x + t.y)}; }
#pragma unroll
    for (int b = 0; b < 8; b += 4) { f32x2 t;
      t = x[b] - x[b + 2]; x[b] += x[b + 2]; x[b + 2] = t;
      t = x[b + 1] - x[b + 3]; x[b + 1] += x[b + 3]; x[b + 3] = (f32x2){t.y, -t.x}; }
#pragma unroll
    for (int b = 0; b < 8; b += 2) { const f32x2 t = x[b] - x[b + 1]; x[b] += x[b + 1]; x[b + 1] = t; }
}
__device__ __forceinline__ void idif8(f32x2 (&x)[8]) {
    const float C = 0.70710678118654752f;
#pragma unroll
    for (int b = 0; b < 8; b += 2) { const f32x2 t = x[b] - x[b + 1]; x[b] += x[b + 1]; x[b + 1] = t; }
#pragma unroll
    for (int b = 0; b < 8; b += 4) { f32x2 v, u;
      v = x[b + 2]; u = x[b]; x[b] = u + v; x[b + 2] = u - v;
      v = (f32x2){-x[b + 3].y, x[b + 3].x}; u = x[b + 1]; x[b + 1] = u + v; x[b + 3] = u - v; }
    { f32x2 v, u, t;
      v = x[4]; u = x[0]; x[0] = u + v; x[4] = u - v;
      t = x[5]; v = (f32x2){C * (t.x - t.y), C * (t.x + t.y)}; u = x[1]; x[1] = u + v; x[5] = u - v;
      t = x[6]; v = (f32x2){-t.y, t.x}; u = x[2]; x[2] = u + v; x[6] = u - v;
      t = x[7]; v = (f32x2){-C * (t.x + t.y), C * (t.x - t.y)}; u = x[3]; x[3] = u + v; x[7] = u - v; }
}
__device__ __forceinline__ void twid8(f32x2 (&x)[8], int pidx, int L, bool conj) {
    const float rev = -(float)pidx / (float)L;
    const float s = __builtin_amdgcn_sinf(rev), c = __builtin_amdgcn_cosf(rev);
    const f32x2 w1 = {c, s}; const f32x2 w2 = cmul(w1, w1), w3 = cmul(w2, w1), w4 = cmul(w2, w2), w5 = cmul(w4, w1), w6 = cmul(w3, w3), w7 = cmul(w4, w3);
    if (!conj) { x[1] = cmul(x[1], w4); x[2] = cmul(x[2], w2); x[3] = cmul(x[3], w6); x[4] = cmul(x[4], w1); x[5] = cmul(x[5], w5); x[6] = cmul(x[6], w3); x[7] = cmul(x[7], w7); }
    else { x[1] = cmulc(x[1], w4); x[2] = cmulc(x[2], w2); x[3] = cmulc(x[3], w6); x[4] = cmulc(x[4], w1); x[5] = cmulc(x[5], w5); x[6] = cmulc(x[6], w3); x[7] = cmulc(x[7], w7); }
}
__device__ __forceinline__ void fft_fwd(f32x2* z) {
    const int tid = TID();
#pragma unroll 1
    for (int L = 8192; L >= 16; L >>= 3) {
        const int S = L >> 3;
#pragma unroll
        for (int qq = 0; qq < 2; ++qq) { const int q = tid + qq * NT;
            const int pidx = q & (S - 1), B = (q / S) * L + pidx;
            f32x2 x[8];
#pragma unroll
            for (int j = 0; j < 8; ++j) x[j] = z[ZI(B + j * S)];
            dif8(x); twid8(x, pidx, L, false);
#pragma unroll
            for (int j = 0; j < 8; ++j) z[ZI(B + j * S)] = x[j];
        }
        __syncthreads();
    }
#pragma unroll 4
    for (int q = tid; q < 4096; q += NT) { const f32x2 a = z[ZI(2 * q)], b = z[ZI(2 * q + 1)]; z[ZI(2 * q)] = a + b; z[ZI(2 * q + 1)] = a - b; }
    __syncthreads();
}
__device__ __forceinline__ void fft_inv(f32x2* z) {
    const int tid = TID();
#pragma unroll 4
    for (int q = tid; q < 4096; q += NT) { const f32x2 a = z[ZI(2 * q)], b = z[ZI(2 * q + 1)]; z[ZI(2 * q)] = a + b; z[ZI(2 * q + 1)] = a - b; }
    __syncthreads();
#pragma unroll 1
    for (int L = 16; L <= 8192; L <<= 3) {
        const int S = L >> 3;
#pragma unroll
        for (int qq = 0; qq < 2; ++qq) { const int q = tid + qq * NT;
            const int pidx = q & (S - 1), B = (q / S) * L + pidx;
            f32x2 x[8];
#pragma unroll
            for (int j = 0; j < 8; ++j) x[j] = z[ZI(B + j * S)];
            twid8(x, pidx, L, true); idif8(x);
#pragma unroll
            for (int j = 0; j < 8; ++j) z[ZI(B + j * S)] = x[j];
        }
        __syncthreads();
    }
}

__device__ __forceinline__ void fft_fwd_h(f32x2* z, int lt) {
#pragma unroll 1
    for (int L = 8192; L >= 16; L >>= 3) {
        const int S = L >> 3;
#pragma unroll 2
        for (int qq = 0; qq < 4; ++qq) { const int q = lt + qq * 256;
            const int pidx = q & (S - 1), B = (q / S) * L + pidx;
            f32x2 x[8];
#pragma unroll
            for (int j = 0; j < 8; ++j) x[j] = z[ZI(B + j * S)];
            dif8(x); twid8(x, pidx, L, false);
#pragma unroll
            for (int j = 0; j < 8; ++j) z[ZI(B + j * S)] = x[j];
        }
        __syncthreads();
    }
#pragma unroll 4
    for (int q = lt; q < 4096; q += 256) { const f32x2 a = z[ZI(2 * q)], b = z[ZI(2 * q + 1)]; z[ZI(2 * q)] = a + b; z[ZI(2 * q + 1)] = a - b; }
    __syncthreads();
}
__device__ __forceinline__ void fft_inv_h(f32x2* z, int lt) {
#pragma unroll 4
    for (int q = lt; q < 4096; q += 256) { const f32x2 a = z[ZI(2 * q)], b = z[ZI(2 * q + 1)]; z[ZI(2 * q)] = a + b; z[ZI(2 * q + 1)] = a - b; }
    __syncthreads();
#pragma unroll 1
    for (int L = 16; L <= 8192; L <<= 3) {
        const int S = L >> 3;
#pragma unroll 2
        for (int qq = 0; qq < 4; ++qq) { const int q = lt + qq * 256;
            const int pidx = q & (S - 1), B = (q / S) * L + pidx;
            f32x2 x[8];
#pragma unroll
            for (int j = 0; j < 8; ++j) x[j] = z[ZI(B + j * S)];
            twid8(x, pidx, L, true); idif8(x);
#pragma unroll
            for (int j = 0; j < 8; ++j) z[ZI(B + j * S)] = x[j];
        }
        __syncthreads();
    }
}

__device__ __forceinline__ void filtfft_item(const Params& p, unsigned char* smem, int oc) {
    f32x2* z = (f32x2*)smem;
    float* red = (float*)(smem + 8704 * 8);
    const int tid = TID();
    const float* filt = (const float*)(p.ws + O_FILT) + (size_t)oc * 8192;
    const float* l1p = (const float*)(p.ws + O_L1P);
    __syncthreads();
#pragma unroll 4
    for (int i = tid; i < 8192; i += NT) z[ZI(i)] = (f32x2){filt[i], 0.f};
    if (tid < 256) red[tid] = l1p[(size_t)tid * 1024 + oc] + l1p[(size_t)tid * 1024 + 512 + oc];
    __syncthreads();
    if (tid < 64) { float v = red[tid] + red[tid + 64] + red[tid + 128] + red[tid + 192]; v = wave_sum(v); if (tid == 0) red[256] = v; }
    fft_fwd(z);
    const float sc = 1.0f / (red[256] * 8192.0f);
    f32x2* fh = (f32x2*)(p.ws + O_FH) + (size_t)oc * 8192;
#pragma unroll 4
    for (int i = tid; i < 8192; i += NT) fh[i] = z[ZI(i)] * sc;
}

__device__ __forceinline__ void hyfft_item(const Params& p, unsigned char* smem, int l, int ch, int bp) {
    f32x2* z = (f32x2*)smem;
    f32x2* zz = (f32x2*)(smem + 8704 * 8);
    const int tid = TID();
    const bf16_t* HV = (const bf16_t*)(p.ws + O_HV);
    const bf16_t* v0 = HV + ((size_t)(2 * bp) * 768 + ch) * 4096; const bf16_t* v1 = v0 + (size_t)768 * 4096;
    const f32x2* fh0 = (const f32x2*)(p.ws + O_FH) + (size_t)ch * 8192; const f32x2* fh1 = fh0 + (size_t)256 * 8192;
    const float sk0 = p.hy_skip[(size_t)l * 512 + ch], sk1 = p.hy_skip[(size_t)l * 512 + 256 + ch];
    bf16_t a0[8], a1[8];
#pragma unroll
    for (int k = 0; k < 8; ++k) { a0[k] = v0[tid + k * NT]; a1[k] = v1[tid + k * NT]; }
    f32x2 fr[16];
#pragma unroll
    for (int k = 0; k < 16; ++k) fr[k] = fh0[tid + k * NT];
    __syncthreads();
#pragma unroll
    for (int k = 0; k < 8; ++k) { const int t = tid + k * NT; z[ZI(t)] = (f32x2){bf2f(a0[k]), bf2f(a1[k])}; z[ZI(4096 + t)] = (f32x2){0.f, 0.f}; }
    __syncthreads();
    fft_fwd(z);
#pragma unroll
    for (int k = 0; k < 16; ++k) { const int i = tid + k * NT; z[ZI(i)] = cmul(z[ZI(i)], fr[k]); }
    bf16_t x0[8], x1[8];
#pragma unroll
    for (int k = 0; k < 8; ++k) { x0[k] = v0[(size_t)256 * 4096 + tid + k * NT]; x1[k] = v1[(size_t)256 * 4096 + tid + k * NT]; }
#pragma unroll
    for (int k = 0; k < 16; ++k) fr[k] = fh1[tid + k * NT];
    __syncthreads();
    fft_inv(z);
#pragma unroll
    for (int k = 0; k < 8; ++k) {
        const int t = tid + k * NT;
        f32x2 y = z[ZI(t)];
        y.x += bf2f(a0[k]) * sk0; y.y += bf2f(a1[k]) * sk0;
        const f32x2 zv = {bf2f(x0[k]) * y.x, bf2f(x1[k]) * y.y};
        zz[t] = zv; z[ZI(t)] = zv; z[ZI(4096 + t)] = (f32x2){0.f, 0.f};
    }
    __syncthreads();
    fft_fwd(z);
#pragma unroll
    for (int k = 0; k < 16; ++k) { const int i = tid + k * NT; z[ZI(i)] = cmul(z[ZI(i)], fr[k]); }
#pragma unroll
    for (int k = 0; k < 8; ++k) { x0[k] = v0[(size_t)512 * 4096 + tid + k * NT]; x1[k] = v1[(size_t)512 * 4096 + tid + k * NT]; }
    __syncthreads();
    fft_inv(z);
    bf16_t* YBT = (bf16_t*)(p.ws + O_YBT);
    bf16_t* o0 = YBT + ((size_t)(2 * bp) * 256 + ch) * 4096; bf16_t* o1 = o0 + (size_t)256 * 4096;
#pragma unroll
    for (int k = 0; k < 8; ++k) {
        const int t = tid + k * NT;
        const f32x2 y = z[ZI(t)] + zz[t] * sk1;
        o0[t] = f2bf(bf2f(x0[k]) * y.x); o1[t] = f2bf(bf2f(x1[k]) * y.y);
    }
}

__device__ __forceinline__ void hyfft_pair(const Params& p, unsigned char* smem, int l, int ch, int pp) {
    const int tid = TID(), hf = __builtin_amdgcn_readfirstlane(tid >> 8), lt = tid & 255, bp = 2 * pp + hf;
    f32x2* z = (f32x2*)(smem + (size_t)hf * 8704 * 8);
    const bf16_t* HV = (const bf16_t*)(p.ws + O_HV);
    const bf16_t* v0 = HV + ((size_t)(2 * bp) * 768 + ch) * 4096; const bf16_t* v1 = v0 + (size_t)768 * 4096;
    const f32x2* fh0 = (const f32x2*)(p.ws + O_FH) + (size_t)ch * 8192; const f32x2* fh1 = fh0 + (size_t)256 * 8192;
    const float sk0 = p.hy_skip[(size_t)l * 512 + ch], sk1 = p.hy_skip[(size_t)l * 512 + 256 + ch];
    unsigned av[16];
#pragma unroll
    for (int k = 0; k < 16; ++k) av[k] = (unsigned)v0[lt + k * 256] | ((unsigned)v1[lt + k * 256] << 16);
    f32x2 fr[32];
#pragma unroll
    for (int k = 0; k < 32; ++k) fr[k] = fh0[lt + k * 256];
    __syncthreads();
#pragma unroll
    for (int k = 0; k < 16; ++k) { const int t = lt + k * 256; z[ZI(t)] = (f32x2){bflo(av[k]), bfhi(av[k])}; z[ZI(4096 + t)] = (f32x2){0.f, 0.f}; }
    __syncthreads();
    fft_fwd_h(z, lt);
#pragma unroll
    for (int k = 0; k < 32; ++k) { const int i = lt + k * 256; z[ZI(i)] = cmul(z[ZI(i)], fr[k]); }
    unsigned xv[16];
#pragma unroll
    for (int k = 0; k < 16; ++k) xv[k] = (unsigned)v0[(size_t)256 * 4096 + lt + k * 256] | ((unsigned)v1[(size_t)256 * 4096 + lt + k * 256] << 16);
#pragma unroll
    for (int k = 0; k < 32; ++k) fr[k] = fh1[lt + k * 256];
    __syncthreads();
    fft_inv_h(z, lt);
    f32x2 zz[16];
#pragma unroll
    for (int k = 0; k < 16; ++k) {
        const int t = lt + k * 256;
        f32x2 y = z[ZI(t)];
        y.x += bflo(av[k]) * sk0; y.y += bfhi(av[k]) * sk0;
        const f32x2 zv = {bflo(xv[k]) * y.x, bfhi(xv[k]) * y.y};
        zz[k] = zv; z[ZI(t)] = zv; z[ZI(4096 + t)] = (f32x2){0.f, 0.f};
    }
    __syncthreads();
    fft_fwd_h(z, lt);
#pragma unroll
    for (int k = 0; k < 32; ++k) { const int i = lt + k * 256; z[ZI(i)] = cmul(z[ZI(i)], fr[k]); }
#pragma unroll
    for (int k = 0; k < 16; ++k) xv[k] = (unsigned)v0[(size_t)512 * 4096 + lt + k * 256] | ((unsigned)v1[(size_t)512 * 4096 + lt + k * 256] << 16);
    __syncthreads();
    fft_inv_h(z, lt);
    bf16_t* YBT = (bf16_t*)(p.ws + O_YBT);
    bf16_t* o0 = YBT + ((size_t)(2 * bp) * 256 + ch) * 4096; bf16_t* o1 = o0 + (size_t)256 * 4096;
#pragma unroll
    for (int k = 0; k < 16; ++k) {
        const int t = lt + k * 256;
        const f32x2 y = z[ZI(t)] + zz[k] * sk1;
        o0[t] = f2bf(bflo(xv[k]) * y.x); o1[t] = f2bf(bfhi(xv[k]) * y.y);
    }
}

__device__ __forceinline__ void hyctx_item(const Params& p, unsigned char* smem, int l, int b, int cp) {
    float* f1 = (float*)smem;
    float* f2 = f1 + 1024;
    float* vv = f2 + 1024;
    float* zc = vv + 512;
    float* red = zc + 512;
    const int tid = TID(), hf = tid >> 8, t = tid & 255, ch = cp * 2 + hf;
    const float* FC = (const float*)(p.ws + O_FILTC); const float* l1p = (const float*)(p.ws + O_L1PC);
    const bf16_t* HVC = (const bf16_t*)(p.ws + O_HVC) + ((size_t)b * 768 + ch) * 256;
    __syncthreads();
    f1[hf * 512 + t] = FC[(size_t)ch * 512 + t]; f1[hf * 512 + 256 + t] = FC[(size_t)ch * 512 + 256 + t];
    f2[hf * 512 + t] = FC[(size_t)(256 + ch) * 512 + t]; f2[hf * 512 + 256 + t] = FC[(size_t)(256 + ch) * 512 + 256 + t];
    const float vt = bf2f(HVC[t]); vv[hf * 256 + t] = vt;
    if (t < 2) { float s = 0.f; for (int it = 0; it < 16; ++it) s += l1p[(size_t)it * 1024 + t * 256 + ch] + l1p[(size_t)it * 1024 + 512 + t * 256 + ch]; red[hf * 2 + t] = s; }
    __syncthreads();
    float a = 0.f;
    for (int s = 0; s < 256; ++s) a += f1[hf * 512 + ((t - s) & 511)] * vv[hf * 256 + s];
    const float y1 = a / red[hf * 2 + 0] + vt * p.hy_skip[(size_t)l * 512 + ch];
    const float zt = bf2f(HVC[(size_t)256 * 256 + t]) * y1; zc[hf * 256 + t] = zt;
    __syncthreads();
    float a2 = 0.f;
    for (int s = 0; s < 256; ++s) a2 += f2[hf * 512 + ((t - s) & 511)] * zc[hf * 256 + s];
    const float y2 = a2 / red[hf * 2 + 1] + zt * p.hy_skip[(size_t)l * 512 + 256 + ch];
    bf16_t* YBTC = (bf16_t*)(p.ws + O_YBTC);
    YBTC[((size_t)b * 256 + ch) * 256 + t] = f2bf(bf2f(HVC[(size_t)512 * 256 + t]) * y2);
}

__device__ __forceinline__ void qk_item(const Params& p, int l, int item, bool dry = false) {
    unsigned zmask = 0u; asm volatile("" : "+v"(zmask));
    const int vi = item * NT + TID();
    const int per = 64 * NK;
    const int which = vi / per, rem = vi % per, kidx = rem % NK;
    bf16_t* ptr = (bf16_t*)(p.ws + (which ? O_KN : O_QN)) + (size_t)rem * 64;
    u32x4 raw[8];
#pragma unroll
    for (int i = 0; i < 8; ++i) raw[i] = *(const u32x4*)(ptr + i * 8);
    float ss = 0.f;
#pragma unroll
    for (int i = 0; i < 8; ++i) { const u32x4 w = raw[i];
        const float a0 = bflo(w.x), a1 = bfhi(w.x), a2 = bflo(w.y), a3 = bfhi(w.y), a4 = bflo(w.z), a5 = bfhi(w.z), a6 = bflo(w.w), a7 = bfhi(w.w);
        ss += a0 * a0 + a1 * a1 + a2 * a2 + a3 * a3 + a4 * a4 + a5 * a5 + a6 * a6 + a7 * a7; }
    const float qs = which ? 1.0f : (0.125f * 1.4426950408889634f);
    const float rinv = rsqrtf(ss * (1.0f / 64.0f) + 1e-6f) * qs;
    const float* gain = p.qk_gain + (size_t)l * 128 + (which ? 64 : 0);
    const bool rope = kidx >= 256;
    const int t = kidx - 256;
#pragma unroll
    for (int a1 = 0; a1 < 2; ++a1) {
        float v[32];
#pragma unroll
        for (int i = 0; i < 4; ++i) { const u32x4 w = raw[a1 * 4 + i];
            v[i * 8 + 0] = bflo(w.x); v[i * 8 + 1] = bfhi(w.x); v[i * 8 + 2] = bflo(w.y); v[i * 8 + 3] = bfhi(w.y);
            v[i * 8 + 4] = bflo(w.z); v[i * 8 + 5] = bfhi(w.z); v[i * 8 + 6] = bflo(w.w); v[i * 8 + 7] = bfhi(w.w); }
#pragma unroll
        for (int i = 0; i < 32; ++i) v[i] = v[i] * rinv * gain[a1 * 32 + i];
        if (rope) {
            const float pos = (float)(a1 ? (t & 63) : (t >> 6));
#pragma unroll
            for (int q = 0; q < 16; ++q) {
                const float inv = exp2f(-(float)q * (13.287712379549449f / 16.0f));
                float sn, cs; __sincosf(pos * inv, &sn, &cs);
                const float x1 = v[q], x2 = v[16 + q];
                v[q] = x1 * cs - x2 * sn; v[16 + q] = x1 * sn + x2 * cs;
            }
        }
#pragma unroll
        for (int i = 0; i < 4; ++i) { u32x4 w; w.x = pk2(v[i * 8], v[i * 8 + 1]); w.y = pk2(v[i * 8 + 2], v[i * 8 + 3]);
            w.z = pk2(v[i * 8 + 4], v[i * 8 + 5]); w.w = pk2(v[i * 8 + 6], v[i * 8 + 7]);
            if (dry) { const u32x4 o = raw[a1 * 4 + i]; w = (u32x4){o.x ^ (w.x & zmask), o.y ^ (w.y & zmask), o.z ^ (w.z & zmask), o.w ^ (w.w & zmask)}; }
            *(u32x4*)(ptr + a1 * 32 + i * 8) = w; }
    }
}

__device__ __forceinline__ void vt_item(const Params& p, unsigned char* smem, int tb) {
    bf16_t* tile = (bf16_t*)smem;
    const int tid = TID(), r0 = tb * 64;
    const bf16_t* src = (const bf16_t*)(p.ws + O_VRAW) + (size_t)r0 * 512;
    __syncthreads();
#pragma unroll
    for (int i = 0; i < 8; ++i) { const int e = tid + i * NT, rr = e >> 6, sg = e & 63; *(u32x4*)(tile + rr * 520 + sg * 8) = *(const u32x4*)(src + (size_t)rr * 512 + sg * 8); }
    __syncthreads();
    int b, kidx0; row_bk(r0, b, kidx0);
    bf16_t* dst = (bf16_t*)(p.ws + O_VT) + ((size_t)b * 512 + tid) * NK + kidx0;
#pragma unroll
    for (int s = 0; s < 8; ++s) {
        unsigned w[4];
#pragma unroll
        for (int j = 0; j < 4; ++j) w[j] = (unsigned)tile[(s * 8 + 2 * j) * 520 + tid] | ((unsigned)tile[(s * 8 + 2 * j + 1) * 520 + tid] << 16);
        *(u32x4*)(dst + s * 8) = (u32x4){w[0], w[1], w[2], w[3]};
    }
}

__device__ __forceinline__ void hyconv_item(const Params& p, unsigned char* smem, int l, int tb) {
    bf16_t* tile = (bf16_t*)smem;
    const int tid = TID(), r0 = tb * 64;
    const bool lat = r0 < TL;
    const int n = lat ? 4096 : 256, rb = lat ? r0 : r0 - TL, b = rb / n, t0 = rb % n;
    const bf16_t* src = (const bf16_t*)(p.ws + O_HYRAW);
    __syncthreads();
    for (int e = tid; e < 66 * 96; e += NT) {
        const int rr = e / 96, sg = e % 96, t = t0 - 1 + rr;
        u32x4 w = {0u, 0u, 0u, 0u};
        if (t >= 0 && t < n) w = *(const u32x4*)(src + (size_t)(r0 - 1 + rr) * 768 + sg * 8);
        *(u32x4*)(tile + rr * 776 + sg * 8) = w;
    }
    __syncthreads();
    const float* cw = p.hy_conv_w + (size_t)l * 3 * 768; const float* cb = p.hy_conv_b + (size_t)l * 768;
    for (int c = tid; c < 768; c += NT) {
        const float w0 = cw[c], w1 = cw[768 + c], w2 = cw[1536 + c], bb = cb[c];
        bf16_t* dst = lat ? (bf16_t*)(p.ws + O_HV) + ((size_t)b * 768 + c) * 4096 + t0 : (bf16_t*)(p.ws + O_HVC) + ((size_t)b * 768 + c) * 256 + t0;
        float pm = bf2f(tile[c]), pc = bf2f(tile[776 + c]);
#pragma unroll
        for (int s = 0; s < 8; ++s) {
            float o[8];
#pragma unroll
            for (int j = 0; j < 8; ++j) { const float pn = bf2f(tile[(s * 8 + j + 2) * 776 + c]); o[j] = pm * w0 + pc * w1 + pn * w2 + bb; pm = pc; pc = pn; }
            *(u32x4*)(dst + s * 8) = (u32x4){pk2(o[0], o[1]), pk2(o[2], o[3]), pk2(o[4], o[5]), pk2(o[6], o[7])};
        }
    }
}

__device__ __forceinline__ float gelu_exact(float v) { return 0.5f * v * (1.0f + erff(v * 0.70710678118654752f)); }
__device__ __forceinline__ void sgu_item(const Params& p, unsigned char* smem, int l, int ci) {
    bf16_t* vt = (bf16_t*)smem;
    const int tid = TID(), lane = tid & 63, wv = __builtin_amdgcn_readfirstlane(tid >> 6), r0 = ci * 128;
    const bf16_t* src = (const bf16_t*)(p.ws + O_SGRAW) + (size_t)r0 * 512;
    const float* lg = p.sg_ln_g + (size_t)l * 256; const float* lb = p.sg_ln_b + (size_t)l * 256;
    __syncthreads();
    {
        const f32x4 g4 = *(const f32x4*)(lg + lane * 4), b4 = *(const f32x4*)(lb + lane * 4);
        u32x2 wr_[16];
#pragma unroll
        for (int k = 0; k < 16; ++k) wr_[k] = *(const u32x2*)(src + (size_t)(wv + 8 * k) * 512 + 256 + lane * 4);
#pragma unroll
        for (int k = 0; k < 16; ++k) {
            const int rr = wv + 8 * k; const u32x2 w = wr_[k];
            float a[4] = {gelu_exact(bflo(w.x)), gelu_exact(bfhi(w.x)), gelu_exact(bflo(w.y)), gelu_exact(bfhi(w.y))};
            const float mu = wave_sum(a[0] + a[1] + a[2] + a[3]) * (1.0f / 256.0f);
            float d[4]; float sq = 0.f;
#pragma unroll
            for (int j = 0; j < 4; ++j) { d[j] = a[j] - mu; sq += d[j] * d[j]; }
            const float rstd = rsqrtf(wave_sum(sq) * (1.0f / 256.0f) + 1e-6f);
#pragma unroll
            for (int j = 0; j < 4; ++j) vt[(lane * 4 + j) * 136 + rr] = f2bf(d[j] * rstd * g4[j] + b4[j]);
        }
    }
    __syncthreads();
    const int g = wv & 3, ih = wv >> 2, l32 = lane & 31, kg = lane >> 5;
    const float* wsb = p.sg_w + ((size_t)l * 4 + g) * 128 * 128;
    const float* bsb = p.sg_b + ((size_t)l * 4 + g) * 128;
    bf16_t* yc = (bf16_t*)(p.ws + O_YCAT) + 768;
#pragma unroll 1
    for (int ib = 0; ib < 2; ++ib) {
        const int i0 = ih * 64 + ib * 32;
        f32x16 acc0, acc1;
#pragma unroll
        for (int r = 0; r < 16; ++r) { acc0[r] = 0.f; acc1[r] = 0.f; }
        const float* wrow = wsb + (size_t)(i0 + l32) * 128 + 8 * kg;
#pragma unroll
        for (int ks = 0; ks < 8; ++ks) {
            const f32x4 w0 = *(const f32x4*)(wrow + 16 * ks), w1 = *(const f32x4*)(wrow + 16 * ks + 4);
            const u32x4 aw = {pk2(w0[0], w0[1]), pk2(w0[2], w0[3]), pk2(w1[0], w1[1]), pk2(w1[2], w1[3])};
            const bf16x8 af = __builtin_bit_cast(bf16x8, aw);
            const bf16x8 b0 = *(const bf16x8*)(vt + (g * 64 + l32) * 136 + 16 * ks + 8 * kg);
            const bf16x8 b1 = *(const bf16x8*)(vt + (g * 64 + 32 + l32) * 136 + 16 * ks + 8 * kg);
            acc0 = __builtin_amdgcn_mfma_f32_32x32x16_bf16(af, b0, acc0, 0, 0, 0);
            acc1 = __builtin_amdgcn_mfma_f32_32x32x16_bf16(af, b1, acc1, 0, 0, 0);
        }
#pragma unroll
        for (int r = 0; r < 16; ++r) {
            const int i = i0 + 8 * (r >> 2) + 4 * kg + (r & 3);
            const float bi = bsb[i];
            const int c0 = g * 64 + l32, c1 = c0 + 32;
            const float u0 = gelu_exact(bf2f(src[(size_t)i * 512 + c0])), u1 = gelu_exact(bf2f(src[(size_t)i * 512 + c1]));
            yc[(size_t)(r0 + i) * 1024 + c0] = f2bf(u0 * (acc0[r] + bi));
            yc[(size_t)(r0 + i) * 1024 + c1] = f2bf(u1 * (acc1[r] + bi));
        }
    }
}

__device__ __forceinline__ void prep_phase(const Params& p, unsigned char* smem, int l) {
    const int n_sg = 0, n_hy = 544, n_vt = 544, n_qk = 1088;
    const int total = n_sg + n_hy + n_vt + n_qk;
    for (int it = blockIdx.x; it < total; it += gridDim.x) {
        int i = it;
        if (i < n_sg) { for (int rep = 0; rep < REP_SGU; ++rep) sgu_item(p, smem, l, i); continue; }
        i -= n_sg;
        if (i < n_hy) { for (int rep = 0; rep < REP_PREP; ++rep) hyconv_item(p, smem, l, i); continue; }
        i -= n_hy;
        if (i < n_vt) { for (int rep = 0; rep < REP_PREP; ++rep) vt_item(p, smem, i); continue; }
        i -= n_vt;
#if REP_QK > 1
        qk_item(p, l, i, true);
#endif
        qk_item(p, l, i);
    }
}

__device__ __forceinline__ void attn_item(const Params& p, unsigned char* smem, int b, int h, int comp, int q0, int rowbase, int nkt) {
    constexpr int ABUF = 64 * 72 + 128 * 72;
    bf16_t* Ks = (bf16_t*)smem;
    bf16_t* Vs = Ks + 64 * 72;
    const int tid = TID(), lane = tid & 63, w = tid >> 6, l32 = lane & 31, g = lane >> 5;
    const size_t hc = (size_t)((b * 4 + h) * 2 + comp);
    const bf16_t* Qb = (const bf16_t*)(p.ws + O_QN) + (hc * NK + q0 + 32 * w + l32) * 64;
    const bf16_t* Kb = (const bf16_t*)(p.ws + O_KN) + hc * NK * 64;
    const bf16_t* Vb = (const bf16_t*)(p.ws + O_VT) + (size_t)((b * 4 + h) * 128) * NK;
    bf16x8 qf[4];
#pragma unroll
    for (int ks = 0; ks < 4; ++ks) qf[ks] = *(const bf16x8*)(Qb + 16 * ks + 8 * g);
    f32x16 O[4];
#pragma unroll
    for (int d = 0; d < 4; ++d)
#pragma unroll
        for (int i = 0; i < 16; ++i) O[d][i] = 0.f;
    float lsum = 0.f;
    const int kkey = tid >> 3, kseg = tid & 7, vdv = tid >> 2, vseg = tid & 3;
    const bf16_t* kg = Kb + (size_t)kkey * 64 + kseg * 8;
    const bf16_t* vg = Vb + (size_t)vdv * NK + vseg * 16;
    u32x4 kreg = *(const u32x4*)kg, vr0 = *(const u32x4*)vg, vr1 = *(const u32x4*)(vg + 8);
    const int pr = (l32 & ~12) | ((l32 & 4) << 1) | ((l32 & 8) >> 1);
    __syncthreads();
    *(u32x4*)(Ks + kkey * 72 + kseg * 8) = kreg; *(u32x4*)(Vs + vdv * 72 + vseg * 16) = vr0; *(u32x4*)(Vs + vdv * 72 + vseg * 16 + 8) = vr1;
    if (nkt > 1) { kreg = *(const u32x4*)(kg + (size_t)64 * 64); vr0 = *(const u32x4*)(vg + 64); vr1 = *(const u32x4*)(vg + 64 + 8); }
    __syncthreads();
    for (int kt = 0; kt < nkt; ++kt) {
        const bf16_t* Kc = Ks + (kt & 1) * ABUF; const bf16_t* Vc = Vs + (kt & 1) * ABUF;
        if (kt + 1 < nkt) {
            bf16_t* Kn = Ks + ((kt + 1) & 1) * ABUF; bf16_t* Vn = Vs + ((kt + 1) & 1) * ABUF;
            *(u32x4*)(Kn + kkey * 72 + kseg * 8) = kreg; *(u32x4*)(Vn + vdv * 72 + vseg * 16) = vr0; *(u32x4*)(Vn + vdv * 72 + vseg * 16 + 8) = vr1;
            if (kt + 2 < nkt) { kreg = *(const u32x4*)(kg + (size_t)(kt + 2) * 64 * 64); vr0 = *(const u32x4*)(vg + (kt + 2) * 64); vr1 = *(const u32x4*)(vg + (kt + 2) * 64 + 8); }
        }
        f32x16 S0, S1;
#pragma unroll
        for (int i = 0; i < 16; ++i) { S0[i] = 0.f; S1[i] = 0.f; }
#pragma unroll
        for (int ks = 0; ks < 4; ++ks) {
            const bf16x8 ka = *(const bf16x8*)(Kc + pr * 72 + 16 * ks + 8 * g);
            const bf16x8 kb = *(const bf16x8*)(Kc + (32 + pr) * 72 + 16 * ks + 8 * g);
            S0 = __builtin_amdgcn_mfma_f32_32x32x16_bf16(ka, qf[ks], S0, 0, 0, 0);
            S1 = __builtin_amdgcn_mfma_f32_32x32x16_bf16(kb, qf[ks], S1, 0, 0, 0);
        }
#pragma unroll
        for (int i = 0; i < 16; ++i) { S0[i] = __builtin_amdgcn_exp2f(S0[i]); S1[i] = __builtin_amdgcn_exp2f(S1[i]); lsum += S0[i] + S1[i]; }
#pragma unroll
        for (int kb2 = 0; kb2 < 2; ++kb2)
#pragma unroll
            for (int s = 0; s < 2; ++s) {
                u32x4 pw;
                if (kb2 == 0) { pw.x = pk2(S0[8 * s], S0[8 * s + 1]); pw.y = pk2(S0[8 * s + 2], S0[8 * s + 3]); pw.z = pk2(S0[8 * s + 4], S0[8 * s + 5]); pw.w = pk2(S0[8 * s + 6], S0[8 * s + 7]); }
                else { pw.x = pk2(S1[8 * s], S1[8 * s + 1]); pw.y = pk2(S1[8 * s + 2], S1[8 * s + 3]); pw.z = pk2(S1[8 * s + 4], S1[8 * s + 5]); pw.w = pk2(S1[8 * s + 6], S1[8 * s + 7]); }
                const bf16x8 pf = __builtin_bit_cast(bf16x8, pw);
#pragma unroll
                for (int d = 0; d < 4; ++d) {
                    const bf16x8 va = *(const bf16x8*)(Vc + (d * 32 + l32) * 72 + kb2 * 32 + 16 * s + 8 * g);
                    O[d] = __builtin_amdgcn_mfma_f32_32x32x16_bf16(va, pf, O[d], 0, 0, 0);
                }
            }
        __syncthreads();
    }
    lsum += __shfl_xor(lsum, 32);
    const float inv = 1.0f / lsum;
    bf16_t* ob = (bf16_t*)(p.ws + O_OC) + ((size_t)(rowbase + 32 * w + l32) * 8 + h * 2 + comp) * 128;
#pragma unroll
    for (int d = 0; d < 4; ++d)
#pragma unroll
        for (int i4 = 0; i4 < 4; ++i4) {
            u32x2 o; o.x = pk2(O[d][4 * i4] * inv, O[d][4 * i4 + 1] * inv); o.y = pk2(O[d][4 * i4 + 2] * inv, O[d][4 * i4 + 3] * inv);
            *(u32x2*)(ob + d * 32 + 8 * i4 + 4 * g) = o;
        }
}

__device__ __forceinline__ void mix_phase(const Params& p, unsigned char* smem, int l) {
    const int n_al = 1024, n_ac = (l == 0) ? 64 : 0, n_hf = 512, n_hc = (l == 0) ? 1024 : 0;
    const int total = n_al + n_ac + n_hf + n_hc;
    for (int it = blockIdx.x; it < total; it += gridDim.x) {
        int i = it;
        if (i < n_al) { const int comp = i & 1, h = (i >> 1) & 3, qt = (i >> 3) & 15, b = i >> 7; for (int rep = 0; rep < REP_ATT; ++rep) attn_item(p, smem, b, h, comp, 256 + qt * 256, b * 4096 + qt * 256, 68); continue; }
        i -= n_al;
        if (i < n_ac) { const int comp = i & 1, h = (i >> 1) & 3, b = i >> 3; attn_item(p, smem, b, h, comp, 0, TL + b * 256, 4); continue; }
        i -= n_ac;
        if (i < n_hf) { for (int rep = 0; rep < REP_HY; ++rep) hyfft_pair(p, smem, l, i >> 1, i & 1); continue; }
        i -= n_hf;
        for (int rep = 0; rep < REP_MISC; ++rep) hyctx_item(p, smem, l, i >> 7, i & 127);
    }
}

__device__ __forceinline__ void ybt_item(const Params& p, unsigned char* smem, int tb) {
    bf16_t* tile = (bf16_t*)smem;
    const int tid = TID(), r0 = tb * 64;
    const bool lat = r0 < TL;
    const int n = lat ? 4096 : 256, rb = lat ? r0 : r0 - TL, b = rb / n, t0 = rb % n;
    const bf16_t* src = (lat ? (const bf16_t*)(p.ws + O_YBT) : (const bf16_t*)(p.ws + O_YBTC)) + (size_t)b * 256 * n + t0;
    __syncthreads();
#pragma unroll
    for (int i = 0; i < 4; ++i) { const int e = tid + i * NT, ch = e >> 3, sg = e & 7; *(u32x4*)(tile + ch * 72 + sg * 8) = *(const u32x4*)(src + (size_t)ch * n + sg * 8); }
    __syncthreads();
    bf16_t* yb = (bf16_t*)(p.ws + O_YCAT) + 512;
#pragma unroll
    for (int i = 0; i < 4; ++i) {
        const int e = tid + i * NT, rr = e >> 5, sg = e & 31;
        unsigned w[4];
#pragma unroll
        for (int j = 0; j < 4; ++j) w[j] = (unsigned)tile[(sg * 8 + 2 * j) * 72 + rr] | ((unsigned)tile[(sg * 8 + 2 * j + 1) * 72 + rr] << 16);
        *(u32x4*)(yb + (size_t)(r0 + rr) * 1024 + sg * 8) = (u32x4){w[0], w[1], w[2], w[3]};
    }
}
__device__ __forceinline__ void post_phase(const Params& p, unsigned char* smem, int l, int M) {
    const int n_sg = M / 128, nb = M / 64;
    for (int it = blockIdx.x; it < n_sg + nb; it += gridDim.x) {
        if (it < n_sg) { for (int rep = 0; rep < REP_SGU; ++rep) sgu_item(p, smem, l, it); }
        else ybt_item(p, smem, it - n_sg);
    }
    const int tid = TID(), lane = tid & 63, wv = tid >> 6;
    const float* lv = p.da_lambda + (size_t)l * 256;
    const float d01 = wave_sum(lv[lane] * lv[64 + lane]), d23 = wave_sum(lv[128 + lane] * lv[192 + lane]);
    const float lam_init = 0.8f - 0.6f * expf(-0.3f * (float)l);
    const float lam = expf(d01) - expf(d23) + lam_init;
    const float* sub = p.da_subln + (size_t)l * 128;
    const float s0 = sub[2 * lane] * (1.0f - lam_init), s1 = sub[2 * lane + 1] * (1.0f - lam_init);
    const bf16_t* OC = (const bf16_t*)(p.ws + O_OC);
    bf16_t* YA = (bf16_t*)(p.ws + O_YCAT);
    const int vstep = gridDim.x * 8;
    for (int v0i = blockIdx.x * 8 + wv; v0i < M * 4; v0i += 4 * vstep) {
        unsigned aw[4], bw[4];
#pragma unroll
        for (int k = 0; k < 4; ++k) { const int vi = v0i + k * vstep; aw[k] = 0u; bw[k] = 0u;
            if (vi < M * 4) { const bf16_t* o0 = OC + (size_t)vi * 256; aw[k] = *(const unsigned*)(o0 + 2 * lane); bw[k] = *(const unsigned*)(o0 + 128 + 2 * lane); } }
#pragma unroll
        for (int k = 0; k < 4; ++k) { const int vi = v0i + k * vstep;
            if (vi < M * 4) {
                const float x0 = bflo(aw[k]) - lam * bflo(bw[k]), x1 = bfhi(aw[k]) - lam * bfhi(bw[k]);
                const float rinv = rsqrtf(wave_sum(x0 * x0 + x1 * x1) * (1.0f / 128.0f) + 1e-6f);
                *(unsigned*)(YA + (size_t)(vi >> 2) * 1024 + (vi & 3) * 128 + 2 * lane) = pk2(x0 * rinv * s0, x1 * rinv * s1);
            } }
    }
}

template <int l> __device__ __forceinline__ void layer_body(unsigned char* smem) {
        const int Mfull = TT, Mpost = (l == 0) ? TT : TL;
        { const Params q = opq(smem); norm_phase(q, l, 0, Mfull, l == 0, (const bf16_t*)q.out); if (l == 1) aux_phase(q, smem, 1); }
        gsync(smem);
        for (int rep = 0; rep < REP_UP; ++rep) { const Params q = opq(smem); EpiSwiglu E; E.G = (bf16_t*)(q.ws + O_GH); run_gemm(smem, (const bf16_t*)(q.ws + O_H), (const bf16_t*)(q.ws + O_WUP0), Mfull, 5632, 1024, E); }
        gsync(smem);
        { const Params q = opq(smem); EpiResid E; E.xin = (const bf16_t*)q.out; E.xout = (bf16_t*)q.out; E.fout = nullptr; E.xc = (float*)(q.ws + O_XC); E.part = (float*)(q.ws + O_PART); E.mod = (const float*)(q.ws + O_MOD) + (size_t)l * 9 * 9216; E.gofs = 2 * 1024; E.coef = 0.5f;
          run_gemm(smem, (const bf16_t*)(q.ws + O_GH), (const bf16_t*)(q.ws + O_WDN0), Mfull, 1024, 2816, E, true);
          for (int rep = 1; rep < REP_DN; ++rep) { E.coef = 0.f; run_gemm(smem, (const bf16_t*)(q.ws + O_GH), (const bf16_t*)(q.ws + O_WDN0), Mfull, 1024, 2816, E); } }
        gsync(smem);
        { const Params q = opq(smem); norm_phase(q, l, 1, Mfull, false, (const bf16_t*)q.out); for (int rep = 0; rep < REP_MISC; ++rep) for (int it = blockIdx.x; it < 512; it += gridDim.x) filtfft_item(q, smem, it); }
        gsync(smem);
        for (int rep = 0; rep < REP_G3; ++rep) { const Params q = opq(smem); EpiIn E; E.qn = (bf16_t*)(q.ws + O_QN); E.kn = (bf16_t*)(q.ws + O_KN); E.vraw = (bf16_t*)(q.ws + O_VRAW); E.hyraw = (bf16_t*)(q.ws + O_HYRAW); E.sgraw = (bf16_t*)(q.ws + O_SGRAW);
          run_gemm(smem, (const bf16_t*)(q.ws + O_H), (const bf16_t*)(q.ws + O_WIN), Mfull, 2816, 1024, E); }
        gsync(smem);
        { const Params q = opq(smem); prep_phase(q, smem, l); }
        gsync(smem);
        { const Params q = opq(smem); mix_phase(q, smem, l); }
        gsync(smem);
        for (int rep = 0; rep < REP_MISC; ++rep) { const Params q = opq(smem); post_phase(q, smem, l, Mpost); }
        gsync(smem);
#pragma unroll 1
        for (int rep9 = 0; rep9 < REP_P9; ++rep9) {
            { const Params q = opq(smem); EpiGate3 E; E.g3 = (bf16_t*)(q.ws + O_G3); E.bias = q.gate_b + (size_t)l * 3072;
              run_gemm(smem, (const bf16_t*)(q.ws + O_H), (const bf16_t*)(q.ws + O_WG), Mpost, 3072, 1024, E); }
            gsync(smem);
            { const Params q = opq(smem); EpiMergeR E; E.g3 = (const bf16_t*)(q.ws + O_G3); E.mb = (bf16_t*)(q.ws + O_MB);
              run_gemm(smem, (const bf16_t*)(q.ws + O_YCAT), (const bf16_t*)(q.ws + O_WBR), Mpost, 1024, 1024, E); }
        }
        gsync(smem);
        { const Params q = opq(smem); EpiResid E; E.xin = (const bf16_t*)q.out; E.xout = (l == 1) ? (bf16_t*)(q.ws + O_XALT) : (bf16_t*)q.out; E.fout = nullptr; E.xc = (float*)(q.ws + O_XC); E.part = (float*)(q.ws + O_PART); E.mod = (const float*)(q.ws + O_MOD) + (size_t)l * 9 * 9216; E.gofs = 5 * 1024; E.coef = 1.0f;
          run_gemm(smem, (const bf16_t*)(q.ws + O_MB), (const bf16_t*)(q.ws + O_WO), Mpost, 1024, 1024, E, l == 0);
          for (int rep = 1; rep < REP_G3; ++rep) { E.coef = 0.f; run_gemm(smem, (const bf16_t*)(q.ws + O_MB), (const bf16_t*)(q.ws + O_WO), Mpost, 1024, 1024, E); } }
        gsync(smem);
        { const Params q = opq(smem); norm_phase(q, l, 2, Mpost, false, (l == 1) ? (const bf16_t*)(q.ws + O_XALT) : (const bf16_t*)q.out); }
        gsync(smem);
        for (int rep = 0; rep < REP_UP; ++rep) { const Params q = opq(smem); EpiSwiglu E; E.G = (bf16_t*)(q.ws + O_GH); run_gemm(smem, (const bf16_t*)(q.ws + O_H), (const bf16_t*)(q.ws + O_WUP1), Mpost, 5632, 1024, E); }
        gsync(smem);
        { const Params q = opq(smem); EpiResid E; E.xin = (l == 1) ? (const bf16_t*)(q.ws + O_XALT) : (const bf16_t*)q.out; E.xout = (bf16_t*)q.out; E.fout = (l == 1) ? q.out : nullptr; E.xc = (float*)(q.ws + O_XC); E.part = (float*)(q.ws + O_PART); E.mod = (const float*)(q.ws + O_MOD) + (size_t)l * 9 * 9216; E.gofs = 8 * 1024; E.coef = 0.5f;
          run_gemm(smem, (const bf16_t*)(q.ws + O_GH), (const bf16_t*)(q.ws + O_WDN1), Mpost, 1024, 2816, E, l == 0); }
}

__global__ void __launch_bounds__(512, 2) fwd_megakernel(Params p) {
    extern __shared__ __attribute__((aligned(16))) unsigned char smem[];
    cg::grid_group grid = cg::this_grid();
    if (threadIdx.x == 0) {
        *(Params*)(smem + POFF) = p;
        volatile unsigned* st = (volatile unsigned*)(smem + POFF + 256); st[0] = 0u; st[1] = 0u;
        xb_add(&((unsigned*)(p.ws + O_BAR))[XB_XCNT(xb_xcc_id())], 1u);
    }
    __syncthreads();
    { const Params q = opq(smem); aux_phase(q, smem, 0); }
    grid.sync();
    layer_body<0>(smem);
    gsync(smem);
    layer_body<1>(smem);
}

extern "C" void kernel_launch(void* const* d_in, const int* in_sizes, int n_in, void* d_out, int out_size, void* d_ws, size_t ws_size, hipStream_t stream) {
    if (ws_size < WS_NEED) { fprintf(stderr, "workspace too small: need %zu have %zu\n", (size_t)WS_NEED, ws_size); return; }
    static int grid_blocks = 0;
    if (!grid_blocks) {
        hipFuncSetAttribute((const void*)fwd_megakernel, hipFuncAttributeMaxDynamicSharedMemorySize, LDS_BYTES);
        int dev = 0, cus = 0, per_cu = 0;
        hipGetDevice(&dev);
        hipDeviceGetAttribute(&cus, hipDeviceAttributeMultiprocessorCount, dev);
        hipOccupancyMaxActiveBlocksPerMultiprocessor(&per_cu, fwd_megakernel, NT, LDS_BYTES);
        if (per_cu < 1) per_cu = 1;
        grid_blocks = cus;
    }
    Params p{};
    const float** pp = (const float**)&p;
    for (int i = 0; i < 30; ++i) pp[i] = (const float*)d_in[i];
    p.out = (float*)d_out;
    p.ws = (unsigned char*)d_ws;
    hipMemsetAsync((unsigned char*)d_ws + O_BAR, 0, 16384, stream);
    void* args[] = {&p};
    hipError_t e = hipLaunchCooperativeKernel((void*)fwd_megakernel, dim3(grid_blocks), dim3(NT), args, LDS_BYTES, stream);
    if (e != hipSuccess) fprintf(stderr, "cooperative launch failed: %s (grid %d)\n", hipGetErrorString(e), grid_blocks);
}
```

```cpp
#include <hip/hip_runtime.h>
#include <hip/hip_cooperative_groups.h>
#include <cstdio>
namespace cg = cooperative_groups;

#define LAS __attribute__((address_space(3)))
typedef unsigned short bf16_t;
typedef short bf16x8 __attribute__((ext_vector_type(8)));
typedef float f32x2 __attribute__((ext_vector_type(2)));
typedef float f32x4 __attribute__((ext_vector_type(4)));
typedef float f32x16 __attribute__((ext_vector_type(16)));
typedef unsigned u32x2 __attribute__((ext_vector_type(2)));
typedef unsigned u32x4 __attribute__((ext_vector_type(4)));
typedef __bf16 bf16v2 __attribute__((ext_vector_type(2)));

constexpr int NT = 512;
#ifndef REP_ATT
#define REP_ATT 1
#endif
#ifndef REP_HY
#define REP_HY 1
#endif
#ifndef REP_AUX
#define REP_AUX 1
#endif
#ifndef REP_MISC
#define REP_MISC 1
#endif
#ifndef REP_PREP
#define REP_PREP 1
#endif
#ifndef REP_UP
#define REP_UP 1
#endif
#ifndef REP_DN
#define REP_DN 1
#endif
#ifndef REP_G3
#define REP_G3 1
#endif
#ifndef REP_P9
#define REP_P9 1
#endif
#ifndef REP_QK
#define REP_QK 1
#endif
#ifndef REP_NORM
#define REP_NORM 1
#endif
#ifndef REP_SGU
#define REP_SGU 1
#endif
constexpr int TL = 32768, TCX = 2048, TT = 34816, DM = 1024, FFH = 2816, SEQ = 4096, CTXL = 256, NK = 4352;
constexpr int LDS_BYTES = 147456;

constexpr size_t AL(size_t x) { return (x + 255) & ~(size_t)255; }
constexpr size_t O_WUP0 = 0;
constexpr size_t O_WUP1 = O_WUP0 + (size_t)5632 * 1024 * 2;
constexpr size_t O_WDN0 = O_WUP1 + (size_t)5632 * 1024 * 2;
constexpr size_t O_WDN1 = O_WDN0 + (size_t)1024 * 2816 * 2;
constexpr size_t O_WIN = O_WDN1 + (size_t)1024 * 2816 * 2;
constexpr size_t O_WG = O_WIN + (size_t)2816 * 1024 * 2;
constexpr size_t O_WBR = O_WG + (size_t)3072 * 1024 * 2;
constexpr size_t O_WO = O_WBR + (size_t)1024 * 1024 * 2;
constexpr size_t O_XC = O_WO + (size_t)1024 * 1024 * 2;
constexpr size_t O_MOD = O_XC + (size_t)TCX * 1024 * 4;
constexpr size_t O_L1P = O_MOD + AL((size_t)2 * 9 * 9216 * 4);
constexpr size_t O_L1PC = O_L1P + (size_t)256 * 1024 * 4;
constexpr size_t O_FILTC = O_L1PC + (size_t)16 * 1024 * 4;
constexpr size_t O_BAR = O_FILTC + (size_t)2 * 256 * 512 * 4;
constexpr size_t O_H = O_BAR + 16384;
constexpr size_t O_AR = O_H + (size_t)TT * 1024 * 2;
constexpr size_t O_GH = O_AR;
constexpr size_t O_VRAW = O_AR;
constexpr size_t O_HYRAW = O_VRAW + (size_t)TT * 512 * 2;
constexpr size_t O_SGRAW = O_HYRAW + (size_t)TT * 768 * 2;
constexpr size_t O_XALT = O_AR + (size_t)TT * 2816 * 2;
constexpr size_t O_PART = O_XALT;
constexpr size_t O_OC = O_AR;
constexpr size_t O_YBT = O_OC + (size_t)TT * 1024 * 2;
constexpr size_t O_YBTC = O_YBT + (size_t)8 * 256 * 4096 * 2;
static_assert(O_YBTC + (size_t)8 * 256 * 256 * 2 <= O_SGRAW, "OC/YBT must not touch SGRAW (read in the post phase)");
constexpr size_t O_G3 = O_AR;
constexpr size_t O_YCAT = O_G3 + (size_t)TT * 3072 * 2;
constexpr size_t O_MB = O_YCAT + (size_t)TT * 1024 * 2;
constexpr size_t SZ_B = (size_t)TT * 1024 * 4 + (size_t)8 * 256 * 4096 * 2 + (size_t)8 * 256 * 256 * 2;
constexpr size_t O_QN = O_AR + AL(SZ_B);
constexpr size_t O_KN = O_QN + (size_t)64 * NK * 64 * 2;
constexpr size_t O_VT = O_KN + (size_t)64 * NK * 64 * 2;
constexpr size_t O_HV = O_VT + (size_t)32 * 128 * NK * 2;
constexpr size_t O_HVC = O_HV + (size_t)8 * 768 * 4096 * 2;
constexpr size_t O_FH = O_HVC + (size_t)8 * 768 * 256 * 2;
constexpr size_t O_FILT = O_HV;
constexpr size_t SZ_C1 = (size_t)8 * 768 * 4096 * 2 + (size_t)8 * 768 * 256 * 2 + (size_t)2 * 256 * 8192 * 8;
constexpr size_t END1 = O_HV + SZ_C1, END2 = O_MB + (size_t)TT * 1024 * 2;
static_assert(O_YCAT >= O_SGRAW + (size_t)TT * 512 * 2, "YCAT is written while OC/YBT/SGRAW are read");
constexpr size_t WS_NEED = AL(END1 > END2 ? END1 : END2);
static_assert(O_GH + (size_t)TT * 2816 * 2 <= O_HV, "Gh must stay inside regions B'+A");
static_assert(O_XALT + (size_t)TL * 1024 * 2 <= O_MB, "X_alt is written while MB is read");
static_assert(O_PART + (size_t)4 * 2048 * 1024 * 4 <= O_HV, "partials must not touch FILT/FH");
static_assert(O_SGRAW + (size_t)TT * 512 * 2 <= O_QN, "raws fit region B'");

struct Params {
    const float *x, *c, *ctx, *c_ctx, *ada_w, *ada_b, *norm_g, *ffn_up, *ffn_down, *w_in, *qk_gain, *da_lambda, *da_subln,
        *hy_conv_w, *hy_conv_b, *hy_w1, *hy_b1, *hy_w2, *hy_b2, *hy_freq, *hy_w3, *hy_skip, *sg_ln_g, *sg_ln_b, *sg_w, *sg_b,
        *gate_w, *gate_b, *w_br, *w_o;
    float* out;
    unsigned char* ws;
};


__device__ __forceinline__ int TID() { int t = threadIdx.x; asm volatile("" : "+v"(t)); return t; }
constexpr int POFF = 147456 - 512;
__device__ __forceinline__ const float* ldp(const unsigned char* smem, int idx) {
    const volatile unsigned* w = (const volatile unsigned*)(smem + POFF + idx * 8);
    const unsigned lo = __builtin_amdgcn_readfirstlane(w[0]), hi = __builtin_amdgcn_readfirstlane(w[1]);
    typedef __attribute__((address_space(1))) const float* gptr_t;
    return (const float*)(gptr_t)(((unsigned long long)hi << 32) | lo);
}
__device__ __forceinline__ Params opq(const unsigned char* smem) {
    Params q;
    q.x = ldp(smem, 0); q.c = ldp(smem, 1); q.ctx = ldp(smem, 2); q.c_ctx = ldp(smem, 3); q.ada_w = ldp(smem, 4); q.ada_b = ldp(smem, 5); q.norm_g = ldp(smem, 6);
    q.ffn_up = ldp(smem, 7); q.ffn_down = ldp(smem, 8); q.w_in = ldp(smem, 9); q.qk_gain = ldp(smem, 10); q.da_lambda = ldp(smem, 11); q.da_subln = ldp(smem, 12);
    q.hy_conv_w = ldp(smem, 13); q.hy_conv_b = ldp(smem, 14); q.hy_w1 = ldp(smem, 15); q.hy_b1 = ldp(smem, 16); q.hy_w2 = ldp(smem, 17); q.hy_b2 = ldp(smem, 18);
    q.hy_freq = ldp(smem, 19); q.hy_w3 = ldp(smem, 20); q.hy_skip = ldp(smem, 21); q.sg_ln_g = ldp(smem, 22); q.sg_ln_b = ldp(smem, 23); q.sg_w = ldp(smem, 24);
    q.sg_b = ldp(smem, 25); q.gate_w = ldp(smem, 26); q.gate_b = ldp(smem, 27); q.w_br = ldp(smem, 28); q.w_o = ldp(smem, 29);
    q.out = (float*)ldp(smem, 30); q.ws = (unsigned char*)ldp(smem, 31);
    return q;
}


#define XB_TMO      128
#define XB_XCNT(j)  (256  + 64 * (j))
#define XB_XSUB(j)  (1280 + 64 * (j))
#define XB_XGEN(j)  (2304 + 64 * (j))
#define XB_TOP      3328
#define XB_TOPGEN   3392
#define XCD_BAR_WORDS 3456
#define XB_SPIN_CAP (1u << 22)
__device__ __forceinline__ unsigned xb_ld(unsigned* p)              { return __hip_atomic_load(p, __ATOMIC_RELAXED, __HIP_MEMORY_SCOPE_AGENT); }
__device__ __forceinline__ unsigned xb_add(unsigned* p, unsigned v) { return __hip_atomic_fetch_add(p, v, __ATOMIC_RELAXED, __HIP_MEMORY_SCOPE_AGENT); }
__device__ __forceinline__ unsigned xb_xcc_id() { return (unsigned)__builtin_amdgcn_s_getreg((3 << 11) | 20) & 0xFu; }
#define XB_SPIN(cond, bar) do { unsigned _sp = 0; while (cond) { __builtin_amdgcn_s_sleep(1); \
    if ((++_sp & 255u) == 0u) { if (xb_ld(&(bar)[XB_TMO])) break; if (_sp > XB_SPIN_CAP) { atomicAdd(&(bar)[XB_TMO], 1u); break; } } } } while (0)
__device__ __forceinline__ void xcd_barrier_complete(unsigned* bar, unsigned x, unsigned& nloc, unsigned& nx) {
    const unsigned G = gridDim.x * gridDim.y * gridDim.z;
    unsigned sum, cnt, mine, sp = 0u;
    for (;;) {
        sum = 0u; cnt = 0u; mine = 0u;
#pragma unroll
        for (unsigned j = 0; j < 16; ++j) { const unsigned c = xb_ld(&bar[XB_XCNT(j)]); sum += c; cnt += (c > 0u) ? 1u : 0u; mine = (j == x) ? c : mine; }
        if (sum == G) break;
        __builtin_amdgcn_s_sleep(1);
        if ((++sp & 255u) == 0u) { if (xb_ld(&bar[XB_TMO])) break; if (sp > XB_SPIN_CAP) { atomicAdd(&bar[XB_TMO], 1u); break; } }
    }
    nloc = mine > 0u ? mine : 1u; nx = cnt > 0u ? cnt : 1u;
}
__device__ __forceinline__ void gsync(unsigned char* smem) {
    asm volatile("s_waitcnt vmcnt(0)" ::: "memory");
    __syncthreads();
    if (threadIdx.x == 0) {
        unsigned* bar = (unsigned*)((unsigned char*)ldp(smem, 31) + O_BAR);
        volatile unsigned* st = (volatile unsigned*)(smem + POFF + 256);
        const unsigned x = xb_xcc_id();
        __builtin_amdgcn_s_waitcnt(0);
        unsigned nloc = st[0], nx = st[1];
        if (nloc == 0u) { xcd_barrier_complete(bar, x, nloc, nx); st[0] = nloc; st[1] = nx; }
        const unsigned old = xb_add(&bar[XB_XSUB(x)], 1u);
        const unsigned gen = old / nloc;
        if (old + 1u == (gen + 1u) * nloc) {
            __builtin_amdgcn_fence(__ATOMIC_RELEASE, "agent");
            asm volatile("s_waitcnt vmcnt(0)" ::: "memory");
            const unsigned og = xb_add(&bar[XB_TOP], 1u);
            const unsigned tg = og / nx;
            if (og + 1u == (tg + 1u) * nx) xb_add(&bar[XB_TOPGEN], 1u);
            else XB_SPIN(xb_ld(&bar[XB_TOPGEN]) == tg, bar);
            __builtin_amdgcn_fence(__ATOMIC_ACQUIRE, "agent");
            xb_add(&bar[XB_XGEN(x)], 1u);
            asm volatile("s_waitcnt vmcnt(0)" ::: "memory");
        } else {
            XB_SPIN(xb_ld(&bar[XB_XGEN(x)]) == gen, bar);
            __builtin_amdgcn_fence(__ATOMIC_ACQUIRE, "agent");
            asm volatile("s_waitcnt vmcnt(0)" ::: "memory");
        }
    }
    __syncthreads();
}

__device__ __forceinline__ unsigned pk2(float a, float b) { f32x2 v = {a, b}; bf16v2 r = __builtin_convertvector(v, bf16v2); return __builtin_bit_cast(unsigned, r); }
__device__ __forceinline__ bf16_t f2bf(float a) { return (bf16_t)(pk2(a, 0.f) & 0xffffu); }
__device__ __forceinline__ float bf2f(bf16_t h) { return __uint_as_float((unsigned)h << 16); }
__device__ __forceinline__ float bflo(unsigned w) { return __uint_as_float(w << 16); }
__device__ __forceinline__ float bfhi(unsigned w) { return __uint_as_float(w & 0xffff0000u); }
__device__ __forceinline__ void row_bk(int r, int& b, int& kidx) { if (r < TL) { b = r >> 12; kidx = 256 + (r & 4095); } else { const int rc = r - TL; b = rc >> 8; kidx = rc & 255; } }
__device__ __forceinline__ float wave_sum(float v) {
#pragma unroll
    for (int o = 32; o > 0; o >>= 1) v += __shfl_xor(v, o);
    return v;
}
__device__ __forceinline__ float sigmoidf_(float v) { return __builtin_amdgcn_rcpf(1.0f + __builtin_amdgcn_exp2f(v * -1.4426950408889634f)); }

namespace pg8 {
constexpr int BM = 256, BK = 64, HALF = 128, HTB = HALF * BK * 2, STAGE_BYTES = 8 * HTB, NXCD = 8, WGM = 8;
__device__ __forceinline__ int lds_byte(int r, int c) { const int st = (r >> 4) * 2 + (c >> 5), rr = r & 15, cc = c & 31, ob = rr * 64 + cc * 2; return st * 1024 + (ob ^ (((ob >> 9) & 1) << 5)); }
__device__ __forceinline__ void stage_rc(int b, int& R, int& C) { const int st = b / 1024, sb = b % 1024, swz = sb ^ (((sb >> 9) & 1) << 5); R = (st >> 1) * 16 + swz / 64; C = (st & 1) * 32 + (swz % 64) / 2; }
__device__ __forceinline__ int perm32(int rho) { const int n = rho >> 4, i = rho & 15; return 8 * (i >> 2) + 4 * n + (i & 3); }
struct Unit { int pm, pn, k0, nt, split; };
struct Gemm { const bf16_t* A; const bf16_t* Bt; int M, N, K; };
struct StaticOrder {
    int nM, nN, nwg, G, c, ntk, ntail;
    __device__ void init(int M, int N, int K, int G_, int c_, bool split_tail) {
        nM = M / BM; nN = N / BM; G = G_; c = c_; ntk = K / BK; ntail = 0;
        if (split_tail) { nM -= 8; ntail = 128; }
        nwg = nM * nN;
    }
    __device__ __forceinline__ bool next(int i, Unit& u) const {
        const long L = (long)i * G + c; if (L >= nwg + ntail) return false;
        int pm, pn, k0 = 0, nt = ntk, split = 0;
        if (L >= nwg) {
            const int j = (int)L - nwg, cu = j >> 2, part = j & 3;
            pm = nM + (cu >> 2); pn = cu & 3; split = 1 + part;
            const int q = (ntk / 4) & ~1, big = (ntk - 4 * q) / 2;
            nt = q + ((part < big) ? 2 : 0);
            k0 = part * q + 2 * (part < big ? part : big);
        } else {
            int wgid = (int)L; { const int q = nwg / NXCD, r = nwg % NXCD, xcd = wgid % NXCD, off = wgid / NXCD; wgid = (xcd < r ? xcd * (q + 1) : r * (q + 1) + (xcd - r) * q) + off; }
            const int nig = WGM * nN, gid = wgid / nig, fm = gid * WGM, gsz = (nM - fm) < WGM ? (nM - fm) : WGM;
            pm = fm + ((wgid % nig) % gsz); pn = (wgid % nig) / gsz;
        }
        u.pm = pm; u.pn = pn; u.k0 = k0; u.nt = nt; u.split = split;
        return true;
    }
};

template <class Epi>
__device__ __forceinline__ void gemm_phase(LAS unsigned char* lds, const Gemm g, const StaticOrder& S, const Epi& E) {
    const int tid = TID(), wid = __builtin_amdgcn_readfirstlane(tid >> 6), lane = tid & 63, wr = wid >> 2, wc = wid & 3, fr = lane & 15, fq = lane >> 4;
    const int K = g.K;
    unsigned voffA[2], voffB[2];
#pragma unroll
    for (int i = 0; i < 2; ++i) { int R, C; stage_rc(tid * 16 + i * 8192, R, C); const int Rb = Epi::PERM ? ((R & ~31) + perm32(R & 31)) : R;
        voffA[i] = (unsigned)(R * K + C) * 2u; voffB[i] = (unsigned)(Rb * K + C) * 2u; }
    const size_t kstep = (size_t)(BK * 2);
    const size_t hstep = (size_t)HALF * K * 2;
    const size_t tstep = 2 * hstep;
    const unsigned ldsw = (unsigned)wid * 1024u;
    const int aoff = lds_byte(wr * 64 + fr, fq * 8), boff = lds_byte(wc * 32 + fr, fq * 8);
#define PG8_SA(b, h) (((b) * 2 + (h)) * HTB)
#define PG8_SB(b, h) ((4 + (b) * 2 + (h)) * HTB)
#define PG8_STAGE(bufoff, gbase, voff) do { _Pragma("unroll") for (int _i = 0; _i < 2; ++_i) \
        __builtin_amdgcn_global_load_lds((const unsigned*)((const char*)(gbase) + (voff)[_i]), (LAS unsigned*)(lds + (bufoff) + ldsw + _i * 8192), 16, 0, 0); } while (0)
#define PG8_LDA(dst, b, h) do { _Pragma("unroll") for (int m = 0; m < 4; ++m) _Pragma("unroll") for (int k = 0; k < 2; ++k) dst[m][k] = *(const LAS bf16x8*)(lds + PG8_SA(b, h) + aoff + m * 2048 + k * 1024); } while (0)
#define PG8_LDB(dst, b, h) do { _Pragma("unroll") for (int n = 0; n < 2; ++n) _Pragma("unroll") for (int k = 0; k < 2; ++k) dst[n][k] = *(const LAS bf16x8*)(lds + PG8_SB(b, h) + boff + n * 2048 + k * 1024); } while (0)
#define PG8_MMA(ai, bj, At, Bt) do { __builtin_amdgcn_s_setprio(1); _Pragma("unroll") for (int m = 0; m < 4; ++m) _Pragma("unroll") for (int n = 0; n < 2; ++n) _Pragma("unroll") for (int k = 0; k < 2; ++k) \
        acc[ai][bj][m][n] = __builtin_amdgcn_mfma_f32_16x16x32_bf16(Bt[n][k], At[m][k], acc[ai][bj][m][n], 0, 0, 0); __builtin_amdgcn_s_setprio(0); } while (0)
#define PG8_WAIT_V(n) asm volatile("s_waitcnt vmcnt(" #n ")" ::: "memory")
#define PG8_WAIT_L(n) asm volatile("s_waitcnt lgkmcnt(" #n ")" ::: "memory")
#define PG8_BAR __builtin_amdgcn_s_barrier()
#define PG8_SCHED __builtin_amdgcn_sched_barrier(0)
    Unit cur, nxt; int ui = 0;
    if (!S.next(0, cur)) return;
    f32x4 acc[2][2][4][2];
#pragma unroll
    for (int a = 0; a < 2; ++a)
#pragma unroll
        for (int b = 0; b < 2; ++b)
#pragma unroll
            for (int m = 0; m < 4; ++m)
#pragma unroll
                for (int n = 0; n < 2; ++n) acc[a][b][m][n] = (f32x4){0.f, 0.f, 0.f, 0.f};
    bf16x8 At[4][2], B0[2][2], B1[2][2];
    const char* cA = (const char*)g.A + (size_t)cur.pm * tstep + (size_t)cur.k0 * kstep; const char* cB = (const char*)g.Bt + (size_t)cur.pn * tstep + (size_t)cur.k0 * kstep;
    PG8_STAGE(PG8_SB(0, 0), cB, voffB); PG8_STAGE(PG8_SA(0, 0), cA, voffA); PG8_STAGE(PG8_SB(0, 1), cB + hstep, voffB); PG8_STAGE(PG8_SA(0, 1), cA + hstep, voffA);
    if (wr == 1) PG8_BAR;
    PG8_WAIT_V(4); PG8_BAR;
    PG8_STAGE(PG8_SB(1, 0), cB + kstep, voffB); PG8_STAGE(PG8_SA(1, 0), cA + kstep, voffA); PG8_STAGE(PG8_SB(1, 1), cB + hstep + kstep, voffB);
    PG8_WAIT_V(6); PG8_BAR;
    for (;;) {
        const bool has_next = S.next(ui + 1, nxt);
        const char* nA = has_next ? (const char*)g.A + (size_t)nxt.pm * tstep + (size_t)nxt.k0 * kstep : cA; const char* nB = has_next ? (const char*)g.Bt + (size_t)nxt.pn * tstep + (size_t)nxt.k0 * kstep : cB;
        const int nt = cur.nt;
        for (int t = 0; t < nt; t += 2) {
            const bool last = (t == nt - 2);
            const char* a1 = cA + (size_t)(t + 1) * kstep;
            const char* a2 = last ? nA : cA + (size_t)(t + 2) * kstep; const char* b2 = last ? nB : cB + (size_t)(t + 2) * kstep;
            const char* a3 = a2 + kstep; const char* b3 = b2 + kstep;
            if constexpr (Epi::RESCALE) { if (t == 8 || t == 12) E.rescale(acc, cur, t == 8 ? 0 : 1, wr, wc, fr, fq); }
            PG8_LDB(B0, 0, 0); PG8_SCHED; PG8_LDA(At, 0, 0); PG8_STAGE(PG8_SA(1, 1), a1 + hstep, voffA);
            PG8_WAIT_L(8); PG8_BAR; PG8_WAIT_L(0); PG8_MMA(0, 0, At, B0); PG8_BAR; PG8_SCHED;
            PG8_LDB(B1, 0, 1); PG8_STAGE(PG8_SB(0, 0), b2, voffB);
            PG8_BAR; PG8_WAIT_L(0); PG8_MMA(0, 1, At, B1); PG8_BAR;
            PG8_LDA(At, 0, 1); PG8_STAGE(PG8_SA(0, 0), a2, voffA);
            PG8_BAR; PG8_WAIT_L(0); PG8_MMA(1, 0, At, B0); PG8_BAR; PG8_SCHED;
            PG8_STAGE(PG8_SB(0, 1), b2 + hstep, voffB);
            PG8_WAIT_V(6); PG8_BAR; PG8_MMA(1, 1, At, B1); PG8_BAR;
            PG8_LDB(B0, 1, 0); PG8_SCHED; PG8_LDA(At, 1, 0); PG8_STAGE(PG8_SA(0, 1), a2 + hstep, voffA);
            PG8_WAIT_L(8); PG8_BAR; PG8_WAIT_L(0); PG8_MMA(0, 0, At, B0); PG8_BAR; PG8_SCHED;
            PG8_LDB(B1, 1, 1); PG8_STAGE(PG8_SB(1, 0), b3, voffB);
            PG8_BAR; PG8_WAIT_L(0); PG8_MMA(0, 1, At, B1); PG8_BAR;
            PG8_LDA(At, 1, 1); PG8_STAGE(PG8_SA(1, 0), a3, voffA);
            PG8_BAR; PG8_WAIT_L(0); PG8_MMA(1, 0, At, B0); PG8_BAR; PG8_SCHED;
            PG8_STAGE(PG8_SB(1, 1), b3 + hstep, voffB);
            PG8_WAIT_V(6); PG8_BAR; PG8_MMA(1, 1, At, B1); PG8_BAR;
        }
        E(acc, cur, wr, wc, fr, fq);
        if (!has_next) break;
#pragma unroll
        for (int a = 0; a < 2; ++a)
#pragma unroll
            for (int b = 0; b < 2; ++b)
#pragma unroll
                for (int m = 0; m < 4; ++m)
#pragma unroll
                    for (int n = 0; n < 2; ++n) acc[a][b][m][n] = (f32x4){0.f, 0.f, 0.f, 0.f};
        cur = nxt; cA = nA; cB = nB; ++ui;
    }
    PG8_WAIT_V(0);
    if (wr == 0) PG8_BAR;
    PG8_BAR;
#undef PG8_SA
#undef PG8_SB
#undef PG8_STAGE
#undef PG8_LDA
#undef PG8_LDB
#undef PG8_MMA
#undef PG8_WAIT_V
#undef PG8_WAIT_L
#undef PG8_BAR
#undef PG8_SCHED
}
}
using pg8::Unit;
typedef f32x4 AccT[2][2][4][2];

struct EpiSwiglu {
    static constexpr bool PERM = true, RESCALE = false;
    bf16_t* G;
    __device__ __forceinline__ void operator()(const AccT& acc, const Unit& u, int wr, int wc, int fr, int fq) const {
        const int row0 = u.pm * 256 + wr * 64 + fr, col0 = u.pn * 128 + wc * 32 + 8 * fq;
#pragma unroll
        for (int ai = 0; ai < 2; ++ai)
#pragma unroll
            for (int m = 0; m < 4; ++m) {
                float gv[8];
#pragma unroll
                for (int n = 0; n < 2; ++n)
#pragma unroll
                    for (int j = 0; j < 4; ++j) { const float a = acc[ai][0][m][n][j], b = acc[ai][1][m][n][j]; gv[n * 4 + j] = a * b * __builtin_amdgcn_rcpf(1.0f + __builtin_amdgcn_exp2f(a * -1.4426950408889634f)); }
                u32x4 w; w.x = pk2(gv[0], gv[1]); w.y = pk2(gv[2], gv[3]); w.z = pk2(gv[4], gv[5]); w.w = pk2(gv[6], gv[7]);
                *(u32x4*)(G + (size_t)(row0 + ai * 128 + m * 16) * FFH + col0) = w;
            }
    }
};
struct EpiResid {
    static constexpr bool PERM = true, RESCALE = false;
    const bf16_t* xin; bf16_t* xout; float* fout; float* xc; float* part; const float* mod; int gofs; float coef;
    __device__ __forceinline__ void operator()(const AccT& acc, const Unit& u, int wr, int wc, int fr, int fq) const {
        const int row0 = u.pm * 256 + wr * 64 + fr, col0 = u.pn * 256 + wc * 32 + 8 * fq;
        const bool lat = u.pm < 128;
        const int mr = lat ? (u.pm >> 4) : 8;
        const float* gp = mod + (size_t)mr * 9216 + gofs + col0;
#pragma unroll
        for (int bj = 0; bj < 2; ++bj) {
            const f32x4 g0 = *(const f32x4*)(gp + bj * 128) * coef, g1 = *(const f32x4*)(gp + bj * 128 + 4) * coef;
            if (lat) {
                u32x4 xw[8];
#pragma unroll
                for (int am = 0; am < 8; ++am) xw[am] = *(const u32x4*)(xin + (size_t)(row0 + (am >> 2) * 128 + (am & 3) * 16) * 1024 + col0 + bj * 128);
#pragma unroll
                for (int am = 0; am < 8; ++am) {
                    const int ai = am >> 2, m = am & 3;
                    const size_t o = (size_t)(row0 + ai * 128 + m * 16) * 1024 + col0 + bj * 128;
                    f32x4 v0 = {bflo(xw[am].x), bfhi(xw[am].x), bflo(xw[am].y), bfhi(xw[am].y)}, v1 = {bflo(xw[am].z), bfhi(xw[am].z), bflo(xw[am].w), bfhi(xw[am].w)};
                    v0 += g0 * acc[ai][bj][m][0]; v1 += g1 * acc[ai][bj][m][1];
                    if (fout) { *(f32x4*)(fout + o) = v0; *(f32x4*)(fout + o + 4) = v1; }
                    else { u32x4 w; w.x = pk2(v0[0], v0[1]); w.y = pk2(v0[2], v0[3]); w.z = pk2(v1[0], v1[1]); w.w = pk2(v1[2], v1[3]); *(u32x4*)(xout + o) = w; }
                }
            } else {
#pragma unroll
                for (int am = 0; am < 8; ++am) {
                    const int ai = am >> 2, m = am & 3;
                    const size_t o = (size_t)(row0 + ai * 128 + m * 16 - TL) * 1024 + col0 + bj * 128;
                    const f32x4 d0 = g0 * acc[ai][bj][m][0], d1 = g1 * acc[ai][bj][m][1];
                    if (u.split) { float* pp = part + (size_t)(u.split - 1) * 2048 * 1024 + o; *(f32x4*)pp = d0; *(f32x4*)(pp + 4) = d1; }
                    else { float* xp = xc + o; *(f32x4*)xp = *(const f32x4*)xp + d0; *(f32x4*)(xp + 4) = *(const f32x4*)(xp + 4) + d1; }
                }
            }
        }
    }
};
struct EpiIn {
    static constexpr bool PERM = true, RESCALE = false;
    bf16_t *qn, *kn, *vraw, *hyraw, *sgraw;
    __device__ __forceinline__ void operator()(const AccT& acc, const Unit& u, int wr, int wc, int fr, int fq) const {
        const int row0 = u.pm * 256 + wr * 64 + fr, pn = u.pn;
#pragma unroll
        for (int ai = 0; ai < 2; ++ai)
#pragma unroll
            for (int m = 0; m < 4; ++m) {
                const int r = row0 + ai * 128 + m * 16;
#pragma unroll
                for (int bj = 0; bj < 2; ++bj) {
                    const f32x4 v0 = acc[ai][bj][m][0], v1 = acc[ai][bj][m][1];
                    u32x4 w; w.x = pk2(v0[0], v0[1]); w.y = pk2(v0[2], v0[3]); w.z = pk2(v1[0], v1[1]); w.w = pk2(v1[2], v1[3]);
                    const int cl = bj * 128 + wc * 32 + 8 * fq;
                    bf16_t* dst;
                    if (pn < 4) {
                        int b, kidx; row_bk(r, b, kidx);
                        const int cc = (pn & 1) * 256 + cl, head = cc >> 7, comp = (cc >> 6) & 1, d = cc & 63;
                        dst = (pn < 2 ? qn : kn) + ((size_t)((b * 4 + head) * 2 + comp) * NK + kidx) * 64 + d;
                    } else if (pn < 6) dst = vraw + (size_t)r * 512 + (pn - 4) * 256 + cl;
                    else if (pn < 9) dst = hyraw + (size_t)r * 768 + (pn - 6) * 256 + cl;
                    else dst = sgraw + (size_t)r * 512 + (pn - 9) * 256 + cl;
                    *(u32x4*)dst = w;
                }
            }
    }
};
struct EpiGate3 {
    static constexpr bool PERM = true, RESCALE = false;
    bf16_t* g3; const float* bias;
    __device__ __forceinline__ void operator()(const AccT& acc, const Unit& u, int wr, int wc, int fr, int fq) const {
        const int row0 = u.pm * 256 + wr * 64 + fr, col0 = u.pn * 256 + wc * 32 + 8 * fq;
#pragma unroll
        for (int bj = 0; bj < 2; ++bj) {
            const f32x4 b0 = *(const f32x4*)(bias + col0 + bj * 128), b1 = *(const f32x4*)(bias + col0 + bj * 128 + 4);
#pragma unroll
            for (int ai = 0; ai < 2; ++ai)
#pragma unroll
                for (int m = 0; m < 4; ++m) {
                    const f32x4 v0 = acc[ai][bj][m][0] + b0, v1 = acc[ai][bj][m][1] + b1;
                    float gv[8];
#pragma unroll
                    for (int j = 0; j < 4; ++j) { gv[j] = fmaxf(sigmoidf_(v0[j]), 1e-5f); gv[4 + j] = fmaxf(sigmoidf_(v1[j]), 1e-5f); }
                    u32x4 w; w.x = pk2(gv[0], gv[1]); w.y = pk2(gv[2], gv[3]); w.z = pk2(gv[4], gv[5]); w.w = pk2(gv[6], gv[7]);
                    *(u32x4*)(g3 + (size_t)(row0 + ai * 128 + m * 16) * 3072 + col0 + bj * 128) = w;
                }
        }
    }
};
struct EpiMergeR {
    static constexpr bool PERM = true, RESCALE = true;
    const bf16_t* g3; bf16_t* mb;
    __device__ __forceinline__ void rescale(AccT& acc, const Unit& u, int which, int wr, int wc, int fr, int fq) const {
        const int row0 = u.pm * 256 + wr * 64 + fr, col0 = u.pn * 256 + wc * 32 + 8 * fq;
        const bf16_t* gb = g3 + (size_t)row0 * 3072 + which * 1024 + col0;
#pragma unroll
        for (int ai = 0; ai < 2; ++ai)
#pragma unroll
            for (int mh = 0; mh < 2; ++mh) {
                u32x4 nw[2][2], dw[2][2];
#pragma unroll
                for (int mm = 0; mm < 2; ++mm)
#pragma unroll
                    for (int bj = 0; bj < 2; ++bj) { const bf16_t* gp = gb + (size_t)(ai * 128 + (mh * 2 + mm) * 16) * 3072 + bj * 128; nw[mm][bj] = *(const u32x4*)gp; dw[mm][bj] = *(const u32x4*)(gp + 1024); }
#pragma unroll
                for (int mm = 0; mm < 2; ++mm)
#pragma unroll
                    for (int bj = 0; bj < 2; ++bj) {
                        const u32x4 n4 = nw[mm][bj], d4 = dw[mm][bj];
                        const f32x4 r0 = {bflo(n4.x) * __builtin_amdgcn_rcpf(bflo(d4.x)), bfhi(n4.x) * __builtin_amdgcn_rcpf(bfhi(d4.x)), bflo(n4.y) * __builtin_amdgcn_rcpf(bflo(d4.y)), bfhi(n4.y) * __builtin_amdgcn_rcpf(bfhi(d4.y))};
                        const f32x4 r1 = {bflo(n4.z) * __builtin_amdgcn_rcpf(bflo(d4.z)), bfhi(n4.z) * __builtin_amdgcn_rcpf(bfhi(d4.z)), bflo(n4.w) * __builtin_amdgcn_rcpf(bflo(d4.w)), bfhi(n4.w) * __builtin_amdgcn_rcpf(bfhi(d4.w))};
                        acc[ai][bj][mh * 2 + mm][0] *= r0; acc[ai][bj][mh * 2 + mm][1] *= r1;
                    }
                __builtin_amdgcn_sched_barrier(0);
            }
    }
    __device__ __forceinline__ void operator()(const AccT& acc, const Unit& u, int wr, int wc, int fr, int fq) const {
        const int row0 = u.pm * 256 + wr * 64 + fr, col0 = u.pn * 256 + wc * 32 + 8 * fq;
#pragma unroll
        for (int bj = 0; bj < 2; ++bj) {
            u32x4 gw[8];
#pragma unroll
            for (int am = 0; am < 8; ++am) gw[am] = *(const u32x4*)(g3 + (size_t)(row0 + (am >> 2) * 128 + (am & 3) * 16) * 3072 + 2048 + col0 + bj * 128);
#pragma unroll
            for (int am = 0; am < 8; ++am) {
                const int ai = am >> 2, m = am & 3;
                const f32x4 v0 = acc[ai][bj][m][0], v1 = acc[ai][bj][m][1];
                u32x4 w; w.x = pk2(v0[0] * bflo(gw[am].x), v0[1] * bfhi(gw[am].x)); w.y = pk2(v0[2] * bflo(gw[am].y), v0[3] * bfhi(gw[am].y));
                w.z = pk2(v1[0] * bflo(gw[am].z), v1[1] * bfhi(gw[am].z)); w.w = pk2(v1[2] * bflo(gw[am].w), v1[3] * bfhi(gw[am].w));
                *(u32x4*)(mb + (size_t)(row0 + ai * 128 + m * 16) * 1024 + col0 + bj * 128) = w;
            }
        }
    }
};

template <class Epi>
__device__ __forceinline__ void run_gemm(unsigned char* smem, const bf16_t* A, const bf16_t* Bt, int M, int N, int K, const Epi& E, bool split_tail = false) {
    asm volatile("" : "+s"(M), "+s"(N), "+s"(K));
    pg8::Gemm g; g.A = A; g.Bt = Bt; g.M = M; g.N = N; g.K = K;
    pg8::StaticOrder S; S.init(M, N, K, gridDim.x, blockIdx.x, split_tail);
    pg8::gemm_phase<Epi>((LAS unsigned char*)smem, g, S, E);
}

__device__ __forceinline__ void mod_item(const Params& p, unsigned char* smem, int m) {
    float* s = (float*)smem;
    float* red = s + 9 * 1024;
    const int tid = TID(), l = m / 144, cb = m % 144;
    __syncthreads();
    for (int i = tid; i < 9216; i += NT) { const float v = (i < 8192) ? p.c[i] : p.c_ctx[i - 8192]; s[i] = v / (1.0f + __expf(-v)); }
    __syncthreads();
    const int kg = tid >> 6, cn = tid & 63, col = cb * 64 + cn;
    const float* w = p.ada_w + (size_t)l * 1024 * 9216 + col;
    float a0 = 0, a1 = 0, a2 = 0, a3 = 0, a4 = 0, a5 = 0, a6 = 0, a7 = 0, a8 = 0;
    for (int k = kg * 128; k < kg * 128 + 128; ++k) {
        const float wv = w[(size_t)k * 9216];
        a0 += s[k] * wv; a1 += s[1024 + k] * wv; a2 += s[2048 + k] * wv; a3 += s[3072 + k] * wv; a4 += s[4096 + k] * wv;
        a5 += s[5120 + k] * wv; a6 += s[6144 + k] * wv; a7 += s[7168 + k] * wv; a8 += s[8192 + k] * wv;
    }
    float* rp = red + kg * 576 + cn;
    rp[0] = a0; rp[64] = a1; rp[128] = a2; rp[192] = a3; rp[256] = a4; rp[320] = a5; rp[384] = a6; rp[448] = a7; rp[512] = a8;
    __syncthreads();
    float* MOD = (float*)(p.ws + O_MOD);
    for (int i = tid; i < 576; i += NT) {
        float v = 0; for (int q = 0; q < 8; ++q) v += red[q * 576 + i];
        const int r = i >> 6, c2 = cb * 64 + (i & 63);
        MOD[((size_t)l * 9 + r) * 9216 + c2] = v + p.ada_b[(size_t)l * 9216 + c2];
    }
}

__device__ __forceinline__ void filt_item(const Params& p, unsigned char* smem, int l, int n, int item, float* filt, float* l1p) {
    float* z = (float*)smem;
    float* h1 = z + 16 * 36;
    float* h2 = h1 + 16 * 64;
    const int tid = TID(), t0 = item * 16;
    __syncthreads();
    for (int i = tid; i < 16 * 33; i += NT) {
        const int tt = i / 33, e = i % 33, t = t0 + tt; float v;
        if (e == 0) v = (float)t / (float)(n - 1);
        else { const int bi = (e - 1) & 15; const float band = 1e-4f + (float)bi * ((15.0f - 1e-4f) / 15.0f); const float wv = (6.283185307179586f / (float)n) * (float)t;
            v = (e <= 16) ? cosf(band * wv) : -sinf(band * wv); }
        z[tt * 36 + e] = v;
    }
    __syncthreads();
    for (int i = tid; i < 16 * 64; i += NT) {
        const int tt = i >> 6, j = i & 63; float a = p.hy_b1[l * 64 + j];
        for (int e = 0; e < 33; ++e) a += z[tt * 36 + e] * p.hy_w1[((size_t)l * 33 + e) * 64 + j];
        h1[i] = sinf(p.hy_freq[l * 64 + j] * a);
    }
    __syncthreads();
    for (int i = tid; i < 16 * 64; i += NT) {
        const int tt = i >> 6, j = i & 63; float a = p.hy_b2[l * 64 + j];
        for (int e = 0; e < 64; ++e) a += h1[tt * 64 + e] * p.hy_w2[((size_t)l * 64 + e) * 64 + j];
        h2[i] = sinf(p.hy_freq[l * 64 + j] * a);
    }
    __syncthreads();
    const float min_decay = -3.0701134573253945f, max_decay = -15.350567286626973f;
#pragma unroll 1
    for (int cc = 0; cc < 2; ++cc) {
        const int col = tid + cc * 512;
        float acc[16];
#pragma unroll
        for (int tt = 0; tt < 16; ++tt) acc[tt] = 0.f;
        for (int e = 0; e < 64; ++e) {
            const float wv = p.hy_w3[((size_t)l * 64 + e) * 1024 + col];
#pragma unroll
            for (int tt = 0; tt < 16; ++tt) acc[tt] += h2[tt * 64 + e] * wv;
        }
        const int dir = col >> 9, oc = col & 511;
        const float ad = fabsf(min_decay + (float)oc * ((max_decay - min_decay) / 511.0f));
        float* dst = filt + (size_t)oc * (2 * n);
        float l1 = 0.f;
#pragma unroll
        for (int tt = 0; tt < 16; ++tt) {
            const int t = t0 + tt; const float tn = (float)t / (float)(n - 1);
            float v = acc[tt] * __expf(-tn * ad);
            if (dir == 0) dst[t] = v;
            else if (t == 0) { dst[n] = 0.f; v = 0.f; }
            else dst[2 * n - t] = v;
            l1 += fabsf(v);
        }
        l1p[(size_t)item * 1024 + col] = l1;
    }
}

struct WDesc { const float* src; bf16_t* dst; int ld, K; };
__device__ __forceinline__ WDesc wdesc(const Params& p, int l, int ti) {
    WDesc d; int K, nrb, mapsw = 0; const float* src; bf16_t* dst; int ld;
    const size_t L = (size_t)l;
    if (ti < 1408) { src = p.ffn_up + (L * 2 + 0) * 1024 * 5632; ld = 5632; K = 1024; dst = (bf16_t*)(p.ws + O_WUP0); mapsw = 1; }
    else if ((ti -= 1408) < 1408) { src = p.ffn_up + (L * 2 + 1) * 1024 * 5632; ld = 5632; K = 1024; dst = (bf16_t*)(p.ws + O_WUP1); mapsw = 1; }
    else if ((ti -= 1408) < 704) { src = p.ffn_down + (L * 2 + 0) * 2816 * 1024; ld = 1024; K = 2816; dst = (bf16_t*)(p.ws + O_WDN0); }
    else if ((ti -= 704) < 704) { src = p.ffn_down + (L * 2 + 1) * 2816 * 1024; ld = 1024; K = 2816; dst = (bf16_t*)(p.ws + O_WDN1); }
    else if ((ti -= 704) < 704) { src = p.w_in + L * 1024 * 2816; ld = 2816; K = 1024; dst = (bf16_t*)(p.ws + O_WIN); }
    else if ((ti -= 704) < 768) { src = p.gate_w + L * 1024 * 3072; ld = 3072; K = 1024; dst = (bf16_t*)(p.ws + O_WG); }
    else if ((ti -= 768) < 256) { src = p.w_br + L * 1024 * 1024; ld = 1024; K = 1024; dst = (bf16_t*)(p.ws + O_WBR); }
    else { ti -= 256; src = p.w_o + L * 1024 * 1024; ld = 1024; K = 1024; dst = (bf16_t*)(p.ws + O_WO); }
    nrb = K / 64;
    const int nb = ti / nrb, kb = ti % nrb, n0 = nb * 64, k0 = kb * 64;
    int scol = n0;
    if (mapsw) { const int pn = n0 >> 8, half = (n0 >> 7) & 1; scol = half * 2816 + pn * 128 + (n0 & 127); }
    d.src = src + (size_t)k0 * ld + scol; d.dst = dst + (size_t)n0 * K + k0; d.ld = ld; d.K = K;
    return d;
}
__device__ __forceinline__ void wconv_tiles(const Params& p, unsigned char* smem, int l, int nw) {
    float* tile = (float*)smem;
    const int tid = TID(), kk0 = tid >> 6, nn0 = tid & 63, nn = tid >> 3, ks = tid & 7;
    int ti = blockIdx.x;
    if (ti >= nw) return;
    WDesc d = wdesc(p, l, ti);
    float v[8];
#pragma unroll
    for (int i = 0; i < 8; ++i) v[i] = d.src[(size_t)(kk0 + 8 * i) * d.ld + nn0];
    for (;;) {
        const int tn = ti + gridDim.x; const bool more = tn < nw;
        WDesc dn = d; float vn[8];
        if (more) { dn = wdesc(p, l, tn);
#pragma unroll
            for (int i = 0; i < 8; ++i) vn[i] = dn.src[(size_t)(kk0 + 8 * i) * dn.ld + nn0]; }
        __syncthreads();
#pragma unroll
        for (int i = 0; i < 8; ++i) tile[(kk0 + 8 * i) * 65 + nn0] = v[i];
        __syncthreads();
        float o[8];
#pragma unroll
        for (int j = 0; j < 8; ++j) o[j] = tile[(ks * 8 + j) * 65 + nn];
        u32x4 w; w.x = pk2(o[0], o[1]); w.y = pk2(o[2], o[3]); w.z = pk2(o[4], o[5]); w.w = pk2(o[6], o[7]);
        *(u32x4*)(d.dst + (size_t)nn * d.K + ks * 8) = w;
        if (!more) break;
        d = dn; ti = tn;
#pragma unroll
        for (int i = 0; i < 8; ++i) v[i] = vn[i];
    }
}

__device__ __forceinline__ void aux_phase(const Params& p, unsigned char* smem, int l) {
    const int nmod = (l == 0) ? 288 : 0, nf = 256, nfc = (l == 0) ? 16 : 0, nw = 6208;
    const int total = nmod + nf + nfc;
    for (int rep = 0; rep < REP_AUX; ++rep) {
        for (int it = blockIdx.x; it < total; it += gridDim.x) {
            int i = it;
            if (i < nmod) { mod_item(p, smem, i); continue; }
            i -= nmod;
            if (i < nf) { filt_item(p, smem, l, 4096, i, (float*)(p.ws + O_FILT), (float*)(p.ws + O_L1P)); continue; }
            i -= nf;
            filt_item(p, smem, l, 256, i, (float*)(p.ws + O_FILTC), (float*)(p.ws + O_L1PC));
        }
        wconv_tiles(p, smem, l, nw);
    }
}

__device__ __forceinline__ void norm_phase(const Params& p, int l, int sub, int M, bool first, const bf16_t* xl) {
    const float* PART = (const float*)(p.ws + O_PART);
    const int tid = TID(), lane = tid & 63, wv = tid >> 6;
    const float* MOD = (const float*)(p.ws + O_MOD) + (size_t)l * 9 * 9216;
    const float* gn = p.norm_g + ((size_t)l * 3 + sub) * 1024;
    float* XC = (float*)(p.ws + O_XC);
    bf16_t* H = (bf16_t*)(p.ws + O_H);
    const int rstep = gridDim.x * 8;
    for (int rep = 0; rep < REP_NORM; ++rep)
    for (int r0 = blockIdx.x * 8 + wv; r0 < M; r0 += 4 * rstep) {
        f32x4 v[4][4]; float ss[4];
#pragma unroll
        for (int k = 0; k < 4; ++k) {
            const int r = r0 + k * rstep; ss[k] = 0.f;
            if (r >= M) { continue; }
            if (r >= TL) {
                const float* src = (first ? p.ctx : XC) + (size_t)(r - TL) * 1024;
#pragma unroll
                for (int i = 0; i < 4; ++i) { const size_t o = (size_t)(r - TL) * 1024 + i * 256 + lane * 4; v[k][i] = *(const f32x4*)(src + i * 256 + lane * 4);
                    if (!first) { v[k][i] += *(const f32x4*)(PART + o); v[k][i] += *(const f32x4*)(PART + 2048 * 1024 + o); v[k][i] += *(const f32x4*)(PART + 2 * 2048 * 1024 + o); v[k][i] += *(const f32x4*)(PART + 3 * 2048 * 1024 + o); } }
            } else if (first) {
                const float* src = p.x + (size_t)r * 1024;
#pragma unroll
                for (int i = 0; i < 4; ++i) v[k][i] = *(const f32x4*)(src + i * 256 + lane * 4);
            } else {
                const bf16_t* src = xl + (size_t)r * 1024;
#pragma unroll
                for (int i = 0; i < 4; ++i) { const u32x2 w = *(const u32x2*)(src + i * 256 + lane * 4); v[k][i] = (f32x4){bflo(w.x), bfhi(w.x), bflo(w.y), bfhi(w.y)}; }
            }
        }
#pragma unroll
        for (int k = 0; k < 4; ++k) {
            const int r = r0 + k * rstep;
            if (r >= M) continue;
            if (r >= TL) {
#pragma unroll
                for (int i = 0; i < 4; ++i) *(f32x4*)(XC + (size_t)(r - TL) * 1024 + i * 256 + lane * 4) = v[k][i];
            } else if (first) {
                bf16_t* dstx = (bf16_t*)p.out + (size_t)r * 1024;
#pragma unroll
                for (int i = 0; i < 4; ++i) { u32x2 w; w.x = pk2(v[k][i][0], v[k][i][1]); w.y = pk2(v[k][i][2], v[k][i][3]); *(u32x2*)(dstx + i * 256 + lane * 4) = w; v[k][i] = (f32x4){bflo(w.x), bfhi(w.x), bflo(w.y), bfhi(w.y)}; }
            }
            float s2 = 0.f;
#pragma unroll
            for (int i = 0; i < 4; ++i) s2 += v[k][i][0] * v[k][i][0] + v[k][i][1] * v[k][i][1] + v[k][i][2] * v[k][i][2] + v[k][i][3] * v[k][i][3];
            s2 = wave_sum(s2);
            const float rinv = rsqrtf(s2 * (1.0f / 1024.0f) + 1e-6f);
            const int mr = r < TL ? (r >> 12) : 8;
            const float* sh = MOD + (size_t)mr * 9216 + (3 * sub) * 1024;
            const float* sc = sh + 1024;
#pragma unroll
            for (int i = 0; i < 4; ++i) {
                const int c = i * 256 + lane * 4;
                const f32x4 g4 = *(const f32x4*)(gn + c), s4 = *(const f32x4*)(sc + c), h4 = *(const f32x4*)(sh + c);
                const f32x4 y = v[k][i] * rinv * g4 * (s4 + 1.0f) + h4;
                u32x2 w; w.x = pk2(y[0], y[1]); w.y = pk2(y[2], y[3]);
                *(u32x2*)(H + (size_t)r * 1024 + c) = w;
            }
        }
    }
}

#define ZI(i) ((i) + ((i) >> 4))
__device__ __forceinline__ f32x2 cmul(f32x2 a, f32x2 b) { return (f32x2){a.x * b.x - a.y * b.y, a.x * b.y + a.y * b.x}; }
__device__ __forceinline__ f32x2 cmulc(f32x2 a, f32x2 b) { return (f32x2){a.x * b.x + a.y * b.y, a.y * b.x - a.x * b.y}; }
__device__ __forceinline__ void dif8(f32x2 (&x)[8]) {
    const float C = 0.70710678118654752f;
    { f32x2 t;
      t = x[0] - x[4]; x[0] += x[4]; x[4] = t;
      t = x[1] - x[5]; x[1] += x[5]; x[5] = (f32x2){C * (t.x + t.y), C * (t.y - t.x)};
      t = x[2] - x[6]; x[2] += x[6]; x[6] = (f32x2){t.y, -t.x};
      t = x[3] - x[7]; x[3] += x[7]; x[7] = (f32x2){C * (t.y - t.x), -C * (t.x + t.y)}; }
#pragma unroll
    for (int b = 0; b < 8; b += 4) { f32x2 t;
      t = x[b] - x[b + 2]; x[b] += x[b + 2]; x[b + 2] = t;
      t = x[b + 1] - x[b + 3]; x[b + 1] += x[b + 3]; x[b + 3] = (f32x2){t.y, -t.x}; }
#pragma unroll
    for (int b = 0; b < 8; b += 2) { const f32x2 t = x[b] - x[b + 1]; x[b] += x[b + 1]; x[b + 1] = t; }
}
__device__ __forceinline__ void idif8(f32x2 (&x)[8]) {
    const float C = 0.70710678118654752f;
#pragma unroll
    for (int b = 0; b < 8; b += 2) { const f32x2 t = x[b] - x[b + 1]; x[b] += x[b + 1]; x[b + 1] = t; }
#pragma unroll
    for (int b = 0; b < 8; b += 4) { f32x2 v, u;
      v = x[b + 2]; u = x[b]; x[b] = u + v; x[b + 2] = u - v;
      v = (f32x2){-x[b + 3].y, x[b + 3].x}; u = x[b + 1]; x[b + 1] = u + v; x[b + 3] = u - v; }
    { f32x2 v, u, t;
      v = x[4]; u = x[0]; x[0] = u + v; x[4] = u - v;
      t = x[5]; v = (f32x2){C * (t.x - t.y), C * (t.x + t.y)}; u = x[1]; x[1] = u + v; x[5] = u - v;
      t = x[6]; v = (f32x2){-t.y, t.x}; u = x[2]; x[2] = u + v; x[6] = u - v;
      t = x[7]; v = (f32x2){-C * (t.x + t.y), C * (t.x - t.y)}; u = x[3]; x[3] = u + v; x[7] = u - v; }
}
__device__ __forceinline__ void twid8(f32x2 (&x)[8], int pidx, int L, bool conj) {
    const float rev = -(float)pidx / (float)L;
    const float s = __builtin_amdgcn_sinf(rev), c = __builtin_amdgcn_cosf(rev);
    const f32x2 w1 = {c, s}; const f32x2 w2 = cmul(w1, w1), w3 = cmul(w2, w1), w4 = cmul(w2, w2), w5 = cmul(w4, w1), w6 = cmul(w3, w3), w7 = cmul(w4, w3);
    if (!conj) { x[1] = cmul(x[1], w4); x[2] = cmul(x[2], w2); x[3] = cmul(x[3], w6); x[4] = cmul(x[4], w1); x[5] = cmul(x[5], w5); x[6] = cmul(x[6], w3); x[7] = cmul(x[7], w7); }
    else { x[1] = cmulc(x[1], w4); x[2] = cmulc(x[2], w2); x[3] = cmulc(x[3], w6); x[4] = cmulc(x[4], w1); x[5] = cmulc(x[5], w5); x[6] = cmulc(x[6], w3); x[7] = cmulc(x[7], w7); }
}
__device__ __forceinline__ void fft_fwd(f32x2* z) {
    const int tid = TID();
#pragma unroll 1
    for (int L = 8192; L >= 16; L >>= 3) {
        const int S = L >> 3;
#pragma unroll
        for (int qq = 0; qq < 2; ++qq) { const int q = tid + qq * NT;
            const int pidx = q & (S - 1), B = (q / S) * L + pidx;
            f32x2 x[8];
#pragma unroll
            for (int j = 0; j < 8; ++j) x[j] = z[ZI(B + j * S)];
            dif8(x); twid8(x, pidx, L, false);
#pragma unroll
            for (int j = 0; j < 8; ++j) z[ZI(B + j * S)] = x[j];
        }
        __syncthreads();
    }
#pragma unroll 4
    for (int q = tid; q < 4096; q += NT) { const f32x2 a = z[ZI(2 * q)], b = z[ZI(2 * q + 1)]; z[ZI(2 * q)] = a + b; z[ZI(2 * q + 1)] = a - b; }
    __syncthreads();
}
__device__ __forceinline__ void fft_inv(f32x2* z) {
    const int tid = TID();
#pragma unroll 4
    for (int q = tid; q < 4096; q += NT) { const f32x2 a = z[ZI(2 * q)], b = z[ZI(2 * q + 1)]; z[ZI(2 * q)] = a + b; z[ZI(2 * q + 1)] = a - b; }
    __syncthreads();
#pragma unroll 1
    for (int L = 16; L <= 8192; L <<= 3) {
        const int S = L >> 3;
#pragma unroll
        for (int qq = 0; qq < 2; ++qq) { const int q = tid + qq * NT;
            const int pidx = q & (S - 1), B = (q / S) * L + pidx;
            f32x2 x[8];
#pragma unroll
            for (int j = 0; j < 8; ++j) x[j] = z[ZI(B + j * S)];
            twid8(x, pidx, L, true); idif8(x);
#pragma unroll
            for (int j = 0; j < 8; ++j) z[ZI(B + j * S)] = x[j];
        }
        __syncthreads();
    }
}

__device__ __forceinline__ void fft_fwd_h(f32x2* z, int lt) {
#pragma unroll 1
    for (int L = 8192; L >= 16; L >>= 3) {
        const int S = L >> 3;
#pragma unroll 2
        for (int qq = 0; qq < 4; ++qq) { const int q = lt + qq * 256;
            const int pidx = q & (S - 1), B = (q / S) * L + pidx;
            f32x2 x[8];
#pragma unroll
            for (int j = 0; j < 8; ++j) x[j] = z[ZI(B + j * S)];
            dif8(x); twid8(x, pidx, L, false);
#pragma unroll
            for (int j = 0; j < 8; ++j) z[ZI(B + j * S)] = x[j];
        }
        __syncthreads();
    }
#pragma unroll 4
    for (int q = lt; q < 4096; q += 256) { const f32x2 a = z[ZI(2 * q)], b = z[ZI(2 * q + 1)]; z[ZI(2 * q)] = a + b; z[ZI(2 * q + 1)] = a - b; }
    __syncthreads();
}
__device__ __forceinline__ void fft_inv_h(f32x2* z, int lt) {
#pragma unroll 4
    for (int q = lt; q < 4096; q += 256) { const f32x2 a = z[ZI(2 * q)], b = z[ZI(2 * q + 1)]; z[ZI(2 * q)] = a + b; z[ZI(2 * q + 1)] = a - b; }
    __syncthreads();
#pragma unroll 1
    for (int L = 16; L <= 8192; L <<= 3) {
        const int S = L >> 3;
#pragma unroll 2
        for (int qq = 0; qq < 4; ++qq) { const int q = lt + qq * 256;
            const int pidx = q & (S - 1), B = (q / S) * L + pidx;
            f32x2 x[8];
#pragma unroll
            for (int j = 0; j < 8; ++j) x[j] = z[ZI(B + j * S)];
            twid8(x, pidx, L, true); idif8(x);
#pragma unroll
            for (int j = 0; j < 8; ++j) z[ZI(B + j * S)] = x[j];
        }
        __syncthreads();
    }
}

__device__ __forceinline__ void filtfft_item(const Params& p, unsigned char* smem, int oc) {
    f32x2* z = (f32x2*)smem;
    float* red = (float*)(smem + 8704 * 8);
    const int tid = TID();
    const float* filt = (const float*)(p.ws + O_FILT) + (size_t)oc * 8192;
    const float* l1p = (const float*)(p.ws + O_L1P);
    __syncthreads();
#pragma unroll 4
    for (int i = tid; i < 8192; i += NT) z[ZI(i)] = (f32x2){filt[i], 0.f};
    if (tid < 256) red[tid] = l1p[(size_t)tid * 1024 + oc] + l1p[(size_t)tid * 1024 + 512 + oc];
    __syncthreads();
    if (tid < 64) { float v = red[tid] + red[tid + 64] + red[tid + 128] + red[tid + 192]; v = wave_sum(v); if (tid == 0) red[256] = v; }
    fft_fwd(z);
    const float sc = 1.0f / (red[256] * 8192.0f);
    f32x2* fh = (f32x2*)(p.ws + O_FH) + (size_t)oc * 8192;
#pragma unroll 4
    for (int i = tid; i < 8192; i += NT) fh[i] = z[ZI(i)] * sc;
}

__device__ __forceinline__ void hyfft_item(const Params& p, unsigned char* smem, int l, int ch, int bp) {
    f32x2* z = (f32x2*)smem;
    f32x2* zz = (f32x2*)(smem + 8704 * 8);
    const int tid = TID();
    const bf16_t* HV = (const bf16_t*)(p.ws + O_HV);
    const bf16_t* v0 = HV + ((size_t)(2 * bp) * 768 + ch) * 4096; const bf16_t* v1 = v0 + (size_t)768 * 4096;
    const f32x2* fh0 = (const f32x2*)(p.ws + O_FH) + (size_t)ch * 8192; const f32x2* fh1 = fh0 + (size_t)256 * 8192;
    const float sk0 = p.hy_skip[(size_t)l * 512 + ch], sk1 = p.hy_skip[(size_t)l * 512 + 256 + ch];
    bf16_t a0[8], a1[8];
#pragma unroll
    for (int k = 0; k < 8; ++k) { a0[k] = v0[tid + k * NT]; a1[k] = v1[tid + k * NT]; }
    f32x2 fr[16];
#pragma unroll
    for (int k = 0; k < 16; ++k) fr[k] = fh0[tid + k * NT];
    __syncthreads();
#pragma unroll
    for (int k = 0; k < 8; ++k) { const int t = tid + k * NT; z[ZI(t)] = (f32x2){bf2f(a0[k]), bf2f(a1[k])}; z[ZI(4096 + t)] = (f32x2){0.f, 0.f}; }
    __syncthreads();
    fft_fwd(z);
#pragma unroll
    for (int k = 0; k < 16; ++k) { const int i = tid + k * NT; z[ZI(i)] = cmul(z[ZI(i)], fr[k]); }
    bf16_t x0[8], x1[8];
#pragma unroll
    for (int k = 0; k < 8; ++k) { x0[k] = v0[(size_t)256 * 4096 + tid + k * NT]; x1[k] = v1[(size_t)256 * 4096 + tid + k * NT]; }
#pragma unroll
    for (int k = 0; k < 16; ++k) fr[k] = fh1[tid + k * NT];
    __syncthreads();
    fft_inv(z);
#pragma unroll
    for (int k = 0; k < 8; ++k) {
        const int t = tid + k * NT;
        f32x2 y = z[ZI(t)];
        y.x += bf2f(a0[k]) * sk0; y.y += bf2f(a1[k]) * sk0;
        const f32x2 zv = {bf2f(x0[k]) * y.x, bf2f(x1[k]) * y.y};
        zz[t] = zv; z[ZI(t)] = zv; z[ZI(4096 + t)] = (f32x2){0.f, 0.f};
    }
    __syncthreads();
    fft_fwd(z);
#pragma unroll
    for (int k = 0; k < 16; ++k) { const int i = tid + k * NT; z[ZI(i)] = cmul(z[ZI(i)], fr[k]); }
#pragma unroll
    for (int k = 0; k < 8; ++k) { x0[k] = v0[(size_t)512 * 4096 + tid + k * NT]; x1[k] = v1[(size_t)512 * 4096 + tid + k * NT]; }
    __syncthreads();
    fft_inv(z);
    bf16_t* YBT = (bf16_t*)(p.ws + O_YBT);
    bf16_t* o0 = YBT + ((size_t)(2 * bp) * 256 + ch) * 4096; bf16_t* o1 = o0 + (size_t)256 * 4096;
#pragma unroll
    for (int k = 0; k < 8; ++k) {
        const int t = tid + k * NT;
        const f32x2 y = z[ZI(t)] + zz[t] * sk1;
        o0[t] = f2bf(bf2f(x0[k]) * y.x); o1[t] = f2bf(bf2f(x1[k]) * y.y);
    }
}

__device__ __forceinline__ void hyfft_pair(const Params& p, unsigned char* smem, int l, int ch, int pp) {
    const int tid = TID(), hf = __builtin_amdgcn_readfirstlane(tid >> 8), lt = tid & 255, bp = 2 * pp + hf;
    f32x2* z = (f32x2*)(smem + (size_t)hf * 8704 * 8);
    const bf16_t* HV = (const bf16_t*)(p.ws + O_HV);
    const bf16_t* v0 = HV + ((size_t)(2 * bp) * 768 + ch) * 4096; const bf16_t* v1 = v0 + (size_t)768 * 4096;
    const f32x2* fh0 = (const f32x2*)(p.ws + O_FH) + (size_t)ch * 8192; const f32x2* fh1 = fh0 + (size_t)256 * 8192;
    const float sk0 = p.hy_skip[(size_t)l * 512 + ch], sk1 = p.hy_skip[(size_t)l * 512 + 256 + ch];
    unsigned av[16];
#pragma unroll
    for (int k = 0; k < 16; ++k) av[k] = (unsigned)v0[lt + k * 256] | ((unsigned)v1[lt + k * 256] << 16);
    f32x2 fr[32];
#pragma unroll
    for (int k = 0; k < 32; ++k) fr[k] = fh0[lt + k * 256];
    __syncthreads();
#pragma unroll
    for (int k = 0; k < 16; ++k) { const int t = lt + k * 256; z[ZI(t)] = (f32x2){bflo(av[k]), bfhi(av[k])}; z[ZI(4096 + t)] = (f32x2){0.f, 0.f}; }
    __syncthreads();
    fft_fwd_h(z, lt);
#pragma unroll
    for (int k = 0; k < 32; ++k) { const int i = lt + k * 256; z[ZI(i)] = cmul(z[ZI(i)], fr[k]); }
    unsigned xv[16];
#pragma unroll
    for (int k = 0; k < 16; ++k) xv[k] = (unsigned)v0[(size_t)256 * 4096 + lt + k * 256] | ((unsigned)v1[(size_t)256 * 4096 + lt + k * 256] << 16);
#pragma unroll
    for (int k = 0; k < 32; ++k) fr[k] = fh1[lt + k * 256];
    __syncthreads();
    fft_inv_h(z, lt);
    f32x2 zz[16];
#pragma unroll
    for (int k = 0; k < 16; ++k) {
        const int t = lt + k * 256;
        f32x2 y = z[ZI(t)];
        y.x += bflo(av[k]) * sk0; y.y += bfhi(av[k]) * sk0;
        const f32x2 zv = {bflo(xv[k]) * y.x, bfhi(xv[k]) * y.y};
        zz[k] = zv; z[ZI(t)] = zv; z[ZI(4096 + t)] = (f32x2){0.f, 0.f};
    }
    __syncthreads();
    fft_fwd_h(z, lt);
#pragma unroll
    for (int k = 0; k < 32; ++k) { const int i = lt + k * 256; z[ZI(i)] = cmul(z[ZI(i)], fr[k]); }
#pragma unroll
    for (int k = 0; k < 16; ++k) xv[k] = (unsigned)v0[(size_t)512 * 4096 + lt + k * 256] | ((unsigned)v1[(size_t)512 * 4096 + lt + k * 256] << 16);
    __syncthreads();
    fft_inv_h(z, lt);
    bf16_t* YBT = (bf16_t*)(p.ws + O_YBT);
    bf16_t* o0 = YBT + ((size_t)(2 * bp) * 256 + ch) * 4096; bf16_t* o1 = o0 + (size_t)256 * 4096;
#pragma unroll
    for (int k = 0; k < 16; ++k) {
        const int t = lt + k * 256;
        const f32x2 y = z[ZI(t)] + zz[k] * sk1;
        o0[t] = f2bf(bflo(xv[k]) * y.x); o1[t] = f2bf(bfhi(xv[k]) * y.y);
    }
}

__device__ __forceinline__ void hyctx_item(const Params& p, unsigned char* smem, int l, int b, int cp) {
    float* f1 = (float*)smem;
    float* f2 = f1 + 1024;
    float* vv = f2 + 1024;
    float* zc = vv + 512;
    float* red = zc + 512;
    const int tid = TID(), hf = tid >> 8, t = tid & 255, ch = cp * 2 + hf;
    const float* FC = (const float*)(p.ws + O_FILTC); const float* l1p = (const float*)(p.ws + O_L1PC);
    const bf16_t* HVC = (const bf16_t*)(p.ws + O_HVC) + ((size_t)b * 768 + ch) * 256;
    __syncthreads();
    f1[hf * 512 + t] = FC[(size_t)ch * 512 + t]; f1[hf * 512 + 256 + t] = FC[(size_t)ch * 512 + 256 + t];
    f2[hf * 512 + t] = FC[(size_t)(256 + ch) * 512 + t]; f2[hf * 512 + 256 + t] = FC[(size_t)(256 + ch) * 512 + 256 + t];
    const float vt = bf2f(HVC[t]); vv[hf * 256 + t] = vt;
    if (t < 2) { float s = 0.f; for (int it = 0; it < 16; ++it) s += l1p[(size_t)it * 1024 + t * 256 + ch] + l1p[(size_t)it * 1024 + 512 + t * 256 + ch]; red[hf * 2 + t] = s; }
    __syncthreads();
    float a = 0.f;
    for (int s = 0; s < 256; ++s) a += f1[hf * 512 + ((t - s) & 511)] * vv[hf * 256 + s];
    const float y1 = a / red[hf * 2 + 0] + vt * p.hy_skip[(size_t)l * 512 + ch];
    const float zt = bf2f(HVC[(size_t)256 * 256 + t]) * y1; zc[hf * 256 + t] = zt;
    __syncthreads();
    float a2 = 0.f;
    for (int s = 0; s < 256; ++s) a2 += f2[hf * 512 + ((t - s) & 511)] * zc[hf * 256 + s];
    const float y2 = a2 / red[hf * 2 + 1] + zt * p.hy_skip[(size_t)l * 512 + 256 + ch];
    bf16_t* YBTC = (bf16_t*)(p.ws + O_YBTC);
    YBTC[((size_t)b * 256 + ch) * 256 + t] = f2bf(bf2f(HVC[(size_t)512 * 256 + t]) * y2);
}

__device__ __forceinline__ void qk_item(const Params& p, int l, int item, bool dry = false) {
    const int tid = TID(), seg = tid & 7, vsub = tid >> 3;
    const int which = (item >= 544) ? 1 : 0;
    const int vbase = (item - which * 544) * 512;
    bf16_t* base = (bf16_t*)(p.ws + (which ? O_KN : O_QN));
    u32x4 raw[8];
#pragma unroll
    for (int it = 0; it < 8; ++it) raw[it] = *(const u32x4*)(base + (size_t)(vbase + it * 64 + vsub) * 64 + seg * 8);
    const float* gp = p.qk_gain + (size_t)l * 128 + which * 64 + seg * 8;
    const f32x4 g0 = *(const f32x4*)gp, g1 = *(const f32x4*)(gp + 4);
    const float gn[8] = {g0[0], g0[1], g0[2], g0[3], g1[0], g1[1], g1[2], g1[3]};
    const float qs = which ? 1.0f : (0.125f * 1.4426950408889634f);
    const int axis = seg >> 2, role = (seg >> 1) & 1, qb = (seg & 1) * 8;
    float inv[8];
#pragma unroll
    for (int e = 0; e < 8; ++e) inv[e] = exp2f(-(float)(qb + e) * (13.287712379549449f / 16.0f));
#pragma unroll
    for (int it = 0; it < 8; ++it) {
        const int rem = vbase + it * 64 + vsub, kidx = rem % NK;
        const u32x4 w = raw[it];
        float v[8] = {bflo(w.x), bfhi(w.x), bflo(w.y), bfhi(w.y), bflo(w.z), bfhi(w.z), bflo(w.w), bfhi(w.w)};
        float ss = 0.f;
#pragma unroll
        for (int e = 0; e < 8; ++e) ss += v[e] * v[e];
        ss += __shfl_xor(ss, 1); ss += __shfl_xor(ss, 2); ss += __shfl_xor(ss, 4);
        const float rinv = rsqrtf(ss * (1.0f / 64.0f) + 1e-6f) * qs;
#pragma unroll
        for (int e = 0; e < 8; ++e) v[e] = v[e] * rinv * gn[e];
        const int t = kidx - 256;
        const float pos = (float)(axis ? (t & 63) : (t >> 6));
        float o[8];
#pragma unroll
        for (int e = 0; e < 8; ++e) {
            const float pe = __shfl_xor(v[e], 2);
            float sn, cs; __sincosf(pos * inv[e], &sn, &cs);
            const float r = role ? (pe * sn + v[e] * cs) : (v[e] * cs - pe * sn);
            o[e] = (kidx >= 256) ? r : v[e];
        }
        u32x4 ow = {pk2(o[0], o[1]), pk2(o[2], o[3]), pk2(o[4], o[5]), pk2(o[6], o[7])};
        if (dry) ow = w;
        *(u32x4*)(base + (size_t)rem * 64 + seg * 8) = ow;
    }
}

__device__ __forceinline__ void vt_item(const Params& p, unsigned char* smem, int tb) {
    bf16_t* tile = (bf16_t*)smem;
    const int tid = TID(), r0 = tb * 64;
    const bf16_t* src = (const bf16_t*)(p.ws + O_VRAW) + (size_t)r0 * 512;
    __syncthreads();
#pragma unroll
    for (int i = 0; i < 8; ++i) { const int e = tid + i * NT, rr = e >> 6, sg = e & 63; *(u32x4*)(tile + rr * 520 + sg * 8) = *(const u32x4*)(src + (size_t)rr * 512 + sg * 8); }
    __syncthreads();
    int b, kidx0; row_bk(r0, b, kidx0);
    bf16_t* dst = (bf16_t*)(p.ws + O_VT) + ((size_t)b * 512 + tid) * NK + kidx0;
#pragma unroll
    for (int s = 0; s < 8; ++s) {
        unsigned w[4];
#pragma unroll
        for (int j = 0; j < 4; ++j) w[j] = (unsigned)tile[(s * 8 + 2 * j) * 520 + tid] | ((unsigned)tile[(s * 8 + 2 * j + 1) * 520 + tid] << 16);
        *(u32x4*)(dst + s * 8) = (u32x4){w[0], w[1], w[2], w[3]};
    }
}

__device__ __forceinline__ void hyconv_item(const Params& p, unsigned char* smem, int l, int tb) {
    bf16_t* tile = (bf16_t*)smem;
    const int tid = TID(), r0 = tb * 64;
    const bool lat = r0 < TL;
    const int n = lat ? 4096 : 256, rb = lat ? r0 : r0 - TL, b = rb / n, t0 = rb % n;
    const bf16_t* src = (const bf16_t*)(p.ws + O_HYRAW);
    __syncthreads();
    for (int e = tid; e < 66 * 96; e += NT) {
        const int rr = e / 96, sg = e % 96, t = t0 - 1 + rr;
        u32x4 w = {0u, 0u, 0u, 0u};
        if (t >= 0 && t < n) w = *(const u32x4*)(src + (size_t)(r0 - 1 + rr) * 768 + sg * 8);
        *(u32x4*)(tile + rr * 776 + sg * 8) = w;
    }
    __syncthreads();
    const float* cw = p.hy_conv_w + (size_t)l * 3 * 768; const float* cb = p.hy_conv_b + (size_t)l * 768;
    for (int c = tid; c < 768; c += NT) {
        const float w0 = cw[c], w1 = cw[768 + c], w2 = cw[1536 + c], bb = cb[c];
        bf16_t* dst = lat ? (bf16_t*)(p.ws + O_HV) + ((size_t)b * 768 + c) * 4096 + t0 : (bf16_t*)(p.ws + O_HVC) + ((size_t)b * 768 + c) * 256 + t0;
        float pm = bf2f(tile[c]), pc = bf2f(tile[776 + c]);
#pragma unroll
        for (int s = 0; s < 8; ++s) {
            float o[8];
#pragma unroll
            for (int j = 0; j < 8; ++j) { const float pn = bf2f(tile[(s * 8 + j + 2) * 776 + c]); o[j] = pm * w0 + pc * w1 + pn * w2 + bb; pm = pc; pc = pn; }
            *(u32x4*)(dst + s * 8) = (u32x4){pk2(o[0], o[1]), pk2(o[2], o[3]), pk2(o[4], o[5]), pk2(o[6], o[7])};
        }
    }
}

__device__ __forceinline__ float gelu_exact(float v) { return 0.5f * v * (1.0f + erff(v * 0.70710678118654752f)); }
__device__ __forceinline__ void sgu_item(const Params& p, unsigned char* smem, int l, int ci) {
    bf16_t* vt = (bf16_t*)smem;
    const int tid = TID(), lane = tid & 63, wv = __builtin_amdgcn_readfirstlane(tid >> 6), r0 = ci * 128;
    const bf16_t* src = (const bf16_t*)(p.ws + O_SGRAW) + (size_t)r0 * 512;
    const float* lg = p.sg_ln_g + (size_t)l * 256; const float* lb = p.sg_ln_b + (size_t)l * 256;
    __syncthreads();
    {
        const f32x4 g4 = *(const f32x4*)(lg + lane * 4), b4 = *(const f32x4*)(lb + lane * 4);
        u32x2 wr_[16];
#pragma unroll
        for (int k = 0; k < 16; ++k) wr_[k] = *(const u32x2*)(src + (size_t)(wv + 8 * k) * 512 + 256 + lane * 4);
#pragma unroll
        for (int k = 0; k < 16; ++k) {
            const int rr = wv + 8 * k; const u32x2 w = wr_[k];
            float a[4] = {gelu_exact(bflo(w.x)), gelu_exact(bfhi(w.x)), gelu_exact(bflo(w.y)), gelu_exact(bfhi(w.y))};
            const float mu = wave_sum(a[0] + a[1] + a[2] + a[3]) * (1.0f / 256.0f);
            float d[4]; float sq = 0.f;
#pragma unroll
            for (int j = 0; j < 4; ++j) { d[j] = a[j] - mu; sq += d[j] * d[j]; }
            const float rstd = rsqrtf(wave_sum(sq) * (1.0f / 256.0f) + 1e-6f);
#pragma unroll
            for (int j = 0; j < 4; ++j) vt[(lane * 4 + j) * 136 + rr] = f2bf(d[j] * rstd * g4[j] + b4[j]);
        }
    }
    __syncthreads();
    const int g = wv & 3, ih = wv >> 2, l32 = lane & 31, kg = lane >> 5;
    const float* wsb = p.sg_w + ((size_t)l * 4 + g) * 128 * 128;
    const float* bsb = p.sg_b + ((size_t)l * 4 + g) * 128;
    bf16_t* yc = (bf16_t*)(p.ws + O_YCAT) + 768;
#pragma unroll 1
    for (int ib = 0; ib < 2; ++ib) {
        const int i0 = ih * 64 + ib * 32;
        f32x16 acc0, acc1;
#pragma unroll
        for (int r = 0; r < 16; ++r) { acc0[r] = 0.f; acc1[r] = 0.f; }
        const float* wrow = wsb + (size_t)(i0 + l32) * 128 + 8 * kg;
#pragma unroll
        for (int ks = 0; ks < 8; ++ks) {
            const f32x4 w0 = *(const f32x4*)(wrow + 16 * ks), w1 = *(const f32x4*)(wrow + 16 * ks + 4);
            const u32x4 aw = {pk2(w0[0], w0[1]), pk2(w0[2], w0[3]), pk2(w1[0], w1[1]), pk2(w1[2], w1[3])};
            const bf16x8 af = __builtin_bit_cast(bf16x8, aw);
            const bf16x8 b0 = *(const bf16x8*)(vt + (g * 64 + l32) * 136 + 16 * ks + 8 * kg);
            const bf16x8 b1 = *(const bf16x8*)(vt + (g * 64 + 32 + l32) * 136 + 16 * ks + 8 * kg);
            acc0 = __builtin_amdgcn_mfma_f32_32x32x16_bf16(af, b0, acc0, 0, 0, 0);
            acc1 = __builtin_amdgcn_mfma_f32_32x32x16_bf16(af, b1, acc1, 0, 0, 0);
        }
#pragma unroll
        for (int r = 0; r < 16; ++r) {
            const int i = i0 + 8 * (r >> 2) + 4 * kg + (r & 3);
            const float bi = bsb[i];
            const int c0 = g * 64 + l32, c1 = c0 + 32;
            const float u0 = gelu_exact(bf2f(src[(size_t)i * 512 + c0])), u1 = gelu_exact(bf2f(src[(size_t)i * 512 + c1]));
            yc[(size_t)(r0 + i) * 1024 + c0] = f2bf(u0 * (acc0[r] + bi));
            yc[(size_t)(r0 + i) * 1024 + c1] = f2bf(u1 * (acc1[r] + bi));
        }
    }
}

__device__ __forceinline__ void prep_phase(const Params& p, unsigned char* smem, int l) {
    const int n_sg = 0, n_hy = 544, n_vt = 544, n_qk = 1088;
    const int total = n_sg + n_hy + n_vt + n_qk;
    for (int it = blockIdx.x; it < total; it += gridDim.x) {
        int i = it;
        if (i < n_sg) { for (int rep = 0; rep < REP_SGU; ++rep) sgu_item(p, smem, l, i); continue; }
        i -= n_sg;
        if (i < n_hy) { for (int rep = 0; rep < REP_PREP; ++rep) hyconv_item(p, smem, l, i); continue; }
        i -= n_hy;
        if (i < n_vt) { for (int rep = 0; rep < REP_PREP; ++rep) vt_item(p, smem, i); continue; }
        i -= n_vt;
#if REP_QK > 1
        qk_item(p, l, i, true);
#endif
        qk_item(p, l, i);
    }
}

__device__ __forceinline__ void attn_item(const Params& p, unsigned char* smem, int b, int h, int comp, int q0, int rowbase, int nkt) {
    constexpr int ABUF = 64 * 72 + 128 * 72;
    bf16_t* Ks = (bf16_t*)smem;
    bf16_t* Vs = Ks + 64 * 72;
    const int tid = TID(), lane = tid & 63, w = tid >> 6, l32 = lane & 31, g = lane >> 5;
    const size_t hc = (size_t)((b * 4 + h) * 2 + comp);
    const bf16_t* Qb = (const bf16_t*)(p.ws + O_QN) + (hc * NK + q0 + 32 * w + l32) * 64;
    const bf16_t* Kb = (const bf16_t*)(p.ws + O_KN) + hc * NK * 64;
    const bf16_t* Vb = (const bf16_t*)(p.ws + O_VT) + (size_t)((b * 4 + h) * 128) * NK;
    bf16x8 qf[4];
#pragma unroll
    for (int ks = 0; ks < 4; ++ks) qf[ks] = *(const bf16x8*)(Qb + 16 * ks + 8 * g);
    f32x16 O[4];
#pragma unroll
    for (int d = 0; d < 4; ++d)
#pragma unroll
        for (int i = 0; i < 16; ++i) O[d][i] = 0.f;
    float lsum = 0.f;
    const int kkey = tid >> 3, kseg = tid & 7, vdv = tid >> 2, vseg = tid & 3;
    const bf16_t* kg = Kb + (size_t)kkey * 64 + kseg * 8;
    const bf16_t* vg = Vb + (size_t)vdv * NK + vseg * 16;
    u32x4 kreg = *(const u32x4*)kg, vr0 = *(const u32x4*)vg, vr1 = *(const u32x4*)(vg + 8);
    const int pr = (l32 & ~12) | ((l32 & 4) << 1) | ((l32 & 8) >> 1);
    __syncthreads();
    *(u32x4*)(Ks + kkey * 72 + kseg * 8) = kreg; *(u32x4*)(Vs + vdv * 72 + vseg * 16) = vr0; *(u32x4*)(Vs + vdv * 72 + vseg * 16 + 8) = vr1;
    if (nkt > 1) { kreg = *(const u32x4*)(kg + (size_t)64 * 64); vr0 = *(const u32x4*)(vg + 64); vr1 = *(const u32x4*)(vg + 64 + 8); }
    __syncthreads();
    for (int kt = 0; kt < nkt; ++kt) {
        const bf16_t* Kc = Ks + (kt & 1) * ABUF; const bf16_t* Vc = Vs + (kt & 1) * ABUF;
        if (kt + 1 < nkt) {
            bf16_t* Kn = Ks + ((kt + 1) & 1) * ABUF; bf16_t* Vn = Vs + ((kt + 1) & 1) * ABUF;
            *(u32x4*)(Kn + kkey * 72 + kseg * 8) = kreg; *(u32x4*)(Vn + vdv * 72 + vseg * 16) = vr0; *(u32x4*)(Vn + vdv * 72 + vseg * 16 + 8) = vr1;
            if (kt + 2 < nkt) { kreg = *(const u32x4*)(kg + (size_t)(kt + 2) * 64 * 64); vr0 = *(const u32x4*)(vg + (kt + 2) * 64); vr1 = *(const u32x4*)(vg + (kt + 2) * 64 + 8); }
        }
        f32x16 S0, S1;
#pragma unroll
        for (int i = 0; i < 16; ++i) { S0[i] = 0.f; S1[i] = 0.f; }
#pragma unroll
        for (int ks = 0; ks < 4; ++ks) {
            const bf16x8 ka = *(const bf16x8*)(Kc + pr * 72 + 16 * ks + 8 * g);
            const bf16x8 kb = *(const bf16x8*)(Kc + (32 + pr) * 72 + 16 * ks + 8 * g);
            S0 = __builtin_amdgcn_mfma_f32_32x32x16_bf16(ka, qf[ks], S0, 0, 0, 0);
            S1 = __builtin_amdgcn_mfma_f32_32x32x16_bf16(kb, qf[ks], S1, 0, 0, 0);
        }
#pragma unroll
        for (int i = 0; i < 16; ++i) { S0[i] = __builtin_amdgcn_exp2f(S0[i]); S1[i] = __builtin_amdgcn_exp2f(S1[i]); lsum += S0[i] + S1[i]; }
#pragma unroll
        for (int kb2 = 0; kb2 < 2; ++kb2)
#pragma unroll
            for (int s = 0; s < 2; ++s) {
                u32x4 pw;
                if (kb2 == 0) { pw.x = pk2(S0[8 * s], S0[8 * s + 1]); pw.y = pk2(S0[8 * s + 2], S0[8 * s + 3]); pw.z = pk2(S0[8 * s + 4], S0[8 * s + 5]); pw.w = pk2(S0[8 * s + 6], S0[8 * s + 7]); }
                else { pw.x = pk2(S1[8 * s], S1[8 * s + 1]); pw.y = pk2(S1[8 * s + 2], S1[8 * s + 3]); pw.z = pk2(S1[8 * s + 4], S1[8 * s + 5]); pw.w = pk2(S1[8 * s + 6], S1[8 * s + 7]); }
                const bf16x8 pf = __builtin_bit_cast(bf16x8, pw);
#pragma unroll
                for (int d = 0; d < 4; ++d) {
                    const bf16x8 va = *(const bf16x8*)(Vc + (d * 32 + l32) * 72 + kb2 * 32 + 16 * s + 8 * g);
                    O[d] = __builtin_amdgcn_mfma_f32_32x32x16_bf16(va, pf, O[d], 0, 0, 0);
                }
            }
        __syncthreads();
    }
    lsum += __shfl_xor(lsum, 32);
    const float inv = 1.0f / lsum;
    bf16_t* ob = (bf16_t*)(p.ws + O_OC) + ((size_t)(rowbase + 32 * w + l32) * 8 + h * 2 + comp) * 128;
#pragma unroll
    for (int d = 0; d < 4; ++d)
#pragma unroll
        for (int i4 = 0; i4 < 4; ++i4) {
            u32x2 o; o.x = pk2(O[d][4 * i4] * inv, O[d][4 * i4 + 1] * inv); o.y = pk2(O[d][4 * i4 + 2] * inv, O[d][4 * i4 + 3] * inv);
            *(u32x2*)(ob + d * 32 + 8 * i4 + 4 * g) = o;
        }
}

__device__ __forceinline__ void mix_phase(const Params& p, unsigned char* smem, int l) {
    const int n_al = 1024, n_ac = (l == 0) ? 64 : 0, n_hf = 512, n_hc = (l == 0) ? 1024 : 0;
    const int total = n_al + n_ac + n_hf + n_hc;
    for (int it = blockIdx.x; it < total; it += gridDim.x) {
        int i = it;
        if (i < n_al) { const int comp = i & 1, h = (i >> 1) & 3, qt = (i >> 3) & 15, b = i >> 7; for (int rep = 0; rep < REP_ATT; ++rep) attn_item(p, smem, b, h, comp, 256 + qt * 256, b * 4096 + qt * 256, 68); continue; }
        i -= n_al;
        if (i < n_ac) { const int comp = i & 1, h = (i >> 1) & 3, b = i >> 3; attn_item(p, smem, b, h, comp, 0, TL + b * 256, 4); continue; }
        i -= n_ac;
        if (i < n_hf) { for (int rep = 0; rep < REP_HY; ++rep) hyfft_pair(p, smem, l, i >> 1, i & 1); continue; }
        i -= n_hf;
        for (int rep = 0; rep < REP_MISC; ++rep) hyctx_item(p, smem, l, i >> 7, i & 127);
    }
}

__device__ __forceinline__ void ybt_item(const Params& p, unsigned char* smem, int tb) {
    bf16_t* tile = (bf16_t*)smem;
    const int tid = TID(), r0 = tb * 64;
    const bool lat = r0 < TL;
    const int n = lat ? 4096 : 256, rb = lat ? r0 : r0 - TL, b = rb / n, t0 = rb % n;
    const bf16_t* src = (lat ? (const bf16_t*)(p.ws + O_YBT) : (const bf16_t*)(p.ws + O_YBTC)) + (size_t)b * 256 * n + t0;
    __syncthreads();
#pragma unroll
    for (int i = 0; i < 4; ++i) { const int e = tid + i * NT, ch = e >> 3, sg = e & 7; *(u32x4*)(tile + ch * 72 + sg * 8) = *(const u32x4*)(src + (size_t)ch * n + sg * 8); }
    __syncthreads();
    bf16_t* yb = (bf16_t*)(p.ws + O_YCAT) + 512;
#pragma unroll
    for (int i = 0; i < 4; ++i) {
        const int e = tid + i * NT, rr = e >> 5, sg = e & 31;
        unsigned w[4];
#pragma unroll
        for (int j = 0; j < 4; ++j) w[j] = (unsigned)tile[(sg * 8 + 2 * j) * 72 + rr] | ((unsigned)tile[(sg * 8 + 2 * j + 1) * 72 + rr] << 16);
        *(u32x4*)(yb + (size_t)(r0 + rr) * 1024 + sg * 8) = (u32x4){w[0], w[1], w[2], w[3]};
    }
}
__device__ __forceinline__ void post_phase(const Params& p, unsigned char* smem, int l, int M) {
    const int n_sg = M / 128, nb = M / 64;
    for (int it = blockIdx.x; it < n_sg + nb; it += gridDim.x) {
        if (it < n_sg) { for (int rep = 0; rep < REP_SGU; ++rep) sgu_item(p, smem, l, it); }
        else ybt_item(p, smem, it - n_sg);
    }
    const int tid = TID(), lane = tid & 63, wv = tid >> 6;
    const float* lv = p.da_lambda + (size_t)l * 256;
    const float d01 = wave_sum(lv[lane] * lv[64 + lane]), d23 = wave_sum(lv[128 + lane] * lv[192 + lane]);
    const float lam_init = 0.8f - 0.6f * expf(-0.3f * (float)l);
    const float lam = expf(d01) - expf(d23) + lam_init;
    const float* sub = p.da_subln + (size_t)l * 128;
    const float s0 = sub[2 * lane] * (1.0f - lam_init), s1 = sub[2 * lane + 1] * (1.0f - lam_init);
    const bf16_t* OC = (const bf16_t*)(p.ws + O_OC);
    bf16_t* YA = (bf16_t*)(p.ws + O_YCAT);
    const int vstep = gridDim.x * 8;
    for (int v0i = blockIdx.x * 8 + wv; v0i < M * 4; v0i += 4 * vstep) {
        unsigned aw[4], bw[4];
#pragma unroll
        for (int k = 0; k < 4; ++k) { const int vi = v0i + k * vstep; aw[k] = 0u; bw[k] = 0u;
            if (vi < M * 4) { const bf16_t* o0 = OC + (size_t)vi * 256; aw[k] = *(const unsigned*)(o0 + 2 * lane); bw[k] = *(const unsigned*)(o0 + 128 + 2 * lane); } }
#pragma unroll
        for (int k = 0; k < 4; ++k) { const int vi = v0i + k * vstep;
            if (vi < M * 4) {
                const float x0 = bflo(aw[k]) - lam * bflo(bw[k]), x1 = bfhi(aw[k]) - lam * bfhi(bw[k]);
                const float rinv = rsqrtf(wave_sum(x0 * x0 + x1 * x1) * (1.0f / 128.0f) + 1e-6f);
                *(unsigned*)(YA + (size_t)(vi >> 2) * 1024 + (vi & 3) * 128 + 2 * lane) = pk2(x0 * rinv * s0, x1 * rinv * s1);
            } }
    }
}

template <int l> __device__ __forceinline__ void layer_body(unsigned char* smem) {
        const int Mfull = TT, Mpost = (l == 0) ? TT : TL;
        { const Params q = opq(smem); norm_phase(q, l, 0, Mfull, l == 0, (const bf16_t*)q.out); if (l == 1) aux_phase(q, smem, 1); }
        gsync(smem);
        for (int rep = 0; rep < REP_UP; ++rep) { const Params q = opq(smem); EpiSwiglu E; E.G = (bf16_t*)(q.ws + O_GH); run_gemm(smem, (const bf16_t*)(q.ws + O_H), (const bf16_t*)(q.ws + O_WUP0), Mfull, 5632, 1024, E); }
        gsync(smem);
        { const Params q = opq(smem); EpiResid E; E.xin = (const bf16_t*)q.out; E.xout = (bf16_t*)q.out; E.fout = nullptr; E.xc = (float*)(q.ws + O_XC); E.part = (float*)(q.ws + O_PART); E.mod = (const float*)(q.ws + O_MOD) + (size_t)l * 9 * 9216; E.gofs = 2 * 1024; E.coef = 0.5f;
          run_gemm(smem, (const bf16_t*)(q.ws + O_GH), (const bf16_t*)(q.ws + O_WDN0), Mfull, 1024, 2816, E, true);
          for (int rep = 1; rep < REP_DN; ++rep) { E.coef = 0.f; run_gemm(smem, (const bf16_t*)(q.ws + O_GH), (const bf16_t*)(q.ws + O_WDN0), Mfull, 1024, 2816, E); } }
        gsync(smem);
        { const Params q = opq(smem); norm_phase(q, l, 1, Mfull, false, (const bf16_t*)q.out); for (int rep = 0; rep < REP_MISC; ++rep) for (int it = blockIdx.x; it < 512; it += gridDim.x) filtfft_item(q, smem, it); }
        gsync(smem);
        for (int rep = 0; rep < REP_G3; ++rep) { const Params q = opq(smem); EpiIn E; E.qn = (bf16_t*)(q.ws + O_QN); E.kn = (bf16_t*)(q.ws + O_KN); E.vraw = (bf16_t*)(q.ws + O_VRAW); E.hyraw = (bf16_t*)(q.ws + O_HYRAW); E.sgraw = (bf16_t*)(q.ws + O_SGRAW);
          run_gemm(smem, (const bf16_t*)(q.ws + O_H), (const bf16_t*)(q.ws + O_WIN), Mfull, 2816, 1024, E); }
        gsync(smem);
        { const Params q = opq(smem); prep_phase(q, smem, l); }
        gsync(smem);
        { const Params q = opq(smem); mix_phase(q, smem, l); }
        gsync(smem);
        for (int rep = 0; rep < REP_MISC; ++rep) { const Params q = opq(smem); post_phase(q, smem, l, Mpost); }
        gsync(smem);
#pragma unroll 1
        for (int rep9 = 0; rep9 < REP_P9; ++rep9) {
            { const Params q = opq(smem); EpiGate3 E; E.g3 = (bf16_t*)(q.ws + O_G3); E.bias = q.gate_b + (size_t)l * 3072;
              run_gemm(smem, (const bf16_t*)(q.ws + O_H), (const bf16_t*)(q.ws + O_WG), Mpost, 3072, 1024, E); }
            gsync(smem);
            { const Params q = opq(smem); EpiMergeR E; E.g3 = (const bf16_t*)(q.ws + O_G3); E.mb = (bf16_t*)(q.ws + O_MB);
              run_gemm(smem, (const bf16_t*)(q.ws + O_YCAT), (const bf16_t*)(q.ws + O_WBR), Mpost, 1024, 1024, E); }
        }
        gsync(smem);
        { const Params q = opq(smem); EpiResid E; E.xin = (const bf16_t*)q.out; E.xout = (l == 1) ? (bf16_t*)(q.ws + O_XALT) : (bf16_t*)q.out; E.fout = nullptr; E.xc = (float*)(q.ws + O_XC); E.part = (float*)(q.ws + O_PART); E.mod = (const float*)(q.ws + O_MOD) + (size_t)l * 9 * 9216; E.gofs = 5 * 1024; E.coef = 1.0f;
          run_gemm(smem, (const bf16_t*)(q.ws + O_MB), (const bf16_t*)(q.ws + O_WO), Mpost, 1024, 1024, E, l == 0);
          for (int rep = 1; rep < REP_G3; ++rep) { E.coef = 0.f; run_gemm(smem, (const bf16_t*)(q.ws + O_MB), (const bf16_t*)(q.ws + O_WO), Mpost, 1024, 1024, E); } }
        gsync(smem);
        { const Params q = opq(smem); norm_phase(q, l, 2, Mpost, false, (l == 1) ? (const bf16_t*)(q.ws + O_XALT) : (const bf16_t*)q.out); }
        gsync(smem);
        for (int rep = 0; rep < REP_UP; ++rep) { const Params q = opq(smem); EpiSwiglu E; E.G = (bf16_t*)(q.ws + O_GH); run_gemm(smem, (const bf16_t*)(q.ws + O_H), (const bf16_t*)(q.ws + O_WUP1), Mpost, 5632, 1024, E); }
        gsync(smem);
        { const Params q = opq(smem); EpiResid E; E.xin = (l == 1) ? (const bf16_t*)(q.ws + O_XALT) : (const bf16_t*)q.out; E.xout = (bf16_t*)q.out; E.fout = (l == 1) ? q.out : nullptr; E.xc = (float*)(q.ws + O_XC); E.part = (float*)(q.ws + O_PART); E.mod = (const float*)(q.ws + O_MOD) + (size_t)l * 9 * 9216; E.gofs = 8 * 1024; E.coef = 0.5f;
          run_gemm(smem, (const bf16_t*)(q.ws + O_GH), (const bf16_t*)(q.ws + O_WDN1), Mpost, 1024, 2816, E, l == 0); }
}

__global__ void __launch_bounds__(512, 2) fwd_megakernel(Params p) {
    extern __shared__ __attribute__((aligned(16))) unsigned char smem[];
    cg::grid_group grid = cg::this_grid();
    if (threadIdx.x == 0) {
        *(Params*)(smem + POFF) = p;
        volatile unsigned* st = (volatile unsigned*)(smem + POFF + 256); st[0] = 0u; st[1] = 0u;
        xb_add(&((unsigned*)(p.ws + O_BAR))[XB_XCNT(xb_xcc_id())], 1u);
    }
    __syncthreads();
    { const Params q = opq(smem); aux_phase(q, smem, 0); }
    grid.sync();
    layer_body<0>(smem);
    gsync(smem);
    layer_body<1>(smem);
}

extern "C" void kernel_launch(void* const* d_in, const int* in_sizes, int n_in, void* d_out, int out_size, void* d_ws, size_t ws_size, hipStream_t stream) {
    if (ws_size < WS_NEED) { fprintf(stderr, "workspace too small: need %zu have %zu\n", (size_t)WS_NEED, ws_size); return; }
    static int grid_blocks = 0;
    if (!grid_blocks) {
        hipFuncSetAttribute((const void*)fwd_megakernel, hipFuncAttributeMaxDynamicSharedMemorySize, LDS_BYTES);
        int dev = 0, cus = 0, per_cu = 0;
        hipGetDevice(&dev);
        hipDeviceGetAttribute(&cus, hipDeviceAttributeMultiprocessorCount, dev);
        hipOccupancyMaxActiveBlocksPerMultiprocessor(&per_cu, fwd_megakernel, NT, LDS_BYTES);
        if (per_cu < 1) per_cu = 1;
        grid_blocks = cus;
    }
    Params p{};
    const float** pp = (const float**)&p;
    for (int i = 0; i < 30; ++i) pp[i] = (const float*)d_in[i];
    p.out = (float*)d_out;
    p.ws = (unsigned char*)d_ws;
    hipMemsetAsync((unsigned char*)d_ws + O_BAR, 0, 16384, stream);
    void* args[] = {&p};
    hipError_t e = hipLaunchCooperativeKernel((void*)fwd_megakernel, dim3(grid_blocks), dim3(NT), args, LDS_BYTES, stream);
    if (e != hipSuccess) fprintf(stderr, "cooperative launch failed: %s (grid %d)\n", hipGetErrorString(e), grid_blocks);
}
```

```cpp
#include <hip/hip_runtime.h>
#include <hip/hip_cooperative_groups.h>
#include <cstdio>
namespace cg = cooperative_groups;

#define LAS __attribute__((address_space(3)))
typedef unsigned short bf16_t;
typedef short bf16x8 __attribute__((ext_vector_type(8)));
typedef float f32x2 __attribute__((ext_vector_type(2)));
typedef float f32x4 __attribute__((ext_vector_type(4)));
typedef float f32x16 __attribute__((ext_vector_type(16)));
typedef unsigned u32x2 __attribute__((ext_vector_type(2)));
typedef unsigned u32x4 __attribute__((ext_vector_type(4)));
typedef __bf16 bf16v2 __attribute__((ext_vector_type(2)));

constexpr int NT = 512;
#ifndef REP_ATT
#define REP_ATT 1
#endif
#ifndef REP_HY
#define REP_HY 1
#endif
#ifndef REP_AUX
#define REP_AUX 1
#endif
#ifndef REP_MISC
#define REP_MISC 1
#endif
#ifndef REP_PREP
#define REP_PREP 1
#endif
#ifndef REP_UP
#define REP_UP 1
#endif
#ifndef REP_DN
#define REP_DN 1
#endif
#ifndef REP_G3
#define REP_G3 1
#endif
#ifndef REP_P9
#define REP_P9 1
#endif
#ifndef REP_QK
#define REP_QK 1
#endif
#ifndef REP_NORM
#define REP_NORM 1
#endif
#ifndef REP_SGU
#define REP_SGU 1
#endif
constexpr int TL = 32768, TCX = 2048, TT = 34816, DM = 1024, FFH = 2816, SEQ = 4096, CTXL = 256, NK = 4352;
constexpr int LDS_BYTES = 147456;

constexpr size_t AL(size_t x) { return (x + 255) & ~(size_t)255; }
constexpr size_t O_WUP0 = 0;
constexpr size_t O_WUP1 = O_WUP0 + (size_t)5632 * 1024 * 2;
constexpr size_t O_WDN0 = O_WUP1 + (size_t)5632 * 1024 * 2;
constexpr size_t O_WDN1 = O_WDN0 + (size_t)1024 * 2816 * 2;
constexpr size_t O_WIN = O_WDN1 + (size_t)1024 * 2816 * 2;
constexpr size_t O_WG = O_WIN + (size_t)2816 * 1024 * 2;
constexpr size_t O_WBR = O_WG + (size_t)3072 * 1024 * 2;
constexpr size_t O_WO = O_WBR + (size_t)1024 * 1024 * 2;
constexpr size_t O_XC = O_WO + (size_t)1024 * 1024 * 2;
constexpr size_t O_MOD = O_XC + (size_t)TCX * 1024 * 4;
constexpr size_t O_L1P = O_MOD + AL((size_t)2 * 9 * 9216 * 4);
constexpr size_t O_L1PC = O_L1P + (size_t)256 * 1024 * 4;
constexpr size_t O_FILTC = O_L1PC + (size_t)16 * 1024 * 4;
constexpr size_t O_BAR = O_FILTC + (size_t)2 * 256 * 512 * 4;
constexpr size_t O_H = O_BAR + 16384;
constexpr size_t O_AR = O_H + (size_t)TT * 1024 * 2;
constexpr size_t O_GH = O_AR;
constexpr size_t O_VRAW = O_AR;
constexpr size_t O_HYRAW = O_VRAW + (size_t)TT * 512 * 2;
constexpr size_t O_SGRAW = O_HYRAW + (size_t)TT * 768 * 2;
constexpr size_t O_XALT = O_AR + (size_t)TT * 2816 * 2;
constexpr size_t O_PART = O_XALT;
constexpr size_t O_OC = O_AR;
constexpr size_t O_YBT = O_OC + (size_t)TT * 1024 * 2;
constexpr size_t O_YBTC = O_YBT + (size_t)8 * 256 * 4096 * 2;
static_assert(O_YBTC + (size_t)8 * 256 * 256 * 2 <= O_SGRAW, "OC/YBT must not touch SGRAW (read in the post phase)");
constexpr size_t O_G3 = O_AR;
constexpr size_t O_YCAT = O_G3 + (size_t)TT * 3072 * 2;
constexpr size_t O_MB = O_YCAT + (size_t)TT * 1024 * 2;
constexpr size_t SZ_B = (size_t)TT * 1024 * 4 + (size_t)8 * 256 * 4096 * 2 + (size_t)8 * 256 * 256 * 2;
constexpr size_t O_QN = O_AR + AL(SZ_B);
constexpr size_t O_KN = O_QN + (size_t)64 * NK * 64 * 2;
constexpr size_t O_VT = O_KN + (size_t)64 * NK * 64 * 2;
constexpr size_t O_HV = O_VT + (size_t)32 * 128 * NK * 2;
constexpr size_t O_HVC = O_HV + (size_t)8 * 768 * 4096 * 2;
constexpr size_t O_FH = O_HVC + (size_t)8 * 768 * 256 * 2;
constexpr size_t O_FILT = O_HV;
constexpr size_t SZ_C1 = (size_t)8 * 768 * 4096 * 2 + (size_t)8 * 768 * 256 * 2 + (size_t)2 * 256 * 8192 * 8;
constexpr size_t END1 = O_HV + SZ_C1, END2 = O_MB + (size_t)TT * 1024 * 2;
static_assert(O_YCAT >= O_SGRAW + (size_t)TT * 512 * 2, "YCAT is written while OC/YBT/SGRAW are read");
constexpr size_t WS_NEED = AL(END1 > END2 ? END1 : END2);
static_assert(O_GH + (size_t)TT * 2816 * 2 <= O_HV, "Gh must stay inside regions B'+A");
static_assert(O_XALT + (size_t)TL * 1024 * 2 <= O_MB, "X_alt is written while MB is read");
static_assert(O_PART + (size_t)4 * 2048 * 1024 * 4 <= O_HV, "partials must not touch FILT/FH");
static_assert(O_SGRAW + (size_t)TT * 512 * 2 <= O_QN, "raws fit region B'");

struct Params {
    const float *x, *c, *ctx, *c_ctx, *ada_w, *ada_b, *norm_g, *ffn_up, *ffn_down, *w_in, *qk_gain, *da_lambda, *da_subln,
        *hy_conv_w, *hy_conv_b, *hy_w1, *hy_b1, *hy_w2, *hy_b2, *hy_freq, *hy_w3, *hy_skip, *sg_ln_g, *sg_ln_b, *sg_w, *sg_b,
        *gate_w, *gate_b, *w_br, *w_o;
    float* out;
    unsigned char* ws;
};


__device__ __forceinline__ int TID() { int t = threadIdx.x; asm volatile("" : "+v"(t)); return t; }
constexpr int POFF = 147456 - 512;
__device__ __forceinline__ const float* ldp(const unsigned char* smem, int idx) {
    const volatile unsigned* w = (const volatile unsigned*)(smem + POFF + idx * 8);
    const unsigned lo = __builtin_amdgcn_readfirstlane(w[0]), hi = __builtin_amdgcn_readfirstlane(w[1]);
    typedef __attribute__((address_space(1))) const float* gptr_t;
    return (const float*)(gptr_t)(((unsigned long long)hi << 32) | lo);
}
__device__ __forceinline__ Params opq(const unsigned char* smem) {
    Params q;
    q.x = ldp(smem, 0); q.c = ldp(smem, 1); q.ctx = ldp(smem, 2); q.c_ctx = ldp(smem, 3); q.ada_w = ldp(smem, 4); q.ada_b = ldp(smem, 5); q.norm_g = ldp(smem, 6);
    q.ffn_up = ldp(smem, 7); q.ffn_down = ldp(smem, 8); q.w_in = ldp(smem, 9); q.qk_gain = ldp(smem, 10); q.da_lambda = ldp(smem, 11); q.da_subln = ldp(smem, 12);
    q.hy_conv_w = ldp(smem, 13); q.hy_conv_b = ldp(smem, 14); q.hy_w1 = ldp(smem, 15); q.hy_b1 = ldp(smem, 16); q.hy_w2 = ldp(smem, 17); q.hy_b2 = ldp(smem, 18);
    q.hy_freq = ldp(smem, 19); q.hy_w3 = ldp(smem, 20); q.hy_skip = ldp(smem, 21); q.sg_ln_g = ldp(smem, 22); q.sg_ln_b = ldp(smem, 23); q.sg_w = ldp(smem, 24);
    q.sg_b = ldp(smem, 25); q.gate_w = ldp(smem, 26); q.gate_b = ldp(smem, 27); q.w_br = ldp(smem, 28); q.w_o = ldp(smem, 29);
    q.out = (float*)ldp(smem, 30); q.ws = (unsigned char*)ldp(smem, 31);
    return q;
}


#define XB_TMO      128
#define XB_XCNT(j)  (256  + 64 * (j))
#define XB_XSUB(j)  (1280 + 64 * (j))
#define XB_XGEN(j)  (2304 + 64 * (j))
#define XB_TOP      3328
#define XB_TOPGEN   3392
#define XCD_BAR_WORDS 3456
#define XB_SPIN_CAP (1u << 22)
__device__ __forceinline__ unsigned xb_ld(unsigned* p)              { return __hip_atomic_load(p, __ATOMIC_RELAXED, __HIP_MEMORY_SCOPE_AGENT); }
__device__ __forceinline__ unsigned xb_add(unsigned* p, unsigned v) { return __hip_atomic_fetch_add(p, v, __ATOMIC_RELAXED, __HIP_MEMORY_SCOPE_AGENT); }
__device__ __forceinline__ unsigned xb_xcc_id() { return (unsigned)__builtin_amdgcn_s_getreg((3 << 11) | 20) & 0xFu; }
#define XB_SPIN(cond, bar) do { unsigned _sp = 0; while (cond) { __builtin_amdgcn_s_sleep(1); \
    if ((++_sp & 255u) == 0u) { if (xb_ld(&(bar)[XB_TMO])) break; if (_sp > XB_SPIN_CAP) { atomicAdd(&(bar)[XB_TMO], 1u); break; } } } } while (0)
__device__ __forceinline__ void xcd_barrier_complete(unsigned* bar, unsigned x, unsigned& nloc, unsigned& nx) {
    const unsigned G = gridDim.x * gridDim.y * gridDim.z;
    unsigned sum, cnt, mine, sp = 0u;
    for (;;) {
        sum = 0u; cnt = 0u; mine = 0u;
#pragma unroll
        for (unsigned j = 0; j < 16; ++j) { const unsigned c = xb_ld(&bar[XB_XCNT(j)]); sum += c; cnt += (c > 0u) ? 1u : 0u; mine = (j == x) ? c : mine; }
        if (sum == G) break;
        __builtin_amdgcn_s_sleep(1);
        if ((++sp & 255u) == 0u) { if (xb_ld(&bar[XB_TMO])) break; if (sp > XB_SPIN_CAP) { atomicAdd(&bar[XB_TMO], 1u); break; } }
    }
    nloc = mine > 0u ? mine : 1u; nx = cnt > 0u ? cnt : 1u;
}
__device__ __forceinline__ void gsync(unsigned char* smem) {
    asm volatile("s_waitcnt vmcnt(0)" ::: "memory");
    __syncthreads();
    if (threadIdx.x == 0) {
        unsigned* bar = (unsigned*)((unsigned char*)ldp(smem, 31) + O_BAR);
        volatile unsigned* st = (volatile unsigned*)(smem + POFF + 256);
        const unsigned x = xb_xcc_id();
        __builtin_amdgcn_s_waitcnt(0);
        unsigned nloc = st[0], nx = st[1];
        if (nloc == 0u) { xcd_barrier_complete(bar, x, nloc, nx); st[0] = nloc; st[1] = nx; }
        const unsigned old = xb_add(&bar[XB_XSUB(x)], 1u);
        const unsigned gen = old / nloc;
        if (old + 1u == (gen + 1u) * nloc) {
            __builtin_amdgcn_fence(__ATOMIC_RELEASE, "agent");
            asm volatile("s_waitcnt vmcnt(0)" ::: "memory");
            const unsigned og = xb_add(&bar[XB_TOP], 1u);
            const unsigned tg = og / nx;
            if (og + 1u == (tg + 1u) * nx) xb_add(&bar[XB_TOPGEN], 1u);
            else XB_SPIN(xb_ld(&bar[XB_TOPGEN]) == tg, bar);
            __builtin_amdgcn_fence(__ATOMIC_ACQUIRE, "agent");
            xb_add(&bar[XB_XGEN(x)], 1u);
            asm volatile("s_waitcnt vmcnt(0)" ::: "memory");
        } else {
            XB_SPIN(xb_ld(&bar[XB_XGEN(x)]) == gen, bar);
            __builtin_amdgcn_fence(__ATOMIC_ACQUIRE, "agent");
            asm volatile("s_waitcnt vmcnt(0)" ::: "memory");
        }
    }
    __syncthreads();
}

__device__ __forceinline__ unsigned pk2(float a, float b) { f32x2 v = {a, b}; bf16v2 r = __builtin_convertvector(v, bf16v2); return __builtin_bit_cast(unsigned, r); }
__device__ __forceinline__ bf16_t f2bf(float a) { return (bf16_t)(pk2(a, 0.f) & 0xffffu); }
__device__ __forceinline__ float bf2f(bf16_t h) { return __uint_as_float((unsigned)h << 16); }
__device__ __forceinline__ float bflo(unsigned w) { return __uint_as_float(w << 16); }
__device__ __forceinline__ float bfhi(unsigned w) { return __uint_as_float(w & 0xffff0000u); }
__device__ __forceinline__ void row_bk(int r, int& b, int& kidx) { if (r < TL) { b = r >> 12; kidx = 256 + (r & 4095); } else { const int rc = r - TL; b = rc >> 8; kidx = rc & 255; } }
__device__ __forceinline__ float wave_sum(float v) {
#pragma unroll
    for (int o = 32; o > 0; o >>= 1) v += __shfl_xor(v, o);
    return v;
}
__device__ __forceinline__ float sigmoidf_(float v) { return __builtin_amdgcn_rcpf(1.0f + __builtin_amdgcn_exp2f(v * -1.4426950408889634f)); }

namespace pg8 {
constexpr int BM = 256, BK = 64, HALF = 128, HTB = HALF * BK * 2, STAGE_BYTES = 8 * HTB, NXCD = 8, WGM = 8;
__device__ __forceinline__ int lds_byte(int r, int c) { const int st = (r >> 4) * 2 + (c >> 5), rr = r & 15, cc = c & 31, ob = rr * 64 + cc * 2; return st * 1024 + (ob ^ (((ob >> 9) & 1) << 5)); }
__device__ __forceinline__ void stage_rc(int b, int& R, int& C) { const int st = b / 1024, sb = b % 1024, swz = sb ^ (((sb >> 9) & 1) << 5); R = (st >> 1) * 16 + swz / 64; C = (st & 1) * 32 + (swz % 64) / 2; }
__device__ __forceinline__ int perm32(int rho) { const int n = rho >> 4, i = rho & 15; return 8 * (i >> 2) + 4 * n + (i & 3); }
struct Unit { int pm, pn, k0, nt, split; };
struct Gemm { const bf16_t* A; const bf16_t* Bt; int M, N, K; };
struct StaticOrder {
    int nM, nN, nwg, G, c, ntk, ntail;
    __device__ void init(int M, int N, int K, int G_, int c_, bool split_tail) {
        nM = M / BM; nN = N / BM; G = G_; c = c_; ntk = K / BK; ntail = 0;
        if (split_tail) { nM -= 8; ntail = 128; }
        nwg = nM * nN;
    }
    __device__ __forceinline__ bool next(int i, Unit& u) const {
        const long L = (long)i * G + c; if (L >= nwg + ntail) return false;
        int pm, pn, k0 = 0, nt = ntk, split = 0;
        if (L >= nwg) {
            const int j = (int)L - nwg, cu = j >> 2, part = j & 3;
            pm = nM + (cu >> 2); pn = cu & 3; split = 1 + part;
            const int q = (ntk / 4) & ~1, big = (ntk - 4 * q) / 2;
            nt = q + ((part < big) ? 2 : 0);
            k0 = part * q + 2 * (part < big ? part : big);
        } else {
            int wgid = (int)L; { const int q = nwg / NXCD, r = nwg % NXCD, xcd = wgid % NXCD, off = wgid / NXCD; wgid = (xcd < r ? xcd * (q + 1) : r * (q + 1) + (xcd - r) * q) + off; }
            const int nig = WGM * nN, gid = wgid / nig, fm = gid * WGM, gsz = (nM - fm) < WGM ? (nM - fm) : WGM;
            pm = fm + ((wgid % nig) % gsz); pn = (wgid % nig) / gsz;
        }
        u.pm = pm; u.pn = pn; u.k0 = k0; u.nt = nt; u.split = split;
        return true;
    }
};

template <class Epi>
__device__ __forceinline__ void gemm_phase(LAS unsigned char* lds, const Gemm g, const StaticOrder& S, const Epi& E) {
    const int tid = TID(), wid = __builtin_amdgcn_readfirstlane(tid >> 6), lane = tid & 63, wr = wid >> 2, wc = wid & 3, fr = lane & 15, fq = lane >> 4;
    const int K = g.K;
    unsigned voffA[2], voffB[2];
#pragma unroll
    for (int i = 0; i < 2; ++i) { int R, C; stage_rc(tid * 16 + i * 8192, R, C); const int Rb = Epi::PERM ? ((R & ~31) + perm32(R & 31)) : R;
        voffA[i] = (unsigned)(R * K + C) * 2u; voffB[i] = (unsigned)(Rb * K + C) * 2u; }
    const size_t kstep = (size_t)(BK * 2);
    const size_t hstep = (size_t)HALF * K * 2;
    const size_t tstep = 2 * hstep;
    const unsigned ldsw = (unsigned)wid * 1024u;
    const int aoff = lds_byte(wr * 64 + fr, fq * 8), boff = lds_byte(wc * 32 + fr, fq * 8);
#define PG8_SA(b, h) (((b) * 2 + (h)) * HTB)
#define PG8_SB(b, h) ((4 + (b) * 2 + (h)) * HTB)
#define PG8_STAGE(bufoff, gbase, voff) do { _Pragma("unroll") for (int _i = 0; _i < 2; ++_i) \
        __builtin_amdgcn_global_load_lds((const unsigned*)((const char*)(gbase) + (voff)[_i]), (LAS unsigned*)(lds + (bufoff) + ldsw + _i * 8192), 16, 0, 0); } while (0)
#define PG8_LDA(dst, b, h) do { _Pragma("unroll") for (int m = 0; m < 4; ++m) _Pragma("unroll") for (int k = 0; k < 2; ++k) dst[m][k] = *(const LAS bf16x8*)(lds + PG8_SA(b, h) + aoff + m * 2048 + k * 1024); } while (0)
#define PG8_LDB(dst, b, h) do { _Pragma("unroll") for (int n = 0; n < 2; ++n) _Pragma("unroll") for (int k = 0; k < 2; ++k) dst[n][k] = *(const LAS bf16x8*)(lds + PG8_SB(b, h) + boff + n * 2048 + k * 1024); } while (0)
#define PG8_MMA(ai, bj, At, Bt) do { __builtin_amdgcn_s_setprio(1); _Pragma("unroll") for (int m = 0; m < 4; ++m) _Pragma("unroll") for (int n = 0; n < 2; ++n) _Pragma("unroll") for (int k = 0; k < 2; ++k) \
        acc[ai][bj][m][n] = __builtin_amdgcn_mfma_f32_16x16x32_bf16(Bt[n][k], At[m][k], acc[ai][bj][m][n], 0, 0, 0); __builtin_amdgcn_s_setprio(0); } while (0)
#define PG8_WAIT_V(n) asm volatile("s_waitcnt vmcnt(" #n ")" ::: "memory")
#define PG8_WAIT_L(n) asm volatile("s_waitcnt lgkmcnt(" #n ")" ::: "memory")
#define PG8_BAR __builtin_amdgcn_s_barrier()
#define PG8_SCHED __builtin_amdgcn_sched_barrier(0)
    Unit cur, nxt; int ui = 0;
    if (!S.next(0, cur)) return;
    f32x4 acc[2][2][4][2];
#pragma unroll
    for (int a = 0; a < 2; ++a)
#pragma unroll
        for (int b = 0; b < 2; ++b)
#pragma unroll
            for (int m = 0; m < 4; ++m)
#pragma unroll
                for (int n = 0; n < 2; ++n) acc[a][b][m][n] = (f32x4){0.f, 0.f, 0.f, 0.f};
    bf16x8 At[4][2], B0[2][2], B1[2][2];
    const char* cA = (const char*)g.A + (size_t)cur.pm * tstep + (size_t)cur.k0 * kstep; const char* cB = (const char*)g.Bt + (size_t)cur.pn * tstep + (size_t)cur.k0 * kstep;
    PG8_STAGE(PG8_SB(0, 0), cB, voffB); PG8_STAGE(PG8_SA(0, 0), cA, voffA); PG8_STAGE(PG8_SB(0, 1), cB + hstep, voffB); PG8_STAGE(PG8_SA(0, 1), cA + hstep, voffA);
    if (wr == 1) PG8_BAR;
    PG8_WAIT_V(4); PG8_BAR;
    PG8_STAGE(PG8_SB(1, 0), cB + kstep, voffB); PG8_STAGE(PG8_SA(1, 0), cA + kstep, voffA); PG8_STAGE(PG8_SB(1, 1), cB + hstep + kstep, voffB);
    PG8_WAIT_V(6); PG8_BAR;
    for (;;) {
        const bool has_next = S.next(ui + 1, nxt);
        const char* nA = has_next ? (const char*)g.A + (size_t)nxt.pm * tstep + (size_t)nxt.k0 * kstep : cA; const char* nB = has_next ? (const char*)g.Bt + (size_t)nxt.pn * tstep + (size_t)nxt.k0 * kstep : cB;
        const int nt = cur.nt;
        for (int t = 0; t < nt; t += 2) {
            const bool last = (t == nt - 2);
            const char* a1 = cA + (size_t)(t + 1) * kstep;
            const char* a2 = last ? nA : cA + (size_t)(t + 2) * kstep; const char* b2 = last ? nB : cB + (size_t)(t + 2) * kstep;
            const char* a3 = a2 + kstep; const char* b3 = b2 + kstep;
            if constexpr (Epi::RESCALE) { if (t == 8 || t == 12) E.rescale(acc, cur, t == 8 ? 0 : 1, wr, wc, fr, fq); }
            PG8_LDB(B0, 0, 0); PG8_SCHED; PG8_LDA(At, 0, 0); PG8_STAGE(PG8_SA(1, 1), a1 + hstep, voffA);
            PG8_WAIT_L(8); PG8_BAR; PG8_WAIT_L(0); PG8_MMA(0, 0, At, B0); PG8_BAR; PG8_SCHED;
            PG8_LDB(B1, 0, 1); PG8_STAGE(PG8_SB(0, 0), b2, voffB);
            PG8_BAR; PG8_WAIT_L(0); PG8_MMA(0, 1, At, B1); PG8_BAR;
            PG8_LDA(At, 0, 1); PG8_STAGE(PG8_SA(0, 0), a2, voffA);
            PG8_BAR; PG8_WAIT_L(0); PG8_MMA(1, 0, At, B0); PG8_BAR; PG8_SCHED;
            PG8_STAGE(PG8_SB(0, 1), b2 + hstep, voffB);
            PG8_WAIT_V(6); PG8_BAR; PG8_MMA(1, 1, At, B1); PG8_BAR;
            PG8_LDB(B0, 1, 0); PG8_SCHED; PG8_LDA(At, 1, 0); PG8_STAGE(PG8_SA(0, 1), a2 + hstep, voffA);
            PG8_WAIT_L(8); PG8_BAR; PG8_WAIT_L(0); PG8_MMA(0, 0, At, B0); PG8_BAR; PG8_SCHED;
            PG8_LDB(B1, 1, 1); PG8_STAGE(PG8_SB(1, 0), b3, voffB);
            PG8_BAR; PG8_WAIT_L(0); PG8_MMA(0, 1, At, B1); PG8_BAR;
            PG8_LDA(At, 1, 1); PG8_STAGE(PG8_SA(1, 0), a3, voffA);
            PG8_BAR; PG8_WAIT_L(0); PG8_MMA(1, 0, At, B0); PG8_BAR; PG8_SCHED;
            PG8_STAGE(PG8_SB(1, 1), b3 + hstep, voffB);
            PG8_WAIT_V(6); PG8_BAR; PG8_MMA(1, 1, At, B1); PG8_BAR;
        }
        E(acc, cur, wr, wc, fr, fq);
        if (!has_next) break;
#pragma unroll
        for (int a = 0; a < 2; ++a)
#pragma unroll
            for (int b = 0; b < 2; ++b)
#pragma unroll
                for (int m = 0; m < 4; ++m)
#pragma unroll
                    for (int n = 0; n < 2; ++n) acc[a][b][m][n] = (f32x4){0.f, 0.f, 0.f, 0.f};
        cur = nxt; cA = nA; cB = nB; ++ui;
    }
    PG8_WAIT_V(0);
    if (wr == 0) PG8_BAR;
    PG8_BAR;
#undef PG8_SA
#undef PG8_SB
#undef PG8_STAGE
#undef PG8_LDA
#undef PG8_LDB
#undef PG8_MMA
#undef PG8_WAIT_V
#undef PG8_WAIT_L
#undef PG8_BAR
#undef PG8_SCHED
}
}
using pg8::Unit;
typedef f32x4 AccT[2][2][4][2];

struct EpiSwiglu {
    static constexpr bool PERM = true, RESCALE = false;
    bf16_t* G;
    __device__ __forceinline__ void operator()(const AccT& acc, const Unit& u, int wr, int wc, int fr, int fq) const {
        const int row0 = u.pm * 256 + wr * 64 + fr, col0 = u.pn * 128 + wc * 32 + 8 * fq;
#pragma unroll
        for (int ai = 0; ai < 2; ++ai)
#pragma unroll
            for (int m = 0; m < 4; ++m) {
                float gv[8];
#pragma unroll
                for (int n = 0; n < 2; ++n)
#pragma unroll
                    for (int j = 0; j < 4; ++j) { const float a = acc[ai][0][m][n][j], b = acc[ai][1][m][n][j]; gv[n * 4 + j] = a * b * __builtin_amdgcn_rcpf(1.0f + __builtin_amdgcn_exp2f(a * -1.4426950408889634f)); }
                u32x4 w; w.x = pk2(gv[0], gv[1]); w.y = pk2(gv[2], gv[3]); w.z = pk2(gv[4], gv[5]); w.w = pk2(gv[6], gv[7]);
                *(u32x4*)(G + (size_t)(row0 + ai * 128 + m * 16) * FFH + col0) = w;
            }
    }
};
struct EpiResid {
    static constexpr bool PERM = true, RESCALE = false;
    const bf16_t* xin; bf16_t* xout; float* fout; float* xc; float* part; const float* mod; int gofs; float coef;
    __device__ __forceinline__ void operator()(const AccT& acc, const Unit& u, int wr, int wc, int fr, int fq) const {
        const int row0 = u.pm * 256 + wr * 64 + fr, col0 = u.pn * 256 + wc * 32 + 8 * fq;
        const bool lat = u.pm < 128;
        const int mr = lat ? (u.pm >> 4) : 8;
        const float* gp = mod + (size_t)mr * 9216 + gofs + col0;
#pragma unroll
        for (int bj = 0; bj < 2; ++bj) {
            const f32x4 g0 = *(const f32x4*)(gp + bj * 128) * coef, g1 = *(const f32x4*)(gp + bj * 128 + 4) * coef;
            if (lat) {
                u32x4 xw[8];
#pragma unroll
                for (int am = 0; am < 8; ++am) xw[am] = *(const u32x4*)(xin + (size_t)(row0 + (am >> 2) * 128 + (am & 3) * 16) * 1024 + col0 + bj * 128);
#pragma unroll
                for (int am = 0; am < 8; ++am) {
                    const int ai = am >> 2, m = am & 3;
                    const size_t o = (size_t)(row0 + ai * 128 + m * 16) * 1024 + col0 + bj * 128;
                    f32x4 v0 = {bflo(xw[am].x), bfhi(xw[am].x), bflo(xw[am].y), bfhi(xw[am].y)}, v1 = {bflo(xw[am].z), bfhi(xw[am].z), bflo(xw[am].w), bfhi(xw[am].w)};
                    v0 += g0 * acc[ai][bj][m][0]; v1 += g1 * acc[ai][bj][m][1];
                    if (fout) { *(f32x4*)(fout + o) = v0; *(f32x4*)(fout + o + 4) = v1; }
                    else { u32x4 w; w.x = pk2(v0[0], v0[1]); w.y = pk2(v0[2], v0[3]); w.z = pk2(v1[0], v1[1]); w.w = pk2(v1[2], v1[3]); *(u32x4*)(xout + o) = w; }
                }
            } else {
#pragma unroll
                for (int am = 0; am < 8; ++am) {
                    const int ai = am >> 2, m = am & 3;
                    const size_t o = (size_t)(row0 + ai * 128 + m * 16 - TL) * 1024 + col0 + bj * 128;
                    const f32x4 d0 = g0 * acc[ai][bj][m][0], d1 = g1 * acc[ai][bj][m][1];
                    if (u.split) { float* pp = part + (size_t)(u.split - 1) * 2048 * 1024 + o; *(f32x4*)pp = d0; *(f32x4*)(pp + 4) = d1; }
                    else { float* xp = xc + o; *(f32x4*)xp = *(const f32x4*)xp + d0; *(f32x4*)(xp + 4) = *(const f32x4*)(xp + 4) + d1; }
                }
            }
        }
    }
};
struct EpiIn {
    static constexpr bool PERM = true, RESCALE = false;
    bf16_t *qn, *kn, *vraw, *hyraw, *sgraw;
    __device__ __forceinline__ void operator()(const AccT& acc, const Unit& u, int wr, int wc, int fr, int fq) const {
        const int row0 = u.pm * 256 + wr * 64 + fr, pn = u.pn;
#pragma unroll
        for (int ai = 0; ai < 2; ++ai)
#pragma unroll
            for (int m = 0; m < 4; ++m) {
                const int r = row0 + ai * 128 + m * 16;
#pragma unroll
                for (int bj = 0; bj < 2; ++bj) {
                    const f32x4 v0 = acc[ai][bj][m][0], v1 = acc[ai][bj][m][1];
                    u32x4 w; w.x = pk2(v0[0], v0[1]); w.y = pk2(v0[2], v0[3]); w.z = pk2(v1[0], v1[1]); w.w = pk2(v1[2], v1[3]);
                    const int cl = bj * 128 + wc * 32 + 8 * fq;
                    bf16_t* dst;
                    if (pn < 4) {
                        int b, kidx; row_bk(r, b, kidx);
                        const int cc = (pn & 1) * 256 + cl, head = cc >> 7, comp = (cc >> 6) & 1, d = cc & 63;
                        dst = (pn < 2 ? qn : kn) + ((size_t)((b * 4 + head) * 2 + comp) * NK + kidx) * 64 + d;
                    } else if (pn < 6) dst = vraw + (size_t)r * 512 + (pn - 4) * 256 + cl;
                    else if (pn < 9) dst = hyraw + (size_t)r * 768 + (pn - 6) * 256 + cl;
                    else dst = sgraw + (size_t)r * 512 + (pn - 9) * 256 + cl;
                    *(u32x4*)dst = w;
                }
            }
    }
};
struct EpiGate3 {
    static constexpr bool PERM = true, RESCALE = false;
    bf16_t* g3; const float* bias;
    __device__ __forceinline__ void operator()(const AccT& acc, const Unit& u, int wr, int wc, int fr, int fq) const {
        const int row0 = u.pm * 256 + wr * 64 + fr, col0 = u.pn * 256 + wc * 32 + 8 * fq;
#pragma unroll
        for (int bj = 0; bj < 2; ++bj) {
            const f32x4 b0 = *(const f32x4*)(bias + col0 + bj * 128), b1 = *(const f32x4*)(bias + col0 + bj * 128 + 4);
#pragma unroll
            for (int ai = 0; ai < 2; ++ai)
#pragma unroll
                for (int m = 0; m < 4; ++m) {
                    const f32x4 v0 = acc[ai][bj][m][0] + b0, v1 = acc[ai][bj][m][1] + b1;
                    float gv[8];
#pragma unroll
                    for (int j = 0; j < 4; ++j) { gv[j] = fmaxf(sigmoidf_(v0[j]), 1e-5f); gv[4 + j] = fmaxf(sigmoidf_(v1[j]), 1e-5f); }
                    u32x4 w; w.x = pk2(gv[0], gv[1]); w.y = pk2(gv[2], gv[3]); w.z = pk2(gv[4], gv[5]); w.w = pk2(gv[6], gv[7]);
                    *(u32x4*)(g3 + (size_t)(row0 + ai * 128 + m * 16) * 3072 + col0 + bj * 128) = w;
                }
        }
    }
};
struct EpiMergeR {
    static constexpr bool PERM = true, RESCALE = true;
    const bf16_t* g3; bf16_t* mb;
    __device__ __forceinline__ void rescale(AccT& acc, const Unit& u, int which, int wr, int wc, int fr, int fq) const {
        const int row0 = u.pm * 256 + wr * 64 + fr, col0 = u.pn * 256 + wc * 32 + 8 * fq;
        const bf16_t* gb = g3 + (size_t)row0 * 3072 + which * 1024 + col0;
#pragma unroll
        for (int ai = 0; ai < 2; ++ai)
#pragma unroll
            for (int mh = 0; mh < 2; ++mh) {
                u32x4 nw[2][2], dw[2][2];
#pragma unroll
                for (int mm = 0; mm < 2; ++mm)
#pragma unroll
                    for (int bj = 0; bj < 2; ++bj) { const bf16_t* gp = gb + (size_t)(ai * 128 + (mh * 2 + mm) * 16) * 3072 + bj * 128; nw[mm][bj] = *(const u32x4*)gp; dw[mm][bj] = *(const u32x4*)(gp + 1024); }
#pragma unroll
                for (int mm = 0; mm < 2; ++mm)
#pragma unroll
                    for (int bj = 0; bj < 2; ++bj) {
                        const u32x4 n4 = nw[mm][bj], d4 = dw[mm][bj];
                        const f32x4 r0 = {bflo(n4.x) * __builtin_amdgcn_rcpf(bflo(d4.x)), bfhi(n4.x) * __builtin_amdgcn_rcpf(bfhi(d4.x)), bflo(n4.y) * __builtin_amdgcn_rcpf(bflo(d4.y)), bfhi(n4.y) * __builtin_amdgcn_rcpf(bfhi(d4.y))};
                        const f32x4 r1 = {bflo(n4.z) * __builtin_amdgcn_rcpf(bflo(d4.z)), bfhi(n4.z) * __builtin_amdgcn_rcpf(bfhi(d4.z)), bflo(n4.w) * __builtin_amdgcn_rcpf(bflo(d4.w)), bfhi(n4.w) * __builtin_amdgcn_rcpf(bfhi(d4.w))};
                        acc[ai][bj][mh * 2 + mm][0] *= r0; acc[ai][bj][mh * 2 + mm][1] *= r1;
                    }
                __builtin_amdgcn_sched_barrier(0);
            }
    }
    __device__ __forceinline__ void operator()(const AccT& acc, const Unit& u, int wr, int wc, int fr, int fq) const {
        const int row0 = u.pm * 256 + wr * 64 + fr, col0 = u.pn * 256 + wc * 32 + 8 * fq;
#pragma unroll
        for (int bj = 0; bj < 2; ++bj) {
            u32x4 gw[8];
#pragma unroll
            for (int am = 0; am < 8; ++am) gw[am] = *(const u32x4*)(g3 + (size_t)(row0 + (am >> 2) * 128 + (am & 3) * 16) * 3072 + 2048 + col0 + bj * 128);
#pragma unroll
            for (int am = 0; am < 8; ++am) {
                const int ai = am >> 2, m = am & 3;
                const f32x4 v0 = acc[ai][bj][m][0], v1 = acc[ai][bj][m][1];
                u32x4 w; w.x = pk2(v0[0] * bflo(gw[am].x), v0[1] * bfhi(gw[am].x)); w.y = pk2(v0[2] * bflo(gw[am].y), v0[3] * bfhi(gw[am].y));
                w.z = pk2(v1[0] * bflo(gw[am].z), v1[1] * bfhi(gw[am].z)); w.w = pk2(v1[2] * bflo(gw[am].w), v1[3] * bfhi(gw[am].w));
                *(u32x4*)(mb + (size_t)(row0 + ai * 128 + m * 16) * 1024 + col0 + bj * 128) = w;
            }
        }
    }
};

template <class Epi>
__device__ __forceinline__ void run_gemm(unsigned char* smem, const bf16_t* A, const bf16_t* Bt, int M, int N, int K, const Epi& E, bool split_tail = false) {
    asm volatile("" : "+s"(M), "+s"(N), "+s"(K));
    pg8::Gemm g; g.A = A; g.Bt = Bt; g.M = M; g.N = N; g.K = K;
    pg8::StaticOrder S; S.init(M, N, K, gridDim.x, blockIdx.x, split_tail);
    pg8::gemm_phase<Epi>((LAS unsigned char*)smem, g, S, E);
}

__device__ __forceinline__ void mod_item(const Params& p, unsigned char* smem, int m) {
    float* s = (float*)smem;
    float* red = s + 9 * 1024;
    const int tid = TID(), l = m / 144, cb = m % 144;
    __syncthreads();
    for (int i = tid; i < 9216; i += NT) { const float v = (i < 8192) ? p.c[i] : p.c_ctx[i - 8192]; s[i] = v / (1.0f + __expf(-v)); }
    __syncthreads();
    const int kg = tid >> 6, cn = tid & 63, col = cb * 64 + cn;
    const float* w = p.ada_w + (size_t)l * 1024 * 9216 + col;
    float a0 = 0, a1 = 0, a2 = 0, a3 = 0, a4 = 0, a5 = 0, a6 = 0, a7 = 0, a8 = 0;
    for (int k = kg * 128; k < kg * 128 + 128; ++k) {
        const float wv = w[(size_t)k * 9216];
        a0 += s[k] * wv; a1 += s[1024 + k] * wv; a2 += s[2048 + k] * wv; a3 += s[3072 + k] * wv; a4 += s[4096 + k] * wv;
        a5 += s[5120 + k] * wv; a6 += s[6144 + k] * wv; a7 += s[7168 + k] * wv; a8 += s[8192 + k] * wv;
    }
    float* rp = red + kg * 576 + cn;
    rp[0] = a0; rp[64] = a1; rp[128] = a2; rp[192] = a3; rp[256] = a4; rp[320] = a5; rp[384] = a6; rp[448] = a7; rp[512] = a8;
    __syncthreads();
    float* MOD = (float*)(p.ws + O_MOD);
    for (int i = tid; i < 576; i += NT) {
        float v = 0; for (int q = 0; q < 8; ++q) v += red[q * 576 + i];
        const int r = i >> 6, c2 = cb * 64 + (i & 63);
        MOD[((size_t)l * 9 + r) * 9216 + c2] = v + p.ada_b[(size_t)l * 9216 + c2];
    }
}

__device__ __forceinline__ void filt_item(const Params& p, unsigned char* smem, int l, int n, int item, float* filt, float* l1p) {
    float* z = (float*)smem;
    float* h1 = z + 16 * 36;
    float* h2 = h1 + 16 * 64;
    const int tid = TID(), t0 = item * 16;
    __syncthreads();
    for (int i = tid; i < 16 * 33; i += NT) {
        const int tt = i / 33, e = i % 33, t = t0 + tt; float v;
        if (e == 0) v = (float)t / (float)(n - 1);
        else { const int bi = (e - 1) & 15; const float band = 1e-4f + (float)bi * ((15.0f - 1e-4f) / 15.0f); const float wv = (6.283185307179586f / (float)n) * (float)t;
            v = (e <= 16) ? cosf(band * wv) : -sinf(band * wv); }
        z[tt * 36 + e] = v;
    }
    __syncthreads();
    for (int i = tid; i < 16 * 64; i += NT) {
        const int tt = i >> 6, j = i & 63; float a = p.hy_b1[l * 64 + j];
        for (int e = 0; e < 33; ++e) a += z[tt * 36 + e] * p.hy_w1[((size_t)l * 33 + e) * 64 + j];
        h1[i] = sinf(p.hy_freq[l * 64 + j] * a);
    }
    __syncthreads();
    for (int i = tid; i < 16 * 64; i += NT) {
        const int tt = i >> 6, j = i & 63; float a = p.hy_b2[l * 64 + j];
        for (int e = 0; e < 64; ++e) a += h1[tt * 64 + e] * p.hy_w2[((size_t)l * 64 + e) * 64 + j];
        h2[i] = sinf(p.hy_freq[l * 64 + j] * a);
    }
    __syncthreads();
    const float min_decay = -3.0701134573253945f, max_decay = -15.350567286626973f;
#pragma unroll 1
    for (int cc = 0; cc < 2; ++cc) {
        const int col = tid + cc * 512;
        float acc[16];
#pragma unroll
        for (int tt = 0; tt < 16; ++tt) acc[tt] = 0.f;
        for (int e = 0; e < 64; ++e) {
            const float wv = p.hy_w3[((size_t)l * 64 + e) * 1024 + col];
#pragma unroll
            for (int tt = 0; tt < 16; ++tt) acc[tt] += h2[tt * 64 + e] * wv;
        }
        const int dir = col >> 9, oc = col & 511;
        const float ad = fabsf(min_decay + (float)oc * ((max_decay - min_decay) / 511.0f));
        float* dst = filt + (size_t)oc * (2 * n);
        float l1 = 0.f;
#pragma unroll
        for (int tt = 0; tt < 16; ++tt) {
            const int t = t0 + tt; const float tn = (float)t / (float)(n - 1);
            float v = acc[tt] * __expf(-tn * ad);
            if (dir == 0) dst[t] = v;
            else if (t == 0) { dst[n] = 0.f; v = 0.f; }
            else dst[2 * n - t] = v;
            l1 += fabsf(v);
        }
        l1p[(size_t)item * 1024 + col] = l1;
    }
}

struct WDesc { const float* src; bf16_t* dst; int ld, K; };
__device__ __forceinline__ WDesc wdesc(const Params& p, int l, int ti) {
    WDesc d; int K, nrb, mapsw = 0; const float* src; bf16_t* dst; int ld;
    const size_t L = (size_t)l;
    if (ti < 1408) { src = p.ffn_up + (L * 2 + 0) * 1024 * 5632; ld = 5632; K = 1024; dst = (bf16_t*)(p.ws + O_WUP0); mapsw = 1; }
    else if ((ti -= 1408) < 1408) { src = p.ffn_up + (L * 2 + 1) * 1024 * 5632; ld = 5632; K = 1024; dst = (bf16_t*)(p.ws + O_WUP1); mapsw = 1; }
    else if ((ti -= 1408) < 704) { src = p.ffn_down + (L * 2 + 0) * 2816 * 1024; ld = 1024; K = 2816; dst = (bf16_t*)(p.ws + O_WDN0); }
    else if ((ti -= 704) < 704) { src = p.ffn_down + (L * 2 + 1) * 2816 * 1024; ld = 1024; K = 2816; dst = (bf16_t*)(p.ws + O_WDN1); }
    else if ((ti -= 704) < 704) { src = p.w_in + L * 1024 * 2816; ld = 2816; K = 1024; dst = (bf16_t*)(p.ws + O_WIN); }
    else if ((ti -= 704) < 768) { src = p.gate_w + L * 1024 * 3072; ld = 3072; K = 1024; dst = (bf16_t*)(p.ws + O_WG); }
    else if ((ti -= 768) < 256) { src = p.w_br + L * 1024 * 1024; ld = 1024; K = 1024; dst = (bf16_t*)(p.ws + O_WBR); }
    else { ti -= 256; src = p.w_o + L * 1024 * 1024; ld = 1024; K = 1024; dst = (bf16_t*)(p.ws + O_WO); }
    nrb = K / 64;
    const int nb = ti / nrb, kb = ti % nrb, n0 = nb * 64, k0 = kb * 64;
    int scol = n0;
    if (mapsw) { const int pn = n0 >> 8, half = (n0 >> 7) & 1; scol = half * 2816 + pn * 128 + (n0 & 127); }
    d.src = src + (size_t)k0 * ld + scol; d.dst = dst + (size_t)n0 * K + k0; d.ld = ld; d.K = K;
    return d;
}
__device__ __forceinline__ void wconv_tiles(const Params& p, unsigned char* smem, int l, int nw) {
    float* tile = (float*)smem;
    const int tid = TID(), kk0 = tid >> 6, nn0 = tid & 63, nn = tid >> 3, ks = tid & 7;
    int ti = blockIdx.x;
    if (ti >= nw) return;
    WDesc d = wdesc(p, l, ti);
    float v[8];
#pragma unroll
    for (int i = 0; i < 8; ++i) v[i] = d.src[(size_t)(kk0 + 8 * i) * d.ld + nn0];
    for (;;) {
        const int tn = ti + gridDim.x; const bool more = tn < nw;
        WDesc dn = d; float vn[8];
        if (more) { dn = wdesc(p, l, tn);
#pragma unroll
            for (int i = 0; i < 8; ++i) vn[i] = dn.src[(size_t)(kk0 + 8 * i) * dn.ld + nn0]; }
        __syncthreads();
#pragma unroll
        for (int i = 0; i < 8; ++i) tile[(kk0 + 8 * i) * 65 + nn0] = v[i];
        __syncthreads();
        float o[8];
#pragma unroll
        for (int j = 0; j < 8; ++j) o[j] = tile[(ks * 8 + j) * 65 + nn];
        u32x4 w; w.x = pk2(o[0], o[1]); w.y = pk2(o[2], o[3]); w.z = pk2(o[4], o[5]); w.w = pk2(o[6], o[7]);
        *(u32x4*)(d.dst + (size_t)nn * d.K + ks * 8) = w;
        if (!more) break;
        d = dn; ti = tn;
#pragma unroll
        for (int i = 0; i < 8; ++i) v[i] = vn[i];
    }
}

__device__ __forceinline__ void aux_phase(const Params& p, unsigned char* smem, int l) {
    const int nmod = (l == 0) ? 288 : 0, nf = 256, nfc = (l == 0) ? 16 : 0, nw = 6208;
    const int total = nmod + nf + nfc;
    for (int rep = 0; rep < REP_AUX; ++rep) {
        for (int it = blockIdx.x; it < total; it += gridDim.x) {
            int i = it;
            if (i < nmod) { mod_item(p, smem, i); continue; }
            i -= nmod;
            if (i < nf) { filt_item(p, smem, l, 4096, i, (float*)(p.ws + O_FILT), (float*)(p.ws + O_L1P)); continue; }
            i -= nf;
            filt_item(p, smem, l, 256, i, (float*)(p.ws + O_FILTC), (float*)(p.ws + O_L1PC));
        }
        wconv_tiles(p, smem, l, nw);
    }
}

__device__ __forceinline__ void norm_phase(const Params& p, int l, int sub, int M, bool first, const bf16_t* xl) {
    const float* PART = (const float*)(p.ws + O_PART);
    const int tid = TID(), lane = tid & 63, wv = tid >> 6;
    const float* MOD = (const float*)(p.ws + O_MOD) + (size_t)l * 9 * 9216;
    const float* gn = p.norm_g + ((size_t)l * 3 + sub) * 1024;
    float* XC = (float*)(p.ws + O_XC);
    bf16_t* H = (bf16_t*)(p.ws + O_H);
    const int rstep = gridDim.x * 8;
    for (int rep = 0; rep < REP_NORM; ++rep)
    for (int r0 = blockIdx.x * 8 + wv; r0 < M; r0 += 4 * rstep) {
        f32x4 v[4][4]; float ss[4];
#pragma unroll
        for (int k = 0; k < 4; ++k) {
            const int r = r0 + k * rstep; ss[k] = 0.f;
            if (r >= M) { continue; }
            if (r >= TL) {
                const float* src = (first ? p.ctx : XC) + (size_t)(r - TL) * 1024;
#pragma unroll
                for (int i = 0; i < 4; ++i) { const size_t o = (size_t)(r - TL) * 1024 + i * 256 + lane * 4; v[k][i] = *(const f32x4*)(src + i * 256 + lane * 4);
                    if (!first) { v[k][i] += *(const f32x4*)(PART + o); v[k][i] += *(const f32x4*)(PART + 2048 * 1024 + o); v[k][i] += *(const f32x4*)(PART + 2 * 2048 * 1024 + o); v[k][i] += *(const f32x4*)(PART + 3 * 2048 * 1024 + o); } }
            } else if (first) {
                const float* src = p.x + (size_t)r * 1024;
#pragma unroll
                for (int i = 0; i < 4; ++i) v[k][i] = *(const f32x4*)(src + i * 256 + lane * 4);
            } else {
                const bf16_t* src = xl + (size_t)r * 1024;
#pragma unroll
                for (int i = 0; i < 4; ++i) { const u32x2 w = *(const u32x2*)(src + i * 256 + lane * 4); v[k][i] = (f32x4){bflo(w.x), bfhi(w.x), bflo(w.y), bfhi(w.y)}; }
            }
        }
#pragma unroll
        for (int k = 0; k < 4; ++k) {
            const int r = r0 + k * rstep;
            if (r >= M) continue;
            if (r >= TL) {
#pragma unroll
                for (int i = 0; i < 4; ++i) *(f32x4*)(XC + (size_t)(r - TL) * 1024 + i * 256 + lane * 4) = v[k][i];
            } else if (first) {
                bf16_t* dstx = (bf16_t*)p.out + (size_t)r * 1024;
#pragma unroll
                for (int i = 0; i < 4; ++i) { u32x2 w; w.x = pk2(v[k][i][0], v[k][i][1]); w.y = pk2(v[k][i][2], v[k][i][3]); *(u32x2*)(dstx + i * 256 + lane * 4) = w; v[k][i] = (f32x4){bflo(w.x), bfhi(w.x), bflo(w.y), bfhi(w.y)}; }
            }
            float s2 = 0.f;
#pragma unroll
            for (int i = 0; i < 4; ++i) s2 += v[k][i][0] * v[k][i][0] + v[k][i][1] * v[k][i][1] + v[k][i][2] * v[k][i][2] + v[k][i][3] * v[k][i][3];
            s2 = wave_sum(s2);
            const float rinv = rsqrtf(s2 * (1.0f / 1024.0f) + 1e-6f);
            const int mr = r < TL ? (r >> 12) : 8;
            const float* sh = MOD + (size_t)mr * 9216 + (3 * sub) * 1024;
            const float* sc = sh + 1024;
#pragma unroll
            for (int i = 0; i < 4; ++i) {
                const int c = i * 256 + lane * 4;
                const f32x4 g4 = *(const f32x4*)(gn + c), s4 = *(const f32x4*)(sc + c), h4 = *(const f32x4*)(sh + c);
                const f32x4 y = v[k][i] * rinv * g4 * (s4 + 1.0f) + h4;
                u32x2 w; w.x = pk2(y[0], y[1]); w.y = pk2(y[2], y[3]);
                *(u32x2*)(H + (size_t)r * 1024 + c) = w;
            }
        }
    }
}

#define ZI(i) ((i) + ((i) >> 4))
__device__ __forceinline__ f32x2 cmul(f32x2 a, f32x2 b) { return (f32x2){a.x * b.x - a.y * b.y, a.x * b.y + a.y * b.x}; }
__device__ __forceinline__ f32x2 cmulc(f32x2 a, f32x2 b) { return (f32x2){a.x * b.x + a.y * b.y, a.y * b.x - a.x * b.y}; }
__device__ __forceinline__ void dif8(f32x2 (&x)[8]) {
    const float C = 0.70710678118654752f;
    { f32x2 t;
      t = x[0] - x[4]; x[0] += x[4]; x[4] = t;
      t = x[1] - x[5]; x[1] += x[5]; x[5] = (f32x2){C * (t.x + t.y), C * (t.y - t.x)};
      t = x[2] - x[6]; x[2] += x[6]; x[6] = (f32x2){t.y, -t.x};
      t = x[3] - x[7]; x[3] += x[7]; x[7] = (f32x2){C * (t.y - t.x), -C * (t.x + t.y)}; }
#pragma unroll
    for (int b = 0; b < 8; b += 4) { f32x2 t;
      t = x[b] - x[b + 2]; x[b] += x[b + 2]; x[b + 2] = t;
      t = x[b + 1] - x[b + 3]; x[b + 1] += x[b + 3]; x[b + 3] = (f32x2){t.y, -t.x}; }
#pragma unroll
    for (int b = 0; b < 8; b += 2) { const f32x2 t = x[b] - x[b + 1]; x[b] += x[b + 1]; x[b + 1] = t; }
}
__device__ __forceinline__ void idif8(f32x2 (&x)[8]) {
    const float C = 0.70710678118654752f;
#pragma unroll
    for (int b = 0; b < 8; b += 2) { const f32x2 t = x[b] - x[b + 1]; x[b] += x[b + 1]; x[b + 1] = t; }
#pragma unroll
    for (int b = 0; b < 8; b += 4) { f32x2 v, u;
      v = x[b + 2]; u = x[b]; x[b] = u + v; x[b + 2] = u - v;
      v = (f32x2){-x[b + 3].y, x[b + 3].x}; u = x[b + 1]; x[b + 1] = u + v; x[b + 3] = u - v; }
    { f32x2 v, u, t;
      v = x[4]; u = x[0]; x[0] = u + v; x[4] = u - v;
      t = x[5]; v = (f32x2){C * (t.x - t.y), C * (t.x + t.y)}; u = x[1]; x[1] = u + v; x[5] = u - v;
      t = x[6]; v = (f32x2){-t.y, t.x}; u = x[2]; x[2] = u + v; x[6] = u - v;
      t = x[7]; v = (f32x2){-C * (t.x + t.y), C * (t.x - t.y)}; u = x[3]; x[3] = u + v; x[7] = u - v; }
}
__device__ __forceinline__ void twid8(f32x2 (&x)[8], int pidx, int L, bool conj) {
    const float rev = -(float)pidx / (float)L;
    const float s = __builtin_amdgcn_sinf(rev), c = __builtin_amdgcn_cosf(rev);
    const f32x2 w1 = {c, s}; const f32x2 w2 = cmul(w1, w1), w3 = cmul(w2, w1), w4 = cmul(w2, w2), w5 = cmul(w4, w1), w6 = cmul(w3, w3), w7 = cmul(w4, w3);
    if (!conj) { x[1] = cmul(x[1], w4); x[2] = cmul(x[2], w2); x[3] = cmul(x[3], w6); x[4] = cmul(x[4], w1); x[5] = cmul(x[5], w5); x[6] = cmul(x[6], w3); x[7] = cmul(x[7], w7); }
    else { x[1] = cmulc(x[1], w4); x[2] = cmulc(x[2], w2); x[3] = cmulc(x[3], w6); x[4] = cmulc(x[4], w1); x[5] = cmulc(x[5], w5); x[6] = cmulc(x[6], w3); x[7] = cmulc(x[7], w7); }
}
__device__ __forceinline__ void fft_fwd(f32x2* z) {
    const int tid = TID();
#pragma unroll 1
    for (int L = 8192; L >= 16; L >>= 3) {
        const int S = L >> 3;
#pragma unroll
        for (int qq = 0; qq < 2; ++qq) { const int q = tid + qq * NT;
            const int pidx = q & (S - 1), B = (q / S) * L + pidx;
            f32x2 x[8];
#pragma unroll
            for (int j = 0; j < 8; ++j) x[j] = z[ZI(B + j * S)];
            dif8(x); twid8(x, pidx, L, false);
#pragma unroll
            for (int j = 0; j < 8; ++j) z[ZI(B + j * S)] = x[j];
        }
        __syncthreads();
    }
#pragma unroll 4
    for (int q = tid; q < 4096; q += NT) { const f32x2 a = z[ZI(2 * q)], b = z[ZI(2 * q + 1)]; z[ZI(2 * q)] = a + b; z[ZI(2 * q + 1)] = a - b; }
    __syncthreads();
}
__device__ __forceinline__ void fft_inv(f32x2* z) {
    const int tid = TID();
#pragma unroll 4
    for (int q = tid; q < 4096; q += NT) { const f32x2 a = z[ZI(2 * q)], b = z[ZI(2 * q + 1)]; z[ZI(2 * q)] = a + b; z[ZI(2 * q + 1)] = a - b; }
    __syncthreads();
#pragma unroll 1
    for (int L = 16; L <= 8192; L <<= 3) {
        const int S = L >> 3;
#pragma unroll
        for (int qq = 0; qq < 2; ++qq) { const int q = tid + qq * NT;
            const int pidx = q & (S - 1), B = (q / S) * L + pidx;
            f32x2 x[8];
#pragma unroll
            for (int j = 0; j < 8; ++j) x[j] = z[ZI(B + j * S)];
            twid8(x, pidx, L, true); idif8(x);
#pragma unroll
            for (int j = 0; j < 8; ++j) z[ZI(B + j * S)] = x[j];
        }
        __syncthreads();
    }
}

__device__ __forceinline__ void fft_fwd_h(f32x2* z, int lt) {
#pragma unroll 1
    for (int L = 8192; L >= 16; L >>= 3) {
        const int S = L >> 3;
#pragma unroll 2
        for (int qq = 0; qq < 4; ++qq) { const int q = lt + qq * 256;
            const int pidx = q & (S - 1), B = (q / S) * L + pidx;
            f32x2 x[8];
#pragma unroll
            for (int j = 0; j < 8; ++j) x[j] = z[ZI(B + j * S)];
            dif8(x); twid8(x, pidx, L, false);
#pragma unroll
            for (int j = 0; j < 8; ++j) z[ZI(B + j * S)] = x[j];
        }
        __syncthreads();
    }
#pragma unroll 4
    for (int q = lt; q < 4096; q += 256) { const f32x2 a = z[ZI(2 * q)], b = z[ZI(2 * q + 1)]; z[ZI(2 * q)] = a + b; z[ZI(2 * q + 1)] = a - b; }
    __syncthreads();
}
__device__ __forceinline__ void fft_inv_h(f32x2* z, int lt) {
#pragma unroll 4
    for (int q = lt; q < 4096; q += 256) { const f32x2 a = z[ZI(2 * q)], b = z[ZI(2 * q + 1)]; z[ZI(2 * q)] = a + b; z[ZI(2 * q + 1)] = a - b; }
    __syncthreads();
#pragma unroll 1
    for (int L = 16; L <= 8192; L <<= 3) {
        const int S = L >> 3;
#pragma unroll 2
        for (int qq = 0; qq < 4; ++qq) { const int q = lt + qq * 256;
            const int pidx = q & (S - 1), B = (q / S) * L + pidx;
            f32x2 x[8];
#pragma unroll
            for (int j = 0; j < 8; ++j) x[j] = z[ZI(B + j * S)];
            twid8(x, pidx, L, true); idif8(x);
#pragma unroll
            for (int j = 0; j < 8; ++j) z[ZI(B + j * S)] = x[j];
        }
        __syncthreads();
    }
}

__device__ __forceinline__ void filtfft_item(const Params& p, unsigned char* smem, int oc) {
    f32x2* z = (f32x2*)smem;
    float* red = (float*)(smem + 8704 * 8);
    const int tid = TID();
    const float* filt = (const float*)(p.ws + O_FILT) + (size_t)oc * 8192;
    const float* l1p = (const float*)(p.ws + O_L1P);
    __syncthreads();
#pragma unroll 4
    for (int i = tid; i < 8192; i += NT) z[ZI(i)] = (f32x2){filt[i], 0.f};
    if (tid < 256) red[tid] = l1p[(size_t)tid * 1024 + oc] + l1p[(size_t)tid * 1024 + 512 + oc];
    __syncthreads();
    if (tid < 64) { float v = red[tid] + red[tid + 64] + red[tid + 128] + red[tid + 192]; v = wave_sum(v); if (tid == 0) red[256] = v; }
    fft_fwd(z);
    const float sc = 1.0f / (red[256] * 8192.0f);
    f32x2* fh = (f32x2*)(p.ws + O_FH) + (size_t)oc * 8192;
#pragma unroll 4
    for (int i = tid; i < 8192; i += NT) fh[i] = z[ZI(i)] * sc;
}

__device__ __forceinline__ void hyfft_item(const Params& p, unsigned char* smem, int l, int ch, int bp) {
    f32x2* z = (f32x2*)smem;
    f32x2* zz = (f32x2*)(smem + 8704 * 8);
    const int tid = TID();
    const bf16_t* HV = (const bf16_t*)(p.ws + O_HV);
    const bf16_t* v0 = HV + ((size_t)(2 * bp) * 768 + ch) * 4096; const bf16_t* v1 = v0 + (size_t)768 * 4096;
    const f32x2* fh0 = (const f32x2*)(p.ws + O_FH) + (size_t)ch * 8192; const f32x2* fh1 = fh0 + (size_t)256 * 8192;
    const float sk0 = p.hy_skip[(size_t)l * 512 + ch], sk1 = p.hy_skip[(size_t)l * 512 + 256 + ch];
    bf16_t a0[8], a1[8];
#pragma unroll
    for (int k = 0; k < 8; ++k) { a0[k] = v0[tid + k * NT]; a1[k] = v1[tid + k * NT]; }
    f32x2 fr[16];
#pragma unroll
    for (int k = 0; k < 16; ++k) fr[k] = fh0[tid + k * NT];
    __syncthreads();
#pragma unroll
    for (int k = 0; k < 8; ++k) { const int t = tid + k * NT; z[ZI(t)] = (f32x2){bf2f(a0[k]), bf2f(a1[k])}; z[ZI(4096 + t)] = (f32x2){0.f, 0.f}; }
    __syncthreads();
    fft_fwd(z);
#pragma unroll
    for (int k = 0; k < 16; ++k) { const int i = tid + k * NT; z[ZI(i)] = cmul(z[ZI(i)], fr[k]); }
    bf16_t x0[8], x1[8];
#pragma unroll
    for (int k = 0; k < 8; ++k) { x0[k] = v0[(size_t)256 * 4096 + tid + k * NT]; x1[k] = v1[(size_t)256 * 4096 + tid + k * NT]; }
#pragma unroll
    for (int k = 0; k < 16; ++k) fr[k] = fh1[tid + k * NT];
    __syncthreads();
    fft_inv(z);
#pragma unroll
    for (int k = 0; k < 8; ++k) {
        const int t = tid + k * NT;
        f32x2 y = z[ZI(t)];
        y.x += bf2f(a0[k]) * sk0; y.y += bf2f(a1[k]) * sk0;
        const f32x2 zv = {bf2f(x0[k]) * y.x, bf2f(x1[k]) * y.y};
        zz[t] = zv; z[ZI(t)] = zv; z[ZI(4096 + t)] = (f32x2){0.f, 0.f};
    }
    __syncthreads();
    fft_fwd(z);
#pragma unroll
    for (int k = 0; k < 16; ++k) { const int i = tid + k * NT; z[ZI(i)] = cmul(z[ZI(i)], fr[k]); }
#pragma unroll
    for (int k = 0; k < 8; ++k) { x0[k] = v0[(size_t)512 * 4096 + tid + k * NT]; x1[k] = v1[(size_t)512 * 4096 + tid + k * NT]; }
    __syncthreads();
    fft_inv(z);
    bf16_t* YBT = (bf16_t*)(p.ws + O_YBT);
    bf16_t* o0 = YBT + ((size_t)(2 * bp) * 256 + ch) * 4096; bf16_t* o1 = o0 + (size_t)256 * 4096;
#pragma unroll
    for (int k = 0; k < 8; ++k) {
        const int t = tid + k * NT;
        const f32x2 y = z[ZI(t)] + zz[t] * sk1;
        o0[t] = f2bf(bf2f(x0[k]) * y.x); o1[t] = f2bf(bf2f(x1[k]) * y.y);
    }
}

__device__ __forceinline__ void hyfft_pair(const Params& p, unsigned char* smem, int l, int ch, int pp) {
    const int tid = TID(), hf = __builtin_amdgcn_readfirstlane(tid >> 8), lt = tid & 255, bp = 2 * pp + hf;
    f32x2* z = (f32x2*)(smem + (size_t)hf * 8704 * 8);
    const bf16_t* HV = (const bf16_t*)(p.ws + O_HV);
    const bf16_t* v0 = HV + ((size_t)(2 * bp) * 768 + ch) * 4096; const bf16_t* v1 = v0 + (size_t)768 * 4096;
    const f32x2* fh0 = (const f32x2*)(p.ws + O_FH) + (size_t)ch * 8192; const f32x2* fh1 = fh0 + (size_t)256 * 8192;
    const float sk0 = p.hy_skip[(size_t)l * 512 + ch], sk1 = p.hy_skip[(size_t)l * 512 + 256 + ch];
    unsigned av[16];
#pragma unroll
    for (int k = 0; k < 16; ++k) av[k] = (unsigned)v0[lt + k * 256] | ((unsigned)v1[lt + k * 256] << 16);
    f32x2 fr[32];
#pragma unroll
    for (int k = 0; k < 32; ++k) fr[k] = fh0[lt + k * 256];
    __syncthreads();
#pragma unroll
    for (int k = 0; k < 16; ++k) { const int t = lt + k * 256; z[ZI(t)] = (f32x2){bflo(av[k]), bfhi(av[k])}; z[ZI(4096 + t)] = (f32x2){0.f, 0.f}; }
    __syncthreads();
    fft_fwd_h(z, lt);
#pragma unroll
    for (int k = 0; k < 32; ++k) { const int i = lt + k * 256; z[ZI(i)] = cmul(z[ZI(i)], fr[k]); }
    unsigned xv[16];
#pragma unroll
    for (int k = 0; k < 16; ++k) xv[k] = (unsigned)v0[(size_t)256 * 4096 + lt + k * 256] | ((unsigned)v1[(size_t)256 * 4096 + lt + k * 256] << 16);
#pragma unroll
    for (int k = 0; k < 32; ++k) fr[k] = fh1[lt + k * 256];
    __syncthreads();
    fft_inv_h(z, lt);
    f32x2 zz[16];
#pragma unroll
    for (int k = 0; k < 16; ++k) {
        const int t = lt + k * 256;
        f32x2 y = z[ZI(t)];
        y.x += bflo(av[k]) * sk0; y.y += bfhi(av[k]) * sk0;
        const f32x2 zv = {bflo(xv[k]) * y.x, bfhi(xv[k]) * y.y};
        zz[k] = zv; z[ZI(t)] = zv; z[ZI(4096 + t)] = (f32x2){0.f, 0.f};
    }
    __syncthreads();
    fft_fwd_h(z, lt);
#pragma unroll
    for (int k = 0; k < 32; ++k) { const int i = lt + k * 256; z[ZI(i)] = cmul(z[ZI(i)], fr[k]); }
#pragma unroll
    for (int k = 0; k < 16; ++k) xv[k] = (unsigned)v0[(size_t)512 * 4096 + lt + k * 256] | ((unsigned)v1[(size_t)512 * 4096 + lt + k * 256] << 16);
    __syncthreads();
    fft_inv_h(z, lt);
    bf16_t* YBT = (bf16_t*)(p.ws + O_YBT);
    bf16_t* o0 = YBT + ((size_t)(2 * bp) * 256 + ch) * 4096; bf16_t* o1 = o0 + (size_t)256 * 4096;
#pragma unroll
    for (int k = 0; k < 16; ++k) {
        const int t = lt + k * 256;
        const f32x2 y = z[ZI(t)] + zz[k] * sk1;
        o0[t] = f2bf(bflo(xv[k]) * y.x); o1[t] = f2bf(bfhi(xv[k]) * y.y);
    }
}

__device__ __forceinline__ void hyctx_item(const Params& p, unsigned char* smem, int l, int b, int cp) {
    float* f1 = (float*)smem;
    float* f2 = f1 + 1024;
    float* vv = f2 + 1024;
    float* zc = vv + 512;
    float* red = zc + 512;
    const int tid = TID(), hf = tid >> 8, t = tid & 255, ch = cp * 2 + hf;
    const float* FC = (const float*)(p.ws + O_FILTC); const float* l1p = (const float*)(p.ws + O_L1PC);
    const bf16_t* HVC = (const bf16_t*)(p.ws + O_HVC) + ((size_t)b * 768 + ch) * 256;
    __syncthreads();
    f1[hf * 512 + t] = FC[(size_t)ch * 512 + t]; f1[hf * 512 + 256 + t] = FC[(size_t)ch * 512 + 256 + t];
    f2[hf * 512 + t] = FC[(size_t)(256 + ch) * 512 + t]; f2[hf * 512 + 256 + t] = FC[(size_t)(256 + ch) * 512 + 256 + t];
    const float vt = bf2f(HVC[t]); vv[hf * 256 + t] = vt;
    if (t < 2) { float s = 0.f; for (int it = 0; it < 16; ++it) s += l1p[(size_t)it * 1024 + t * 256 + ch] + l1p[(size_t)it * 1024 + 512 + t * 256 + ch]; red[hf * 2 + t] = s; }
    __syncthreads();
    float a = 0.f;
    for (int s = 0; s < 256; ++s) a += f1[hf * 512 + ((t - s) & 511)] * vv[hf * 256 + s];
    const float y1 = a / red[hf * 2 + 0] + vt * p.hy_skip[(size_t)l * 512 + ch];
    const float zt = bf2f(HVC[(size_t)256 * 256 + t]) * y1; zc[hf * 256 + t] = zt;
    __syncthreads();
    float a2 = 0.f;
    for (int s = 0; s < 256; ++s) a2 += f2[hf * 512 + ((t - s) & 511)] * zc[hf * 256 + s];
    const float y2 = a2 / red[hf * 2 + 1] + zt * p.hy_skip[(size_t)l * 512 + 256 + ch];
    bf16_t* YBTC = (bf16_t*)(p.ws + O_YBTC);
    YBTC[((size_t)b * 256 + ch) * 256 + t] = f2bf(bf2f(HVC[(size_t)512 * 256 + t]) * y2);
}

__device__ __forceinline__ void qk_item(const Params& p, int l, int item, bool dry = false) {
    const int tid = TID(), seg = tid & 7, vsub = tid >> 3;
    const int which = (item >= 544) ? 1 : 0;
    const int vbase = (item - which * 544) * 512;
    bf16_t* base = (bf16_t*)(p.ws + (which ? O_KN : O_QN));
    u32x4 raw[8];
#pragma unroll
    for (int it = 0; it < 8; ++it) raw[it] = *(const u32x4*)(base + (size_t)(vbase + it * 64 + vsub) * 64 + seg * 8);
    const float* gp = p.qk_gain + (size_t)l * 128 + which * 64 + seg * 8;
    const f32x4 g0 = *(const f32x4*)gp, g1 = *(const f32x4*)(gp + 4);
    const float gn[8] = {g0[0], g0[1], g0[2], g0[3], g1[0], g1[1], g1[2], g1[3]};
    const float qs = which ? 1.0f : (0.125f * 1.4426950408889634f);
    const int axis = seg >> 2, role = (seg >> 1) & 1, qb = (seg & 1) * 8;
    float inv[8];
#pragma unroll
    for (int e = 0; e < 8; ++e) inv[e] = exp2f(-(float)(qb + e) * (13.287712379549449f / 16.0f));
#pragma unroll
    for (int it = 0; it < 8; ++it) {
        const int rem = vbase + it * 64 + vsub, kidx = rem % NK;
        const u32x4 w = raw[it];
        float v[8] = {bflo(w.x), bfhi(w.x), bflo(w.y), bfhi(w.y), bflo(w.z), bfhi(w.z), bflo(w.w), bfhi(w.w)};
        float ss = 0.f;
#pragma unroll
        for (int e = 0; e < 8; ++e) ss += v[e] * v[e];
        ss += __shfl_xor(ss, 1); ss += __shfl_xor(ss, 2); ss += __shfl_xor(ss, 4);
        const float rinv = rsqrtf(ss * (1.0f / 64.0f) + 1e-6f) * qs;
#pragma unroll
        for (int e = 0; e < 8; ++e) v[e] = v[e] * rinv * gn[e];
        const int t = kidx - 256;
        const float pos = (float)(axis ? (t & 63) : (t >> 6));
        float o[8];
#pragma unroll
        for (int e = 0; e < 8; ++e) {
            const float pe = __shfl_xor(v[e], 2);
            float sn, cs; __sincosf(pos * inv[e], &sn, &cs);
            const float r = role ? (pe * sn + v[e] * cs) : (v[e] * cs - pe * sn);
            o[e] = (kidx >= 256) ? r : v[e];
        }
        u32x4 ow = {pk2(o[0], o[1]), pk2(o[2], o[3]), pk2(o[4], o[5]), pk2(o[6], o[7])};
        if (dry) ow = w;
        *(u32x4*)(base + (size_t)rem * 64 + seg * 8) = ow;
    }
}

__device__ __forceinline__ void vt_item(const Params& p, unsigned char* smem, int tb) {
    bf16_t* tile = (bf16_t*)smem;
    const int tid = TID(), r0 = tb * 64;
    const bf16_t* src = (const bf16_t*)(p.ws + O_VRAW) + (size_t)r0 * 512;
    __syncthreads();
#pragma unroll
    for (int i = 0; i < 8; ++i) { const int e = tid + i * NT, rr = e >> 6, sg = e & 63; *(u32x4*)(tile + rr * 520 + sg * 8) = *(const u32x4*)(src + (size_t)rr * 512 + sg * 8); }
    __syncthreads();
    int b, kidx0; row_bk(r0, b, kidx0);
    bf16_t* dst = (bf16_t*)(p.ws + O_VT) + ((size_t)b * 512 + tid) * NK + kidx0;
#pragma unroll
    for (int s = 0; s < 8; ++s) {
        unsigned w[4];
#pragma unroll
        for (int j = 0; j < 4; ++j) w[j] = (unsigned)tile[(s * 8 + 2 * j) * 520 + tid] | ((unsigned)tile[(s * 8 + 2 * j + 1) * 520 + tid] << 16);
        *(u32x4*)(dst + s * 8) = (u32x4){w[0], w[1], w[2], w[3]};
    }
}

__device__ __forceinline__ void hyconv_item(const Params& p, unsigned char* smem, int l, int tb) {
    bf16_t* tile = (bf16_t*)smem;
    const int tid = TID(), r0 = tb * 64;
    const bool lat = r0 < TL;
    const int n = lat ? 4096 : 256, rb = lat ? r0 : r0 - TL, b = rb / n, t0 = rb % n;
    const bf16_t* src = (const bf16_t*)(p.ws + O_HYRAW);
    __syncthreads();
    {
        u32x4 wv[13];
#pragma unroll
        for (int k = 0; k < 13; ++k) {
            const int e = tid + k * NT, rr = e / 96, sg = e % 96, t = t0 - 1 + rr;
            wv[k] = (u32x4){0u, 0u, 0u, 0u};
            if (e < 66 * 96 && t >= 0 && t < n) wv[k] = *(const u32x4*)(src + (size_t)(r0 - 1 + rr) * 768 + sg * 8);
        }
#pragma unroll
        for (int k = 0; k < 13; ++k) { const int e = tid + k * NT, rr = e / 96, sg = e % 96; if (e < 66 * 96) *(u32x4*)(tile + rr * 776 + sg * 8) = wv[k]; }
    }
    __syncthreads();
    const float* cw = p.hy_conv_w + (size_t)l * 3 * 768; const float* cb = p.hy_conv_b + (size_t)l * 768;
    for (int c = tid; c < 768; c += NT) {
        const float w0 = cw[c], w1 = cw[768 + c], w2 = cw[1536 + c], bb = cb[c];
        bf16_t* dst = lat ? (bf16_t*)(p.ws + O_HV) + ((size_t)b * 768 + c) * 4096 + t0 : (bf16_t*)(p.ws + O_HVC) + ((size_t)b * 768 + c) * 256 + t0;
        float pm = bf2f(tile[c]), pc = bf2f(tile[776 + c]);
#pragma unroll
        for (int s = 0; s < 8; ++s) {
            float o[8];
#pragma unroll
            for (int j = 0; j < 8; ++j) { const float pn = bf2f(tile[(s * 8 + j + 2) * 776 + c]); o[j] = pm * w0 + pc * w1 + pn * w2 + bb; pm = pc; pc = pn; }
            *(u32x4*)(dst + s * 8) = (u32x4){pk2(o[0], o[1]), pk2(o[2], o[3]), pk2(o[4], o[5]), pk2(o[6], o[7])};
        }
    }
}

__device__ __forceinline__ float gelu_exact(float v) { return 0.5f * v * (1.0f + erff(v * 0.70710678118654752f)); }
__device__ __forceinline__ void sgu_item(const Params& p, unsigned char* smem, int l, int ci) {
    bf16_t* vt = (bf16_t*)smem;
    const int tid = TID(), lane = tid & 63, wv = __builtin_amdgcn_readfirstlane(tid >> 6), r0 = ci * 128;
    const bf16_t* src = (const bf16_t*)(p.ws + O_SGRAW) + (size_t)r0 * 512;
    const float* lg = p.sg_ln_g + (size_t)l * 256; const float* lb = p.sg_ln_b + (size_t)l * 256;
    __syncthreads();
    {
        const f32x4 g4 = *(const f32x4*)(lg + lane * 4), b4 = *(const f32x4*)(lb + lane * 4);
        u32x2 wr_[16];
#pragma unroll
        for (int k = 0; k < 16; ++k) wr_[k] = *(const u32x2*)(src + (size_t)(wv + 8 * k) * 512 + 256 + lane * 4);
#pragma unroll
        for (int k = 0; k < 16; ++k) {
            const int rr = wv + 8 * k; const u32x2 w = wr_[k];
            float a[4] = {gelu_exact(bflo(w.x)), gelu_exact(bfhi(w.x)), gelu_exact(bflo(w.y)), gelu_exact(bfhi(w.y))};
            const float mu = wave_sum(a[0] + a[1] + a[2] + a[3]) * (1.0f / 256.0f);
            float d[4]; float sq = 0.f;
#pragma unroll
            for (int j = 0; j < 4; ++j) { d[j] = a[j] - mu; sq += d[j] * d[j]; }
            const float rstd = rsqrtf(wave_sum(sq) * (1.0f / 256.0f) + 1e-6f);
#pragma unroll
            for (int j = 0; j < 4; ++j) vt[(lane * 4 + j) * 136 + rr] = f2bf(d[j] * rstd * g4[j] + b4[j]);
        }
    }
    __syncthreads();
    const int g = wv & 3, ih = wv >> 2, l32 = lane & 31, kg = lane >> 5;
    const float* wsb = p.sg_w + ((size_t)l * 4 + g) * 128 * 128;
    const float* bsb = p.sg_b + ((size_t)l * 4 + g) * 128;
    bf16_t* yc = (bf16_t*)(p.ws + O_YCAT) + 768;
#pragma unroll 1
    for (int ib = 0; ib < 2; ++ib) {
        const int i0 = ih * 64 + ib * 32;
        f32x16 acc0, acc1;
#pragma unroll
        for (int r = 0; r < 16; ++r) { acc0[r] = 0.f; acc1[r] = 0.f; }
        const float* wrow = wsb + (size_t)(i0 + l32) * 128 + 8 * kg;
#pragma unroll
        for (int ks = 0; ks < 8; ++ks) {
            const f32x4 w0 = *(const f32x4*)(wrow + 16 * ks), w1 = *(const f32x4*)(wrow + 16 * ks + 4);
            const u32x4 aw = {pk2(w0[0], w0[1]), pk2(w0[2], w0[3]), pk2(w1[0], w1[1]), pk2(w1[2], w1[3])};
            const bf16x8 af = __builtin_bit_cast(bf16x8, aw);
            const bf16x8 b0 = *(const bf16x8*)(vt + (g * 64 + l32) * 136 + 16 * ks + 8 * kg);
            const bf16x8 b1 = *(const bf16x8*)(vt + (g * 64 + 32 + l32) * 136 + 16 * ks + 8 * kg);
            acc0 = __builtin_amdgcn_mfma_f32_32x32x16_bf16(af, b0, acc0, 0, 0, 0);
            acc1 = __builtin_amdgcn_mfma_f32_32x32x16_bf16(af, b1, acc1, 0, 0, 0);
        }
#pragma unroll
        for (int r = 0; r < 16; ++r) {
            const int i = i0 + 8 * (r >> 2) + 4 * kg + (r & 3);
            const float bi = bsb[i];
            const int c0 = g * 64 + l32, c1 = c0 + 32;
            const float u0 = gelu_exact(bf2f(src[(size_t)i * 512 + c0])), u1 = gelu_exact(bf2f(src[(size_t)i * 512 + c1]));
            yc[(size_t)(r0 + i) * 1024 + c0] = f2bf(u0 * (acc0[r] + bi));
            yc[(size_t)(r0 + i) * 1024 + c1] = f2bf(u1 * (acc1[r] + bi));
        }
    }
}

__device__ __forceinline__ void prep_phase(const Params& p, unsigned char* smem, int l) {
    const int n_sg = 0, n_hy = 544, n_vt = 544, n_qk = 1088;
    const int total = n_sg + n_hy + n_vt + n_qk;
    for (int it = blockIdx.x; it < total; it += gridDim.x) {
        int i = it;
        if (i < n_sg) { for (int rep = 0; rep < REP_SGU; ++rep) sgu_item(p, smem, l, i); continue; }
        i -= n_sg;
        if (i < n_hy) { for (int rep = 0; rep < REP_PREP; ++rep) hyconv_item(p, smem, l, i); continue; }
        i -= n_hy;
        if (i < n_vt) { for (int rep = 0; rep < REP_PREP; ++rep) vt_item(p, smem, i); continue; }
        i -= n_vt;
#if REP_QK > 1
        qk_item(p, l, i, true);
#endif
        qk_item(p, l, i);
    }
}

__device__ __forceinline__ void attn_item(const Params& p, unsigned char* smem, int b, int h, int comp, int q0, int rowbase, int nkt) {
    constexpr int ABUF = 64 * 72 + 128 * 72;
    bf16_t* Ks = (bf16_t*)smem;
    bf16_t* Vs = Ks + 64 * 72;
    const int tid = TID(), lane = tid & 63, w = tid >> 6, l32 = lane & 31, g = lane >> 5;
    const size_t hc = (size_t)((b * 4 + h) * 2 + comp);
    const bf16_t* Qb = (const bf16_t*)(p.ws + O_QN) + (hc * NK + q0 + 32 * w + l32) * 64;
    const bf16_t* Kb = (const bf16_t*)(p.ws + O_KN) + hc * NK * 64;
    const bf16_t* Vb = (const bf16_t*)(p.ws + O_VT) + (size_t)((b * 4 + h) * 128) * NK;
    bf16x8 qf[4];
#pragma unroll
    for (int ks = 0; ks < 4; ++ks) qf[ks] = *(const bf16x8*)(Qb + 16 * ks + 8 * g);
    f32x16 O[4];
#pragma unroll
    for (int d = 0; d < 4; ++d)
#pragma unroll
        for (int i = 0; i < 16; ++i) O[d][i] = 0.f;
    float lsum = 0.f;
    const int kkey = tid >> 3, kseg = tid & 7, vdv = tid >> 2, vseg = tid & 3;
    const bf16_t* kg = Kb + (size_t)kkey * 64 + kseg * 8;
    const bf16_t* vg = Vb + (size_t)vdv * NK + vseg * 16;
    u32x4 kreg = *(const u32x4*)kg, vr0 = *(const u32x4*)vg, vr1 = *(const u32x4*)(vg + 8);
    const int pr = (l32 & ~12) | ((l32 & 4) << 1) | ((l32 & 8) >> 1);
    __syncthreads();
    *(u32x4*)(Ks + kkey * 72 + kseg * 8) = kreg; *(u32x4*)(Vs + vdv * 72 + vseg * 16) = vr0; *(u32x4*)(Vs + vdv * 72 + vseg * 16 + 8) = vr1;
    if (nkt > 1) { kreg = *(const u32x4*)(kg + (size_t)64 * 64); vr0 = *(const u32x4*)(vg + 64); vr1 = *(const u32x4*)(vg + 64 + 8); }
    __syncthreads();
    for (int kt = 0; kt < nkt; ++kt) {
        const bf16_t* Kc = Ks + (kt & 1) * ABUF; const bf16_t* Vc = Vs + (kt & 1) * ABUF;
        if (kt + 1 < nkt) {
            bf16_t* Kn = Ks + ((kt + 1) & 1) * ABUF; bf16_t* Vn = Vs + ((kt + 1) & 1) * ABUF;
            *(u32x4*)(Kn + kkey * 72 + kseg * 8) = kreg; *(u32x4*)(Vn + vdv * 72 + vseg * 16) = vr0; *(u32x4*)(Vn + vdv * 72 + vseg * 16 + 8) = vr1;
            if (kt + 2 < nkt) { kreg = *(const u32x4*)(kg + (size_t)(kt + 2) * 64 * 64); vr0 = *(const u32x4*)(vg + (kt + 2) * 64); vr1 = *(const u32x4*)(vg + (kt + 2) * 64 + 8); }
        }
        f32x16 S0, S1;
#pragma unroll
        for (int i = 0; i < 16; ++i) { S0[i] = 0.f; S1[i] = 0.f; }
#pragma unroll
        for (int ks = 0; ks < 4; ++ks) {
            const bf16x8 ka = *(const bf16x8*)(Kc + pr * 72 + 16 * ks + 8 * g);
            const bf16x8 kb = *(const bf16x8*)(Kc + (32 + pr) * 72 + 16 * ks + 8 * g);
            S0 = __builtin_amdgcn_mfma_f32_32x32x16_bf16(ka, qf[ks], S0, 0, 0, 0);
            S1 = __builtin_amdgcn_mfma_f32_32x32x16_bf16(kb, qf[ks], S1, 0, 0, 0);
        }
#pragma unroll
        for (int i = 0; i < 16; ++i) { S0[i] = __builtin_amdgcn_exp2f(S0[i]); S1[i] = __builtin_amdgcn_exp2f(S1[i]); lsum += S0[i] + S1[i]; }
#pragma unroll
        for (int kb2 = 0; kb2 < 2; ++kb2)
#pragma unroll
            for (int s = 0; s < 2; ++s) {
                u32x4 pw;
                if (kb2 == 0) { pw.x = pk2(S0[8 * s], S0[8 * s + 1]); pw.y = pk2(S0[8 * s + 2], S0[8 * s + 3]); pw.z = pk2(S0[8 * s + 4], S0[8 * s + 5]); pw.w = pk2(S0[8 * s + 6], S0[8 * s + 7]); }
                else { pw.x = pk2(S1[8 * s], S1[8 * s + 1]); pw.y = pk2(S1[8 * s + 2], S1[8 * s + 3]); pw.z = pk2(S1[8 * s + 4], S1[8 * s + 5]); pw.w = pk2(S1[8 * s + 6], S1[8 * s + 7]); }
                const bf16x8 pf = __builtin_bit_cast(bf16x8, pw);
#pragma unroll
                for (int d = 0; d < 4; ++d) {
                    const bf16x8 va = *(const bf16x8*)(Vc + (d * 32 + l32) * 72 + kb2 * 32 + 16 * s + 8 * g);
                    O[d] = __builtin_amdgcn_mfma_f32_32x32x16_bf16(va, pf, O[d], 0, 0, 0);
                }
            }
        __syncthreads();
    }
    lsum += __shfl_xor(lsum, 32);
    const float inv = 1.0f / lsum;
    bf16_t* ob = (bf16_t*)(p.ws + O_OC) + ((size_t)(rowbase + 32 * w + l32) * 8 + h * 2 + comp) * 128;
#pragma unroll
    for (int d = 0; d < 4; ++d)
#pragma unroll
        for (int i4 = 0; i4 < 4; ++i4) {
            u32x2 o; o.x = pk2(O[d][4 * i4] * inv, O[d][4 * i4 + 1] * inv); o.y = pk2(O[d][4 * i4 + 2] * inv, O[d][4 * i4 + 3] * inv);
            *(u32x2*)(ob + d * 32 + 8 * i4 + 4 * g) = o;
        }
}

__device__ __forceinline__ void mix_phase(const Params& p, unsigned char* smem, int l) {
    const int n_al = 1024, n_ac = (l == 0) ? 64 : 0, n_hf = 512, n_hc = (l == 0) ? 1024 : 0;
    const int total = n_al + n_ac + n_hf + n_hc;
    for (int it = blockIdx.x; it < total; it += gridDim.x) {
        int i = it;
        if (i < n_al) { const int comp = i & 1, h = (i >> 1) & 3, qt = (i >> 3) & 15, b = i >> 7; for (int rep = 0; rep < REP_ATT; ++rep) attn_item(p, smem, b, h, comp, 256 + qt * 256, b * 4096 + qt * 256, 68); continue; }
        i -= n_al;
        if (i < n_ac) { const int comp = i & 1, h = (i >> 1) & 3, b = i >> 3; attn_item(p, smem, b, h, comp, 0, TL + b * 256, 4); continue; }
        i -= n_ac;
        if (i < n_hf) { for (int rep = 0; rep < REP_HY; ++rep) hyfft_pair(p, smem, l, i >> 1, i & 1); continue; }
        i -= n_hf;
        for (int rep = 0; rep < REP_MISC; ++rep) hyctx_item(p, smem, l, i >> 7, i & 127);
    }
}

__device__ __forceinline__ void ybt_item(const Params& p, unsigned char* smem, int tb) {
    bf16_t* tile = (bf16_t*)smem;
    const int tid = TID(), r0 = tb * 64;
    const bool lat = r0 < TL;
    const int n = lat ? 4096 : 256, rb = lat ? r0 : r0 - TL, b = rb / n, t0 = rb % n;
    const bf16_t* src = (lat ? (const bf16_t*)(p.ws + O_YBT) : (const bf16_t*)(p.ws + O_YBTC)) + (size_t)b * 256 * n + t0;
    __syncthreads();
#pragma unroll
    for (int i = 0; i < 4; ++i) { const int e = tid + i * NT, ch = e >> 3, sg = e & 7; *(u32x4*)(tile + ch * 72 + sg * 8) = *(const u32x4*)(src + (size_t)ch * n + sg * 8); }
    __syncthreads();
    bf16_t* yb = (bf16_t*)(p.ws + O_YCAT) + 512;
#pragma unroll
    for (int i = 0; i < 4; ++i) {
        const int e = tid + i * NT, rr = e >> 5, sg = e & 31;
        unsigned w[4];
#pragma unroll
        for (int j = 0; j < 4; ++j) w[j] = (unsigned)tile[(sg * 8 + 2 * j) * 72 + rr] | ((unsigned)tile[(sg * 8 + 2 * j + 1) * 72 + rr] << 16);
        *(u32x4*)(yb + (size_t)(r0 + rr) * 1024 + sg * 8) = (u32x4){w[0], w[1], w[2], w[3]};
    }
}
__device__ __forceinline__ void post_phase(const Params& p, unsigned char* smem, int l, int M) {
    const int n_sg = M / 128, nb = M / 64;
    for (int it = blockIdx.x; it < n_sg + nb; it += gridDim.x) {
        if (it < n_sg) { for (int rep = 0; rep < REP_SGU; ++rep) sgu_item(p, smem, l, it); }
        else ybt_item(p, smem, it - n_sg);
    }
    const int tid = TID(), lane = tid & 63, wv = tid >> 6;
    const float* lv = p.da_lambda + (size_t)l * 256;
    const float d01 = wave_sum(lv[lane] * lv[64 + lane]), d23 = wave_sum(lv[128 + lane] * lv[192 + lane]);
    const float lam_init = 0.8f - 0.6f * expf(-0.3f * (float)l);
    const float lam = expf(d01) - expf(d23) + lam_init;
    const float* sub = p.da_subln + (size_t)l * 128;
    const float s0 = sub[2 * lane] * (1.0f - lam_init), s1 = sub[2 * lane + 1] * (1.0f - lam_init);
    const bf16_t* OC = (const bf16_t*)(p.ws + O_OC);
    bf16_t* YA = (bf16_t*)(p.ws + O_YCAT);
    const int vstep = gridDim.x * 8;
    for (int v0i = blockIdx.x * 8 + wv; v0i < M * 4; v0i += 4 * vstep) {
        unsigned aw[4], bw[4];
#pragma unroll
        for (int k = 0; k < 4; ++k) { const int vi = v0i + k * vstep; aw[k] = 0u; bw[k] = 0u;
            if (vi < M * 4) { const bf16_t* o0 = OC + (size_t)vi * 256; aw[k] = *(const unsigned*)(o0 + 2 * lane); bw[k] = *(const unsigned*)(o0 + 128 + 2 * lane); } }
#pragma unroll
        for (int k = 0; k < 4; ++k) { const int vi = v0i + k * vstep;
            if (vi < M * 4) {
                const float x0 = bflo(aw[k]) - lam * bflo(bw[k]), x1 = bfhi(aw[k]) - lam * bfhi(bw[k]);
                const float rinv = rsqrtf(wave_sum(x0 * x0 + x1 * x1) * (1.0f / 128.0f) + 1e-6f);
                *(unsigned*)(YA + (size_t)(vi >> 2) * 1024 + (vi & 3) * 128 + 2 * lane) = pk2(x0 * rinv * s0, x1 * rinv * s1);
            } }
    }
}

template <int l> __device__ __forceinline__ void layer_body(unsigned char* smem) {
        const int Mfull = TT, Mpost = (l == 0) ? TT : TL;
        { const Params q = opq(smem); norm_phase(q, l, 0, Mfull, l == 0, (const bf16_t*)q.out); if (l == 1) aux_phase(q, smem, 1); }
        gsync(smem);
        for (int rep = 0; rep < REP_UP; ++rep) { const Params q = opq(smem); EpiSwiglu E; E.G = (bf16_t*)(q.ws + O_GH); run_gemm(smem, (const bf16_t*)(q.ws + O_H), (const bf16_t*)(q.ws + O_WUP0), Mfull, 5632, 1024, E); }
        gsync(smem);
        { const Params q = opq(smem); EpiResid E; E.xin = (const bf16_t*)q.out; E.xout = (bf16_t*)q.out; E.fout = nullptr; E.xc = (float*)(q.ws + O_XC); E.part = (float*)(q.ws + O_PART); E.mod = (const float*)(q.ws + O_MOD) + (size_t)l * 9 * 9216; E.gofs = 2 * 1024; E.coef = 0.5f;
          run_gemm(smem, (const bf16_t*)(q.ws + O_GH), (const bf16_t*)(q.ws + O_WDN0), Mfull, 1024, 2816, E, true);
          for (int rep = 1; rep < REP_DN; ++rep) { E.coef = 0.f; run_gemm(smem, (const bf16_t*)(q.ws + O_GH), (const bf16_t*)(q.ws + O_WDN0), Mfull, 1024, 2816, E); } }
        gsync(smem);
        { const Params q = opq(smem); norm_phase(q, l, 1, Mfull, false, (const bf16_t*)q.out); for (int rep = 0; rep < REP_MISC; ++rep) for (int it = blockIdx.x; it < 512; it += gridDim.x) filtfft_item(q, smem, it); }
        gsync(smem);
        for (int rep = 0; rep < REP_G3; ++rep) { const Params q = opq(smem); EpiIn E; E.qn = (bf16_t*)(q.ws + O_QN); E.kn = (bf16_t*)(q.ws + O_KN); E.vraw = (bf16_t*)(q.ws + O_VRAW); E.hyraw = (bf16_t*)(q.ws + O_HYRAW); E.sgraw = (bf16_t*)(q.ws + O_SGRAW);
          run_gemm(smem, (const bf16_t*)(q.ws + O_H), (const bf16_t*)(q.ws + O_WIN), Mfull, 2816, 1024, E); }
        gsync(smem);
        { const Params q = opq(smem); prep_phase(q, smem, l); }
        gsync(smem);
        { const Params q = opq(smem); mix_phase(q, smem, l); }
        gsync(smem);
        for (int rep = 0; rep < REP_MISC; ++rep) { const Params q = opq(smem); post_phase(q, smem, l, Mpost); }
        gsync(smem);
#pragma unroll 1
        for (int rep9 = 0; rep9 < REP_P9; ++rep9) {
            { const Params q = opq(smem); EpiGate3 E; E.g3 = (bf16_t*)(q.ws + O_G3); E.bias = q.gate_b + (size_t)l * 3072;
              run_gemm(smem, (const bf16_t*)(q.ws + O_H), (const bf16_t*)(q.ws + O_WG), Mpost, 3072, 1024, E); }
            gsync(smem);
            { const Params q = opq(smem); EpiMergeR E; E.g3 = (const bf16_t*)(q.ws + O_G3); E.mb = (bf16_t*)(q.ws + O_MB);
              run_gemm(smem, (const bf16_t*)(q.ws + O_YCAT), (const bf16_t*)(q.ws + O_WBR), Mpost, 1024, 1024, E); }
        }
        gsync(smem);
        { const Params q = opq(smem); EpiResid E; E.xin = (const bf16_t*)q.out; E.xout = (l == 1) ? (bf16_t*)(q.ws + O_XALT) : (bf16_t*)q.out; E.fout = nullptr; E.xc = (float*)(q.ws + O_XC); E.part = (float*)(q.ws + O_PART); E.mod = (const float*)(q.ws + O_MOD) + (size_t)l * 9 * 9216; E.gofs = 5 * 1024; E.coef = 1.0f;
          run_gemm(smem, (const bf16_t*)(q.ws + O_MB), (const bf16_t*)(q.ws + O_WO), Mpost, 1024, 1024, E, l == 0);
          for (int rep = 1; rep < REP_G3; ++rep) { E.coef = 0.f; run_gemm(smem, (const bf16_t*)(q.ws + O_MB), (const bf16_t*)(q.ws + O_WO), Mpost, 1024, 1024, E); } }
        gsync(smem);
        { const Params q = opq(smem); norm_phase(q, l, 2, Mpost, false, (l == 1) ? (const bf16_t*)(q.ws + O_XALT) : (const bf16_t*)q.out); }
        gsync(smem);
        for (int rep = 0; rep < REP_UP; ++rep) { const Params q = opq(smem); EpiSwiglu E; E.G = (bf16_t*)(q.ws + O_GH); run_gemm(smem, (const bf16_t*)(q.ws + O_H), (const bf16_t*)(q.ws + O_WUP1), Mpost, 5632, 1024, E); }
        gsync(smem);
        { const Params q = opq(smem); EpiResid E; E.xin = (l == 1) ? (const bf16_t*)(q.ws + O_XALT) : (const bf16_t*)q.out; E.xout = (bf16_t*)q.out; E.fout = (l == 1) ? q.out : nullptr; E.xc = (float*)(q.ws + O_XC); E.part = (float*)(q.ws + O_PART); E.mod = (const float*)(q.ws + O_MOD) + (size_t)l * 9 * 9216; E.gofs = 8 * 1024; E.coef = 0.5f;
          run_gemm(smem, (const bf16_t*)(q.ws + O_GH), (const bf16_t*)(q.ws + O_WDN1), Mpost, 1024, 2816, E, l == 0); }
}

__global__ void __launch_bounds__(512, 2) fwd_megakernel(Params p) {
    extern __shared__ __attribute__((aligned(16))) unsigned char smem[];
    cg::grid_group grid = cg::this_grid();
    if (threadIdx.x == 0) {
        *(Params*)(smem + POFF) = p;
        volatile unsigned* st = (volatile unsigned*)(smem + POFF + 256); st[0] = 0u; st[1] = 0u;
        xb_add(&((unsigned*)(p.ws + O_BAR))[XB_XCNT(xb_xcc_id())], 1u);
    }
    __syncthreads();
    { const Params q = opq(smem); aux_phase(q, smem, 0); }
    grid.sync();
    layer_body<0>(smem);
    gsync(smem);
    layer_body<1>(smem);
}

extern "C" void kernel_launch(void* const* d_in, const int* in_sizes, int n_in, void* d_out, int out_size, void* d_ws, size_t ws_size, hipStream_t stream) {
    if (ws_size < WS_NEED) { fprintf(stderr, "workspace too small: need %zu have %zu\n", (size_t)WS_NEED, ws_size); return; }
    static int grid_blocks = 0;
    if (!grid_blocks) {
        hipFuncSetAttribute((const void*)fwd_megakernel, hipFuncAttributeMaxDynamicSharedMemorySize, LDS_BYTES);
        int dev = 0, cus = 0, per_cu = 0;
        hipGetDevice(&dev);
        hipDeviceGetAttribute(&cus, hipDeviceAttributeMultiprocessorCount, dev);
        hipOccupancyMaxActiveBlocksPerMultiprocessor(&per_cu, fwd_megakernel, NT, LDS_BYTES);
        if (per_cu < 1) per_cu = 1;
        grid_blocks = cus;
    }
    Params p{};
    const float** pp = (const float**)&p;
    for (int i = 0; i < 30; ++i) pp[i] = (const float*)d_in[i];
    p.out = (float*)d_out;
    p.ws = (unsigned char*)d_ws;
    hipMemsetAsync((unsigned char*)d_ws + O_BAR, 0, 16384, stream);
    void* args[] = {&p};
    hipError_t e = hipLaunchCooperativeKernel((void*)fwd_megakernel, dim3(grid_blocks), dim3(NT), args, LDS_BYTES, stream);
    if (e != hipSuccess) fprintf(stderr, "cooperative launch failed: %s (grid %d)\n", hipGetErrorString(e), grid_blocks);
}
```

```cpp
#include <hip/hip_runtime.h>
#include <hip/hip_cooperative_groups.h>
#include <cstdio>
namespace cg = cooperative_groups;

#define LAS __attribute__((address_space(3)))
typedef unsigned short bf16_t;
typedef short bf16x8 __attribute__((ext_vector_type(8)));
typedef float f32x2 __attribute__((ext_vector_type(2)));
typedef float f32x4 __attribute__((ext_vector_type(4)));
typedef float f32x16 __attribute__((ext_vector_type(16)));
typedef unsigned u32x2 __attribute__((ext_vector_type(2)));
typedef unsigned u32x4 __attribute__((ext_vector_type(4)));
typedef __bf16 bf16v2 __attribute__((ext_vector_type(2)));

constexpr int NT = 512;
#ifndef REP_ATT
#define REP_ATT 1
#endif
#ifndef REP_HY
#define REP_HY 1
#endif
#ifndef REP_AUX
#define REP_AUX 1
#endif
#ifndef REP_MISC
#define REP_MISC 1
#endif
#ifndef REP_PREP
#define REP_PREP 1
#endif
#ifndef REP_UP
#define REP_UP 1
#endif
#ifndef REP_DN
#define REP_DN 1
#endif
#ifndef REP_G3
#define REP_G3 1
#endif
#ifndef REP_P9
#define REP_P9 1
#endif
#ifndef REP_QK
#define REP_QK 1
#endif
#ifndef REP_NORM
#define REP_NORM 1
#endif
#ifndef REP_SGU
#define REP_SGU 1
#endif
constexpr int TL = 32768, TCX = 2048, TT = 34816, DM = 1024, FFH = 2816, SEQ = 4096, CTXL = 256, NK = 4352;
constexpr int LDS_BYTES = 147456;

constexpr size_t AL(size_t x) { return (x + 255) & ~(size_t)255; }
constexpr size_t O_WUP0 = 0;
constexpr size_t O_WUP1 = O_WUP0 + (size_t)5632 * 1024 * 2;
constexpr size_t O_WDN0 = O_WUP1 + (size_t)5632 * 1024 * 2;
constexpr size_t O_WDN1 = O_WDN0 + (size_t)1024 * 2816 * 2;
constexpr size_t O_WIN = O_WDN1 + (size_t)1024 * 2816 * 2;
constexpr size_t O_WG = O_WIN + (size_t)2816 * 1024 * 2;
constexpr size_t O_WBR = O_WG + (size_t)3072 * 1024 * 2;
constexpr size_t O_WO = O_WBR + (size_t)1024 * 1024 * 2;
constexpr size_t O_XC = O_WO + (size_t)1024 * 1024 * 2;
constexpr size_t O_MOD = O_XC + (size_t)TCX * 1024 * 4;
constexpr size_t O_L1P = O_MOD + AL((size_t)2 * 9 * 9216 * 4);
constexpr size_t O_L1PC = O_L1P + (size_t)256 * 1024 * 4;
constexpr size_t O_FILTC = O_L1PC + (size_t)16 * 1024 * 4;
constexpr size_t O_BAR = O_FILTC + (size_t)2 * 256 * 512 * 4;
constexpr size_t O_H = O_BAR + 16384;
constexpr size_t O_AR = O_H + (size_t)TT * 1024 * 2;
constexpr size_t O_GH = O_AR;
constexpr size_t O_VRAW = O_AR;
constexpr size_t O_HYRAW = O_VRAW + (size_t)TT * 512 * 2;
constexpr size_t O_SGRAW = O_HYRAW + (size_t)TT * 768 * 2;
constexpr size_t O_XALT = O_AR + (size_t)TT * 2816 * 2;
constexpr size_t O_PART = O_XALT;
constexpr size_t O_OC = O_AR;
constexpr size_t O_YBT = O_OC + (size_t)TT * 1024 * 2;
constexpr size_t O_YBTC = O_YBT + (size_t)8 * 256 * 4096 * 2;
static_assert(O_YBTC + (size_t)8 * 256 * 256 * 2 <= O_SGRAW, "OC/YBT must not touch SGRAW (read in the post phase)");
constexpr size_t O_G3 = O_AR;
constexpr size_t O_YCAT = O_G3 + (size_t)TT * 3072 * 2;
constexpr size_t O_MB = O_YCAT + (size_t)TT * 1024 * 2;
constexpr size_t SZ_B = (size_t)TT * 1024 * 4 + (size_t)8 * 256 * 4096 * 2 + (size_t)8 * 256 * 256 * 2;
constexpr size_t O_QN = O_AR + AL(SZ_B);
constexpr size_t O_KN = O_QN + (size_t)64 * NK * 64 * 2;
constexpr size_t O_VT = O_KN + (size_t)64 * NK * 64 * 2;
constexpr size_t O_HV = O_VT + (size_t)32 * 128 * NK * 2;
constexpr size_t O_HVC = O_HV + (size_t)8 * 768 * 4096 * 2;
constexpr size_t O_FH = O_HVC + (size_t)8 * 768 * 256 * 2;
constexpr size_t O_FILT = O_HV;
constexpr size_t SZ_C1 = (size_t)8 * 768 * 4096 * 2 + (size_t)8 * 768 * 256 * 2 + (size_t)2 * 256 * 8192 * 8;
constexpr size_t END1 = O_HV + SZ_C1, END2 = O_MB + (size_t)TT * 1024 * 2;
static_assert(O_YCAT >= O_SGRAW + (size_t)TT * 512 * 2, "YCAT is written while OC/YBT/SGRAW are read");
constexpr size_t WS_NEED = AL(END1 > END2 ? END1 : END2);
static_assert(O_GH + (size_t)TT * 2816 * 2 <= O_HV, "Gh must stay inside regions B'+A");
static_assert(O_XALT + (size_t)TL * 1024 * 2 <= O_MB, "X_alt is written while MB is read");
static_assert(O_PART + (size_t)4 * 2048 * 1024 * 4 <= O_HV, "partials must not touch FILT/FH");
static_assert(O_SGRAW + (size_t)TT * 512 * 2 <= O_QN, "raws fit region B'");

struct Params {
    const float *x, *c, *ctx, *c_ctx, *ada_w, *ada_b, *norm_g, *ffn_up, *ffn_down, *w_in, *qk_gain, *da_lambda, *da_subln,
        *hy_conv_w, *hy_conv_b, *hy_w1, *hy_b1, *hy_w2, *hy_b2, *hy_freq, *hy_w3, *hy_skip, *sg_ln_g, *sg_ln_b, *sg_w, *sg_b,
        *gate_w, *gate_b, *w_br, *w_o;
    float* out;
    unsigned char* ws;
};


__device__ __forceinline__ int TID() { int t = threadIdx.x; asm volatile("" : "+v"(t)); return t; }
constexpr int POFF = 147456 - 512;
__device__ __forceinline__ const float* ldp(const unsigned char* smem, int idx) {
    const volatile unsigned* w = (const volatile unsigned*)(smem + POFF + idx * 8);
    const unsigned lo = __builtin_amdgcn_readfirstlane(w[0]), hi = __builtin_amdgcn_readfirstlane(w[1]);
    typedef __attribute__((address_space(1))) const float* gptr_t;
    return (const float*)(gptr_t)(((unsigned long long)hi << 32) | lo);
}
__device__ __forceinline__ Params opq(const unsigned char* smem) {
    Params q;
    q.x = ldp(smem, 0); q.c = ldp(smem, 1); q.ctx = ldp(smem, 2); q.c_ctx = ldp(smem, 3); q.ada_w = ldp(smem, 4); q.ada_b = ldp(smem, 5); q.norm_g = ldp(smem, 6);
    q.ffn_up = ldp(smem, 7); q.ffn_down = ldp(smem, 8); q.w_in = ldp(smem, 9); q.qk_gain = ldp(smem, 10); q.da_lambda = ldp(smem, 11); q.da_subln = ldp(smem, 12);
    q.hy_conv_w = ldp(smem, 13); q.hy_conv_b = ldp(smem, 14); q.hy_w1 = ldp(smem, 15); q.hy_b1 = ldp(smem, 16); q.hy_w2 = ldp(smem, 17); q.hy_b2 = ldp(smem, 18);
    q.hy_freq = ldp(smem, 19); q.hy_w3 = ldp(smem, 20); q.hy_skip = ldp(smem, 21); q.sg_ln_g = ldp(smem, 22); q.sg_ln_b = ldp(smem, 23); q.sg_w = ldp(smem, 24);
    q.sg_b = ldp(smem, 25); q.gate_w = ldp(smem, 26); q.gate_b = ldp(smem, 27); q.w_br = ldp(smem, 28); q.w_o = ldp(smem, 29);
    q.out = (float*)ldp(smem, 30); q.ws = (unsigned char*)ldp(smem, 31);
    return q;
}


#define XB_TMO      128
#define XB_XCNT(j)  (256  + 64 * (j))
#define XB_XSUB(j)  (1280 + 64 * (j))
#define XB_XGEN(j)  (2304 + 64 * (j))
#define XB_TOP      3328
#define XB_TOPGEN   3392
#define XCD_BAR_WORDS 3456
#define XB_SPIN_CAP (1u << 22)
__device__ __forceinline__ unsigned xb_ld(unsigned* p)              { return __hip_atomic_load(p, __ATOMIC_RELAXED, __HIP_MEMORY_SCOPE_AGENT); }
__device__ __forceinline__ unsigned xb_add(unsigned* p, unsigned v) { return __hip_atomic_fetch_add(p, v, __ATOMIC_RELAXED, __HIP_MEMORY_SCOPE_AGENT); }
__device__ __forceinline__ unsigned xb_xcc_id() { return (unsigned)__builtin_amdgcn_s_getreg((3 << 11) | 20) & 0xFu; }
#define XB_SPIN(cond, bar) do { unsigned _sp = 0; while (cond) { __builtin_amdgcn_s_sleep(1); \
    if ((++_sp & 255u) == 0u) { if (xb_ld(&(bar)[XB_TMO])) break; if (_sp > XB_SPIN_CAP) { atomicAdd(&(bar)[XB_TMO], 1u); break; } } } } while (0)
__device__ __forceinline__ void xcd_barrier_complete(unsigned* bar, unsigned x, unsigned& nloc, unsigned& nx) {
    const unsigned G = gridDim.x * gridDim.y * gridDim.z;
    unsigned sum, cnt, mine, sp = 0u;
    for (;;) {
        sum = 0u; cnt = 0u; mine = 0u;
#pragma unroll
        for (unsigned j = 0; j < 16; ++j) { const unsigned c = xb_ld(&bar[XB_XCNT(j)]); sum += c; cnt += (c > 0u) ? 1u : 0u; mine = (j == x) ? c : mine; }
        if (sum == G) break;
        __builtin_amdgcn_s_sleep(1);
        if ((++sp & 255u) == 0u) { if (xb_ld(&bar[XB_TMO])) break; if (sp > XB_SPIN_CAP) { atomicAdd(&bar[XB_TMO], 1u); break; } }
    }
    nloc = mine > 0u ? mine : 1u; nx = cnt > 0u ? cnt : 1u;
}
__device__ __forceinline__ void gsync(unsigned char* smem) {
    asm volatile("s_waitcnt vmcnt(0)" ::: "memory");
    __syncthreads();
    if (threadIdx.x == 0) {
        unsigned* bar = (unsigned*)((unsigned char*)ldp(smem, 31) + O_BAR);
        volatile unsigned* st = (volatile unsigned*)(smem + POFF + 256);
        const unsigned x = xb_xcc_id();
        __builtin_amdgcn_s_waitcnt(0);
        unsigned nloc = st[0], nx = st[1];
        if (nloc == 0u) { xcd_barrier_complete(bar, x, nloc, nx); st[0] = nloc; st[1] = nx; }
        const unsigned old = xb_add(&bar[XB_XSUB(x)], 1u);
        const unsigned gen = old / nloc;
        if (old + 1u == (gen + 1u) * nloc) {
            __builtin_amdgcn_fence(__ATOMIC_RELEASE, "agent");
            asm volatile("s_waitcnt vmcnt(0)" ::: "memory");
            const unsigned og = xb_add(&bar[XB_TOP], 1u);
            const unsigned tg = og / nx;
            if (og + 1u == (tg + 1u) * nx) xb_add(&bar[XB_TOPGEN], 1u);
            else XB_SPIN(xb_ld(&bar[XB_TOPGEN]) == tg, bar);
            __builtin_amdgcn_fence(__ATOMIC_ACQUIRE, "agent");
            xb_add(&bar[XB_XGEN(x)], 1u);
            asm volatile("s_waitcnt vmcnt(0)" ::: "memory");
        } else {
            XB_SPIN(xb_ld(&bar[XB_XGEN(x)]) == gen, bar);
            __builtin_amdgcn_fence(__ATOMIC_ACQUIRE, "agent");
            asm volatile("s_waitcnt vmcnt(0)" ::: "memory");
        }
    }
    __syncthreads();
}

__device__ __forceinline__ unsigned pk2(float a, float b) { f32x2 v = {a, b}; bf16v2 r = __builtin_convertvector(v, bf16v2); return __builtin_bit_cast(unsigned, r); }
__device__ __forceinline__ bf16_t f2bf(float a) { return (bf16_t)(pk2(a, 0.f) & 0xffffu); }
__device__ __forceinline__ float bf2f(bf16_t h) { return __uint_as_float((unsigned)h << 16); }
__device__ __forceinline__ float bflo(unsigned w) { return __uint_as_float(w << 16); }
__device__ __forceinline__ float bfhi(unsigned w) { return __uint_as_float(w & 0xffff0000u); }
__device__ __forceinline__ void row_bk(int r, int& b, int& kidx) { if (r < TL) { b = r >> 12; kidx = 256 + (r & 4095); } else { const int rc = r - TL; b = rc >> 8; kidx = rc & 255; } }
__device__ __forceinline__ float wave_sum(float v) {
#pragma unroll
    for (int o = 32; o > 0; o >>= 1) v += __shfl_xor(v, o);
    return v;
}
__device__ __forceinline__ float sigmoidf_(float v) { return __builtin_amdgcn_rcpf(1.0f + __builtin_amdgcn_exp2f(v * -1.4426950408889634f)); }

namespace pg8 {
constexpr int BM = 256, BK = 64, HALF = 128, HTB = HALF * BK * 2, STAGE_BYTES = 8 * HTB, NXCD = 8, WGM = 8;
__device__ __forceinline__ int lds_byte(int r, int c) { const int st = (r >> 4) * 2 + (c >> 5), rr = r & 15, cc = c & 31, ob = rr * 64 + cc * 2; return st * 1024 + (ob ^ (((ob >> 9) & 1) << 5)); }
__device__ __forceinline__ void stage_rc(int b, int& R, int& C) { const int st = b / 1024, sb = b % 1024, swz = sb ^ (((sb >> 9) & 1) << 5); R = (st >> 1) * 16 + swz / 64; C = (st & 1) * 32 + (swz % 64) / 2; }
__device__ __forceinline__ int perm32(int rho) { const int n = rho >> 4, i = rho & 15; return 8 * (i >> 2) + 4 * n + (i & 3); }
struct Unit { int pm, pn, k0, nt, split; };
struct Gemm { const bf16_t* A; const bf16_t* Bt; int M, N, K; };
struct StaticOrder {
    int nM, nN, nwg, G, c, ntk, ntail;
    __device__ void init(int M, int N, int K, int G_, int c_, bool split_tail) {
        nM = M / BM; nN = N / BM; G = G_; c = c_; ntk = K / BK; ntail = 0;
        if (split_tail) { nM -= 8; ntail = 128; }
        nwg = nM * nN;
    }
    __device__ __forceinline__ bool next(int i, Unit& u) const {
        const long L = (long)i * G + c; if (L >= nwg + ntail) return false;
        int pm, pn, k0 = 0, nt = ntk, split = 0;
        if (L >= nwg) {
            const int j = (int)L - nwg, cu = j >> 2, part = j & 3;
            pm = nM + (cu >> 2); pn = cu & 3; split = 1 + part;
            const int q = (ntk / 4) & ~1, big = (ntk - 4 * q) / 2;
            nt = q + ((part < big) ? 2 : 0);
            k0 = part * q + 2 * (part < big ? part : big);
        } else {
            int wgid = (int)L; { const int q = nwg / NXCD, r = nwg % NXCD, xcd = wgid % NXCD, off = wgid / NXCD; wgid = (xcd < r ? xcd * (q + 1) : r * (q + 1) + (xcd - r) * q) + off; }
            const int nig = WGM * nN, gid = wgid / nig, fm = gid * WGM, gsz = (nM - fm) < WGM ? (nM - fm) : WGM;
            pm = fm + ((wgid % nig) % gsz); pn = (wgid % nig) / gsz;
        }
        u.pm = pm; u.pn = pn; u.k0 = k0; u.nt = nt; u.split = split;
        return true;
    }
};

template <class Epi>
__device__ __forceinline__ void gemm_phase(LAS unsigned char* lds, const Gemm g, const StaticOrder& S, const Epi& E) {
    const int tid = TID(), wid = __builtin_amdgcn_readfirstlane(tid >> 6), lane = tid & 63, wr = wid >> 2, wc = wid & 3, fr = lane & 15, fq = lane >> 4;
    const int K = g.K;
    unsigned voffA[2], voffB[2];
#pragma unroll
    for (int i = 0; i < 2; ++i) { int R, C; stage_rc(tid * 16 + i * 8192, R, C); const int Rb = Epi::PERM ? ((R & ~31) + perm32(R & 31)) : R;
        voffA[i] = (unsigned)(R * K + C) * 2u; voffB[i] = (unsigned)(Rb * K + C) * 2u; }
    const size_t kstep = (size_t)(BK * 2);
    const size_t hstep = (size_t)HALF * K * 2;
    const size_t tstep = 2 * hstep;
    const unsigned ldsw = (unsigned)wid * 1024u;
    const int aoff = lds_byte(wr * 64 + fr, fq * 8), boff = lds_byte(wc * 32 + fr, fq * 8);
#define PG8_SA(b, h) (((b) * 2 + (h)) * HTB)
#define PG8_SB(b, h) ((4 + (b) * 2 + (h)) * HTB)
#define PG8_STAGE(bufoff, gbase, voff) do { _Pragma("unroll") for (int _i = 0; _i < 2; ++_i) \
        __builtin_amdgcn_global_load_lds((const unsigned*)((const char*)(gbase) + (voff)[_i]), (LAS unsigned*)(lds + (bufoff) + ldsw + _i * 8192), 16, 0, 0); } while (0)
#define PG8_LDA(dst, b, h) do { _Pragma("unroll") for (int m = 0; m < 4; ++m) _Pragma("unroll") for (int k = 0; k < 2; ++k) dst[m][k] = *(const LAS bf16x8*)(lds + PG8_SA(b, h) + aoff + m * 2048 + k * 1024); } while (0)
#define PG8_LDB(dst, b, h) do { _Pragma("unroll") for (int n = 0; n < 2; ++n) _Pragma("unroll") for (int k = 0; k < 2; ++k) dst[n][k] = *(const LAS bf16x8*)(lds + PG8_SB(b, h) + boff + n * 2048 + k * 1024); } while (0)
#define PG8_MMA(ai, bj, At, Bt) do { __builtin_amdgcn_s_setprio(1); _Pragma("unroll") for (int m = 0; m < 4; ++m) _Pragma("unroll") for (int n = 0; n < 2; ++n) _Pragma("unroll") for (int k = 0; k < 2; ++k) \
        acc[ai][bj][m][n] = __builtin_amdgcn_mfma_f32_16x16x32_bf16(Bt[n][k], At[m][k], acc[ai][bj][m][n], 0, 0, 0); __builtin_amdgcn_s_setprio(0); } while (0)
#define PG8_WAIT_V(n) asm volatile("s_waitcnt vmcnt(" #n ")" ::: "memory")
#define PG8_WAIT_L(n) asm volatile("s_waitcnt lgkmcnt(" #n ")" ::: "memory")
#define PG8_BAR __builtin_amdgcn_s_barrier()
#define PG8_SCHED __builtin_amdgcn_sched_barrier(0)
    Unit cur, nxt; int ui = 0;
    if (!S.next(0, cur)) return;
    f32x4 acc[2][2][4][2];
#pragma unroll
    for (int a = 0; a < 2; ++a)
#pragma unroll
        for (int b = 0; b < 2; ++b)
#pragma unroll
            for (int m = 0; m < 4; ++m)
#pragma unroll
                for (int n = 0; n < 2; ++n) acc[a][b][m][n] = (f32x4){0.f, 0.f, 0.f, 0.f};
    bf16x8 At[4][2], B0[2][2], B1[2][2];
    const char* cA = (const char*)g.A + (size_t)cur.pm * tstep + (size_t)cur.k0 * kstep; const char* cB = (const char*)g.Bt + (size_t)cur.pn * tstep + (size_t)cur.k0 * kstep;
    PG8_STAGE(PG8_SB(0, 0), cB, voffB); PG8_STAGE(PG8_SA(0, 0), cA, voffA); PG8_STAGE(PG8_SB(0, 1), cB + hstep, voffB); PG8_STAGE(PG8_SA(0, 1), cA + hstep, voffA);
    if (wr == 1) PG8_BAR;
    PG8_WAIT_V(4); PG8_BAR;
    PG8_STAGE(PG8_SB(1, 0), cB + kstep, voffB); PG8_STAGE(PG8_SA(1, 0), cA + kstep, voffA); PG8_STAGE(PG8_SB(1, 1), cB + hstep + kstep, voffB);
    PG8_WAIT_V(6); PG8_BAR;
    for (;;) {
        const bool has_next = S.next(ui + 1, nxt);
        const char* nA = has_next ? (const char*)g.A + (size_t)nxt.pm * tstep + (size_t)nxt.k0 * kstep : cA; const char* nB = has_next ? (const char*)g.Bt + (size_t)nxt.pn * tstep + (size_t)nxt.k0 * kstep : cB;
        const int nt = cur.nt;
        for (int t = 0; t < nt; t += 2) {
            const bool last = (t == nt - 2);
            const char* a1 = cA + (size_t)(t + 1) * kstep;
            const char* a2 = last ? nA : cA + (size_t)(t + 2) * kstep; const char* b2 = last ? nB : cB + (size_t)(t + 2) * kstep;
            const char* a3 = a2 + kstep; const char* b3 = b2 + kstep;
            if constexpr (Epi::RESCALE) { if (t == 8 || t == 12) E.rescale(acc, cur, t == 8 ? 0 : 1, wr, wc, fr, fq); }
            PG8_LDB(B0, 0, 0); PG8_SCHED; PG8_LDA(At, 0, 0); PG8_STAGE(PG8_SA(1, 1), a1 + hstep, voffA);
            PG8_WAIT_L(8); PG8_BAR; PG8_WAIT_L(0); PG8_MMA(0, 0, At, B0); PG8_BAR; PG8_SCHED;
            PG8_LDB(B1, 0, 1); PG8_STAGE(PG8_SB(0, 0), b2, voffB);
            PG8_BAR; PG8_WAIT_L(0); PG8_MMA(0, 1, At, B1); PG8_BAR;
            PG8_LDA(At, 0, 1); PG8_STAGE(PG8_SA(0, 0), a2, voffA);
            PG8_BAR; PG8_WAIT_L(0); PG8_MMA(1, 0, At, B0); PG8_BAR; PG8_SCHED;
            PG8_STAGE(PG8_SB(0, 1), b2 + hstep, voffB);
            PG8_WAIT_V(6); PG8_BAR; PG8_MMA(1, 1, At, B1); PG8_BAR;
            PG8_LDB(B0, 1, 0); PG8_SCHED; PG8_LDA(At, 1, 0); PG8_STAGE(PG8_SA(0, 1), a2 + hstep, voffA);
            PG8_WAIT_L(8); PG8_BAR; PG8_WAIT_L(0); PG8_MMA(0, 0, At, B0); PG8_BAR; PG8_SCHED;
            PG8_LDB(B1, 1, 1); PG8_STAGE(PG8_SB(1, 0), b3, voffB);
            PG8_BAR; PG8_WAIT_L(0); PG8_MMA(0, 1, At, B1); PG8_BAR;
            PG8_LDA(At, 1, 1); PG8_STAGE(PG8_SA(1, 0), a3, voffA);
            PG8_BAR; PG8_WAIT_L(0); PG8_MMA(1, 0, At, B0); PG8_BAR; PG8_SCHED;
            PG8_STAGE(PG8_SB(1, 1), b3 + hstep, voffB);
            PG8_WAIT_V(6); PG8_BAR; PG8_MMA(1, 1, At, B1); PG8_BAR;
        }
        E(acc, cur, wr, wc, fr, fq);
        if (!has_next) break;
#pragma unroll
        for (int a = 0; a < 2; ++a)
#pragma unroll
            for (int b = 0; b < 2; ++b)
#pragma unroll
                for (int m = 0; m < 4; ++m)
#pragma unroll
                    for (int n = 0; n < 2; ++n) acc[a][b][m][n] = (f32x4){0.f, 0.f, 0.f, 0.f};
        cur = nxt; cA = nA; cB = nB; ++ui;
    }
    PG8_WAIT_V(0);
    if (wr == 0) PG8_BAR;
    PG8_BAR;
#undef PG8_SA
#undef PG8_SB
#undef PG8_STAGE
#undef PG8_LDA
#undef PG8_LDB
#undef PG8_MMA
#undef PG8_WAIT_V
#undef PG8_WAIT_L
#undef PG8_BAR
#undef PG8_SCHED
}
}
using pg8::Unit;
typedef f32x4 AccT[2][2][4][2];

struct EpiSwiglu {
    static constexpr bool PERM = true, RESCALE = false;
    bf16_t* G;
    __device__ __forceinline__ void operator()(const AccT& acc, const Unit& u, int wr, int wc, int fr, int fq) const {
        const int row0 = u.pm * 256 + wr * 64 + fr, col0 = u.pn * 128 + wc * 32 + 8 * fq;
#pragma unroll
        for (int ai = 0; ai < 2; ++ai)
#pragma unroll
            for (int m = 0; m < 4; ++m) {
                float gv[8];
#pragma unroll
                for (int n = 0; n < 2; ++n)
#pragma unroll
                    for (int j = 0; j < 4; ++j) { const float a = acc[ai][0][m][n][j], b = acc[ai][1][m][n][j]; gv[n * 4 + j] = a * b * __builtin_amdgcn_rcpf(1.0f + __builtin_amdgcn_exp2f(a * -1.4426950408889634f)); }
                u32x4 w; w.x = pk2(gv[0], gv[1]); w.y = pk2(gv[2], gv[3]); w.z = pk2(gv[4], gv[5]); w.w = pk2(gv[6], gv[7]);
                *(u32x4*)(G + (size_t)(row0 + ai * 128 + m * 16) * FFH + col0) = w;
            }
    }
};
struct EpiResid {
    static constexpr bool PERM = true, RESCALE = false;
    const bf16_t* xin; bf16_t* xout; float* fout; float* xc; float* part; const float* mod; int gofs; float coef;
    __device__ __forceinline__ void operator()(const AccT& acc, const Unit& u, int wr, int wc, int fr, int fq) const {
        const int row0 = u.pm * 256 + wr * 64 + fr, col0 = u.pn * 256 + wc * 32 + 8 * fq;
        const bool lat = u.pm < 128;
        const int mr = lat ? (u.pm >> 4) : 8;
        const float* gp = mod + (size_t)mr * 9216 + gofs + col0;
#pragma unroll
        for (int bj = 0; bj < 2; ++bj) {
            const f32x4 g0 = *(const f32x4*)(gp + bj * 128) * coef, g1 = *(const f32x4*)(gp + bj * 128 + 4) * coef;
            if (lat) {
                u32x4 xw[8];
#pragma unroll
                for (int am = 0; am < 8; ++am) xw[am] = *(const u32x4*)(xin + (size_t)(row0 + (am >> 2) * 128 + (am & 3) * 16) * 1024 + col0 + bj * 128);
#pragma unroll
                for (int am = 0; am < 8; ++am) {
                    const int ai = am >> 2, m = am & 3;
                    const size_t o = (size_t)(row0 + ai * 128 + m * 16) * 1024 + col0 + bj * 128;
                    f32x4 v0 = {bflo(xw[am].x), bfhi(xw[am].x), bflo(xw[am].y), bfhi(xw[am].y)}, v1 = {bflo(xw[am].z), bfhi(xw[am].z), bflo(xw[am].w), bfhi(xw[am].w)};
                    v0 += g0 * acc[ai][bj][m][0]; v1 += g1 * acc[ai][bj][m][1];
                    if (fout) { *(f32x4*)(fout + o) = v0; *(f32x4*)(fout + o + 4) = v1; }
                    else { u32x4 w; w.x = pk2(v0[0], v0[1]); w.y = pk2(v0[2], v0[3]); w.z = pk2(v1[0], v1[1]); w.w = pk2(v1[2], v1[3]); *(u32x4*)(xout + o) = w; }
                }
            } else {
#pragma unroll
                for (int am = 0; am < 8; ++am) {
                    const int ai = am >> 2, m = am & 3;
                    const size_t o = (size_t)(row0 + ai * 128 + m * 16 - TL) * 1024 + col0 + bj * 128;
                    const f32x4 d0 = g0 * acc[ai][bj][m][0], d1 = g1 * acc[ai][bj][m][1];
                    if (u.split) { float* pp = part + (size_t)(u.split - 1) * 2048 * 1024 + o; *(f32x4*)pp = d0; *(f32x4*)(pp + 4) = d1; }
                    else { float* xp = xc + o; *(f32x4*)xp = *(const f32x4*)xp + d0; *(f32x4*)(xp + 4) = *(const f32x4*)(xp + 4) + d1; }
                }
            }
        }
    }
};
struct EpiIn {
    static constexpr bool PERM = true, RESCALE = false;
    bf16_t *qn, *kn, *vraw, *hyraw, *sgraw;
    __device__ __forceinline__ void operator()(const AccT& acc, const Unit& u, int wr, int wc, int fr, int fq) const {
        const int row0 = u.pm * 256 + wr * 64 + fr, pn = u.pn;
#pragma unroll
        for (int ai = 0; ai < 2; ++ai)
#pragma unroll
            for (int m = 0; m < 4; ++m) {
                const int r = row0 + ai * 128 + m * 16;
#pragma unroll
                for (int bj = 0; bj < 2; ++bj) {
                    const f32x4 v0 = acc[ai][bj][m][0], v1 = acc[ai][bj][m][1];
                    u32x4 w; w.x = pk2(v0[0], v0[1]); w.y = pk2(v0[2], v0[3]); w.z = pk2(v1[0], v1[1]); w.w = pk2(v1[2], v1[3]);
                    const int cl = bj * 128 + wc * 32 + 8 * fq;
                    bf16_t* dst;
                    if (pn < 4) {
                        int b, kidx; row_bk(r, b, kidx);
                        const int cc = (pn & 1) * 256 + cl, head = cc >> 7, comp = (cc >> 6) & 1, d = cc & 63;
                        dst = (pn < 2 ? qn : kn) + ((size_t)((b * 4 + head) * 2 + comp) * NK + kidx) * 64 + d;
                    } else if (pn < 6) dst = vraw + (size_t)r * 512 + (pn - 4) * 256 + cl;
                    else if (pn < 9) dst = hyraw + (size_t)r * 768 + (pn - 6) * 256 + cl;
                    else dst = sgraw + (size_t)r * 512 + (pn - 9) * 256 + cl;
                    *(u32x4*)dst = w;
                }
            }
    }
};
struct EpiGate3 {
    static constexpr bool PERM = true, RESCALE = false;
    bf16_t* g3; const float* bias;
    __device__ __forceinline__ void operator()(const AccT& acc, const Unit& u, int wr, int wc, int fr, int fq) const {
        const int row0 = u.pm * 256 + wr * 64 + fr, col0 = u.pn * 256 + wc * 32 + 8 * fq;
#pragma unroll
        for (int bj = 0; bj < 2; ++bj) {
            const f32x4 b0 = *(const f32x4*)(bias + col0 + bj * 128), b1 = *(const f32x4*)(bias + col0 + bj * 128 + 4);
#pragma unroll
            for (int ai = 0; ai < 2; ++ai)
#pragma unroll
                for (int m = 0; m < 4; ++m) {
                    const f32x4 v0 = acc[ai][bj][m][0] + b0, v1 = acc[ai][bj][m][1] + b1;
                    float gv[8];
#pragma unroll
                    for (int j = 0; j < 4; ++j) { gv[j] = fmaxf(sigmoidf_(v0[j]), 1e-5f); gv[4 + j] = fmaxf(sigmoidf_(v1[j]), 1e-5f); }
                    u32x4 w; w.x = pk2(gv[0], gv[1]); w.y = pk2(gv[2], gv[3]); w.z = pk2(gv[4], gv[5]); w.w = pk2(gv[6], gv[7]);
                    *(u32x4*)(g3 + (size_t)(row0 + ai * 128 + m * 16) * 3072 + col0 + bj * 128) = w;
                }
        }
    }
};
struct EpiMergeR {
    static constexpr bool PERM = true, RESCALE = true;
    const bf16_t* g3; bf16_t* mb;
    __device__ __forceinline__ void rescale(AccT& acc, const Unit& u, int which, int wr, int wc, int fr, int fq) const {
        const int row0 = u.pm * 256 + wr * 64 + fr, col0 = u.pn * 256 + wc * 32 + 8 * fq;
        const bf16_t* gb = g3 + (size_t)row0 * 3072 + which * 1024 + col0;
#pragma unroll
        for (int ai = 0; ai < 2; ++ai)
#pragma unroll
            for (int mh = 0; mh < 2; ++mh) {
                u32x4 nw[2][2], dw[2][2];
#pragma unroll
                for (int mm = 0; mm < 2; ++mm)
#pragma unroll
                    for (int bj = 0; bj < 2; ++bj) { const bf16_t* gp = gb + (size_t)(ai * 128 + (mh * 2 + mm) * 16) * 3072 + bj * 128; nw[mm][bj] = *(const u32x4*)gp; dw[mm][bj] = *(const u32x4*)(gp + 1024); }
#pragma unroll
                for (int mm = 0; mm < 2; ++mm)
#pragma unroll
                    for (int bj = 0; bj < 2; ++bj) {
                        const u32x4 n4 = nw[mm][bj], d4 = dw[mm][bj];
                        const f32x4 r0 = {bflo(n4.x) * __builtin_amdgcn_rcpf(bflo(d4.x)), bfhi(n4.x) * __builtin_amdgcn_rcpf(bfhi(d4.x)), bflo(n4.y) * __builtin_amdgcn_rcpf(bflo(d4.y)), bfhi(n4.y) * __builtin_amdgcn_rcpf(bfhi(d4.y))};
                        const f32x4 r1 = {bflo(n4.z) * __builtin_amdgcn_rcpf(bflo(d4.z)), bfhi(n4.z) * __builtin_amdgcn_rcpf(bfhi(d4.z)), bflo(n4.w) * __builtin_amdgcn_rcpf(bflo(d4.w)), bfhi(n4.w) * __builtin_amdgcn_rcpf(bfhi(d4.w))};
                        acc[ai][bj][mh * 2 + mm][0] *= r0; acc[ai][bj][mh * 2 + mm][1] *= r1;
                    }
                __builtin_amdgcn_sched_barrier(0);
            }
    }
    __device__ __forceinline__ void operator()(const AccT& acc, const Unit& u, int wr, int wc, int fr, int fq) const {
        const int row0 = u.pm * 256 + wr * 64 + fr, col0 = u.pn * 256 + wc * 32 + 8 * fq;
#pragma unroll
        for (int bj = 0; bj < 2; ++bj) {
            u32x4 gw[8];
#pragma unroll
            for (int am = 0; am < 8; ++am) gw[am] = *(const u32x4*)(g3 + (size_t)(row0 + (am >> 2) * 128 + (am & 3) * 16) * 3072 + 2048 + col0 + bj * 128);
#pragma unroll
            for (int am = 0; am < 8; ++am) {
                const int ai = am >> 2, m = am & 3;
                const f32x4 v0 = acc[ai][bj][m][0], v1 = acc[ai][bj][m][1];
                u32x4 w; w.x = pk2(v0[0] * bflo(gw[am].x), v0[1] * bfhi(gw[am].x)); w.y = pk2(v0[2] * bflo(gw[am].y), v0[3] * bfhi(gw[am].y));
                w.z = pk2(v1[0] * bflo(gw[am].z), v1[1] * bfhi(gw[am].z)); w.w = pk2(v1[2] * bflo(gw[am].w), v1[3] * bfhi(gw[am].w));
                *(u32x4*)(mb + (size_t)(row0 + ai * 128 + m * 16) * 1024 + col0 + bj * 128) = w;
            }
        }
    }
};

template <class Epi>
__device__ __forceinline__ void run_gemm(unsigned char* smem, const bf16_t* A, const bf16_t* Bt, int M, int N, int K, const Epi& E, bool split_tail = false) {
    asm volatile("" : "+s"(M), "+s"(N), "+s"(K));
    pg8::Gemm g; g.A = A; g.Bt = Bt; g.M = M; g.N = N; g.K = K;
    pg8::StaticOrder S; S.init(M, N, K, gridDim.x, blockIdx.x, split_tail);
    pg8::gemm_phase<Epi>((LAS unsigned char*)smem, g, S, E);
}

__device__ __forceinline__ void mod_item(const Params& p, unsigned char* smem, int m) {
    float* s = (float*)smem;
    float* red = s + 9 * 1024;
    const int tid = TID(), l = m / 144, cb = m % 144;
    __syncthreads();
    for (int i = tid; i < 9216; i += NT) { const float v = (i < 8192) ? p.c[i] : p.c_ctx[i - 8192]; s[i] = v / (1.0f + __expf(-v)); }
    __syncthreads();
    const int kg = tid >> 6, cn = tid & 63, col = cb * 64 + cn;
    const float* w = p.ada_w + (size_t)l * 1024 * 9216 + col;
    float a0 = 0, a1 = 0, a2 = 0, a3 = 0, a4 = 0, a5 = 0, a6 = 0, a7 = 0, a8 = 0;
    for (int k = kg * 128; k < kg * 128 + 128; ++k) {
        const float wv = w[(size_t)k * 9216];
        a0 += s[k] * wv; a1 += s[1024 + k] * wv; a2 += s[2048 + k] * wv; a3 += s[3072 + k] * wv; a4 += s[4096 + k] * wv;
        a5 += s[5120 + k] * wv; a6 += s[6144 + k] * wv; a7 += s[7168 + k] * wv; a8 += s[8192 + k] * wv;
    }
    float* rp = red + kg * 576 + cn;
    rp[0] = a0; rp[64] = a1; rp[128] = a2; rp[192] = a3; rp[256] = a4; rp[320] = a5; rp[384] = a6; rp[448] = a7; rp[512] = a8;
    __syncthreads();
    float* MOD = (float*)(p.ws + O_MOD);
    for (int i = tid; i < 576; i += NT) {
        float v = 0; for (int q = 0; q < 8; ++q) v += red[q * 576 + i];
        const int r = i >> 6, c2 = cb * 64 + (i & 63);
        MOD[((size_t)l * 9 + r) * 9216 + c2] = v + p.ada_b[(size_t)l * 9216 + c2];
    }
}

__device__ __forceinline__ void filt_item(const Params& p, unsigned char* smem, int l, int n, int item, float* filt, float* l1p) {
    float* z = (float*)smem;
    float* h1 = z + 16 * 36;
    float* h2 = h1 + 16 * 64;
    float* stage = h2 + 16 * 64;
    const int tid = TID(), t0 = item * 16;
    __syncthreads();
    for (int i = tid; i < 16 * 33; i += NT) {
        const int tt = i / 33, e = i % 33, t = t0 + tt; float v;
        if (e == 0) v = (float)t / (float)(n - 1);
        else { const int bi = (e - 1) & 15; const float band = 1e-4f + (float)bi * ((15.0f - 1e-4f) / 15.0f); const float wv = (6.283185307179586f / (float)n) * (float)t;
            v = (e <= 16) ? cosf(band * wv) : -sinf(band * wv); }
        z[tt * 36 + e] = v;
    }
    __syncthreads();
    for (int i = tid; i < 16 * 64; i += NT) {
        const int tt = i >> 6, j = i & 63; float a = p.hy_b1[l * 64 + j];
        for (int e = 0; e < 33; ++e) a += z[tt * 36 + e] * p.hy_w1[((size_t)l * 33 + e) * 64 + j];
        h1[i] = sinf(p.hy_freq[l * 64 + j] * a);
    }
    __syncthreads();
    for (int i = tid; i < 16 * 64; i += NT) {
        const int tt = i >> 6, j = i & 63; float a = p.hy_b2[l * 64 + j];
        for (int e = 0; e < 64; ++e) a += h1[tt * 64 + e] * p.hy_w2[((size_t)l * 64 + e) * 64 + j];
        h2[i] = sinf(p.hy_freq[l * 64 + j] * a);
    }
    __syncthreads();
    const float min_decay = -3.0701134573253945f, max_decay = -15.350567286626973f;
#pragma unroll 1
    for (int cc = 0; cc < 2; ++cc) {
        const int col = tid + cc * 512;
        float acc[16];
#pragma unroll
        for (int tt = 0; tt < 16; ++tt) acc[tt] = 0.f;
        for (int e = 0; e < 64; ++e) {
            const float wv = p.hy_w3[((size_t)l * 64 + e) * 1024 + col];
#pragma unroll
            for (int tt = 0; tt < 16; ++tt) acc[tt] += h2[tt * 64 + e] * wv;
        }
        const int oc = col & 511, dir = col >> 9;
        const float ad = fabsf(min_decay + (float)oc * ((max_decay - min_decay) / 511.0f));
        float l1 = 0.f;
#pragma unroll
        for (int tt = 0; tt < 16; ++tt) {
            const int t = t0 + tt; const float tn = (float)t / (float)(n - 1);
            float v = acc[tt] * __expf(-tn * ad);
            if (dir == 1 && t == 0) v = 0.f;
            stage[col * 17 + tt] = v;
            l1 += fabsf(v);
        }
        l1p[(size_t)item * 1024 + col] = l1;
    }
    __syncthreads();
#pragma unroll 4
    for (int k = 0; k < 32; ++k) {
        const int e = tid + k * NT, col = e >> 4, tt = e & 15, t = t0 + tt;
        const int oc = col & 511, dir = col >> 9;
        const int pos = (dir == 0) ? t : ((t == 0) ? n : 2 * n - t);
        filt[(size_t)oc * (2 * n) + pos] = stage[col * 17 + tt];
    }
}

struct WDesc { const float* src; bf16_t* dst; int ld, K; };
__device__ __forceinline__ WDesc wdesc(const Params& p, int l, int ti) {
    WDesc d; int K, nrb, mapsw = 0; const float* src; bf16_t* dst; int ld;
    const size_t L = (size_t)l;
    if (ti < 1408) { src = p.ffn_up + (L * 2 + 0) * 1024 * 5632; ld = 5632; K = 1024; dst = (bf16_t*)(p.ws + O_WUP0); mapsw = 1; }
    else if ((ti -= 1408) < 1408) { src = p.ffn_up + (L * 2 + 1) * 1024 * 5632; ld = 5632; K = 1024; dst = (bf16_t*)(p.ws + O_WUP1); mapsw = 1; }
    else if ((ti -= 1408) < 704) { src = p.ffn_down + (L * 2 + 0) * 2816 * 1024; ld = 1024; K = 2816; dst = (bf16_t*)(p.ws + O_WDN0); }
    else if ((ti -= 704) < 704) { src = p.ffn_down + (L * 2 + 1) * 2816 * 1024; ld = 1024; K = 2816; dst = (bf16_t*)(p.ws + O_WDN1); }
    else if ((ti -= 704) < 704) { src = p.w_in + L * 1024 * 2816; ld = 2816; K = 1024; dst = (bf16_t*)(p.ws + O_WIN); }
    else if ((ti -= 704) < 768) { src = p.gate_w + L * 1024 * 3072; ld = 3072; K = 1024; dst = (bf16_t*)(p.ws + O_WG); }
    else if ((ti -= 768) < 256) { src = p.w_br + L * 1024 * 1024; ld = 1024; K = 1024; dst = (bf16_t*)(p.ws + O_WBR); }
    else { ti -= 256; src = p.w_o + L * 1024 * 1024; ld = 1024; K = 1024; dst = (bf16_t*)(p.ws + O_WO); }
    nrb = K / 64;
    const int nb = ti / nrb, kb = ti % nrb, n0 = nb * 64, k0 = kb * 64;
    int scol = n0;
    if (mapsw) { const int pn = n0 >> 8, half = (n0 >> 7) & 1; scol = half * 2816 + pn * 128 + (n0 & 127); }
    d.src = src + (size_t)k0 * ld + scol; d.dst = dst + (size_t)n0 * K + k0; d.ld = ld; d.K = K;
    return d;
}
__device__ __forceinline__ void wconv_tiles(const Params& p, unsigned char* smem, int l, int nw) {
    float* tile = (float*)smem;
    const int tid = TID(), kk0 = tid >> 6, nn0 = tid & 63, nn = tid >> 3, ks = tid & 7;
    int ti = blockIdx.x;
    if (ti >= nw) return;
    WDesc d = wdesc(p, l, ti);
    float v[8];
#pragma unroll
    for (int i = 0; i < 8; ++i) v[i] = d.src[(size_t)(kk0 + 8 * i) * d.ld + nn0];
    for (;;) {
        const int tn = ti + gridDim.x; const bool more = tn < nw;
        WDesc dn = d; float vn[8];
        if (more) { dn = wdesc(p, l, tn);
#pragma unroll
            for (int i = 0; i < 8; ++i) vn[i] = dn.src[(size_t)(kk0 + 8 * i) * dn.ld + nn0]; }
        __syncthreads();
#pragma unroll
        for (int i = 0; i < 8; ++i) tile[(kk0 + 8 * i) * 65 + nn0] = v[i];
        __syncthreads();
        float o[8];
#pragma unroll
        for (int j = 0; j < 8; ++j) o[j] = tile[(ks * 8 + j) * 65 + nn];
        u32x4 w; w.x = pk2(o[0], o[1]); w.y = pk2(o[2], o[3]); w.z = pk2(o[4], o[5]); w.w = pk2(o[6], o[7]);
        *(u32x4*)(d.dst + (size_t)nn * d.K + ks * 8) = w;
        if (!more) break;
        d = dn; ti = tn;
#pragma unroll
        for (int i = 0; i < 8; ++i) v[i] = vn[i];
    }
}

__device__ __forceinline__ void aux_phase(const Params& p, unsigned char* smem, int l) {
    const int nmod = (l == 0) ? 288 : 0, nf = 256, nfc = (l == 0) ? 16 : 0, nw = 6208;
    const int total = nmod + nf + nfc;
    for (int rep = 0; rep < REP_AUX; ++rep) {
        for (int it = blockIdx.x; it < total; it += gridDim.x) {
            int i = it;
            if (i < nmod) { mod_item(p, smem, i); continue; }
            i -= nmod;
            if (i < nf) { filt_item(p, smem, l, 4096, i, (float*)(p.ws + O_FILT), (float*)(p.ws + O_L1P)); continue; }
            i -= nf;
            filt_item(p, smem, l, 256, i, (float*)(p.ws + O_FILTC), (float*)(p.ws + O_L1PC));
        }
        wconv_tiles(p, smem, l, nw);
    }
}

__device__ __forceinline__ void norm_phase(const Params& p, int l, int sub, int M, bool first, const bf16_t* xl) {
    const float* PART = (const float*)(p.ws + O_PART);
    const int tid = TID(), lane = tid & 63, wv = tid >> 6;
    const float* MOD = (const float*)(p.ws + O_MOD) + (size_t)l * 9 * 9216;
    const float* gn = p.norm_g + ((size_t)l * 3 + sub) * 1024;
    float* XC = (float*)(p.ws + O_XC);
    bf16_t* H = (bf16_t*)(p.ws + O_H);
    const int rstep = gridDim.x * 8;
    for (int rep = 0; rep < REP_NORM; ++rep)
    for (int r0 = blockIdx.x * 8 + wv; r0 < M; r0 += 4 * rstep) {
        f32x4 v[4][4]; float ss[4];
#pragma unroll
        for (int k = 0; k < 4; ++k) {
            const int r = r0 + k * rstep; ss[k] = 0.f;
            if (r >= M) { continue; }
            if (r >= TL) {
                const float* src = (first ? p.ctx : XC) + (size_t)(r - TL) * 1024;
#pragma unroll
                for (int i = 0; i < 4; ++i) { const size_t o = (size_t)(r - TL) * 1024 + i * 256 + lane * 4; v[k][i] = *(const f32x4*)(src + i * 256 + lane * 4);
                    if (!first) { v[k][i] += *(const f32x4*)(PART + o); v[k][i] += *(const f32x4*)(PART + 2048 * 1024 + o); v[k][i] += *(const f32x4*)(PART + 2 * 2048 * 1024 + o); v[k][i] += *(const f32x4*)(PART + 3 * 2048 * 1024 + o); } }
            } else if (first) {
                const float* src = p.x + (size_t)r * 1024;
#pragma unroll
                for (int i = 0; i < 4; ++i) v[k][i] = *(const f32x4*)(src + i * 256 + lane * 4);
            } else {
                const bf16_t* src = xl + (size_t)r * 1024;
#pragma unroll
                for (int i = 0; i < 4; ++i) { const u32x2 w = *(const u32x2*)(src + i * 256 + lane * 4); v[k][i] = (f32x4){bflo(w.x), bfhi(w.x), bflo(w.y), bfhi(w.y)}; }
            }
        }
#pragma unroll
        for (int k = 0; k < 4; ++k) {
            const int r = r0 + k * rstep;
            if (r >= M) continue;
            if (r >= TL) {
#pragma unroll
                for (int i = 0; i < 4; ++i) *(f32x4*)(XC + (size_t)(r - TL) * 1024 + i * 256 + lane * 4) = v[k][i];
            } else if (first) {
                bf16_t* dstx = (bf16_t*)p.out + (size_t)r * 1024;
#pragma unroll
                for (int i = 0; i < 4; ++i) { u32x2 w; w.x = pk2(v[k][i][0], v[k][i][1]); w.y = pk2(v[k][i][2], v[k][i][3]); *(u32x2*)(dstx + i * 256 + lane * 4) = w; v[k][i] = (f32x4){bflo(w.x), bfhi(w.x), bflo(w.y), bfhi(w.y)}; }
            }
            float s2 = 0.f;
#pragma unroll
            for (int i = 0; i < 4; ++i) s2 += v[k][i][0] * v[k][i][0] + v[k][i][1] * v[k][i][1] + v[k][i][2] * v[k][i][2] + v[k][i][3] * v[k][i][3];
            s2 = wave_sum(s2);
            const float rinv = rsqrtf(s2 * (1.0f / 1024.0f) + 1e-6f);
            const int mr = r < TL ? (r >> 12) : 8;
            const float* sh = MOD + (size_t)mr * 9216 + (3 * sub) * 1024;
            const float* sc = sh + 1024;
#pragma unroll
            for (int i = 0; i < 4; ++i) {
                const int c = i * 256 + lane * 4;
                const f32x4 g4 = *(const f32x4*)(gn + c), s4 = *(const f32x4*)(sc + c), h4 = *(const f32x4*)(sh + c);
                const f32x4 y = v[k][i] * rinv * g4 * (s4 + 1.0f) + h4;
                u32x2 w; w.x = pk2(y[0], y[1]); w.y = pk2(y[2], y[3]);
                *(u32x2*)(H + (size_t)r * 1024 + c) = w;
            }
        }
    }
}

#define ZI(i) ((i) + ((i) >> 4))
__device__ __forceinline__ f32x2 cmul(f32x2 a, f32x2 b) { return (f32x2){a.x * b.x - a.y * b.y, a.x * b.y + a.y * b.x}; }
__device__ __forceinline__ f32x2 cmulc(f32x2 a, f32x2 b) { return (f32x2){a.x * b.x + a.y * b.y, a.y * b.x - a.x * b.y}; }
__device__ __forceinline__ void dif8(f32x2 (&x)[8]) {
    const float C = 0.70710678118654752f;
    { f32x2 t;
      t = x[0] - x[4]; x[0] += x[4]; x[4] = t;
      t = x[1] - x[5]; x[1] += x[5]; x[5] = (f32x2){C * (t.x + t.y), C * (t.y - t.x)};
      t = x[2] - x[6]; x[2] += x[6]; x[6] = (f32x2){t.y, -t.x};
      t = x[3] - x[7]; x[3] += x[7]; x[7] = (f32x2){C * (t.y - t.x), -C * (t.x + t.y)}; }
#pragma unroll
    for (int b = 0; b < 8; b += 4) { f32x2 t;
      t = x[b] - x[b + 2]; x[b] += x[b + 2]; x[b + 2] = t;
      t = x[b + 1] - x[b + 3]; x[b + 1] += x[b + 3]; x[b + 3] = (f32x2){t.y, -t.x}; }
#pragma unroll
    for (int b = 0; b < 8; b += 2) { const f32x2 t = x[b] - x[b + 1]; x[b] += x[b + 1]; x[b + 1] = t; }
}
__device__ __forceinline__ void idif8(f32x2 (&x)[8]) {
    const float C = 0.70710678118654752f;
#pragma unroll
    for (int b = 0; b < 8; b += 2) { const f32x2 t = x[b] - x[b + 1]; x[b] += x[b + 1]; x[b + 1] = t; }
#pragma unroll
    for (int b = 0; b < 8; b += 4) { f32x2 v, u;
      v = x[b + 2]; u = x[b]; x[b] = u + v; x[b + 2] = u - v;
      v = (f32x2){-x[b + 3].y, x[b + 3].x}; u = x[b + 1]; x[b + 1] = u + v; x[b + 3] = u - v; }
    { f32x2 v, u, t;
      v = x[4]; u = x[0]; x[0] = u + v; x[4] = u - v;
      t = x[5]; v = (f32x2){C * (t.x - t.y), C * (t.x + t.y)}; u = x[1]; x[1] = u + v; x[5] = u - v;
      t = x[6]; v = (f32x2){-t.y, t.x}; u = x[2]; x[2] = u + v; x[6] = u - v;
      t = x[7]; v = (f32x2){-C * (t.x + t.y), C * (t.x - t.y)}; u = x[3]; x[3] = u + v; x[7] = u - v; }
}
__device__ __forceinline__ void twid8(f32x2 (&x)[8], int pidx, int L, bool conj) {
    const float rev = -(float)pidx / (float)L;
    const float s = __builtin_amdgcn_sinf(rev), c = __builtin_amdgcn_cosf(rev);
    const f32x2 w1 = {c, s}; const f32x2 w2 = cmul(w1, w1), w3 = cmul(w2, w1), w4 = cmul(w2, w2), w5 = cmul(w4, w1), w6 = cmul(w3, w3), w7 = cmul(w4, w3);
    if (!conj) { x[1] = cmul(x[1], w4); x[2] = cmul(x[2], w2); x[3] = cmul(x[3], w6); x[4] = cmul(x[4], w1); x[5] = cmul(x[5], w5); x[6] = cmul(x[6], w3); x[7] = cmul(x[7], w7); }
    else { x[1] = cmulc(x[1], w4); x[2] = cmulc(x[2], w2); x[3] = cmulc(x[3], w6); x[4] = cmulc(x[4], w1); x[5] = cmulc(x[5], w5); x[6] = cmulc(x[6], w3); x[7] = cmulc(x[7], w7); }
}
__device__ __forceinline__ void fft_fwd(f32x2* z) {
    const int tid = TID();
#pragma unroll 1
    for (int L = 8192; L >= 16; L >>= 3) {
        const int S = L >> 3;
#pragma unroll
        for (int qq = 0; qq < 2; ++qq) { const int q = tid + qq * NT;
            const int pidx = q & (S - 1), B = (q / S) * L + pidx;
            f32x2 x[8];
#pragma unroll
            for (int j = 0; j < 8; ++j) x[j] = z[ZI(B + j * S)];
            dif8(x); twid8(x, pidx, L, false);
#pragma unroll
            for (int j = 0; j < 8; ++j) z[ZI(B + j * S)] = x[j];
        }
        __syncthreads();
    }
#pragma unroll 4
    for (int q = tid; q < 4096; q += NT) { const f32x2 a = z[ZI(2 * q)], b = z[ZI(2 * q + 1)]; z[ZI(2 * q)] = a + b; z[ZI(2 * q + 1)] = a - b; }
    __syncthreads();
}
__device__ __forceinline__ void fft_inv(f32x2* z) {
    const int tid = TID();
#pragma unroll 4
    for (int q = tid; q < 4096; q += NT) { const f32x2 a = z[ZI(2 * q)], b = z[ZI(2 * q + 1)]; z[ZI(2 * q)] = a + b; z[ZI(2 * q + 1)] = a - b; }
    __syncthreads();
#pragma unroll 1
    for (int L = 16; L <= 8192; L <<= 3) {
        const int S = L >> 3;
#pragma unroll
        for (int qq = 0; qq < 2; ++qq) { const int q = tid + qq * NT;
            const int pidx = q & (S - 1), B = (q / S) * L + pidx;
            f32x2 x[8];
#pragma unroll
            for (int j = 0; j < 8; ++j) x[j] = z[ZI(B + j * S)];
            twid8(x, pidx, L, true); idif8(x);
#pragma unroll
            for (int j = 0; j < 8; ++j) z[ZI(B + j * S)] = x[j];
        }
        __syncthreads();
    }
}

__device__ __forceinline__ void fft_fwd_h(f32x2* z, int lt) {
#pragma unroll 1
    for (int L = 8192; L >= 16; L >>= 3) {
        const int S = L >> 3;
#pragma unroll 2
        for (int qq = 0; qq < 4; ++qq) { const int q = lt + qq * 256;
            const int pidx = q & (S - 1), B = (q / S) * L + pidx;
            f32x2 x[8];
#pragma unroll
            for (int j = 0; j < 8; ++j) x[j] = z[ZI(B + j * S)];
            dif8(x); twid8(x, pidx, L, false);
#pragma unroll
            for (int j = 0; j < 8; ++j) z[ZI(B + j * S)] = x[j];
        }
        __syncthreads();
    }
#pragma unroll 4
    for (int q = lt; q < 4096; q += 256) { const f32x2 a = z[ZI(2 * q)], b = z[ZI(2 * q + 1)]; z[ZI(2 * q)] = a + b; z[ZI(2 * q + 1)] = a - b; }
    __syncthreads();
}
__device__ __forceinline__ void fft_inv_h(f32x2* z, int lt) {
#pragma unroll 4
    for (int q = lt; q < 4096; q += 256) { const f32x2 a = z[ZI(2 * q)], b = z[ZI(2 * q + 1)]; z[ZI(2 * q)] = a + b; z[ZI(2 * q + 1)] = a - b; }
    __syncthreads();
#pragma unroll 1
    for (int L = 16; L <= 8192; L <<= 3) {
        const int S = L >> 3;
#pragma unroll 2
        for (int qq = 0; qq < 4; ++qq) { const int q = lt + qq * 256;
            const int pidx = q & (S - 1), B = (q / S) * L + pidx;
            f32x2 x[8];
#pragma unroll
            for (int j = 0; j < 8; ++j) x[j] = z[ZI(B + j * S)];
            twid8(x, pidx, L, true); idif8(x);
#pragma unroll
            for (int j = 0; j < 8; ++j) z[ZI(B + j * S)] = x[j];
        }
        __syncthreads();
    }
}

__device__ __forceinline__ void filtfft_item(const Params& p, unsigned char* smem, int oc) {
    f32x2* z = (f32x2*)smem;
    float* red = (float*)(smem + 8704 * 8);
    const int tid = TID();
    const float* filt = (const float*)(p.ws + O_FILT) + (size_t)oc * 8192;
    const float* l1p = (const float*)(p.ws + O_L1P);
    __syncthreads();
#pragma unroll 4
    for (int i = tid; i < 8192; i += NT) z[ZI(i)] = (f32x2){filt[i], 0.f};
    if (tid < 256) red[tid] = l1p[(size_t)tid * 1024 + oc] + l1p[(size_t)tid * 1024 + 512 + oc];
    __syncthreads();
    if (tid < 64) { float v = red[tid] + red[tid + 64] + red[tid + 128] + red[tid + 192]; v = wave_sum(v); if (tid == 0) red[256] = v; }
    fft_fwd(z);
    const float sc = 1.0f / (red[256] * 8192.0f);
    f32x2* fh = (f32x2*)(p.ws + O_FH) + (size_t)oc * 8192;
#pragma unroll 4
    for (int i = tid; i < 8192; i += NT) fh[i] = z[ZI(i)] * sc;
}

__device__ __forceinline__ void hyfft_item(const Params& p, unsigned char* smem, int l, int ch, int bp) {
    f32x2* z = (f32x2*)smem;
    f32x2* zz = (f32x2*)(smem + 8704 * 8);
    const int tid = TID();
    const bf16_t* HV = (const bf16_t*)(p.ws + O_HV);
    const bf16_t* v0 = HV + ((size_t)(2 * bp) * 768 + ch) * 4096; const bf16_t* v1 = v0 + (size_t)768 * 4096;
    const f32x2* fh0 = (const f32x2*)(p.ws + O_FH) + (size_t)ch * 8192; const f32x2* fh1 = fh0 + (size_t)256 * 8192;
    const float sk0 = p.hy_skip[(size_t)l * 512 + ch], sk1 = p.hy_skip[(size_t)l * 512 + 256 + ch];
    bf16_t a0[8], a1[8];
#pragma unroll
    for (int k = 0; k < 8; ++k) { a0[k] = v0[tid + k * NT]; a1[k] = v1[tid + k * NT]; }
    f32x2 fr[16];
#pragma unroll
    for (int k = 0; k < 16; ++k) fr[k] = fh0[tid + k * NT];
    __syncthreads();
#pragma unroll
    for (int k = 0; k < 8; ++k) { const int t = tid + k * NT; z[ZI(t)] = (f32x2){bf2f(a0[k]), bf2f(a1[k])}; z[ZI(4096 + t)] = (f32x2){0.f, 0.f}; }
    __syncthreads();
    fft_fwd(z);
#pragma unroll
    for (int k = 0; k < 16; ++k) { const int i = tid + k * NT; z[ZI(i)] = cmul(z[ZI(i)], fr[k]); }
    bf16_t x0[8], x1[8];
#pragma unroll
    for (int k = 0; k < 8; ++k) { x0[k] = v0[(size_t)256 * 4096 + tid + k * NT]; x1[k] = v1[(size_t)256 * 4096 + tid + k * NT]; }
#pragma unroll
    for (int k = 0; k < 16; ++k) fr[k] = fh1[tid + k * NT];
    __syncthreads();
    fft_inv(z);
#pragma unroll
    for (int k = 0; k < 8; ++k) {
        const int t = tid + k * NT;
        f32x2 y = z[ZI(t)];
        y.x += bf2f(a0[k]) * sk0; y.y += bf2f(a1[k]) * sk0;
        const f32x2 zv = {bf2f(x0[k]) * y.x, bf2f(x1[k]) * y.y};
        zz[t] = zv; z[ZI(t)] = zv; z[ZI(4096 + t)] = (f32x2){0.f, 0.f};
    }
    __syncthreads();
    fft_fwd(z);
#pragma unroll
    for (int k = 0; k < 16; ++k) { const int i = tid + k * NT; z[ZI(i)] = cmul(z[ZI(i)], fr[k]); }
#pragma unroll
    for (int k = 0; k < 8; ++k) { x0[k] = v0[(size_t)512 * 4096 + tid + k * NT]; x1[k] = v1[(size_t)512 * 4096 + tid + k * NT]; }
    __syncthreads();
    fft_inv(z);
    bf16_t* YBT = (bf16_t*)(p.ws + O_YBT);
    bf16_t* o0 = YBT + ((size_t)(2 * bp) * 256 + ch) * 4096; bf16_t* o1 = o0 + (size_t)256 * 4096;
#pragma unroll
    for (int k = 0; k < 8; ++k) {
        const int t = tid + k * NT;
        const f32x2 y = z[ZI(t)] + zz[t] * sk1;
        o0[t] = f2bf(bf2f(x0[k]) * y.x); o1[t] = f2bf(bf2f(x1[k]) * y.y);
    }
}

__device__ __forceinline__ void hyfft_pair(const Params& p, unsigned char* smem, int l, int ch, int pp) {
    const int tid = TID(), hf = __builtin_amdgcn_readfirstlane(tid >> 8), lt = tid & 255, bp = 2 * pp + hf;
    f32x2* z = (f32x2*)(smem + (size_t)hf * 8704 * 8);
    const bf16_t* HV = (const bf16_t*)(p.ws + O_HV);
    const bf16_t* v0 = HV + ((size_t)(2 * bp) * 768 + ch) * 4096; const bf16_t* v1 = v0 + (size_t)768 * 4096;
    const f32x2* fh0 = (const f32x2*)(p.ws + O_FH) + (size_t)ch * 8192; const f32x2* fh1 = fh0 + (size_t)256 * 8192;
    const float sk0 = p.hy_skip[(size_t)l * 512 + ch], sk1 = p.hy_skip[(size_t)l * 512 + 256 + ch];
    unsigned av[16];
#pragma unroll
    for (int k = 0; k < 16; ++k) av[k] = (unsigned)v0[lt + k * 256] | ((unsigned)v1[lt + k * 256] << 16);
    f32x2 fr[32];
#pragma unroll
    for (int k = 0; k < 32; ++k) fr[k] = fh0[lt + k * 256];
    __syncthreads();
#pragma unroll
    for (int k = 0; k < 16; ++k) { const int t = lt + k * 256; z[ZI(t)] = (f32x2){bflo(av[k]), bfhi(av[k])}; z[ZI(4096 + t)] = (f32x2){0.f, 0.f}; }
    __syncthreads();
    fft_fwd_h(z, lt);
#pragma unroll
    for (int k = 0; k < 32; ++k) { const int i = lt + k * 256; z[ZI(i)] = cmul(z[ZI(i)], fr[k]); }
    unsigned xv[16];
#pragma unroll
    for (int k = 0; k < 16; ++k) xv[k] = (unsigned)v0[(size_t)256 * 4096 + lt + k * 256] | ((unsigned)v1[(size_t)256 * 4096 + lt + k * 256] << 16);
#pragma unroll
    for (int k = 0; k < 32; ++k) fr[k] = fh1[lt + k * 256];
    __syncthreads();
    fft_inv_h(z, lt);
    f32x2 zz[16];
#pragma unroll
    for (int k = 0; k < 16; ++k) {
        const int t = lt + k * 256;
        f32x2 y = z[ZI(t)];
        y.x += bflo(av[k]) * sk0; y.y += bfhi(av[k]) * sk0;
        const f32x2 zv = {bflo(xv[k]) * y.x, bfhi(xv[k]) * y.y};
        zz[k] = zv; z[ZI(t)] = zv; z[ZI(4096 + t)] = (f32x2){0.f, 0.f};
    }
    __syncthreads();
    fft_fwd_h(z, lt);
#pragma unroll
    for (int k = 0; k < 32; ++k) { const int i = lt + k * 256; z[ZI(i)] = cmul(z[ZI(i)], fr[k]); }
#pragma unroll
    for (int k = 0; k < 16; ++k) xv[k] = (unsigned)v0[(size_t)512 * 4096 + lt + k * 256] | ((unsigned)v1[(size_t)512 * 4096 + lt + k * 256] << 16);
    __syncthreads();
    fft_inv_h(z, lt);
    bf16_t* YBT = (bf16_t*)(p.ws + O_YBT);
    bf16_t* o0 = YBT + ((size_t)(2 * bp) * 256 + ch) * 4096; bf16_t* o1 = o0 + (size_t)256 * 4096;
#pragma unroll
    for (int k = 0; k < 16; ++k) {
        const int t = lt + k * 256;
        const f32x2 y = z[ZI(t)] + zz[k] * sk1;
        o0[t] = f2bf(bflo(xv[k]) * y.x); o1[t] = f2bf(bfhi(xv[k]) * y.y);
    }
}

__device__ __forceinline__ void hyctx_item(const Params& p, unsigned char* smem, int l, int b, int cp) {
    float* f1 = (float*)smem;
    float* f2 = f1 + 1024;
    float* vv = f2 + 1024;
    float* zc = vv + 512;
    float* red = zc + 512;
    const int tid = TID(), hf = tid >> 8, t = tid & 255, ch = cp * 2 + hf;
    const float* FC = (const float*)(p.ws + O_FILTC); const float* l1p = (const float*)(p.ws + O_L1PC);
    const bf16_t* HVC = (const bf16_t*)(p.ws + O_HVC) + ((size_t)b * 768 + ch) * 256;
    __syncthreads();
    f1[hf * 512 + t] = FC[(size_t)ch * 512 + t]; f1[hf * 512 + 256 + t] = FC[(size_t)ch * 512 + 256 + t];
    f2[hf * 512 + t] = FC[(size_t)(256 + ch) * 512 + t]; f2[hf * 512 + 256 + t] = FC[(size_t)(256 + ch) * 512 + 256 + t];
    const float vt = bf2f(HVC[t]); vv[hf * 256 + t] = vt;
    if (t < 2) { float s = 0.f; for (int it = 0; it < 16; ++it) s += l1p[(size_t)it * 1024 + t * 256 + ch] + l1p[(size_t)it * 1024 + 512 + t * 256 + ch]; red[hf * 2 + t] = s; }
    __syncthreads();
    float a = 0.f;
    for (int s = 0; s < 256; ++s) a += f1[hf * 512 + ((t - s) & 511)] * vv[hf * 256 + s];
    const float y1 = a / red[hf * 2 + 0] + vt * p.hy_skip[(size_t)l * 512 + ch];
    const float zt = bf2f(HVC[(size_t)256 * 256 + t]) * y1; zc[hf * 256 + t] = zt;
    __syncthreads();
    float a2 = 0.f;
    for (int s = 0; s < 256; ++s) a2 += f2[hf * 512 + ((t - s) & 511)] * zc[hf * 256 + s];
    const float y2 = a2 / red[hf * 2 + 1] + zt * p.hy_skip[(size_t)l * 512 + 256 + ch];
    bf16_t* YBTC = (bf16_t*)(p.ws + O_YBTC);
    YBTC[((size_t)b * 256 + ch) * 256 + t] = f2bf(bf2f(HVC[(size_t)512 * 256 + t]) * y2);
}

__device__ __forceinline__ void qk_item(const Params& p, int l, int item, bool dry = false) {
    const int tid = TID(), seg = tid & 7, vsub = tid >> 3;
    const int which = (item >= 544) ? 1 : 0;
    const int vbase = (item - which * 544) * 512;
    bf16_t* base = (bf16_t*)(p.ws + (which ? O_KN : O_QN));
    u32x4 raw[8];
#pragma unroll
    for (int it = 0; it < 8; ++it) raw[it] = *(const u32x4*)(base + (size_t)(vbase + it * 64 + vsub) * 64 + seg * 8);
    const float* gp = p.qk_gain + (size_t)l * 128 + which * 64 + seg * 8;
    const f32x4 g0 = *(const f32x4*)gp, g1 = *(const f32x4*)(gp + 4);
    const float gn[8] = {g0[0], g0[1], g0[2], g0[3], g1[0], g1[1], g1[2], g1[3]};
    const float qs = which ? 1.0f : (0.125f * 1.4426950408889634f);
    const int axis = seg >> 2, role = (seg >> 1) & 1, qb = (seg & 1) * 8;
    float inv[8];
#pragma unroll
    for (int e = 0; e < 8; ++e) inv[e] = exp2f(-(float)(qb + e) * (13.287712379549449f / 16.0f));
#pragma unroll
    for (int it = 0; it < 8; ++it) {
        const int rem = vbase + it * 64 + vsub, kidx = rem % NK;
        const u32x4 w = raw[it];
        float v[8] = {bflo(w.x), bfhi(w.x), bflo(w.y), bfhi(w.y), bflo(w.z), bfhi(w.z), bflo(w.w), bfhi(w.w)};
        float ss = 0.f;
#pragma unroll
        for (int e = 0; e < 8; ++e) ss += v[e] * v[e];
        ss += __shfl_xor(ss, 1); ss += __shfl_xor(ss, 2); ss += __shfl_xor(ss, 4);
        const float rinv = rsqrtf(ss * (1.0f / 64.0f) + 1e-6f) * qs;
#pragma unroll
        for (int e = 0; e < 8; ++e) v[e] = v[e] * rinv * gn[e];
        const int t = kidx - 256;
        const float pos = (float)(axis ? (t & 63) : (t >> 6));
        float o[8];
#pragma unroll
        for (int e = 0; e < 8; ++e) {
            const float pe = __shfl_xor(v[e], 2);
            float sn, cs; __sincosf(pos * inv[e], &sn, &cs);
            const float r = role ? (pe * sn + v[e] * cs) : (v[e] * cs - pe * sn);
            o[e] = (kidx >= 256) ? r : v[e];
        }
        u32x4 ow = {pk2(o[0], o[1]), pk2(o[2], o[3]), pk2(o[4], o[5]), pk2(o[6], o[7])};
        if (dry) ow = w;
        *(u32x4*)(base + (size_t)rem * 64 + seg * 8) = ow;
    }
}

__device__ __forceinline__ void vt_item(const Params& p, unsigned char* smem, int tb) {
    bf16_t* tile = (bf16_t*)smem;
    const int tid = TID(), r0 = tb * 64;
    const bf16_t* src = (const bf16_t*)(p.ws + O_VRAW) + (size_t)r0 * 512;
    __syncthreads();
#pragma unroll
    for (int i = 0; i < 8; ++i) { const int e = tid + i * NT, rr = e >> 6, sg = e & 63; *(u32x4*)(tile + rr * 520 + sg * 8) = *(const u32x4*)(src + (size_t)rr * 512 + sg * 8); }
    __syncthreads();
    int b, kidx0; row_bk(r0, b, kidx0);
    bf16_t* dst = (bf16_t*)(p.ws + O_VT) + ((size_t)b * 512 + tid) * NK + kidx0;
#pragma unroll
    for (int s = 0; s < 8; ++s) {
        unsigned w[4];
#pragma unroll
        for (int j = 0; j < 4; ++j) w[j] = (unsigned)tile[(s * 8 + 2 * j) * 520 + tid] | ((unsigned)tile[(s * 8 + 2 * j + 1) * 520 + tid] << 16);
        *(u32x4*)(dst + s * 8) = (u32x4){w[0], w[1], w[2], w[3]};
    }
}

__device__ __forceinline__ void hyconv_item(const Params& p, unsigned char* smem, int l, int tb) {
    bf16_t* tile = (bf16_t*)smem;
    const int tid = TID(), r0 = tb * 64;
    const bool lat = r0 < TL;
    const int n = lat ? 4096 : 256, rb = lat ? r0 : r0 - TL, b = rb / n, t0 = rb % n;
    const bf16_t* src = (const bf16_t*)(p.ws + O_HYRAW);
    __syncthreads();
    {
        u32x4 wv[13];
#pragma unroll
        for (int k = 0; k < 13; ++k) {
            const int e = tid + k * NT, rr = e / 96, sg = e % 96, t = t0 - 1 + rr;
            wv[k] = (u32x4){0u, 0u, 0u, 0u};
            if (e < 66 * 96 && t >= 0 && t < n) wv[k] = *(const u32x4*)(src + (size_t)(r0 - 1 + rr) * 768 + sg * 8);
        }
#pragma unroll
        for (int k = 0; k < 13; ++k) { const int e = tid + k * NT, rr = e / 96, sg = e % 96; if (e < 66 * 96) *(u32x4*)(tile + rr * 776 + sg * 8) = wv[k]; }
    }
    __syncthreads();
    const float* cw = p.hy_conv_w + (size_t)l * 3 * 768; const float* cb = p.hy_conv_b + (size_t)l * 768;
    for (int c = tid; c < 768; c += NT) {
        const float w0 = cw[c], w1 = cw[768 + c], w2 = cw[1536 + c], bb = cb[c];
        bf16_t* dst = lat ? (bf16_t*)(p.ws + O_HV) + ((size_t)b * 768 + c) * 4096 + t0 : (bf16_t*)(p.ws + O_HVC) + ((size_t)b * 768 + c) * 256 + t0;
        float pm = bf2f(tile[c]), pc = bf2f(tile[776 + c]);
#pragma unroll
        for (int s = 0; s < 8; ++s) {
            float o[8];
#pragma unroll
            for (int j = 0; j < 8; ++j) { const float pn = bf2f(tile[(s * 8 + j + 2) * 776 + c]); o[j] = pm * w0 + pc * w1 + pn * w2 + bb; pm = pc; pc = pn; }
            *(u32x4*)(dst + s * 8) = (u32x4){pk2(o[0], o[1]), pk2(o[2], o[3]), pk2(o[4], o[5]), pk2(o[6], o[7])};
        }
    }
}

__device__ __forceinline__ float gelu_exact(float v) { return 0.5f * v * (1.0f + erff(v * 0.70710678118654752f)); }
__device__ __forceinline__ void sgu_item(const Params& p, unsigned char* smem, int l, int ci) {
    bf16_t* vt = (bf16_t*)smem;
    const int tid = TID(), lane = tid & 63, wv = __builtin_amdgcn_readfirstlane(tid >> 6), r0 = ci * 128;
    const bf16_t* src = (const bf16_t*)(p.ws + O_SGRAW) + (size_t)r0 * 512;
    const float* lg = p.sg_ln_g + (size_t)l * 256; const float* lb = p.sg_ln_b + (size_t)l * 256;
    __syncthreads();
    {
        const f32x4 g4 = *(const f32x4*)(lg + lane * 4), b4 = *(const f32x4*)(lb + lane * 4);
        u32x2 wr_[16];
#pragma unroll
        for (int k = 0; k < 16; ++k) wr_[k] = *(const u32x2*)(src + (size_t)(wv + 8 * k) * 512 + 256 + lane * 4);
#pragma unroll
        for (int k = 0; k < 16; ++k) {
            const int rr = wv + 8 * k; const u32x2 w = wr_[k];
            float a[4] = {gelu_exact(bflo(w.x)), gelu_exact(bfhi(w.x)), gelu_exact(bflo(w.y)), gelu_exact(bfhi(w.y))};
            const float mu = wave_sum(a[0] + a[1] + a[2] + a[3]) * (1.0f / 256.0f);
            float d[4]; float sq = 0.f;
#pragma unroll
            for (int j = 0; j < 4; ++j) { d[j] = a[j] - mu; sq += d[j] * d[j]; }
            const float rstd = rsqrtf(wave_sum(sq) * (1.0f / 256.0f) + 1e-6f);
#pragma unroll
            for (int j = 0; j < 4; ++j) vt[(lane * 4 + j) * 136 + rr] = f2bf(d[j] * rstd * g4[j] + b4[j]);
        }
    }
    __syncthreads();
    const int g = wv & 3, ih = wv >> 2, l32 = lane & 31, kg = lane >> 5;
    const float* wsb = p.sg_w + ((size_t)l * 4 + g) * 128 * 128;
    const float* bsb = p.sg_b + ((size_t)l * 4 + g) * 128;
    bf16_t* yc = (bf16_t*)(p.ws + O_YCAT) + 768;
#pragma unroll 1
    for (int ib = 0; ib < 2; ++ib) {
        const int i0 = ih * 64 + ib * 32;
        f32x16 acc0, acc1;
#pragma unroll
        for (int r = 0; r < 16; ++r) { acc0[r] = 0.f; acc1[r] = 0.f; }
        const float* wrow = wsb + (size_t)(i0 + l32) * 128 + 8 * kg;
#pragma unroll
        for (int ks = 0; ks < 8; ++ks) {
            const f32x4 w0 = *(const f32x4*)(wrow + 16 * ks), w1 = *(const f32x4*)(wrow + 16 * ks + 4);
            const u32x4 aw = {pk2(w0[0], w0[1]), pk2(w0[2], w0[3]), pk2(w1[0], w1[1]), pk2(w1[2], w1[3])};
            const bf16x8 af = __builtin_bit_cast(bf16x8, aw);
            const bf16x8 b0 = *(const bf16x8*)(vt + (g * 64 + l32) * 136 + 16 * ks + 8 * kg);
            const bf16x8 b1 = *(const bf16x8*)(vt + (g * 64 + 32 + l32) * 136 + 16 * ks + 8 * kg);
            acc0 = __builtin_amdgcn_mfma_f32_32x32x16_bf16(af, b0, acc0, 0, 0, 0);
            acc1 = __builtin_amdgcn_mfma_f32_32x32x16_bf16(af, b1, acc1, 0, 0, 0);
        }
#pragma unroll
        for (int r = 0; r < 16; ++r) {
            const int i = i0 + 8 * (r >> 2) + 4 * kg + (r & 3);
            const float bi = bsb[i];
            const int c0 = g * 64 + l32, c1 = c0 + 32;
            const float u0 = gelu_exact(bf2f(src[(size_t)i * 512 + c0])), u1 = gelu_exact(bf2f(src[(size_t)i * 512 + c1]));
            yc[(size_t)(r0 + i) * 1024 + c0] = f2bf(u0 * (acc0[r] + bi));
            yc[(size_t)(r0 + i) * 1024 + c1] = f2bf(u1 * (acc1[r] + bi));
        }
    }
}

__device__ __forceinline__ void prep_phase(const Params& p, unsigned char* smem, int l) {
    const int n_sg = 0, n_hy = 544, n_vt = 544, n_qk = 1088;
    const int total = n_sg + n_hy + n_vt + n_qk;
    for (int it = blockIdx.x; it < total; it += gridDim.x) {
        int i = it;
        if (i < n_sg) { for (int rep = 0; rep < REP_SGU; ++rep) sgu_item(p, smem, l, i); continue; }
        i -= n_sg;
        if (i < n_hy) { for (int rep = 0; rep < REP_PREP; ++rep) hyconv_item(p, smem, l, i); continue; }
        i -= n_hy;
        if (i < n_vt) { for (int rep = 0; rep < REP_PREP; ++rep) vt_item(p, smem, i); continue; }
        i -= n_vt;
#if REP_QK > 1
        qk_item(p, l, i, true);
#endif
        qk_item(p, l, i);
    }
}

__device__ __forceinline__ void attn_item(const Params& p, unsigned char* smem, int b, int h, int comp, int q0, int rowbase, int nkt) {
    constexpr int ABUF = 64 * 72 + 128 * 72;
    bf16_t* Ks = (bf16_t*)smem;
    bf16_t* Vs = Ks + 64 * 72;
    const int tid = TID(), lane = tid & 63, w = tid >> 6, l32 = lane & 31, g = lane >> 5;
    const size_t hc = (size_t)((b * 4 + h) * 2 + comp);
    const bf16_t* Qb = (const bf16_t*)(p.ws + O_QN) + (hc * NK + q0 + 32 * w + l32) * 64;
    const bf16_t* Kb = (const bf16_t*)(p.ws + O_KN) + hc * NK * 64;
    const bf16_t* Vb = (const bf16_t*)(p.ws + O_VT) + (size_t)((b * 4 + h) * 128) * NK;
    bf16x8 qf[4];
#pragma unroll
    for (int ks = 0; ks < 4; ++ks) qf[ks] = *(const bf16x8*)(Qb + 16 * ks + 8 * g);
    f32x16 O[4];
#pragma unroll
    for (int d = 0; d < 4; ++d)
#pragma unroll
        for (int i = 0; i < 16; ++i) O[d][i] = 0.f;
    float lsum = 0.f;
    const int kkey = tid >> 3, kseg = tid & 7, vdv = tid >> 2, vseg = tid & 3;
    const bf16_t* kg = Kb + (size_t)kkey * 64 + kseg * 8;
    const bf16_t* vg = Vb + (size_t)vdv * NK + vseg * 16;
    u32x4 kreg = *(const u32x4*)kg, vr0 = *(const u32x4*)vg, vr1 = *(const u32x4*)(vg + 8);
    const int pr = (l32 & ~12) | ((l32 & 4) << 1) | ((l32 & 8) >> 1);
    __syncthreads();
    *(u32x4*)(Ks + kkey * 72 + kseg * 8) = kreg; *(u32x4*)(Vs + vdv * 72 + vseg * 16) = vr0; *(u32x4*)(Vs + vdv * 72 + vseg * 16 + 8) = vr1;
    if (nkt > 1) { kreg = *(const u32x4*)(kg + (size_t)64 * 64); vr0 = *(const u32x4*)(vg + 64); vr1 = *(const u32x4*)(vg + 64 + 8); }
    __syncthreads();
    for (int kt = 0; kt < nkt; ++kt) {
        const bf16_t* Kc = Ks + (kt & 1) * ABUF; const bf16_t* Vc = Vs + (kt & 1) * ABUF;
        if (kt + 1 < nkt) {
            bf16_t* Kn = Ks + ((kt + 1) & 1) * ABUF; bf16_t* Vn = Vs + ((kt + 1) & 1) * ABUF;
            *(u32x4*)(Kn + kkey * 72 + kseg * 8) = kreg; *(u32x4*)(Vn + vdv * 72 + vseg * 16) = vr0; *(u32x4*)(Vn + vdv * 72 + vseg * 16 + 8) = vr1;
            if (kt + 2 < nkt) { kreg = *(const u32x4*)(kg + (size_t)(kt + 2) * 64 * 64); vr0 = *(const u32x4*)(vg + (kt + 2) * 64); vr1 = *(const u32x4*)(vg + (kt + 2) * 64 + 8); }
        }
        f32x16 S0, S1;
#pragma unroll
        for (int i = 0; i < 16; ++i) { S0[i] = 0.f; S1[i] = 0.f; }
#pragma unroll
        for (int ks = 0; ks < 4; ++ks) {
            const bf16x8 ka = *(const bf16x8*)(Kc + pr * 72 + 16 * ks + 8 * g);
            const bf16x8 kb = *(const bf16x8*)(Kc + (32 + pr) * 72 + 16 * ks + 8 * g);
            S0 = __builtin_amdgcn_mfma_f32_32x32x16_bf16(ka, qf[ks], S0, 0, 0, 0);
            S1 = __builtin_amdgcn_mfma_f32_32x32x16_bf16(kb, qf[ks], S1, 0, 0, 0);
        }
#pragma unroll
        for (int i = 0; i < 16; ++i) { S0[i] = __builtin_amdgcn_exp2f(S0[i]); S1[i] = __builtin_amdgcn_exp2f(S1[i]); lsum += S0[i] + S1[i]; }
#pragma unroll
        for (int kb2 = 0; kb2 < 2; ++kb2)
#pragma unroll
            for (int s = 0; s < 2; ++s) {
                u32x4 pw;
                if (kb2 == 0) { pw.x = pk2(S0[8 * s], S0[8 * s + 1]); pw.y = pk2(S0[8 * s + 2], S0[8 * s + 3]); pw.z = pk2(S0[8 * s + 4], S0[8 * s + 5]); pw.w = pk2(S0[8 * s + 6], S0[8 * s + 7]); }
                else { pw.x = pk2(S1[8 * s], S1[8 * s + 1]); pw.y = pk2(S1[8 * s + 2], S1[8 * s + 3]); pw.z = pk2(S1[8 * s + 4], S1[8 * s + 5]); pw.w = pk2(S1[8 * s + 6], S1[8 * s + 7]); }
                const bf16x8 pf = __builtin_bit_cast(bf16x8, pw);
#pragma unroll
                for (int d = 0; d < 4; ++d) {
                    const bf16x8 va = *(const bf16x8*)(Vc + (d * 32 + l32) * 72 + kb2 * 32 + 16 * s + 8 * g);
                    O[d] = __builtin_amdgcn_mfma_f32_32x32x16_bf16(va, pf, O[d], 0, 0, 0);
                }
            }
        __syncthreads();
    }
    lsum += __shfl_xor(lsum, 32);
    const float inv = 1.0f / lsum;
    bf16_t* ob = (bf16_t*)(p.ws + O_OC) + ((size_t)(rowbase + 32 * w + l32) * 8 + h * 2 + comp) * 128;
#pragma unroll
    for (int d = 0; d < 4; ++d)
#pragma unroll
        for (int i4 = 0; i4 < 4; ++i4) {
            u32x2 o; o.x = pk2(O[d][4 * i4] * inv, O[d][4 * i4 + 1] * inv); o.y = pk2(O[d][4 * i4 + 2] * inv, O[d][4 * i4 + 3] * inv);
            *(u32x2*)(ob + d * 32 + 8 * i4 + 4 * g) = o;
        }
}

__device__ __forceinline__ void mix_phase(const Params& p, unsigned char* smem, int l) {
    const int n_al = 1024, n_ac = (l == 0) ? 64 : 0, n_hf = 512, n_hc = (l == 0) ? 1024 : 0;
    const int total = n_al + n_ac + n_hf + n_hc;
    for (int it = blockIdx.x; it < total; it += gridDim.x) {
        int i = it;
        if (i < n_al) { const int comp = i & 1, h = (i >> 1) & 3, qt = (i >> 3) & 15, b = i >> 7; for (int rep = 0; rep < REP_ATT; ++rep) attn_item(p, smem, b, h, comp, 256 + qt * 256, b * 4096 + qt * 256, 68); continue; }
        i -= n_al;
        if (i < n_ac) { const int comp = i & 1, h = (i >> 1) & 3, b = i >> 3; attn_item(p, smem, b, h, comp, 0, TL + b * 256, 4); continue; }
        i -= n_ac;
        if (i < n_hf) { for (int rep = 0; rep < REP_HY; ++rep) hyfft_pair(p, smem, l, i >> 1, i & 1); continue; }
        i -= n_hf;
        for (int rep = 0; rep < REP_MISC; ++rep) hyctx_item(p, smem, l, i >> 7, i & 127);
    }
}

__device__ __forceinline__ void ybt_item(const Params& p, unsigned char* smem, int tb) {
    bf16_t* tile = (bf16_t*)smem;
    const int tid = TID(), r0 = tb * 64;
    const bool lat = r0 < TL;
    const int n = lat ? 4096 : 256, rb = lat ? r0 : r0 - TL, b = rb / n, t0 = rb % n;
    const bf16_t* src = (lat ? (const bf16_t*)(p.ws + O_YBT) : (const bf16_t*)(p.ws + O_YBTC)) + (size_t)b * 256 * n + t0;
    __syncthreads();
#pragma unroll
    for (int i = 0; i < 4; ++i) { const int e = tid + i * NT, ch = e >> 3, sg = e & 7; *(u32x4*)(tile + ch * 72 + sg * 8) = *(const u32x4*)(src + (size_t)ch * n + sg * 8); }
    __syncthreads();
    bf16_t* yb = (bf16_t*)(p.ws + O_YCAT) + 512;
#pragma unroll
    for (int i = 0; i < 4; ++i) {
        const int e = tid + i * NT, rr = e >> 5, sg = e & 31;
        unsigned w[4];
#pragma unroll
        for (int j = 0; j < 4; ++j) w[j] = (unsigned)tile[(sg * 8 + 2 * j) * 72 + rr] | ((unsigned)tile[(sg * 8 + 2 * j + 1) * 72 + rr] << 16);
        *(u32x4*)(yb + (size_t)(r0 + rr) * 1024 + sg * 8) = (u32x4){w[0], w[1], w[2], w[3]};
    }
}
__device__ __forceinline__ void post_phase(const Params& p, unsigned char* smem, int l, int M) {
    const int n_sg = M / 128, nb = M / 64;
    for (int it = blockIdx.x; it < n_sg + nb; it += gridDim.x) {
        if (it < n_sg) { for (int rep = 0; rep < REP_SGU; ++rep) sgu_item(p, smem, l, it); }
        else ybt_item(p, smem, it - n_sg);
    }
    const int tid = TID(), lane = tid & 63, wv = tid >> 6;
    const float* lv = p.da_lambda + (size_t)l * 256;
    const float d01 = wave_sum(lv[lane] * lv[64 + lane]), d23 = wave_sum(lv[128 + lane] * lv[192 + lane]);
    const float lam_init = 0.8f - 0.6f * expf(-0.3f * (float)l);
    const float lam = expf(d01) - expf(d23) + lam_init;
    const float* sub = p.da_subln + (size_t)l * 128;
    const float s0 = sub[2 * lane] * (1.0f - lam_init), s1 = sub[2 * lane + 1] * (1.0f - lam_init);
    const bf16_t* OC = (const bf16_t*)(p.ws + O_OC);
    bf16_t* YA = (bf16_t*)(p.ws + O_YCAT);
    const int vstep = gridDim.x * 8;
    for (int v0i = blockIdx.x * 8 + wv; v0i < M * 4; v0i += 4 * vstep) {
        unsigned aw[4], bw[4];
#pragma unroll
        for (int k = 0; k < 4; ++k) { const int vi = v0i + k * vstep; aw[k] = 0u; bw[k] = 0u;
            if (vi < M * 4) { const bf16_t* o0 = OC + (size_t)vi * 256; aw[k] = *(const unsigned*)(o0 + 2 * lane); bw[k] = *(const unsigned*)(o0 + 128 + 2 * lane); } }
#pragma unroll
        for (int k = 0; k < 4; ++k) { const int vi = v0i + k * vstep;
            if (vi < M * 4) {
                const float x0 = bflo(aw[k]) - lam * bflo(bw[k]), x1 = bfhi(aw[k]) - lam * bfhi(bw[k]);
                const float rinv = rsqrtf(wave_sum(x0 * x0 + x1 * x1) * (1.0f / 128.0f) + 1e-6f);
                *(unsigned*)(YA + (size_t)(vi >> 2) * 1024 + (vi & 3) * 128 + 2 * lane) = pk2(x0 * rinv * s0, x1 * rinv * s1);
            } }
    }
}

template <int l> __device__ __forceinline__ void layer_body(unsigned char* smem) {
        const int Mfull = TT, Mpost = (l == 0) ? TT : TL;
        { const Params q = opq(smem); norm_phase(q, l, 0, Mfull, l == 0, (const bf16_t*)q.out); if (l == 1) aux_phase(q, smem, 1); }
        gsync(smem);
        for (int rep = 0; rep < REP_UP; ++rep) { const Params q = opq(smem); EpiSwiglu E; E.G = (bf16_t*)(q.ws + O_GH); run_gemm(smem, (const bf16_t*)(q.ws + O_H), (const bf16_t*)(q.ws + O_WUP0), Mfull, 5632, 1024, E); }
        gsync(smem);
        { const Params q = opq(smem); EpiResid E; E.xin = (const bf16_t*)q.out; E.xout = (bf16_t*)q.out; E.fout = nullptr; E.xc = (float*)(q.ws + O_XC); E.part = (float*)(q.ws + O_PART); E.mod = (const float*)(q.ws + O_MOD) + (size_t)l * 9 * 9216; E.gofs = 2 * 1024; E.coef = 0.5f;
          run_gemm(smem, (const bf16_t*)(q.ws + O_GH), (const bf16_t*)(q.ws + O_WDN0), Mfull, 1024, 2816, E, true);
          for (int rep = 1; rep < REP_DN; ++rep) { E.coef = 0.f; run_gemm(smem, (const bf16_t*)(q.ws + O_GH), (const bf16_t*)(q.ws + O_WDN0), Mfull, 1024, 2816, E); } }
        gsync(smem);
        { const Params q = opq(smem); norm_phase(q, l, 1, Mfull, false, (const bf16_t*)q.out); for (int rep = 0; rep < REP_MISC; ++rep) for (int it = blockIdx.x; it < 512; it += gridDim.x) filtfft_item(q, smem, it); }
        gsync(smem);
        for (int rep = 0; rep < REP_G3; ++rep) { const Params q = opq(smem); EpiIn E; E.qn = (bf16_t*)(q.ws + O_QN); E.kn = (bf16_t*)(q.ws + O_KN); E.vraw = (bf16_t*)(q.ws + O_VRAW); E.hyraw = (bf16_t*)(q.ws + O_HYRAW); E.sgraw = (bf16_t*)(q.ws + O_SGRAW);
          run_gemm(smem, (const bf16_t*)(q.ws + O_H), (const bf16_t*)(q.ws + O_WIN), Mfull, 2816, 1024, E); }
        gsync(smem);
        { const Params q = opq(smem); prep_phase(q, smem, l); }
        gsync(smem);
        { const Params q = opq(smem); mix_phase(q, smem, l); }
        gsync(smem);
        for (int rep = 0; rep < REP_MISC; ++rep) { const Params q = opq(smem); post_phase(q, smem, l, Mpost); }
        gsync(smem);
#pragma unroll 1
        for (int rep9 = 0; rep9 < REP_P9; ++rep9) {
            { const Params q = opq(smem); EpiGate3 E; E.g3 = (bf16_t*)(q.ws + O_G3); E.bias = q.gate_b + (size_t)l * 3072;
              run_gemm(smem, (const bf16_t*)(q.ws + O_H), (const bf16_t*)(q.ws + O_WG), Mpost, 3072, 1024, E); }
            gsync(smem);
            { const Params q = opq(smem); EpiMergeR E; E.g3 = (const bf16_t*)(q.ws + O_G3); E.mb = (bf16_t*)(q.ws + O_MB);
              run_gemm(smem, (const bf16_t*)(q.ws + O_YCAT), (const bf16_t*)(q.ws + O_WBR), Mpost, 1024, 1024, E); }
        }
        gsync(smem);
        { const Params q = opq(smem); EpiResid E; E.xin = (const bf16_t*)q.out; E.xout = (l == 1) ? (bf16_t*)(q.ws + O_XALT) : (bf16_t*)q.out; E.fout = nullptr; E.xc = (float*)(q.ws + O_XC); E.part = (float*)(q.ws + O_PART); E.mod = (const float*)(q.ws + O_MOD) + (size_t)l * 9 * 9216; E.gofs = 5 * 1024; E.coef = 1.0f;
          run_gemm(smem, (const bf16_t*)(q.ws + O_MB), (const bf16_t*)(q.ws + O_WO), Mpost, 1024, 1024, E, l == 0);
          for (int rep = 1; rep < REP_G3; ++rep) { E.coef = 0.f; run_gemm(smem, (const bf16_t*)(q.ws + O_MB), (const bf16_t*)(q.ws + O_WO), Mpost, 1024, 1024, E); } }
        gsync(smem);
        { const Params q = opq(smem); norm_phase(q, l, 2, Mpost, false, (l == 1) ? (const bf16_t*)(q.ws + O_XALT) : (const bf16_t*)q.out); }
        gsync(smem);
        for (int rep = 0; rep < REP_UP; ++rep) { const Params q = opq(smem); EpiSwiglu E; E.G = (bf16_t*)(q.ws + O_GH); run_gemm(smem, (const bf16_t*)(q.ws + O_H), (const bf16_t*)(q.ws + O_WUP1), Mpost, 5632, 1024, E); }
        gsync(smem);
        { const Params q = opq(smem); EpiResid E; E.xin = (l == 1) ? (const bf16_t*)(q.ws + O_XALT) : (const bf16_t*)q.out; E.xout = (bf16_t*)q.out; E.fout = (l == 1) ? q.out : nullptr; E.xc = (float*)(q.ws + O_XC); E.part = (float*)(q.ws + O_PART); E.mod = (const float*)(q.ws + O_MOD) + (size_t)l * 9 * 9216; E.gofs = 8 * 1024; E.coef = 0.5f;
          run_gemm(smem, (const bf16_t*)(q.ws + O_GH), (const bf16_t*)(q.ws + O_WDN1), Mpost, 1024, 2816, E, l == 0); }
}

__global__ void __launch_bounds__(512, 2) fwd_megakernel(Params p) {
    extern __shared__ __attribute__((aligned(16))) unsigned char smem[];
    cg::grid_group grid = cg::this_grid();
    if (threadIdx.x == 0) {
        *(Params*)(smem + POFF) = p;
        volatile unsigned* st = (volatile unsigned*)(smem + POFF + 256); st[0] = 0u; st[1] = 0u;
        xb_add(&((unsigned*)(p.ws + O_BAR))[XB_XCNT(xb_xcc_id())], 1u);
    }
    __syncthreads();
    { const Params q = opq(smem); aux_phase(q, smem, 0); }
    grid.sync();
    layer_body<0>(smem);
    gsync(smem);
    layer_body<1>(smem);
}

extern "C" void kernel_launch(void* const* d_in, const int* in_sizes, int n_in, void* d_out, int out_size, void* d_ws, size_t ws_size, hipStream_t stream) {
    if (ws_size < WS_NEED) { fprintf(stderr, "workspace too small: need %zu have %zu\n", (size_t)WS_NEED, ws_size); return; }
    static int grid_blocks = 0;
    if (!grid_blocks) {
        hipFuncSetAttribute((const void*)fwd_megakernel, hipFuncAttributeMaxDynamicSharedMemorySize, LDS_BYTES);
        int dev = 0, cus = 0, per_cu = 0;
        hipGetDevice(&dev);
        hipDeviceGetAttribute(&cus, hipDeviceAttributeMultiprocessorCount, dev);
        hipOccupancyMaxActiveBlocksPerMultiprocessor(&per_cu, fwd_megakernel, NT, LDS_BYTES);
        if (per_cu < 1) per_cu = 1;
        grid_blocks = cus;
    }
    Params p{};
    const float** pp = (const float**)&p;
    for (int i = 0; i < 30; ++i) pp[i] = (const float*)d_in[i];
    p.out = (float*)d_out;
    p.ws = (unsigned char*)d_ws;
    hipMemsetAsync((unsigned char*)d_ws + O_BAR, 0, 16384, stream);
    void* args[] = {&p};
    hipError_t e = hipLaunchCooperativeKernel((void*)fwd_megakernel, dim3(grid_blocks), dim3(NT), args, LDS_BYTES, stream);
    if (e != hipSuccess) fprintf(stderr, "cooperative launch failed: %s (grid %d)\n", hipGetErrorString(e), grid_blocks);
}
```

```cpp
#include <hip/hip_runtime.h>
#include <hip/hip_cooperative_groups.h>
#include <cstdio>
namespace cg = cooperative_groups;

#define LAS __attribute__((address_space(3)))
typedef unsigned short bf16_t;
typedef short bf16x8 __attribute__((ext_vector_type(8)));
typedef float f32x2 __attribute__((ext_vector_type(2)));
typedef float f32x4 __attribute__((ext_vector_type(4)));
typedef float f32x16 __attribute__((ext_vector_type(16)));
typedef unsigned u32x2 __attribute__((ext_vector_type(2)));
typedef unsigned u32x4 __attribute__((ext_vector_type(4)));
typedef __bf16 bf16v2 __attribute__((ext_vector_type(2)));

constexpr int NT = 512;
#ifndef REP_ATT
#define REP_ATT 1
#endif
#ifndef REP_HY
#define REP_HY 1
#endif
#ifndef REP_AUX
#define REP_AUX 1
#endif
#ifndef REP_MISC
#define REP_MISC 1
#endif
#ifndef REP_PREP
#define REP_PREP 1
#endif
#ifndef REP_UP
#define REP_UP 1
#endif
#ifndef REP_DN
#define REP_DN 1
#endif
#ifndef REP_G3
#define REP_G3 1
#endif
#ifndef REP_P9
#define REP_P9 1
#endif
#ifndef REP_QK
#define REP_QK 1
#endif
#ifndef REP_NORM
#define REP_NORM 1
#endif
#ifndef REP_SGU
#define REP_SGU 1
#endif
constexpr int TL = 32768, TCX = 2048, TT = 34816, DM = 1024, FFH = 2816, SEQ = 4096, CTXL = 256, NK = 4352;
constexpr int LDS_BYTES = 147456;

constexpr size_t AL(size_t x) { return (x + 255) & ~(size_t)255; }
constexpr size_t O_WUP0 = 0;
constexpr size_t O_WUP1 = O_WUP0 + (size_t)5632 * 1024 * 2;
constexpr size_t O_WDN0 = O_WUP1 + (size_t)5632 * 1024 * 2;
constexpr size_t O_WDN1 = O_WDN0 + (size_t)1024 * 2816 * 2;
constexpr size_t O_WIN = O_WDN1 + (size_t)1024 * 2816 * 2;
constexpr size_t O_WG = O_WIN + (size_t)2816 * 1024 * 2;
constexpr size_t O_WBR = O_WG + (size_t)3072 * 1024 * 2;
constexpr size_t O_WO = O_WBR + (size_t)1024 * 1024 * 2;
constexpr size_t O_XC = O_WO + (size_t)1024 * 1024 * 2;
constexpr size_t O_MOD = O_XC + (size_t)TCX * 1024 * 4;
constexpr size_t O_L1P = O_MOD + AL((size_t)2 * 9 * 9216 * 4);
constexpr size_t O_L1PC = O_L1P + (size_t)256 * 1024 * 4;
constexpr size_t O_FILTC = O_L1PC + (size_t)16 * 1024 * 4;
constexpr size_t O_BAR = O_FILTC + (size_t)2 * 256 * 512 * 4;
constexpr size_t O_H = O_BAR + 16384;
constexpr size_t O_AR = O_H + (size_t)TT * 1024 * 2;
constexpr size_t O_GH = O_AR;
constexpr size_t O_VRAW = O_AR;
constexpr size_t O_HYRAW = O_VRAW + (size_t)TT * 512 * 2;
constexpr size_t O_SGRAW = O_HYRAW + (size_t)TT * 768 * 2;
constexpr size_t O_XALT = O_AR + (size_t)TT * 2816 * 2;
constexpr size_t O_PART = O_XALT;
constexpr size_t O_OC = O_AR;
constexpr size_t O_YBT = O_OC + (size_t)TT * 1024 * 2;
constexpr size_t O_YBTC = O_YBT + (size_t)8 * 256 * 4096 * 2;
static_assert(O_YBTC + (size_t)8 * 256 * 256 * 2 <= O_SGRAW, "OC/YBT must not touch SGRAW (read in the post phase)");
constexpr size_t O_G3 = O_AR;
constexpr size_t O_YCAT = O_G3 + (size_t)TT * 3072 * 2;
constexpr size_t O_MB = O_YCAT + (size_t)TT * 1024 * 2;
constexpr size_t SZ_B = (size_t)TT * 1024 * 4 + (size_t)8 * 256 * 4096 * 2 + (size_t)8 * 256 * 256 * 2;
constexpr size_t O_QN = O_AR + AL(SZ_B);
constexpr size_t O_KN = O_QN + (size_t)64 * NK * 64 * 2;
constexpr size_t O_VT = O_KN + (size_t)64 * NK * 64 * 2;
constexpr size_t O_HV = O_VT + (size_t)32 * 128 * NK * 2;
constexpr size_t O_HVC = O_HV + (size_t)8 * 768 * 4096 * 2;
constexpr size_t O_FH = O_HVC + (size_t)8 * 768 * 256 * 2;
constexpr size_t O_FILT = O_HV;
constexpr size_t SZ_C1 = (size_t)8 * 768 * 4096 * 2 + (size_t)8 * 768 * 256 * 2 + (size_t)2 * 256 * 8192 * 8;
constexpr size_t END1 = O_HV + SZ_C1, END2 = O_MB + (size_t)TT * 1024 * 2;
static_assert(O_YCAT >= O_SGRAW + (size_t)TT * 512 * 2, "YCAT is written while OC/YBT/SGRAW are read");
constexpr size_t WS_NEED = AL(END1 > END2 ? END1 : END2);
static_assert(O_GH + (size_t)TT * 2816 * 2 <= O_HV, "Gh must stay inside regions B'+A");
static_assert(O_XALT + (size_t)TL * 1024 * 2 <= O_MB, "X_alt is written while MB is read");
static_assert(O_PART + (size_t)4 * 2048 * 1024 * 4 <= O_HV, "partials must not touch FILT/FH");
static_assert(O_SGRAW + (size_t)TT * 512 * 2 <= O_QN, "raws fit region B'");

struct Params {
    const float *x, *c, *ctx, *c_ctx, *ada_w, *ada_b, *norm_g, *ffn_up, *ffn_down, *w_in, *qk_gain, *da_lambda, *da_subln,
        *hy_conv_w, *hy_conv_b, *hy_w1, *hy_b1, *hy_w2, *hy_b2, *hy_freq, *hy_w3, *hy_skip, *sg_ln_g, *sg_ln_b, *sg_w, *sg_b,
        *gate_w, *gate_b, *w_br, *w_o;
    float* out;
    unsigned char* ws;
};


__device__ __forceinline__ int TID() { int t = threadIdx.x; asm volatile("" : "+v"(t)); return t; }
constexpr int POFF = 147456 - 512;
__device__ __forceinline__ const float* ldp(const unsigned char* smem, int idx) {
    const volatile unsigned* w = (const volatile unsigned*)(smem + POFF + idx * 8);
    const unsigned lo = __builtin_amdgcn_readfirstlane(w[0]), hi = __builtin_amdgcn_readfirstlane(w[1]);
    typedef __attribute__((address_space(1))) const float* gptr_t;
    return (const float*)(gptr_t)(((unsigned long long)hi << 32) | lo);
}
__device__ __forceinline__ Params opq(const unsigned char* smem) {
    Params q;
    q.x = ldp(smem, 0); q.c = ldp(smem, 1); q.ctx = ldp(smem, 2); q.c_ctx = ldp(smem, 3); q.ada_w = ldp(smem, 4); q.ada_b = ldp(smem, 5); q.norm_g = ldp(smem, 6);
    q.ffn_up = ldp(smem, 7); q.ffn_down = ldp(smem, 8); q.w_in = ldp(smem, 9); q.qk_gain = ldp(smem, 10); q.da_lambda = ldp(smem, 11); q.da_subln = ldp(smem, 12);
    q.hy_conv_w = ldp(smem, 13); q.hy_conv_b = ldp(smem, 14); q.hy_w1 = ldp(smem, 15); q.hy_b1 = ldp(smem, 16); q.hy_w2 = ldp(smem, 17); q.hy_b2 = ldp(smem, 18);
    q.hy_freq = ldp(smem, 19); q.hy_w3 = ldp(smem, 20); q.hy_skip = ldp(smem, 21); q.sg_ln_g = ldp(smem, 22); q.sg_ln_b = ldp(smem, 23); q.sg_w = ldp(smem, 24);
    q.sg_b = ldp(smem, 25); q.gate_w = ldp(smem, 26); q.gate_b = ldp(smem, 27); q.w_br = ldp(smem, 28); q.w_o = ldp(smem, 29);
    q.out = (float*)ldp(smem, 30); q.ws = (unsigned char*)ldp(smem, 31);
    return q;
}


#define XB_TMO      128
#define XB_XCNT(j)  (256  + 64 * (j))
#define XB_XSUB(j)  (1280 + 64 * (j))
#define XB_XGEN(j)  (2304 + 64 * (j))
#define XB_TOP      3328
#define XB_TOPGEN   3392
#define XCD_BAR_WORDS 3456
#define XB_SPIN_CAP (1u << 22)
__device__ __forceinline__ unsigned xb_ld(unsigned* p)              { return __hip_atomic_load(p, __ATOMIC_RELAXED, __HIP_MEMORY_SCOPE_AGENT); }
__device__ __forceinline__ unsigned xb_add(unsigned* p, unsigned v) { return __hip_atomic_fetch_add(p, v, __ATOMIC_RELAXED, __HIP_MEMORY_SCOPE_AGENT); }
__device__ __forceinline__ unsigned xb_xcc_id() { return (unsigned)__builtin_amdgcn_s_getreg((3 << 11) | 20) & 0xFu; }
#define XB_SPIN(cond, bar) do { unsigned _sp = 0; while (cond) { __builtin_amdgcn_s_sleep(1); \
    if ((++_sp & 255u) == 0u) { if (xb_ld(&(bar)[XB_TMO])) break; if (_sp > XB_SPIN_CAP) { atomicAdd(&(bar)[XB_TMO], 1u); break; } } } } while (0)
__device__ __forceinline__ void xcd_barrier_complete(unsigned* bar, unsigned x, unsigned& nloc, unsigned& nx) {
    const unsigned G = gridDim.x * gridDim.y * gridDim.z;
    unsigned sum, cnt, mine, sp = 0u;
    for (;;) {
        sum = 0u; cnt = 0u; mine = 0u;
#pragma unroll
        for (unsigned j = 0; j < 16; ++j) { const unsigned c = xb_ld(&bar[XB_XCNT(j)]); sum += c; cnt += (c > 0u) ? 1u : 0u; mine = (j == x) ? c : mine; }
        if (sum == G) break;
        __builtin_amdgcn_s_sleep(1);
        if ((++sp & 255u) == 0u) { if (xb_ld(&bar[XB_TMO])) break; if (sp > XB_SPIN_CAP) { atomicAdd(&bar[XB_TMO], 1u); break; } }
    }
    nloc = mine > 0u ? mine : 1u; nx = cnt > 0u ? cnt : 1u;
}
__device__ __forceinline__ void gsync(unsigned char* smem) {
    asm volatile("s_waitcnt vmcnt(0)" ::: "memory");
    __syncthreads();
    if (threadIdx.x == 0) {
        unsigned* bar = (unsigned*)((unsigned char*)ldp(smem, 31) + O_BAR);
        volatile unsigned* st = (volatile unsigned*)(smem + POFF + 256);
        const unsigned x = xb_xcc_id();
        __builtin_amdgcn_s_waitcnt(0);
        unsigned nloc = st[0], nx = st[1];
        if (nloc == 0u) { xcd_barrier_complete(bar, x, nloc, nx); st[0] = nloc; st[1] = nx; }
        const unsigned old = xb_add(&bar[XB_XSUB(x)], 1u);
        const unsigned gen = old / nloc;
        if (old + 1u == (gen + 1u) * nloc) {
            __builtin_amdgcn_fence(__ATOMIC_RELEASE, "agent");
            asm volatile("s_waitcnt vmcnt(0)" ::: "memory");
            const unsigned og = xb_add(&bar[XB_TOP], 1u);
            const unsigned tg = og / nx;
            if (og + 1u == (tg + 1u) * nx) xb_add(&bar[XB_TOPGEN], 1u);
            else XB_SPIN(xb_ld(&bar[XB_TOPGEN]) == tg, bar);
            __builtin_amdgcn_fence(__ATOMIC_ACQUIRE, "agent");
            xb_add(&bar[XB_XGEN(x)], 1u);
            asm volatile("s_waitcnt vmcnt(0)" ::: "memory");
        } else {
            XB_SPIN(xb_ld(&bar[XB_XGEN(x)]) == gen, bar);
            __builtin_amdgcn_fence(__ATOMIC_ACQUIRE, "agent");
            asm volatile("s_waitcnt vmcnt(0)" ::: "memory");
        }
    }
    __syncthreads();
}

__device__ __forceinline__ unsigned pk2(float a, float b) { f32x2 v = {a, b}; bf16v2 r = __builtin_convertvector(v, bf16v2); return __builtin_bit_cast(unsigned, r); }
__device__ __forceinline__ bf16_t f2bf(float a) { return (bf16_t)(pk2(a, 0.f) & 0xffffu); }
__device__ __forceinline__ float bf2f(bf16_t h) { return __uint_as_float((unsigned)h << 16); }
__device__ __forceinline__ float bflo(unsigned w) { return __uint_as_float(w << 16); }
__device__ __forceinline__ float bfhi(unsigned w) { return __uint_as_float(w & 0xffff0000u); }
__device__ __forceinline__ void row_bk(int r, int& b, int& kidx) { if (r < TL) { b = r >> 12; kidx = 256 + (r & 4095); } else { const int rc = r - TL; b = rc >> 8; kidx = rc & 255; } }
__device__ __forceinline__ float wave_sum(float v) {
#pragma unroll
    for (int o = 32; o > 0; o >>= 1) v += __shfl_xor(v, o);
    return v;
}
__device__ __forceinline__ float sigmoidf_(float v) { return __builtin_amdgcn_rcpf(1.0f + __builtin_amdgcn_exp2f(v * -1.4426950408889634f)); }

namespace pg8 {
constexpr int BM = 256, BK = 64, HALF = 128, HTB = HALF * BK * 2, STAGE_BYTES = 8 * HTB, NXCD = 8, WGM = 8;
__device__ __forceinline__ int lds_byte(int r, int c) { const int st = (r >> 4) * 2 + (c >> 5), rr = r & 15, cc = c & 31, ob = rr * 64 + cc * 2; return st * 1024 + (ob ^ (((ob >> 9) & 1) << 5)); }
__device__ __forceinline__ void stage_rc(int b, int& R, int& C) { const int st = b / 1024, sb = b % 1024, swz = sb ^ (((sb >> 9) & 1) << 5); R = (st >> 1) * 16 + swz / 64; C = (st & 1) * 32 + (swz % 64) / 2; }
__device__ __forceinline__ int perm32(int rho) { const int n = rho >> 4, i = rho & 15; return 8 * (i >> 2) + 4 * n + (i & 3); }
struct Unit { int pm, pn, k0, nt, split; };
struct Gemm { const bf16_t* A; const bf16_t* Bt; int M, N, K; };
struct StaticOrder {
    int nM, nN, nwg, G, c, ntk, ntail;
    __device__ void init(int M, int N, int K, int G_, int c_, bool split_tail) {
        nM = M / BM; nN = N / BM; G = G_; c = c_; ntk = K / BK; ntail = 0;
        if (split_tail) { nM -= 8; ntail = 128; }
        nwg = nM * nN;
    }
    __device__ __forceinline__ bool next(int i, Unit& u) const {
        const long L = (long)i * G + c; if (L >= nwg + ntail) return false;
        int pm, pn, k0 = 0, nt = ntk, split = 0;
        if (L >= nwg) {
            const int j = (int)L - nwg, cu = j >> 2, part = j & 3;
            pm = nM + (cu >> 2); pn = cu & 3; split = 1 + part;
            const int q = (ntk / 4) & ~1, big = (ntk - 4 * q) / 2;
            nt = q + ((part < big) ? 2 : 0);
            k0 = part * q + 2 * (part < big ? part : big);
        } else {
            int wgid = (int)L; { const int q = nwg / NXCD, r = nwg % NXCD, xcd = wgid % NXCD, off = wgid / NXCD; wgid = (xcd < r ? xcd * (q + 1) : r * (q + 1) + (xcd - r) * q) + off; }
            const int nig = WGM * nN, gid = wgid / nig, fm = gid * WGM, gsz = (nM - fm) < WGM ? (nM - fm) : WGM;
            pm = fm + ((wgid % nig) % gsz); pn = (wgid % nig) / gsz;
        }
        u.pm = pm; u.pn = pn; u.k0 = k0; u.nt = nt; u.split = split;
        return true;
    }
};

template <class Epi>
__device__ __forceinline__ void gemm_phase(LAS unsigned char* lds, const Gemm g, const StaticOrder& S, const Epi& E) {
    const int tid = TID(), wid = __builtin_amdgcn_readfirstlane(tid >> 6), lane = tid & 63, wr = wid >> 2, wc = wid & 3, fr = lane & 15, fq = lane >> 4;
    const int K = g.K;
    unsigned voffA[2], voffB[2];
#pragma unroll
    for (int i = 0; i < 2; ++i) { int R, C; stage_rc(tid * 16 + i * 8192, R, C); const int Rb = Epi::PERM ? ((R & ~31) + perm32(R & 31)) : R;
        voffA[i] = (unsigned)(R * K + C) * 2u; voffB[i] = (unsigned)(Rb * K + C) * 2u; }
    const size_t kstep = (size_t)(BK * 2);
    const size_t hstep = (size_t)HALF * K * 2;
    const size_t tstep = 2 * hstep;
    const unsigned ldsw = (unsigned)wid * 1024u;
    const int aoff = lds_byte(wr * 64 + fr, fq * 8), boff = lds_byte(wc * 32 + fr, fq * 8);
#define PG8_SA(b, h) (((b) * 2 + (h)) * HTB)
#define PG8_SB(b, h) ((4 + (b) * 2 + (h)) * HTB)
#define PG8_STAGE(bufoff, gbase, voff) do { _Pragma("unroll") for (int _i = 0; _i < 2; ++_i) \
        __builtin_amdgcn_global_load_lds((const unsigned*)((const char*)(gbase) + (voff)[_i]), (LAS unsigned*)(lds + (bufoff) + ldsw + _i * 8192), 16, 0, 0); } while (0)
#define PG8_LDA(dst, b, h) do { _Pragma("unroll") for (int m = 0; m < 4; ++m) _Pragma("unroll") for (int k = 0; k < 2; ++k) dst[m][k] = *(const LAS bf16x8*)(lds + PG8_SA(b, h) + aoff + m * 2048 + k * 1024); } while (0)
#define PG8_LDB(dst, b, h) do { _Pragma("unroll") for (int n = 0; n < 2; ++n) _Pragma("unroll") for (int k = 0; k < 2; ++k) dst[n][k] = *(const LAS bf16x8*)(lds + PG8_SB(b, h) + boff + n * 2048 + k * 1024); } while (0)
#define PG8_MMA(ai, bj, At, Bt) do { __builtin_amdgcn_s_setprio(1); _Pragma("unroll") for (int m = 0; m < 4; ++m) _Pragma("unroll") for (int n = 0; n < 2; ++n) _Pragma("unroll") for (int k = 0; k < 2; ++k) \
        acc[ai][bj][m][n] = __builtin_amdgcn_mfma_f32_16x16x32_bf16(Bt[n][k], At[m][k], acc[ai][bj][m][n], 0, 0, 0); __builtin_amdgcn_s_setprio(0); } while (0)
#define PG8_WAIT_V(n) asm volatile("s_waitcnt vmcnt(" #n ")" ::: "memory")
#define PG8_WAIT_L(n) asm volatile("s_waitcnt lgkmcnt(" #n ")" ::: "memory")
#define PG8_BAR __builtin_amdgcn_s_barrier()
#define PG8_SCHED __builtin_amdgcn_sched_barrier(0)
    Unit cur, nxt; int ui = 0;
    if (!S.next(0, cur)) return;
    f32x4 acc[2][2][4][2];
#pragma unroll
    for (int a = 0; a < 2; ++a)
#pragma unroll
        for (int b = 0; b < 2; ++b)
#pragma unroll
            for (int m = 0; m < 4; ++m)
#pragma unroll
                for (int n = 0; n < 2; ++n) acc[a][b][m][n] = (f32x4){0.f, 0.f, 0.f, 0.f};
    bf16x8 At[4][2], B0[2][2], B1[2][2];
    const char* cA = (const char*)g.A + (size_t)cur.pm * tstep + (size_t)cur.k0 * kstep; const char* cB = (const char*)g.Bt + (size_t)cur.pn * tstep + (size_t)cur.k0 * kstep;
    PG8_STAGE(PG8_SB(0, 0), cB, voffB); PG8_STAGE(PG8_SA(0, 0), cA, voffA); PG8_STAGE(PG8_SB(0, 1), cB + hstep, voffB); PG8_STAGE(PG8_SA(0, 1), cA + hstep, voffA);
    if (wr == 1) PG8_BAR;
    PG8_WAIT_V(4); PG8_BAR;
    PG8_STAGE(PG8_SB(1, 0), cB + kstep, voffB); PG8_STAGE(PG8_SA(1, 0), cA + kstep, voffA); PG8_STAGE(PG8_SB(1, 1), cB + hstep + kstep, voffB);
    PG8_WAIT_V(6); PG8_BAR;
    for (;;) {
        const bool has_next = S.next(ui + 1, nxt);
        const char* nA = has_next ? (const char*)g.A + (size_t)nxt.pm * tstep + (size_t)nxt.k0 * kstep : cA; const char* nB = has_next ? (const char*)g.Bt + (size_t)nxt.pn * tstep + (size_t)nxt.k0 * kstep : cB;
        const int nt = cur.nt;
        for (int t = 0; t < nt; t += 2) {
            const bool last = (t == nt - 2);
            const char* a1 = cA + (size_t)(t + 1) * kstep;
            const char* a2 = last ? nA : cA + (size_t)(t + 2) * kstep; const char* b2 = last ? nB : cB + (size_t)(t + 2) * kstep;
            const char* a3 = a2 + kstep; const char* b3 = b2 + kstep;
            if constexpr (Epi::RESCALE) { if (t == 8 || t == 12) E.rescale(acc, cur, t == 8 ? 0 : 1, wr, wc, fr, fq); }
            PG8_LDB(B0, 0, 0); PG8_SCHED; PG8_LDA(At, 0, 0); PG8_STAGE(PG8_SA(1, 1), a1 + hstep, voffA);
            PG8_WAIT_L(8); PG8_BAR; PG8_WAIT_L(0); PG8_MMA(0, 0, At, B0); PG8_BAR; PG8_SCHED;
            PG8_LDB(B1, 0, 1); PG8_STAGE(PG8_SB(0, 0), b2, voffB);
            PG8_BAR; PG8_WAIT_L(0); PG8_MMA(0, 1, At, B1); PG8_BAR;
            PG8_LDA(At, 0, 1); PG8_STAGE(PG8_SA(0, 0), a2, voffA);
            PG8_BAR; PG8_WAIT_L(0); PG8_MMA(1, 0, At, B0); PG8_BAR; PG8_SCHED;
            PG8_STAGE(PG8_SB(0, 1), b2 + hstep, voffB);
            PG8_WAIT_V(6); PG8_BAR; PG8_MMA(1, 1, At, B1); PG8_BAR;
            PG8_LDB(B0, 1, 0); PG8_SCHED; PG8_LDA(At, 1, 0); PG8_STAGE(PG8_SA(0, 1), a2 + hstep, voffA);
            PG8_WAIT_L(8); PG8_BAR; PG8_WAIT_L(0); PG8_MMA(0, 0, At, B0); PG8_BAR; PG8_SCHED;
            PG8_LDB(B1, 1, 1); PG8_STAGE(PG8_SB(1, 0), b3, voffB);
            PG8_BAR; PG8_WAIT_L(0); PG8_MMA(0, 1, At, B1); PG8_BAR;
            PG8_LDA(At, 1, 1); PG8_STAGE(PG8_SA(1, 0), a3, voffA);
            PG8_BAR; PG8_WAIT_L(0); PG8_MMA(1, 0, At, B0); PG8_BAR; PG8_SCHED;
            PG8_STAGE(PG8_SB(1, 1), b3 + hstep, voffB);
            PG8_WAIT_V(6); PG8_BAR; PG8_MMA(1, 1, At, B1); PG8_BAR;
        }
        E(acc, cur, wr, wc, fr, fq);
        if (!has_next) break;
#pragma unroll
        for (int a = 0; a < 2; ++a)
#pragma unroll
            for (int b = 0; b < 2; ++b)
#pragma unroll
                for (int m = 0; m < 4; ++m)
#pragma unroll
                    for (int n = 0; n < 2; ++n) acc[a][b][m][n] = (f32x4){0.f, 0.f, 0.f, 0.f};
        cur = nxt; cA = nA; cB = nB; ++ui;
    }
    PG8_WAIT_V(0);
    if (wr == 0) PG8_BAR;
    PG8_BAR;
#undef PG8_SA
#undef PG8_SB
#undef PG8_STAGE
#undef PG8_LDA
#undef PG8_LDB
#undef PG8_MMA
#undef PG8_WAIT_V
#undef PG8_WAIT_L
#undef PG8_BAR
#undef PG8_SCHED
}
}
using pg8::Unit;
typedef f32x4 AccT[2][2][4][2];

struct EpiSwiglu {
    static constexpr bool PERM = true, RESCALE = false;
    bf16_t* G;
    __device__ __forceinline__ void operator()(const AccT& acc, const Unit& u, int wr, int wc, int fr, int fq) const {
        const int row0 = u.pm * 256 + wr * 64 + fr, col0 = u.pn * 128 + wc * 32 + 8 * fq;
#pragma unroll
        for (int ai = 0; ai < 2; ++ai)
#pragma unroll
            for (int m = 0; m < 4; ++m) {
                float gv[8];
#pragma unroll
                for (int n = 0; n < 2; ++n)
#pragma unroll
                    for (int j = 0; j < 4; ++j) { const float a = acc[ai][0][m][n][j], b = acc[ai][1][m][n][j]; gv[n * 4 + j] = a * b * __builtin_amdgcn_rcpf(1.0f + __builtin_amdgcn_exp2f(a * -1.4426950408889634f)); }
                u32x4 w; w.x = pk2(gv[0], gv[1]); w.y = pk2(gv[2], gv[3]); w.z = pk2(gv[4], gv[5]); w.w = pk2(gv[6], gv[7]);
                *(u32x4*)(G + (size_t)(row0 + ai * 128 + m * 16) * FFH + col0) = w;
            }
    }
};
struct EpiResid {
    static constexpr bool PERM = true, RESCALE = false;
    const bf16_t* xin; bf16_t* xout; float* fout; float* xc; float* part; const float* mod; int gofs; float coef;
    __device__ __forceinline__ void operator()(const AccT& acc, const Unit& u, int wr, int wc, int fr, int fq) const {
        const int row0 = u.pm * 256 + wr * 64 + fr, col0 = u.pn * 256 + wc * 32 + 8 * fq;
        const bool lat = u.pm < 128;
        const int mr = lat ? (u.pm >> 4) : 8;
        const float* gp = mod + (size_t)mr * 9216 + gofs + col0;
#pragma unroll
        for (int bj = 0; bj < 2; ++bj) {
            const f32x4 g0 = *(const f32x4*)(gp + bj * 128) * coef, g1 = *(const f32x4*)(gp + bj * 128 + 4) * coef;
            if (lat) {
                u32x4 xw[8];
#pragma unroll
                for (int am = 0; am < 8; ++am) xw[am] = *(const u32x4*)(xin + (size_t)(row0 + (am >> 2) * 128 + (am & 3) * 16) * 1024 + col0 + bj * 128);
#pragma unroll
                for (int am = 0; am < 8; ++am) {
                    const int ai = am >> 2, m = am & 3;
                    const size_t o = (size_t)(row0 + ai * 128 + m * 16) * 1024 + col0 + bj * 128;
                    f32x4 v0 = {bflo(xw[am].x), bfhi(xw[am].x), bflo(xw[am].y), bfhi(xw[am].y)}, v1 = {bflo(xw[am].z), bfhi(xw[am].z), bflo(xw[am].w), bfhi(xw[am].w)};
                    v0 += g0 * acc[ai][bj][m][0]; v1 += g1 * acc[ai][bj][m][1];
                    if (fout) { *(f32x4*)(fout + o) = v0; *(f32x4*)(fout + o + 4) = v1; }
                    else { u32x4 w; w.x = pk2(v0[0], v0[1]); w.y = pk2(v0[2], v0[3]); w.z = pk2(v1[0], v1[1]); w.w = pk2(v1[2], v1[3]); *(u32x4*)(xout + o) = w; }
                }
            } else {
#pragma unroll
                for (int am = 0; am < 8; ++am) {
                    const int ai = am >> 2, m = am & 3;
                    const size_t o = (size_t)(row0 + ai * 128 + m * 16 - TL) * 1024 + col0 + bj * 128;
                    const f32x4 d0 = g0 * acc[ai][bj][m][0], d1 = g1 * acc[ai][bj][m][1];
                    if (u.split) { float* pp = part + (size_t)(u.split - 1) * 2048 * 1024 + o; *(f32x4*)pp = d0; *(f32x4*)(pp + 4) = d1; }
                    else { float* xp = xc + o; *(f32x4*)xp = *(const f32x4*)xp + d0; *(f32x4*)(xp + 4) = *(const f32x4*)(xp + 4) + d1; }
                }
            }
        }
    }
};
struct EpiIn {
    static constexpr bool PERM = true, RESCALE = false;
    bf16_t *qn, *kn, *vraw, *hyraw, *sgraw;
    __device__ __forceinline__ void operator()(const AccT& acc, const Unit& u, int wr, int wc, int fr, int fq) const {
        const int row0 = u.pm * 256 + wr * 64 + fr, pn = u.pn;
#pragma unroll
        for (int ai = 0; ai < 2; ++ai)
#pragma unroll
            for (int m = 0; m < 4; ++m) {
                const int r = row0 + ai * 128 + m * 16;
#pragma unroll
                for (int bj = 0; bj < 2; ++bj) {
                    const f32x4 v0 = acc[ai][bj][m][0], v1 = acc[ai][bj][m][1];
                    u32x4 w; w.x = pk2(v0[0], v0[1]); w.y = pk2(v0[2], v0[3]); w.z = pk2(v1[0], v1[1]); w.w = pk2(v1[2], v1[3]);
                    const int cl = bj * 128 + wc * 32 + 8 * fq;
                    bf16_t* dst;
                    if (pn < 4) {
                        int b, kidx; row_bk(r, b, kidx);
                        const int cc = (pn & 1) * 256 + cl, head = cc >> 7, comp = (cc >> 6) & 1, d = cc & 63;
                        dst = (pn < 2 ? qn : kn) + ((size_t)((b * 4 + head) * 2 + comp) * NK + kidx) * 64 + d;
                    } else if (pn < 6) dst = vraw + (size_t)r * 512 + (pn - 4) * 256 + cl;
                    else if (pn < 9) dst = hyraw + (size_t)r * 768 + (pn - 6) * 256 + cl;
                    else dst = sgraw + (size_t)r * 512 + (pn - 9) * 256 + cl;
                    *(u32x4*)dst = w;
                }
            }
    }
};
struct EpiGate3 {
    static constexpr bool PERM = true, RESCALE = false;
    bf16_t* g3; const float* bias;
    __device__ __forceinline__ void operator()(const AccT& acc, const Unit& u, int wr, int wc, int fr, int fq) const {
        const int row0 = u.pm * 256 + wr * 64 + fr, col0 = u.pn * 256 + wc * 32 + 8 * fq;
#pragma unroll
        for (int bj = 0; bj < 2; ++bj) {
            const f32x4 b0 = *(const f32x4*)(bias + col0 + bj * 128), b1 = *(const f32x4*)(bias + col0 + bj * 128 + 4);
#pragma unroll
            for (int ai = 0; ai < 2; ++ai)
#pragma unroll
                for (int m = 0; m < 4; ++m) {
                    const f32x4 v0 = acc[ai][bj][m][0] + b0, v1 = acc[ai][bj][m][1] + b1;
                    float gv[8];
#pragma unroll
                    for (int j = 0; j < 4; ++j) { gv[j] = fmaxf(sigmoidf_(v0[j]), 1e-5f); gv[4 + j] = fmaxf(sigmoidf_(v1[j]), 1e-5f); }
                    u32x4 w; w.x = pk2(gv[0], gv[1]); w.y = pk2(gv[2], gv[3]); w.z = pk2(gv[4], gv[5]); w.w = pk2(gv[6], gv[7]);
                    *(u32x4*)(g3 + (size_t)(row0 + ai * 128 + m * 16) * 3072 + col0 + bj * 128) = w;
                }
        }
    }
};
struct EpiMergeR {
    static constexpr bool PERM = true, RESCALE = true;
    const bf16_t* g3; bf16_t* mb;
    __device__ __forceinline__ void rescale(AccT& acc, const Unit& u, int which, int wr, int wc, int fr, int fq) const {
        const int row0 = u.pm * 256 + wr * 64 + fr, col0 = u.pn * 256 + wc * 32 + 8 * fq;
        const bf16_t* gb = g3 + (size_t)row0 * 3072 + which * 1024 + col0;
#pragma unroll
        for (int ai = 0; ai < 2; ++ai)
#pragma unroll
            for (int mh = 0; mh < 2; ++mh) {
                u32x4 nw[2][2], dw[2][2];
#pragma unroll
                for (int mm = 0; mm < 2; ++mm)
#pragma unroll
                    for (int bj = 0; bj < 2; ++bj) { const bf16_t* gp = gb + (size_t)(ai * 128 + (mh * 2 + mm) * 16) * 3072 + bj * 128; nw[mm][bj] = *(const u32x4*)gp; dw[mm][bj] = *(const u32x4*)(gp + 1024); }
#pragma unroll
                for (int mm = 0; mm < 2; ++mm)
#pragma unroll
                    for (int bj = 0; bj < 2; ++bj) {
                        const u32x4 n4 = nw[mm][bj], d4 = dw[mm][bj];
                        const f32x4 r0 = {bflo(n4.x) * __builtin_amdgcn_rcpf(bflo(d4.x)), bfhi(n4.x) * __builtin_amdgcn_rcpf(bfhi(d4.x)), bflo(n4.y) * __builtin_amdgcn_rcpf(bflo(d4.y)), bfhi(n4.y) * __builtin_amdgcn_rcpf(bfhi(d4.y))};
                        const f32x4 r1 = {bflo(n4.z) * __builtin_amdgcn_rcpf(bflo(d4.z)), bfhi(n4.z) * __builtin_amdgcn_rcpf(bfhi(d4.z)), bflo(n4.w) * __builtin_amdgcn_rcpf(bflo(d4.w)), bfhi(n4.w) * __builtin_amdgcn_rcpf(bfhi(d4.w))};
                        acc[ai][bj][mh * 2 + mm][0] *= r0; acc[ai][bj][mh * 2 + mm][1] *= r1;
                    }
                __builtin_amdgcn_sched_barrier(0);
            }
    }
    __device__ __forceinline__ void operator()(const AccT& acc, const Unit& u, int wr, int wc, int fr, int fq) const {
        const int row0 = u.pm * 256 + wr * 64 + fr, col0 = u.pn * 256 + wc * 32 + 8 * fq;
#pragma unroll
        for (int bj = 0; bj < 2; ++bj) {
            u32x4 gw[8];
#pragma unroll
            for (int am = 0; am < 8; ++am) gw[am] = *(const u32x4*)(g3 + (size_t)(row0 + (am >> 2) * 128 + (am & 3) * 16) * 3072 + 2048 + col0 + bj * 128);
#pragma unroll
            for (int am = 0; am < 8; ++am) {
                const int ai = am >> 2, m = am & 3;
                const f32x4 v0 = acc[ai][bj][m][0], v1 = acc[ai][bj][m][1];
                u32x4 w; w.x = pk2(v0[0] * bflo(gw[am].x), v0[1] * bfhi(gw[am].x)); w.y = pk2(v0[2] * bflo(gw[am].y), v0[3] * bfhi(gw[am].y));
                w.z = pk2(v1[0] * bflo(gw[am].z), v1[1] * bfhi(gw[am].z)); w.w = pk2(v1[2] * bflo(gw[am].w), v1[3] * bfhi(gw[am].w));
                *(u32x4*)(mb + (size_t)(row0 + ai * 128 + m * 16) * 1024 + col0 + bj * 128) = w;
            }
        }
    }
};

template <class Epi>
__device__ __forceinline__ void run_gemm(unsigned char* smem, const bf16_t* A, const bf16_t* Bt, int M, int N, int K, const Epi& E, bool split_tail = false) {
    asm volatile("" : "+s"(M), "+s"(N), "+s"(K));
    pg8::Gemm g; g.A = A; g.Bt = Bt; g.M = M; g.N = N; g.K = K;
    pg8::StaticOrder S; S.init(M, N, K, gridDim.x, blockIdx.x, split_tail);
    pg8::gemm_phase<Epi>((LAS unsigned char*)smem, g, S, E);
}

__device__ __forceinline__ void mod_item(const Params& p, unsigned char* smem, int m) {
    float* s = (float*)smem;
    float* red = s + 9 * 1024;
    const int tid = TID(), l = m / 144, cb = m % 144;
    __syncthreads();
    for (int i = tid; i < 9216; i += NT) { const float v = (i < 8192) ? p.c[i] : p.c_ctx[i - 8192]; s[i] = v / (1.0f + __expf(-v)); }
    __syncthreads();
    const int kg = tid >> 6, cn = tid & 63, col = cb * 64 + cn;
    const float* w = p.ada_w + (size_t)l * 1024 * 9216 + col;
    float a0 = 0, a1 = 0, a2 = 0, a3 = 0, a4 = 0, a5 = 0, a6 = 0, a7 = 0, a8 = 0;
    for (int k = kg * 128; k < kg * 128 + 128; ++k) {
        const float wv = w[(size_t)k * 9216];
        a0 += s[k] * wv; a1 += s[1024 + k] * wv; a2 += s[2048 + k] * wv; a3 += s[3072 + k] * wv; a4 += s[4096 + k] * wv;
        a5 += s[5120 + k] * wv; a6 += s[6144 + k] * wv; a7 += s[7168 + k] * wv; a8 += s[8192 + k] * wv;
    }
    float* rp = red + kg * 576 + cn;
    rp[0] = a0; rp[64] = a1; rp[128] = a2; rp[192] = a3; rp[256] = a4; rp[320] = a5; rp[384] = a6; rp[448] = a7; rp[512] = a8;
    __syncthreads();
    float* MOD = (float*)(p.ws + O_MOD);
    for (int i = tid; i < 576; i += NT) {
        float v = 0; for (int q = 0; q < 8; ++q) v += red[q * 576 + i];
        const int r = i >> 6, c2 = cb * 64 + (i & 63);
        MOD[((size_t)l * 9 + r) * 9216 + c2] = v + p.ada_b[(size_t)l * 9216 + c2];
    }
}

__device__ __forceinline__ void filt_item(const Params& p, unsigned char* smem, int l, int n, int item, float* filt, float* l1p) {
    float* z = (float*)smem;
    float* h1 = z + 16 * 36;
    float* h2 = h1 + 16 * 64;
    float* stage = h2 + 16 * 64;
    const int tid = TID(), t0 = item * 16;
    __syncthreads();
    for (int i = tid; i < 16 * 33; i += NT) {
        const int tt = i / 33, e = i % 33, t = t0 + tt; float v;
        if (e == 0) v = (float)t / (float)(n - 1);
        else { const int bi = (e - 1) & 15; const float band = 1e-4f + (float)bi * ((15.0f - 1e-4f) / 15.0f); const float wv = (6.283185307179586f / (float)n) * (float)t;
            v = (e <= 16) ? cosf(band * wv) : -sinf(band * wv); }
        z[tt * 36 + e] = v;
    }
    __syncthreads();
    for (int i = tid; i < 16 * 64; i += NT) {
        const int tt = i >> 6, j = i & 63; float a = p.hy_b1[l * 64 + j];
        for (int e = 0; e < 33; ++e) a += z[tt * 36 + e] * p.hy_w1[((size_t)l * 33 + e) * 64 + j];
        h1[i] = sinf(p.hy_freq[l * 64 + j] * a);
    }
    __syncthreads();
    for (int i = tid; i < 16 * 64; i += NT) {
        const int tt = i >> 6, j = i & 63; float a = p.hy_b2[l * 64 + j];
        for (int e = 0; e < 64; ++e) a += h1[tt * 64 + e] * p.hy_w2[((size_t)l * 64 + e) * 64 + j];
        h2[i] = sinf(p.hy_freq[l * 64 + j] * a);
    }
    __syncthreads();
    const float min_decay = -3.0701134573253945f, max_decay = -15.350567286626973f;
#pragma unroll 1
    for (int cc = 0; cc < 2; ++cc) {
        const int col = tid + cc * 512;
        float acc[16];
#pragma unroll
        for (int tt = 0; tt < 16; ++tt) acc[tt] = 0.f;
        for (int e = 0; e < 64; ++e) {
            const float wv = p.hy_w3[((size_t)l * 64 + e) * 1024 + col];
#pragma unroll
            for (int tt = 0; tt < 16; ++tt) acc[tt] += h2[tt * 64 + e] * wv;
        }
        const int oc = col & 511, dir = col >> 9;
        const float ad = fabsf(min_decay + (float)oc * ((max_decay - min_decay) / 511.0f));
        float l1 = 0.f;
#pragma unroll
        for (int tt = 0; tt < 16; ++tt) {
            const int t = t0 + tt; const float tn = (float)t / (float)(n - 1);
            float v = acc[tt] * __expf(-tn * ad);
            if (dir == 1 && t == 0) v = 0.f;
            stage[col * 17 + tt] = v;
            l1 += fabsf(v);
        }
        l1p[(size_t)item * 1024 + col] = l1;
    }
    __syncthreads();
#pragma unroll 4
    for (int k = 0; k < 32; ++k) {
        const int e = tid + k * NT, col = e >> 4, tt = e & 15, t = t0 + tt;
        const int oc = col & 511, dir = col >> 9;
        const int pos = (dir == 0) ? t : ((t == 0) ? n : 2 * n - t);
        filt[(size_t)oc * (2 * n) + pos] = stage[col * 17 + tt];
    }
}

struct WDesc { const float* src; bf16_t* dst; int ld, K; };
__device__ __forceinline__ WDesc wdesc(const Params& p, int l, int ti) {
    WDesc d; int K, nrb, mapsw = 0; const float* src; bf16_t* dst; int ld;
    const size_t L = (size_t)l;
    if (ti < 1408) { src = p.ffn_up + (L * 2 + 0) * 1024 * 5632; ld = 5632; K = 1024; dst = (bf16_t*)(p.ws + O_WUP0); mapsw = 1; }
    else if ((ti -= 1408) < 1408) { src = p.ffn_up + (L * 2 + 1) * 1024 * 5632; ld = 5632; K = 1024; dst = (bf16_t*)(p.ws + O_WUP1); mapsw = 1; }
    else if ((ti -= 1408) < 704) { src = p.ffn_down + (L * 2 + 0) * 2816 * 1024; ld = 1024; K = 2816; dst = (bf16_t*)(p.ws + O_WDN0); }
    else if ((ti -= 704) < 704) { src = p.ffn_down + (L * 2 + 1) * 2816 * 1024; ld = 1024; K = 2816; dst = (bf16_t*)(p.ws + O_WDN1); }
    else if ((ti -= 704) < 704) { src = p.w_in + L * 1024 * 2816; ld = 2816; K = 1024; dst = (bf16_t*)(p.ws + O_WIN); }
    else if ((ti -= 704) < 768) { src = p.gate_w + L * 1024 * 3072; ld = 3072; K = 1024; dst = (bf16_t*)(p.ws + O_WG); }
    else if ((ti -= 768) < 256) { src = p.w_br + L * 1024 * 1024; ld = 1024; K = 1024; dst = (bf16_t*)(p.ws + O_WBR); }
    else { ti -= 256; src = p.w_o + L * 1024 * 1024; ld = 1024; K = 1024; dst = (bf16_t*)(p.ws + O_WO); }
    nrb = K / 64;
    const int nb = ti / nrb, kb = ti % nrb, n0 = nb * 64, k0 = kb * 64;
    int scol = n0;
    if (mapsw) { const int pn = n0 >> 8, half = (n0 >> 7) & 1; scol = half * 2816 + pn * 128 + (n0 & 127); }
    d.src = src + (size_t)k0 * ld + scol; d.dst = dst + (size_t)n0 * K + k0; d.ld = ld; d.K = K;
    return d;
}
__device__ __forceinline__ void wconv_tiles(const Params& p, unsigned char* smem, int l, int nw) {
    float* tile = (float*)smem;
    const int tid = TID(), kk0 = tid >> 6, nn0 = tid & 63, nn = tid >> 3, ks = tid & 7;
    int ti = blockIdx.x;
    if (ti >= nw) return;
    WDesc d = wdesc(p, l, ti);
    float v[8];
#pragma unroll
    for (int i = 0; i < 8; ++i) v[i] = d.src[(size_t)(kk0 + 8 * i) * d.ld + nn0];
    for (;;) {
        const int tn = ti + gridDim.x; const bool more = tn < nw;
        WDesc dn = d; float vn[8];
        if (more) { dn = wdesc(p, l, tn);
#pragma unroll
            for (int i = 0; i < 8; ++i) vn[i] = dn.src[(size_t)(kk0 + 8 * i) * dn.ld + nn0]; }
        __syncthreads();
#pragma unroll
        for (int i = 0; i < 8; ++i) tile[(kk0 + 8 * i) * 65 + nn0] = v[i];
        __syncthreads();
        float o[8];
#pragma unroll
        for (int j = 0; j < 8; ++j) o[j] = tile[(ks * 8 + j) * 65 + nn];
        u32x4 w; w.x = pk2(o[0], o[1]); w.y = pk2(o[2], o[3]); w.z = pk2(o[4], o[5]); w.w = pk2(o[6], o[7]);
        *(u32x4*)(d.dst + (size_t)nn * d.K + ks * 8) = w;
        if (!more) break;
        d = dn; ti = tn;
#pragma unroll
        for (int i = 0; i < 8; ++i) v[i] = vn[i];
    }
}

__device__ __forceinline__ void aux_phase(const Params& p, unsigned char* smem, int l) {
    const int nmod = (l == 0) ? 288 : 0, nf = 256, nfc = (l == 0) ? 16 : 0, nw = 6208;
    const int total = nmod + nf + nfc;
    for (int rep = 0; rep < REP_AUX; ++rep) {
        for (int it = blockIdx.x; it < total; it += gridDim.x) {
            int i = it;
            if (i < nmod) { mod_item(p, smem, i); continue; }
            i -= nmod;
            if (i < nf) { filt_item(p, smem, l, 4096, i, (float*)(p.ws + O_FILT), (float*)(p.ws + O_L1P)); continue; }
            i -= nf;
            filt_item(p, smem, l, 256, i, (float*)(p.ws + O_FILTC), (float*)(p.ws + O_L1PC));
        }
        wconv_tiles(p, smem, l, nw);
    }
}

__device__ __forceinline__ void norm_phase(const Params& p, int l, int sub, int M, bool first, const bf16_t* xl) {
    const float* PART = (const float*)(p.ws + O_PART);
    const int tid = TID(), lane = tid & 63, wv = tid >> 6;
    const float* MOD = (const float*)(p.ws + O_MOD) + (size_t)l * 9 * 9216;
    const float* gn = p.norm_g + ((size_t)l * 3 + sub) * 1024;
    float* XC = (float*)(p.ws + O_XC);
    bf16_t* H = (bf16_t*)(p.ws + O_H);
    const int rstep = gridDim.x * 8;
    for (int rep = 0; rep < REP_NORM; ++rep)
    for (int r0 = blockIdx.x * 8 + wv; r0 < M; r0 += 4 * rstep) {
        f32x4 v[4][4]; float ss[4];
#pragma unroll
        for (int k = 0; k < 4; ++k) {
            const int r = r0 + k * rstep; ss[k] = 0.f;
            if (r >= M) { continue; }
            if (r >= TL) {
                const float* src = (first ? p.ctx : XC) + (size_t)(r - TL) * 1024;
#pragma unroll
                for (int i = 0; i < 4; ++i) { const size_t o = (size_t)(r - TL) * 1024 + i * 256 + lane * 4; v[k][i] = *(const f32x4*)(src + i * 256 + lane * 4);
                    if (!first) { v[k][i] += *(const f32x4*)(PART + o); v[k][i] += *(const f32x4*)(PART + 2048 * 1024 + o); v[k][i] += *(const f32x4*)(PART + 2 * 2048 * 1024 + o); v[k][i] += *(const f32x4*)(PART + 3 * 2048 * 1024 + o); } }
            } else if (first) {
                const float* src = p.x + (size_t)r * 1024;
#pragma unroll
                for (int i = 0; i < 4; ++i) v[k][i] = *(const f32x4*)(src + i * 256 + lane * 4);
            } else {
                const bf16_t* src = xl + (size_t)r * 1024;
#pragma unroll
                for (int i = 0; i < 4; ++i) { const u32x2 w = *(const u32x2*)(src + i * 256 + lane * 4); v[k][i] = (f32x4){bflo(w.x), bfhi(w.x), bflo(w.y), bfhi(w.y)}; }
            }
        }
#pragma unroll
        for (int k = 0; k < 4; ++k) {
            const int r = r0 + k * rstep;
            if (r >= M) continue;
            if (r >= TL) {
#pragma unroll
                for (int i = 0; i < 4; ++i) *(f32x4*)(XC + (size_t)(r - TL) * 1024 + i * 256 + lane * 4) = v[k][i];
            } else if (first) {
                bf16_t* dstx = (bf16_t*)p.out + (size_t)r * 1024;
#pragma unroll
                for (int i = 0; i < 4; ++i) { u32x2 w; w.x = pk2(v[k][i][0], v[k][i][1]); w.y = pk2(v[k][i][2], v[k][i][3]); *(u32x2*)(dstx + i * 256 + lane * 4) = w; v[k][i] = (f32x4){bflo(w.x), bfhi(w.x), bflo(w.y), bfhi(w.y)}; }
            }
            float s2 = 0.f;
#pragma unroll
            for (int i = 0; i < 4; ++i) s2 += v[k][i][0] * v[k][i][0] + v[k][i][1] * v[k][i][1] + v[k][i][2] * v[k][i][2] + v[k][i][3] * v[k][i][3];
            s2 = wave_sum(s2);
            const float rinv = rsqrtf(s2 * (1.0f / 1024.0f) + 1e-6f);
            const int mr = r < TL ? (r >> 12) : 8;
            const float* sh = MOD + (size_t)mr * 9216 + (3 * sub) * 1024;
            const float* sc = sh + 1024;
#pragma unroll
            for (int i = 0; i < 4; ++i) {
                const int c = i * 256 + lane * 4;
                const f32x4 g4 = *(const f32x4*)(gn + c), s4 = *(const f32x4*)(sc + c), h4 = *(const f32x4*)(sh + c);
                const f32x4 y = v[k][i] * rinv * g4 * (s4 + 1.0f) + h4;
                u32x2 w; w.x = pk2(y[0], y[1]); w.y = pk2(y[2], y[3]);
                *(u32x2*)(H + (size_t)r * 1024 + c) = w;
            }
        }
    }
}

#define ZI(i) ((i) + ((i) >> 4))
__device__ __forceinline__ f32x2 cmul(f32x2 a, f32x2 b) { return (f32x2){a.x * b.x - a.y * b.y, a.x * b.y + a.y * b.x}; }
__device__ __forceinline__ f32x2 cmulc(f32x2 a, f32x2 b) { return (f32x2){a.x * b.x + a.y * b.y, a.y * b.x - a.x * b.y}; }
__device__ __forceinline__ void dif8(f32x2 (&x)[8]) {
    const float C = 0.70710678118654752f;
    { f32x2 t;
      t = x[0] - x[4]; x[0] += x[4]; x[4] = t;
      t = x[1] - x[5]; x[1] += x[5]; x[5] = (f32x2){C * (t.x + t.y), C * (t.y - t.x)};
      t = x[2] - x[6]; x[2] += x[6]; x[6] = (f32x2){t.y, -t.x};
      t = x[3] - x[7]; x[3] += x[7]; x[7] = (f32x2){C * (t.y - t.x), -C * (t.x + t.y)}; }
#pragma unroll
    for (int b = 0; b < 8; b += 4) { f32x2 t;
      t = x[b] - x[b + 2]; x[b] += x[b + 2]; x[b + 2] = t;
      t = x[b + 1] - x[b + 3]; x[b + 1] += x[b + 3]; x[b + 3] = (f32x2){t.y, -t.x}; }
#pragma unroll
    for (int b = 0; b < 8; b += 2) { const f32x2 t = x[b] - x[b + 1]; x[b] += x[b + 1]; x[b + 1] = t; }
}
__device__ __forceinline__ void idif8(f32x2 (&x)[8]) {
    const float C = 0.70710678118654752f;
#pragma unroll
    for (int b = 0; b < 8; b += 2) { const f32x2 t = x[b] - x[b + 1]; x[b] += x[b + 1]; x[b + 1] = t; }
#pragma unroll
    for (int b = 0; b < 8; b += 4) { f32x2 v, u;
      v = x[b + 2]; u = x[b]; x[b] = u + v; x[b + 2] = u - v;
      v = (f32x2){-x[b + 3].y, x[b + 3].x}; u = x[b + 1]; x[b + 1] = u + v; x[b + 3] = u - v; }
    { f32x2 v, u, t;
      v = x[4]; u = x[0]; x[0] = u + v; x[4] = u - v;
      t = x[5]; v = (f32x2){C * (t.x - t.y), C * (t.x + t.y)}; u = x[1]; x[1] = u + v; x[5] = u - v;
      t = x[6]; v = (f32x2){-t.y, t.x}; u = x[2]; x[2] = u + v; x[6] = u - v;
      t = x[7]; v = (f32x2){-C * (t.x + t.y), C * (t.x - t.y)}; u = x[3]; x[3] = u + v; x[7] = u - v; }
}
__device__ __forceinline__ void twid8(f32x2 (&x)[8], int pidx, int L, bool conj) {
    const float rev = -(float)pidx / (float)L;
    const float s = __builtin_amdgcn_sinf(rev), c = __builtin_amdgcn_cosf(rev);
    const f32x2 w1 = {c, s}; const f32x2 w2 = cmul(w1, w1), w3 = cmul(w2, w1), w4 = cmul(w2, w2), w5 = cmul(w4, w1), w6 = cmul(w3, w3), w7 = cmul(w4, w3);
    if (!conj) { x[1] = cmul(x[1], w4); x[2] = cmul(x[2], w2); x[3] = cmul(x[3], w6); x[4] = cmul(x[4], w1); x[5] = cmul(x[5], w5); x[6] = cmul(x[6], w3); x[7] = cmul(x[7], w7); }
    else { x[1] = cmulc(x[1], w4); x[2] = cmulc(x[2], w2); x[3] = cmulc(x[3], w6); x[4] = cmulc(x[4], w1); x[5] = cmulc(x[5], w5); x[6] = cmulc(x[6], w3); x[7] = cmulc(x[7], w7); }
}
__device__ __forceinline__ void fft_fwd(f32x2* z) {
    const int tid = TID();
#pragma unroll 1
    for (int L = 8192; L >= 16; L >>= 3) {
        const int S = L >> 3;
#pragma unroll
        for (int qq = 0; qq < 2; ++qq) { const int q = tid + qq * NT;
            const int pidx = q & (S - 1), B = (q / S) * L + pidx;
            f32x2 x[8];
#pragma unroll
            for (int j = 0; j < 8; ++j) x[j] = z[ZI(B + j * S)];
            dif8(x); twid8(x, pidx, L, false);
#pragma unroll
            for (int j = 0; j < 8; ++j) z[ZI(B + j * S)] = x[j];
        }
        __syncthreads();
    }
#pragma unroll 4
    for (int q = tid; q < 4096; q += NT) { const f32x2 a = z[ZI(2 * q)], b = z[ZI(2 * q + 1)]; z[ZI(2 * q)] = a + b; z[ZI(2 * q + 1)] = a - b; }
    __syncthreads();
}
__device__ __forceinline__ void fft_inv(f32x2* z) {
    const int tid = TID();
#pragma unroll 4
    for (int q = tid; q < 4096; q += NT) { const f32x2 a = z[ZI(2 * q)], b = z[ZI(2 * q + 1)]; z[ZI(2 * q)] = a + b; z[ZI(2 * q + 1)] = a - b; }
    __syncthreads();
#pragma unroll 1
    for (int L = 16; L <= 8192; L <<= 3) {
        const int S = L >> 3;
#pragma unroll
        for (int qq = 0; qq < 2; ++qq) { const int q = tid + qq * NT;
            const int pidx = q & (S - 1), B = (q / S) * L + pidx;
            f32x2 x[8];
#pragma unroll
            for (int j = 0; j < 8; ++j) x[j] = z[ZI(B + j * S)];
            twid8(x, pidx, L, true); idif8(x);
#pragma unroll
            for (int j = 0; j < 8; ++j) z[ZI(B + j * S)] = x[j];
        }
        __syncthreads();
    }
}

__device__ __forceinline__ void fft_fwd_h(f32x2* z, int lt) {
#pragma unroll 1
    for (int L = 8192; L >= 16; L >>= 3) {
        const int S = L >> 3;
#pragma unroll 2
        for (int qq = 0; qq < 4; ++qq) { const int q = lt + qq * 256;
            const int pidx = q & (S - 1), B = (q / S) * L + pidx;
            f32x2 x[8];
#pragma unroll
            for (int j = 0; j < 8; ++j) x[j] = z[ZI(B + j * S)];
            dif8(x); twid8(x, pidx, L, false);
#pragma unroll
            for (int j = 0; j < 8; ++j) z[ZI(B + j * S)] = x[j];
        }
        __syncthreads();
    }
#pragma unroll 4
    for (int q = lt; q < 4096; q += 256) { const f32x2 a = z[ZI(2 * q)], b = z[ZI(2 * q + 1)]; z[ZI(2 * q)] = a + b; z[ZI(2 * q + 1)] = a - b; }
    __syncthreads();
}
__device__ __forceinline__ void fft_inv_h(f32x2* z, int lt) {
#pragma unroll 4
    for (int q = lt; q < 4096; q += 256) { const f32x2 a = z[ZI(2 * q)], b = z[ZI(2 * q + 1)]; z[ZI(2 * q)] = a + b; z[ZI(2 * q + 1)] = a - b; }
    __syncthreads();
#pragma unroll 1
    for (int L = 16; L <= 8192; L <<= 3) {
        const int S = L >> 3;
#pragma unroll 2
        for (int qq = 0; qq < 4; ++qq) { const int q = lt + qq * 256;
            const int pidx = q & (S - 1), B = (q / S) * L + pidx;
            f32x2 x[8];
#pragma unroll
            for (int j = 0; j < 8; ++j) x[j] = z[ZI(B + j * S)];
            twid8(x, pidx, L, true); idif8(x);
#pragma unroll
            for (int j = 0; j < 8; ++j) z[ZI(B + j * S)] = x[j];
        }
        __syncthreads();
    }
}

__device__ __forceinline__ void filtfft_item(const Params& p, unsigned char* smem, int oc) {
    f32x2* z = (f32x2*)smem;
    float* red = (float*)(smem + 8704 * 8);
    const int tid = TID();
    const float* filt = (const float*)(p.ws + O_FILT) + (size_t)oc * 8192;
    const float* l1p = (const float*)(p.ws + O_L1P);
    __syncthreads();
#pragma unroll 4
    for (int i = tid; i < 8192; i += NT) z[ZI(i)] = (f32x2){filt[i], 0.f};
    if (tid < 256) red[tid] = l1p[(size_t)tid * 1024 + oc] + l1p[(size_t)tid * 1024 + 512 + oc];
    __syncthreads();
    if (tid < 64) { float v = red[tid] + red[tid + 64] + red[tid + 128] + red[tid + 192]; v = wave_sum(v); if (tid == 0) red[256] = v; }
    fft_fwd(z);
    const float sc = 1.0f / (red[256] * 8192.0f);
    f32x2* fh = (f32x2*)(p.ws + O_FH) + (size_t)oc * 8192;
#pragma unroll 4
    for (int i = tid; i < 8192; i += NT) fh[i] = z[ZI(i)] * sc;
}

__device__ __forceinline__ void hyfft_item(const Params& p, unsigned char* smem, int l, int ch, int bp) {
    f32x2* z = (f32x2*)smem;
    f32x2* zz = (f32x2*)(smem + 8704 * 8);
    const int tid = TID();
    const bf16_t* HV = (const bf16_t*)(p.ws + O_HV);
    const bf16_t* v0 = HV + ((size_t)(2 * bp) * 768 + ch) * 4096; const bf16_t* v1 = v0 + (size_t)768 * 4096;
    const f32x2* fh0 = (const f32x2*)(p.ws + O_FH) + (size_t)ch * 8192; const f32x2* fh1 = fh0 + (size_t)256 * 8192;
    const float sk0 = p.hy_skip[(size_t)l * 512 + ch], sk1 = p.hy_skip[(size_t)l * 512 + 256 + ch];
    bf16_t a0[8], a1[8];
#pragma unroll
    for (int k = 0; k < 8; ++k) { a0[k] = v0[tid + k * NT]; a1[k] = v1[tid + k * NT]; }
    f32x2 fr[16];
#pragma unroll
    for (int k = 0; k < 16; ++k) fr[k] = fh0[tid + k * NT];
    __syncthreads();
#pragma unroll
    for (int k = 0; k < 8; ++k) { const int t = tid + k * NT; z[ZI(t)] = (f32x2){bf2f(a0[k]), bf2f(a1[k])}; z[ZI(4096 + t)] = (f32x2){0.f, 0.f}; }
    __syncthreads();
    fft_fwd(z);
#pragma unroll
    for (int k = 0; k < 16; ++k) { const int i = tid + k * NT; z[ZI(i)] = cmul(z[ZI(i)], fr[k]); }
    bf16_t x0[8], x1[8];
#pragma unroll
    for (int k = 0; k < 8; ++k) { x0[k] = v0[(size_t)256 * 4096 + tid + k * NT]; x1[k] = v1[(size_t)256 * 4096 + tid + k * NT]; }
#pragma unroll
    for (int k = 0; k < 16; ++k) fr[k] = fh1[tid + k * NT];
    __syncthreads();
    fft_inv(z);
#pragma unroll
    for (int k = 0; k < 8; ++k) {
        const int t = tid + k * NT;
        f32x2 y = z[ZI(t)];
        y.x += bf2f(a0[k]) * sk0; y.y += bf2f(a1[k]) * sk0;
        const f32x2 zv = {bf2f(x0[k]) * y.x, bf2f(x1[k]) * y.y};
        zz[t] = zv; z[ZI(t)] = zv; z[ZI(4096 + t)] = (f32x2){0.f, 0.f};
    }
    __syncthreads();
    fft_fwd(z);
#pragma unroll
    for (int k = 0; k < 16; ++k) { const int i = tid + k * NT; z[ZI(i)] = cmul(z[ZI(i)], fr[k]); }
#pragma unroll
    for (int k = 0; k < 8; ++k) { x0[k] = v0[(size_t)512 * 4096 + tid + k * NT]; x1[k] = v1[(size_t)512 * 4096 + tid + k * NT]; }
    __syncthreads();
    fft_inv(z);
    bf16_t* YBT = (bf16_t*)(p.ws + O_YBT);
    bf16_t* o0 = YBT + ((size_t)(2 * bp) * 256 + ch) * 4096; bf16_t* o1 = o0 + (size_t)256 * 4096;
#pragma unroll
    for (int k = 0; k < 8; ++k) {
        const int t = tid + k * NT;
        const f32x2 y = z[ZI(t)] + zz[t] * sk1;
        o0[t] = f2bf(bf2f(x0[k]) * y.x); o1[t] = f2bf(bf2f(x1[k]) * y.y);
    }
}

__device__ __forceinline__ void hyfft_pair(const Params& p, unsigned char* smem, int l, int ch, int pp) {
    const int tid = TID(), hf = __builtin_amdgcn_readfirstlane(tid >> 8), lt = tid & 255, bp = 2 * pp + hf;
    f32x2* z = (f32x2*)(smem + (size_t)hf * 8704 * 8);
    const bf16_t* HV = (const bf16_t*)(p.ws + O_HV);
    const bf16_t* v0 = HV + ((size_t)(2 * bp) * 768 + ch) * 4096; const bf16_t* v1 = v0 + (size_t)768 * 4096;
    const f32x2* fh0 = (const f32x2*)(p.ws + O_FH) + (size_t)ch * 8192; const f32x2* fh1 = fh0 + (size_t)256 * 8192;
    const float sk0 = p.hy_skip[(size_t)l * 512 + ch], sk1 = p.hy_skip[(size_t)l * 512 + 256 + ch];
    unsigned av[16];
#pragma unroll
    for (int k = 0; k < 16; ++k) av[k] = (unsigned)v0[lt + k * 256] | ((unsigned)v1[lt + k * 256] << 16);
    f32x2 fr[32];
#pragma unroll
    for (int k = 0; k < 32; ++k) fr[k] = fh0[lt + k * 256];
    __syncthreads();
#pragma unroll
    for (int k = 0; k < 16; ++k) { const int t = lt + k * 256; z[ZI(t)] = (f32x2){bflo(av[k]), bfhi(av[k])}; z[ZI(4096 + t)] = (f32x2){0.f, 0.f}; }
    __syncthreads();
    fft_fwd_h(z, lt);
#pragma unroll
    for (int k = 0; k < 32; ++k) { const int i = lt + k * 256; z[ZI(i)] = cmul(z[ZI(i)], fr[k]); }
    unsigned xv[16];
#pragma unroll
    for (int k = 0; k < 16; ++k) xv[k] = (unsigned)v0[(size_t)256 * 4096 + lt + k * 256] | ((unsigned)v1[(size_t)256 * 4096 + lt + k * 256] << 16);
#pragma unroll
    for (int k = 0; k < 32; ++k) fr[k] = fh1[lt + k * 256];
    __syncthreads();
    fft_inv_h(z, lt);
    f32x2 zz[16];
#pragma unroll
    for (int k = 0; k < 16; ++k) {
        const int t = lt + k * 256;
        f32x2 y = z[ZI(t)];
        y.x += bflo(av[k]) * sk0; y.y += bfhi(av[k]) * sk0;
        const f32x2 zv = {bflo(xv[k]) * y.x, bfhi(xv[k]) * y.y};
        zz[k] = zv; z[ZI(t)] = zv; z[ZI(4096 + t)] = (f32x2){0.f, 0.f};
    }
    __syncthreads();
    fft_fwd_h(z, lt);
#pragma unroll
    for (int k = 0; k < 32; ++k) { const int i = lt + k * 256; z[ZI(i)] = cmul(z[ZI(i)], fr[k]); }
#pragma unroll
    for (int k = 0; k < 16; ++k) xv[k] = (unsigned)v0[(size_t)512 * 4096 + lt + k * 256] | ((unsigned)v1[(size_t)512 * 4096 + lt + k * 256] << 16);
    __syncthreads();
    fft_inv_h(z, lt);
    bf16_t* YBT = (bf16_t*)(p.ws + O_YBT);
    bf16_t* o0 = YBT + ((size_t)(2 * bp) * 256 + ch) * 4096; bf16_t* o1 = o0 + (size_t)256 * 4096;
#pragma unroll
    for (int k = 0; k < 16; ++k) {
        const int t = lt + k * 256;
        const f32x2 y = z[ZI(t)] + zz[k] * sk1;
        o0[t] = f2bf(bflo(xv[k]) * y.x); o1[t] = f2bf(bfhi(xv[k]) * y.y);
    }
}

__device__ __forceinline__ void hyctx_item(const Params& p, unsigned char* smem, int l, int b, int cp) {
    float* f1 = (float*)smem;
    float* f2 = f1 + 1024;
    float* vv = f2 + 1024;
    float* zc = vv + 512;
    float* red = zc + 512;
    const int tid = TID(), hf = tid >> 8, t = tid & 255, ch = cp * 2 + hf;
    const float* FC = (const float*)(p.ws + O_FILTC); const float* l1p = (const float*)(p.ws + O_L1PC);
    const bf16_t* HVC = (const bf16_t*)(p.ws + O_HVC) + ((size_t)b * 768 + ch) * 256;
    __syncthreads();
    f1[hf * 512 + t] = FC[(size_t)ch * 512 + t]; f1[hf * 512 + 256 + t] = FC[(size_t)ch * 512 + 256 + t];
    f2[hf * 512 + t] = FC[(size_t)(256 + ch) * 512 + t]; f2[hf * 512 + 256 + t] = FC[(size_t)(256 + ch) * 512 + 256 + t];
    const float vt = bf2f(HVC[t]); vv[hf * 256 + t] = vt;
    if (t < 2) { float s = 0.f; for (int it = 0; it < 16; ++it) s += l1p[(size_t)it * 1024 + t * 256 + ch] + l1p[(size_t)it * 1024 + 512 + t * 256 + ch]; red[hf * 2 + t] = s; }
    __syncthreads();
    float a = 0.f;
    for (int s = 0; s < 256; ++s) a += f1[hf * 512 + ((t - s) & 511)] * vv[hf * 256 + s];
    const float y1 = a / red[hf * 2 + 0] + vt * p.hy_skip[(size_t)l * 512 + ch];
    const float zt = bf2f(HVC[(size_t)256 * 256 + t]) * y1; zc[hf * 256 + t] = zt;
    __syncthreads();
    float a2 = 0.f;
    for (int s = 0; s < 256; ++s) a2 += f2[hf * 512 + ((t - s) & 511)] * zc[hf * 256 + s];
    const float y2 = a2 / red[hf * 2 + 1] + zt * p.hy_skip[(size_t)l * 512 + 256 + ch];
    bf16_t* YBTC = (bf16_t*)(p.ws + O_YBTC);
    YBTC[((size_t)b * 256 + ch) * 256 + t] = f2bf(bf2f(HVC[(size_t)512 * 256 + t]) * y2);
}

__device__ __forceinline__ void qk_item(const Params& p, int l, int item, bool dry = false) {
    const int tid = TID(), seg = tid & 7, vsub = tid >> 3;
    const int which = (item >= 544) ? 1 : 0;
    const int vbase = (item - which * 544) * 512;
    bf16_t* base = (bf16_t*)(p.ws + (which ? O_KN : O_QN));
    u32x4 raw[8];
#pragma unroll
    for (int it = 0; it < 8; ++it) raw[it] = *(const u32x4*)(base + (size_t)(vbase + it * 64 + vsub) * 64 + seg * 8);
    const float* gp = p.qk_gain + (size_t)l * 128 + which * 64 + seg * 8;
    const f32x4 g0 = *(const f32x4*)gp, g1 = *(const f32x4*)(gp + 4);
    const float gn[8] = {g0[0], g0[1], g0[2], g0[3], g1[0], g1[1], g1[2], g1[3]};
    const float qs = which ? 1.0f : (0.125f * 1.4426950408889634f);
    const int axis = seg >> 2, role = (seg >> 1) & 1, qb = (seg & 1) * 8;
    float inv[8];
#pragma unroll
    for (int e = 0; e < 8; ++e) inv[e] = exp2f(-(float)(qb + e) * (13.287712379549449f / 16.0f));
#pragma unroll
    for (int it = 0; it < 8; ++it) {
        const int rem = vbase + it * 64 + vsub, kidx = rem % NK;
        const u32x4 w = raw[it];
        float v[8] = {bflo(w.x), bfhi(w.x), bflo(w.y), bfhi(w.y), bflo(w.z), bfhi(w.z), bflo(w.w), bfhi(w.w)};
        float ss = 0.f;
#pragma unroll
        for (int e = 0; e < 8; ++e) ss += v[e] * v[e];
        ss += __shfl_xor(ss, 1); ss += __shfl_xor(ss, 2); ss += __shfl_xor(ss, 4);
        const float rinv = rsqrtf(ss * (1.0f / 64.0f) + 1e-6f) * qs;
#pragma unroll
        for (int e = 0; e < 8; ++e) v[e] = v[e] * rinv * gn[e];
        const int t = kidx - 256;
        const float pos = (float)(axis ? (t & 63) : (t >> 6));
        float o[8];
#pragma unroll
        for (int e = 0; e < 8; ++e) {
            const float pe = __shfl_xor(v[e], 2);
            float sn, cs; __sincosf(pos * inv[e], &sn, &cs);
            const float r = role ? (pe * sn + v[e] * cs) : (v[e] * cs - pe * sn);
            o[e] = (kidx >= 256) ? r : v[e];
        }
        u32x4 ow = {pk2(o[0], o[1]), pk2(o[2], o[3]), pk2(o[4], o[5]), pk2(o[6], o[7])};
        if (dry) ow = w;
        *(u32x4*)(base + (size_t)rem * 64 + seg * 8) = ow;
    }
}

__device__ __forceinline__ void vt_item(const Params& p, unsigned char* smem, int tb) {
    bf16_t* tile = (bf16_t*)smem;
    const int tid = TID(), r0 = tb * 64;
    const bf16_t* src = (const bf16_t*)(p.ws + O_VRAW) + (size_t)r0 * 512;
    __syncthreads();
#pragma unroll
    for (int i = 0; i < 8; ++i) { const int e = tid + i * NT, rr = e >> 6, sg = e & 63; *(u32x4*)(tile + rr * 520 + sg * 8) = *(const u32x4*)(src + (size_t)rr * 512 + sg * 8); }
    __syncthreads();
    int b, kidx0; row_bk(r0, b, kidx0);
    bf16_t* dst = (bf16_t*)(p.ws + O_VT) + ((size_t)b * 512 + tid) * NK + kidx0;
#pragma unroll
    for (int s = 0; s < 8; ++s) {
        unsigned w[4];
#pragma unroll
        for (int j = 0; j < 4; ++j) w[j] = (unsigned)tile[(s * 8 + 2 * j) * 520 + tid] | ((unsigned)tile[(s * 8 + 2 * j + 1) * 520 + tid] << 16);
        *(u32x4*)(dst + s * 8) = (u32x4){w[0], w[1], w[2], w[3]};
    }
}

__device__ __forceinline__ void hyconv_item(const Params& p, unsigned char* smem, int l, int tb) {
    bf16_t* tile = (bf16_t*)smem;
    const int tid = TID(), r0 = tb * 64;
    const bool lat = r0 < TL;
    const int n = lat ? 4096 : 256, rb = lat ? r0 : r0 - TL, b = rb / n, t0 = rb % n;
    const bf16_t* src = (const bf16_t*)(p.ws + O_HYRAW);
    __syncthreads();
    {
        u32x4 wv[13];
#pragma unroll
        for (int k = 0; k < 13; ++k) {
            const int e = tid + k * NT, rr = e / 96, sg = e % 96, t = t0 - 1 + rr;
            wv[k] = (u32x4){0u, 0u, 0u, 0u};
            if (e < 66 * 96 && t >= 0 && t < n) wv[k] = *(const u32x4*)(src + (size_t)(r0 - 1 + rr) * 768 + sg * 8);
        }
#pragma unroll
        for (int k = 0; k < 13; ++k) { const int e = tid + k * NT, rr = e / 96, sg = e % 96; if (e < 66 * 96) *(u32x4*)(tile + rr * 776 + sg * 8) = wv[k]; }
    }
    __syncthreads();
    const float* cw = p.hy_conv_w + (size_t)l * 3 * 768; const float* cb = p.hy_conv_b + (size_t)l * 768;
    for (int c = tid; c < 768; c += NT) {
        const float w0 = cw[c], w1 = cw[768 + c], w2 = cw[1536 + c], bb = cb[c];
        bf16_t* dst = lat ? (bf16_t*)(p.ws + O_HV) + ((size_t)b * 768 + c) * 4096 + t0 : (bf16_t*)(p.ws + O_HVC) + ((size_t)b * 768 + c) * 256 + t0;
        float pm = bf2f(tile[c]), pc = bf2f(tile[776 + c]);
#pragma unroll
        for (int s = 0; s < 8; ++s) {
            float o[8];
#pragma unroll
            for (int j = 0; j < 8; ++j) { const float pn = bf2f(tile[(s * 8 + j + 2) * 776 + c]); o[j] = pm * w0 + pc * w1 + pn * w2 + bb; pm = pc; pc = pn; }
            *(u32x4*)(dst + s * 8) = (u32x4){pk2(o[0], o[1]), pk2(o[2], o[3]), pk2(o[4], o[5]), pk2(o[6], o[7])};
        }
    }
}

__device__ __forceinline__ float gelu_exact(float v) { return 0.5f * v * (1.0f + erff(v * 0.70710678118654752f)); }
__device__ __forceinline__ void sgu_item(const Params& p, unsigned char* smem, int l, int ci) {
    bf16_t* vt = (bf16_t*)smem;
    const int tid = TID(), lane = tid & 63, wv = __builtin_amdgcn_readfirstlane(tid >> 6), r0 = ci * 128;
    const bf16_t* src = (const bf16_t*)(p.ws + O_SGRAW) + (size_t)r0 * 512;
    const float* lg = p.sg_ln_g + (size_t)l * 256; const float* lb = p.sg_ln_b + (size_t)l * 256;
    __syncthreads();
    {
        const f32x4 g4 = *(const f32x4*)(lg + lane * 4), b4 = *(const f32x4*)(lb + lane * 4);
        u32x2 wr_[16];
#pragma unroll
        for (int k = 0; k < 16; ++k) wr_[k] = *(const u32x2*)(src + (size_t)(wv + 8 * k) * 512 + 256 + lane * 4);
#pragma unroll
        for (int k = 0; k < 16; ++k) {
            const int rr = wv + 8 * k; const u32x2 w = wr_[k];
            float a[4] = {gelu_exact(bflo(w.x)), gelu_exact(bfhi(w.x)), gelu_exact(bflo(w.y)), gelu_exact(bfhi(w.y))};
            const float mu = wave_sum(a[0] + a[1] + a[2] + a[3]) * (1.0f / 256.0f);
            float d[4]; float sq = 0.f;
#pragma unroll
            for (int j = 0; j < 4; ++j) { d[j] = a[j] - mu; sq += d[j] * d[j]; }
            const float rstd = rsqrtf(wave_sum(sq) * (1.0f / 256.0f) + 1e-6f);
#pragma unroll
            for (int j = 0; j < 4; ++j) vt[(lane * 4 + j) * 136 + rr] = f2bf(d[j] * rstd * g4[j] + b4[j]);
        }
    }
    __syncthreads();
    const int g = wv & 3, ih = wv >> 2, l32 = lane & 31, kg = lane >> 5;
    const float* wsb = p.sg_w + ((size_t)l * 4 + g) * 128 * 128;
    const float* bsb = p.sg_b + ((size_t)l * 4 + g) * 128;
    bf16_t* yc = (bf16_t*)(p.ws + O_YCAT) + 768;
#pragma unroll 1
    for (int ib = 0; ib < 2; ++ib) {
        const int i0 = ih * 64 + ib * 32;
        f32x16 acc0, acc1;
#pragma unroll
        for (int r = 0; r < 16; ++r) { acc0[r] = 0.f; acc1[r] = 0.f; }
        const float* wrow = wsb + (size_t)(i0 + l32) * 128 + 8 * kg;
#pragma unroll
        for (int ks = 0; ks < 8; ++ks) {
            const f32x4 w0 = *(const f32x4*)(wrow + 16 * ks), w1 = *(const f32x4*)(wrow + 16 * ks + 4);
            const u32x4 aw = {pk2(w0[0], w0[1]), pk2(w0[2], w0[3]), pk2(w1[0], w1[1]), pk2(w1[2], w1[3])};
            const bf16x8 af = __builtin_bit_cast(bf16x8, aw);
            const bf16x8 b0 = *(const bf16x8*)(vt + (g * 64 + l32) * 136 + 16 * ks + 8 * kg);
            const bf16x8 b1 = *(const bf16x8*)(vt + (g * 64 + 32 + l32) * 136 + 16 * ks + 8 * kg);
            acc0 = __builtin_amdgcn_mfma_f32_32x32x16_bf16(af, b0, acc0, 0, 0, 0);
            acc1 = __builtin_amdgcn_mfma_f32_32x32x16_bf16(af, b1, acc1, 0, 0, 0);
        }
#pragma unroll
        for (int r = 0; r < 16; ++r) {
            const int i = i0 + 8 * (r >> 2) + 4 * kg + (r & 3);
            const float bi = bsb[i];
            const int c0 = g * 64 + l32, c1 = c0 + 32;
            const float u0 = gelu_exact(bf2f(src[(size_t)i * 512 + c0])), u1 = gelu_exact(bf2f(src[(size_t)i * 512 + c1]));
            yc[(size_t)(r0 + i) * 1024 + c0] = f2bf(u0 * (acc0[r] + bi));
            yc[(size_t)(r0 + i) * 1024 + c1] = f2bf(u1 * (acc1[r] + bi));
        }
    }
}

__device__ __forceinline__ void prep_phase(const Params& p, unsigned char* smem, int l) {
    const int n_sg = 0, n_hy = 544, n_vt = 544, n_qk = 1088;
    const int total = n_sg + n_hy + n_vt + n_qk;
    for (int it = blockIdx.x; it < total; it += gridDim.x) {
        int i = it;
        if (i < n_sg) { for (int rep = 0; rep < REP_SGU; ++rep) sgu_item(p, smem, l, i); continue; }
        i -= n_sg;
        if (i < n_hy) { for (int rep = 0; rep < REP_PREP; ++rep) hyconv_item(p, smem, l, i); continue; }
        i -= n_hy;
        if (i < n_vt) { for (int rep = 0; rep < REP_PREP; ++rep) vt_item(p, smem, i); continue; }
        i -= n_vt;
#if REP_QK > 1
        qk_item(p, l, i, true);
#endif
        qk_item(p, l, i);
    }
}

__device__ __forceinline__ void attn_item(const Params& p, unsigned char* smem, int b, int h, int comp, int q0, int rowbase, int nkt) {
    constexpr int ABUF = 64 * 72 + 128 * 72;
    bf16_t* Ks = (bf16_t*)smem;
    bf16_t* Vs = Ks + 64 * 72;
    const int tid = TID(), lane = tid & 63, w = tid >> 6, l32 = lane & 31, g = lane >> 5;
    const size_t hc = (size_t)((b * 4 + h) * 2 + comp);
    const bf16_t* Qb = (const bf16_t*)(p.ws + O_QN) + (hc * NK + q0 + 32 * w + l32) * 64;
    const bf16_t* Kb = (const bf16_t*)(p.ws + O_KN) + hc * NK * 64;
    const bf16_t* Vb = (const bf16_t*)(p.ws + O_VT) + (size_t)((b * 4 + h) * 128) * NK;
    bf16x8 qf[4];
#pragma unroll
    for (int ks = 0; ks < 4; ++ks) qf[ks] = *(const bf16x8*)(Qb + 16 * ks + 8 * g);
    f32x16 O[4];
#pragma unroll
    for (int d = 0; d < 4; ++d)
#pragma unroll
        for (int i = 0; i < 16; ++i) O[d][i] = 0.f;
    float lsum = 0.f;
    const int kkey = tid >> 3, kseg = tid & 7, vdv = tid >> 2, vseg = tid & 3;
    const bf16_t* kg = Kb + (size_t)kkey * 64 + kseg * 8;
    const bf16_t* vg = Vb + (size_t)vdv * NK + vseg * 16;
    u32x4 kreg = *(const u32x4*)kg, vr0 = *(const u32x4*)vg, vr1 = *(const u32x4*)(vg + 8);
    const int pr = (l32 & ~12) | ((l32 & 4) << 1) | ((l32 & 8) >> 1);
    __syncthreads();
    *(u32x4*)(Ks + kkey * 72 + kseg * 8) = kreg; *(u32x4*)(Vs + vdv * 72 + vseg * 16) = vr0; *(u32x4*)(Vs + vdv * 72 + vseg * 16 + 8) = vr1;
    if (nkt > 1) { kreg = *(const u32x4*)(kg + (size_t)64 * 64); vr0 = *(const u32x4*)(vg + 64); vr1 = *(const u32x4*)(vg + 64 + 8); }
    __syncthreads();
    for (int kt = 0; kt < nkt; ++kt) {
        const bf16_t* Kc = Ks + (kt & 1) * ABUF; const bf16_t* Vc = Vs + (kt & 1) * ABUF;
        if (kt + 1 < nkt) {
            bf16_t* Kn = Ks + ((kt + 1) & 1) * ABUF; bf16_t* Vn = Vs + ((kt + 1) & 1) * ABUF;
            *(u32x4*)(Kn + kkey * 72 + kseg * 8) = kreg; *(u32x4*)(Vn + vdv * 72 + vseg * 16) = vr0; *(u32x4*)(Vn + vdv * 72 + vseg * 16 + 8) = vr1;
            if (kt + 2 < nkt) { kreg = *(const u32x4*)(kg + (size_t)(kt + 2) * 64 * 64); vr0 = *(const u32x4*)(vg + (kt + 2) * 64); vr1 = *(const u32x4*)(vg + (kt + 2) * 64 + 8); }
        }
        f32x16 S0, S1;
#pragma unroll
        for (int i = 0; i < 16; ++i) { S0[i] = 0.f; S1[i] = 0.f; }
#pragma unroll
        for (int ks = 0; ks < 4; ++ks) {
            const bf16x8 ka = *(const bf16x8*)(Kc + pr * 72 + 16 * ks + 8 * g);
            const bf16x8 kb = *(const bf16x8*)(Kc + (32 + pr) * 72 + 16 * ks + 8 * g);
            S0 = __builtin_amdgcn_mfma_f32_32x32x16_bf16(ka, qf[ks], S0, 0, 0, 0);
            S1 = __builtin_amdgcn_mfma_f32_32x32x16_bf16(kb, qf[ks], S1, 0, 0, 0);
        }
#pragma unroll
        for (int i = 0; i < 16; ++i) { S0[i] = __builtin_amdgcn_exp2f(S0[i]); S1[i] = __builtin_amdgcn_exp2f(S1[i]); lsum += S0[i] + S1[i]; }
#pragma unroll
        for (int kb2 = 0; kb2 < 2; ++kb2)
#pragma unroll
            for (int s = 0; s < 2; ++s) {
                u32x4 pw;
                if (kb2 == 0) { pw.x = pk2(S0[8 * s], S0[8 * s + 1]); pw.y = pk2(S0[8 * s + 2], S0[8 * s + 3]); pw.z = pk2(S0[8 * s + 4], S0[8 * s + 5]); pw.w = pk2(S0[8 * s + 6], S0[8 * s + 7]); }
                else { pw.x = pk2(S1[8 * s], S1[8 * s + 1]); pw.y = pk2(S1[8 * s + 2], S1[8 * s + 3]); pw.z = pk2(S1[8 * s + 4], S1[8 * s + 5]); pw.w = pk2(S1[8 * s + 6], S1[8 * s + 7]); }
                const bf16x8 pf = __builtin_bit_cast(bf16x8, pw);
#pragma unroll
                for (int d = 0; d < 4; ++d) {
                    const bf16x8 va = *(const bf16x8*)(Vc + (d * 32 + l32) * 72 + kb2 * 32 + 16 * s + 8 * g);
                    O[d] = __builtin_amdgcn_mfma_f32_32x32x16_bf16(va, pf, O[d], 0, 0, 0);
                }
            }
        __syncthreads();
    }
    lsum += __shfl_xor(lsum, 32);
    const float inv = 1.0f / lsum;
    bf16_t* stg = (bf16_t*)(smem + 4 * ABUF) + (size_t)(32 * w) * 136;
#pragma unroll
    for (int d = 0; d < 4; ++d)
#pragma unroll
        for (int i4 = 0; i4 < 4; ++i4) {
            u32x2 o; o.x = pk2(O[d][4 * i4] * inv, O[d][4 * i4 + 1] * inv); o.y = pk2(O[d][4 * i4 + 2] * inv, O[d][4 * i4 + 3] * inv);
            *(u32x2*)(stg + l32 * 136 + d * 32 + 8 * i4 + 4 * g) = o;
        }
    bf16_t* ob = (bf16_t*)(p.ws + O_OC) + ((size_t)(rowbase + 32 * w) * 8 + h * 2 + comp) * 128;
#pragma unroll
    for (int k = 0; k < 8; ++k) {
        const int rr = 4 * k + (lane >> 4), pc = lane & 15;
        *(u32x4*)(ob + (size_t)rr * 1024 + pc * 8) = *(const u32x4*)(stg + rr * 136 + pc * 8);
    }
}

__device__ __forceinline__ void mix_phase(const Params& p, unsigned char* smem, int l) {
    const int n_al = 1024, n_ac = (l == 0) ? 64 : 0, n_hf = 512, n_hc = (l == 0) ? 1024 : 0;
    const int total = n_al + n_ac + n_hf + n_hc;
    for (int it = blockIdx.x; it < total; it += gridDim.x) {
        int i = it;
        if (i < n_al) { const int comp = i & 1, h = (i >> 1) & 3, qt = (i >> 3) & 15, b = i >> 7; for (int rep = 0; rep < REP_ATT; ++rep) attn_item(p, smem, b, h, comp, 256 + qt * 256, b * 4096 + qt * 256, 68); continue; }
        i -= n_al;
        if (i < n_ac) { const int comp = i & 1, h = (i >> 1) & 3, b = i >> 3; attn_item(p, smem, b, h, comp, 0, TL + b * 256, 4); continue; }
        i -= n_ac;
        if (i < n_hf) { for (int rep = 0; rep < REP_HY; ++rep) hyfft_pair(p, smem, l, i >> 1, i & 1); continue; }
        i -= n_hf;
        for (int rep = 0; rep < REP_MISC; ++rep) hyctx_item(p, smem, l, i >> 7, i & 127);
    }
}

__device__ __forceinline__ void ybt_item(const Params& p, unsigned char* smem, int tb) {
    bf16_t* tile = (bf16_t*)smem;
    const int tid = TID(), r0 = tb * 64;
    const bool lat = r0 < TL;
    const int n = lat ? 4096 : 256, rb = lat ? r0 : r0 - TL, b = rb / n, t0 = rb % n;
    const bf16_t* src = (lat ? (const bf16_t*)(p.ws + O_YBT) : (const bf16_t*)(p.ws + O_YBTC)) + (size_t)b * 256 * n + t0;
    __syncthreads();
#pragma unroll
    for (int i = 0; i < 4; ++i) { const int e = tid + i * NT, ch = e >> 3, sg = e & 7; *(u32x4*)(tile + ch * 72 + sg * 8) = *(const u32x4*)(src + (size_t)ch * n + sg * 8); }
    __syncthreads();
    bf16_t* yb = (bf16_t*)(p.ws + O_YCAT) + 512;
#pragma unroll
    for (int i = 0; i < 4; ++i) {
        const int e = tid + i * NT, rr = e >> 5, sg = e & 31;
        unsigned w[4];
#pragma unroll
        for (int j = 0; j < 4; ++j) w[j] = (unsigned)tile[(sg * 8 + 2 * j) * 72 + rr] | ((unsigned)tile[(sg * 8 + 2 * j + 1) * 72 + rr] << 16);
        *(u32x4*)(yb + (size_t)(r0 + rr) * 1024 + sg * 8) = (u32x4){w[0], w[1], w[2], w[3]};
    }
}
__device__ __forceinline__ void post_phase(const Params& p, unsigned char* smem, int l, int M) {
    const int n_sg = M / 128, nb = M / 64;
    for (int it = blockIdx.x; it < n_sg + nb; it += gridDim.x) {
        if (it < n_sg) { for (int rep = 0; rep < REP_SGU; ++rep) sgu_item(p, smem, l, it); }
        else ybt_item(p, smem, it - n_sg);
    }
    const int tid = TID(), lane = tid & 63, wv = tid >> 6;
    const float* lv = p.da_lambda + (size_t)l * 256;
    const float d01 = wave_sum(lv[lane] * lv[64 + lane]), d23 = wave_sum(lv[128 + lane] * lv[192 + lane]);
    const float lam_init = 0.8f - 0.6f * expf(-0.3f * (float)l);
    const float lam = expf(d01) - expf(d23) + lam_init;
    const float* sub = p.da_subln + (size_t)l * 128;
    const float s0 = sub[2 * lane] * (1.0f - lam_init), s1 = sub[2 * lane + 1] * (1.0f - lam_init);
    const bf16_t* OC = (const bf16_t*)(p.ws + O_OC);
    bf16_t* YA = (bf16_t*)(p.ws + O_YCAT);
    const int vstep = gridDim.x * 8;
    for (int v0i = blockIdx.x * 8 + wv; v0i < M * 4; v0i += 4 * vstep) {
        unsigned aw[4], bw[4];
#pragma unroll
        for (int k = 0; k < 4; ++k) { const int vi = v0i + k * vstep; aw[k] = 0u; bw[k] = 0u;
            if (vi < M * 4) { const bf16_t* o0 = OC + (size_t)vi * 256; aw[k] = *(const unsigned*)(o0 + 2 * lane); bw[k] = *(const unsigned*)(o0 + 128 + 2 * lane); } }
#pragma unroll
        for (int k = 0; k < 4; ++k) { const int vi = v0i + k * vstep;
            if (vi < M * 4) {
                const float x0 = bflo(aw[k]) - lam * bflo(bw[k]), x1 = bfhi(aw[k]) - lam * bfhi(bw[k]);
                const float rinv = rsqrtf(wave_sum(x0 * x0 + x1 * x1) * (1.0f / 128.0f) + 1e-6f);
                *(unsigned*)(YA + (size_t)(vi >> 2) * 1024 + (vi & 3) * 128 + 2 * lane) = pk2(x0 * rinv * s0, x1 * rinv * s1);
            } }
    }
}

template <int l> __device__ __forceinline__ void layer_body(unsigned char* smem) {
        const int Mfull = TT, Mpost = (l == 0) ? TT : TL;
        { const Params q = opq(smem); norm_phase(q, l, 0, Mfull, l == 0, (const bf16_t*)q.out); if (l == 1) aux_phase(q, smem, 1); }
        gsync(smem);
        for (int rep = 0; rep < REP_UP; ++rep) { const Params q = opq(smem); EpiSwiglu E; E.G = (bf16_t*)(q.ws + O_GH); run_gemm(smem, (const bf16_t*)(q.ws + O_H), (const bf16_t*)(q.ws + O_WUP0), Mfull, 5632, 1024, E); }
        gsync(smem);
        { const Params q = opq(smem); EpiResid E; E.xin = (const bf16_t*)q.out; E.xout = (bf16_t*)q.out; E.fout = nullptr; E.xc = (float*)(q.ws + O_XC); E.part = (float*)(q.ws + O_PART); E.mod = (const float*)(q.ws + O_MOD) + (size_t)l * 9 * 9216; E.gofs = 2 * 1024; E.coef = 0.5f;
          run_gemm(smem, (const bf16_t*)(q.ws + O_GH), (const bf16_t*)(q.ws + O_WDN0), Mfull, 1024, 2816, E, true);
          for (int rep = 1; rep < REP_DN; ++rep) { E.coef = 0.f; run_gemm(smem, (const bf16_t*)(q.ws + O_GH), (const bf16_t*)(q.ws + O_WDN0), Mfull, 1024, 2816, E); } }
        gsync(smem);
        { const Params q = opq(smem); norm_phase(q, l, 1, Mfull, false, (const bf16_t*)q.out); for (int rep = 0; rep < REP_MISC; ++rep) for (int it = blockIdx.x; it < 512; it += gridDim.x) filtfft_item(q, smem, it); }
        gsync(smem);
        for (int rep = 0; rep < REP_G3; ++rep) { const Params q = opq(smem); EpiIn E; E.qn = (bf16_t*)(q.ws + O_QN); E.kn = (bf16_t*)(q.ws + O_KN); E.vraw = (bf16_t*)(q.ws + O_VRAW); E.hyraw = (bf16_t*)(q.ws + O_HYRAW); E.sgraw = (bf16_t*)(q.ws + O_SGRAW);
          run_gemm(smem, (const bf16_t*)(q.ws + O_H), (const bf16_t*)(q.ws + O_WIN), Mfull, 2816, 1024, E); }
        gsync(smem);
        { const Params q = opq(smem); prep_phase(q, smem, l); }
        gsync(smem);
        { const Params q = opq(smem); mix_phase(q, smem, l); }
        gsync(smem);
        for (int rep = 0; rep < REP_MISC; ++rep) { const Params q = opq(smem); post_phase(q, smem, l, Mpost); }
        gsync(smem);
#pragma unroll 1
        for (int rep9 = 0; rep9 < REP_P9; ++rep9) {
            { const Params q = opq(smem); EpiGate3 E; E.g3 = (bf16_t*)(q.ws + O_G3); E.bias = q.gate_b + (size_t)l * 3072;
              run_gemm(smem, (const bf16_t*)(q.ws + O_H), (const bf16_t*)(q.ws + O_WG), Mpost, 3072, 1024, E); }
            gsync(smem);
            { const Params q = opq(smem); EpiMergeR E; E.g3 = (const bf16_t*)(q.ws + O_G3); E.mb = (bf16_t*)(q.ws + O_MB);
              run_gemm(smem, (const bf16_t*)(q.ws + O_YCAT), (const bf16_t*)(q.ws + O_WBR), Mpost, 1024, 1024, E); }
        }
        gsync(smem);
        { const Params q = opq(smem); EpiResid E; E.xin = (const bf16_t*)q.out; E.xout = (l == 1) ? (bf16_t*)(q.ws + O_XALT) : (bf16_t*)q.out; E.fout = nullptr; E.xc = (float*)(q.ws + O_XC); E.part = (float*)(q.ws + O_PART); E.mod = (const float*)(q.ws + O_MOD) + (size_t)l * 9 * 9216; E.gofs = 5 * 1024; E.coef = 1.0f;
          run_gemm(smem, (const bf16_t*)(q.ws + O_MB), (const bf16_t*)(q.ws + O_WO), Mpost, 1024, 1024, E, l == 0);
          for (int rep = 1; rep < REP_G3; ++rep) { E.coef = 0.f; run_gemm(smem, (const bf16_t*)(q.ws + O_MB), (const bf16_t*)(q.ws + O_WO), Mpost, 1024, 1024, E); } }
        gsync(smem);
        { const Params q = opq(smem); norm_phase(q, l, 2, Mpost, false, (l == 1) ? (const bf16_t*)(q.ws + O_XALT) : (const bf16_t*)q.out); }
        gsync(smem);
        for (int rep = 0; rep < REP_UP; ++rep) { const Params q = opq(smem); EpiSwiglu E; E.G = (bf16_t*)(q.ws + O_GH); run_gemm(smem, (const bf16_t*)(q.ws + O_H), (const bf16_t*)(q.ws + O_WUP1), Mpost, 5632, 1024, E); }
        gsync(smem);
        { const Params q = opq(smem); EpiResid E; E.xin = (l == 1) ? (const bf16_t*)(q.ws + O_XALT) : (const bf16_t*)q.out; E.xout = (bf16_t*)q.out; E.fout = (l == 1) ? q.out : nullptr; E.xc = (float*)(q.ws + O_XC); E.part = (float*)(q.ws + O_PART); E.mod = (const float*)(q.ws + O_MOD) + (size_t)l * 9 * 9216; E.gofs = 8 * 1024; E.coef = 0.5f;
          run_gemm(smem, (const bf16_t*)(q.ws + O_GH), (const bf16_t*)(q.ws + O_WDN1), Mpost, 1024, 2816, E, l == 0); }
}

__global__ void __launch_bounds__(512, 2) fwd_megakernel(Params p) {
    extern __shared__ __attribute__((aligned(16))) unsigned char smem[];
    cg::grid_group grid = cg::this_grid();
    if (threadIdx.x == 0) {
        *(Params*)(smem + POFF) = p;
        volatile unsigned* st = (volatile unsigned*)(smem + POFF + 256); st[0] = 0u; st[1] = 0u;
        xb_add(&((unsigned*)(p.ws + O_BAR))[XB_XCNT(xb_xcc_id())], 1u);
    }
    __syncthreads();
    { const Params q = opq(smem); aux_phase(q, smem, 0); }
    grid.sync();
    layer_body<0>(smem);
    gsync(smem);
    layer_body<1>(smem);
}

extern "C" void kernel_launch(void* const* d_in, const int* in_sizes, int n_in, void* d_out, int out_size, void* d_ws, size_t ws_size, hipStream_t stream) {
    if (ws_size < WS_NEED) { fprintf(stderr, "workspace too small: need %zu have %zu\n", (size_t)WS_NEED, ws_size); return; }
    static int grid_blocks = 0;
    if (!grid_blocks) {
        hipFuncSetAttribute((const void*)fwd_megakernel, hipFuncAttributeMaxDynamicSharedMemorySize, LDS_BYTES);
        int dev = 0, cus = 0, per_cu = 0;
        hipGetDevice(&dev);
        hipDeviceGetAttribute(&cus, hipDeviceAttributeMultiprocessorCount, dev);
        hipOccupancyMaxActiveBlocksPerMultiprocessor(&per_cu, fwd_megakernel, NT, LDS_BYTES);
        if (per_cu < 1) per_cu = 1;
        grid_blocks = cus;
    }
    Params p{};
    const float** pp = (const float**)&p;
    for (int i = 0; i < 30; ++i) pp[i] = (const float*)d_in[i];
    p.out = (float*)d_out;
    p.ws = (unsigned char*)d_ws;
    hipMemsetAsync((unsigned char*)d_ws + O_BAR, 0, 16384, stream);
    void* args[] = {&p};
    hipError_t e = hipLaunchCooperativeKernel((void*)fwd_megakernel, dim3(grid_blocks), dim3(NT), args, LDS_BYTES, stream);
    if (e != hipSuccess) fprintf(stderr, "cooperative launch failed: %s (grid %d)\n", hipGetErrorString(e), grid_blocks);
}
```

```cpp
#include <hip/hip_runtime.h>
#include <hip/hip_cooperative_groups.h>
#include <cstdio>
namespace cg = cooperative_groups;

#define LAS __attribute__((address_space(3)))
typedef unsigned short bf16_t;
typedef short bf16x8 __attribute__((ext_vector_type(8)));
typedef float f32x2 __attribute__((ext_vector_type(2)));
typedef float f32x4 __attribute__((ext_vector_type(4)));
typedef float f32x16 __attribute__((ext_vector_type(16)));
typedef unsigned u32x2 __attribute__((ext_vector_type(2)));
typedef unsigned u32x4 __attribute__((ext_vector_type(4)));
typedef __bf16 bf16v2 __attribute__((ext_vector_type(2)));

constexpr int NT = 512;
#ifndef REP_ATT
#define REP_ATT 1
#endif
#ifndef REP_HY
#define REP_HY 1
#endif
#ifndef REP_AUX
#define REP_AUX 1
#endif
#ifndef REP_MISC
#define REP_MISC 1
#endif
#ifndef REP_PREP
#define REP_PREP 1
#endif
#ifndef REP_UP
#define REP_UP 1
#endif
#ifndef REP_DN
#define REP_DN 1
#endif
#ifndef REP_G3
#define REP_G3 1
#endif
#ifndef REP_P9
#define REP_P9 1
#endif
#ifndef REP_QK
#define REP_QK 1
#endif
#ifndef REP_NORM
#define REP_NORM 1
#endif
#ifndef REP_SGU
#define REP_SGU 1
#endif
constexpr int TL = 32768, TCX = 2048, TT = 34816, DM = 1024, FFH = 2816, SEQ = 4096, CTXL = 256, NK = 4352;
constexpr int LDS_BYTES = 147456;

constexpr size_t AL(size_t x) { return (x + 255) & ~(size_t)255; }
constexpr size_t O_WUP0 = 0;
constexpr size_t O_WUP1 = O_WUP0 + (size_t)5632 * 1024 * 2;
constexpr size_t O_WDN0 = O_WUP1 + (size_t)5632 * 1024 * 2;
constexpr size_t O_WDN1 = O_WDN0 + (size_t)1024 * 2816 * 2;
constexpr size_t O_WIN = O_WDN1 + (size_t)1024 * 2816 * 2;
constexpr size_t O_WG = O_WIN + (size_t)2816 * 1024 * 2;
constexpr size_t O_WBR = O_WG + (size_t)3072 * 1024 * 2;
constexpr size_t O_WO = O_WBR + (size_t)1024 * 1024 * 2;
constexpr size_t O_XC = O_WO + (size_t)1024 * 1024 * 2;
constexpr size_t O_MOD = O_XC + (size_t)TCX * 1024 * 4;
constexpr size_t O_L1P = O_MOD + AL((size_t)2 * 9 * 9216 * 4);
constexpr size_t O_L1PC = O_L1P + (size_t)256 * 1024 * 4;
constexpr size_t O_FILTC = O_L1PC + (size_t)16 * 1024 * 4;
constexpr size_t O_BAR = O_FILTC + (size_t)2 * 256 * 512 * 4;
constexpr size_t O_H = O_BAR + 16384;
constexpr size_t O_AR = O_H + (size_t)TT * 1024 * 2;
constexpr size_t O_GH = O_AR;
constexpr size_t O_VRAW = O_AR;
constexpr size_t O_HYRAW = O_VRAW + (size_t)TT * 512 * 2;
constexpr size_t O_SGRAW = O_HYRAW + (size_t)TT * 768 * 2;
constexpr size_t O_XALT = O_AR + (size_t)TT * 2816 * 2;
constexpr size_t O_PART = O_XALT;
constexpr size_t O_OC = O_AR;
constexpr size_t O_YBT = O_OC + (size_t)TT * 1024 * 2;
constexpr size_t O_YBTC = O_YBT + (size_t)8 * 256 * 4096 * 2;
static_assert(O_YBTC + (size_t)8 * 256 * 256 * 2 <= O_SGRAW, "OC/YBT must not touch SGRAW (read in the post phase)");
constexpr size_t O_G3 = O_AR;
constexpr size_t O_YCAT = O_G3 + (size_t)TT * 3072 * 2;
constexpr size_t O_MB = O_YCAT + (size_t)TT * 1024 * 2;
constexpr size_t SZ_B = (size_t)TT * 1024 * 4 + (size_t)8 * 256 * 4096 * 2 + (size_t)8 * 256 * 256 * 2;
constexpr size_t O_QN = O_AR + AL(SZ_B);
constexpr size_t O_KN = O_QN + (size_t)64 * NK * 64 * 2;
constexpr size_t O_VT = O_KN + (size_t)64 * NK * 64 * 2;
constexpr size_t O_HV = O_VT + (size_t)32 * 128 * NK * 2;
constexpr size_t O_HVC = O_HV + (size_t)8 * 768 * 4096 * 2;
constexpr size_t O_FH = O_HVC + (size_t)8 * 768 * 256 * 2;
constexpr size_t O_FILT = O_HV;
constexpr size_t SZ_C1 = (size_t)8 * 768 * 4096 * 2 + (size_t)8 * 768 * 256 * 2 + (size_t)2 * 256 * 8192 * 8;
constexpr size_t END1 = O_HV + SZ_C1, END2 = O_MB + (size_t)TT * 1024 * 2;
static_assert(O_YCAT >= O_SGRAW + (size_t)TT * 512 * 2, "YCAT is written while OC/YBT/SGRAW are read");
constexpr size_t WS_NEED = AL(END1 > END2 ? END1 : END2);
static_assert(O_GH + (size_t)TT * 2816 * 2 <= O_HV, "Gh must stay inside regions B'+A");
static_assert(O_XALT + (size_t)TL * 1024 * 2 <= O_MB, "X_alt is written while MB is read");
static_assert(O_PART + (size_t)4 * 2048 * 1024 * 4 <= O_HV, "partials must not touch FILT/FH");
static_assert(O_SGRAW + (size_t)TT * 512 * 2 <= O_QN, "raws fit region B'");

struct Params {
    const float *x, *c, *ctx, *c_ctx, *ada_w, *ada_b, *norm_g, *ffn_up, *ffn_down, *w_in, *qk_gain, *da_lambda, *da_subln,
        *hy_conv_w, *hy_conv_b, *hy_w1, *hy_b1, *hy_w2, *hy_b2, *hy_freq, *hy_w3, *hy_skip, *sg_ln_g, *sg_ln_b, *sg_w, *sg_b,
        *gate_w, *gate_b, *w_br, *w_o;
    float* out;
    unsigned char* ws;
};


__device__ __forceinline__ int TID() { int t = threadIdx.x; asm volatile("" : "+v"(t)); return t; }
constexpr int POFF = 147456 - 512;
__device__ __forceinline__ const float* ldp(const unsigned char* smem, int idx) {
    const volatile unsigned* w = (const volatile unsigned*)(smem + POFF + idx * 8);
    const unsigned lo = __builtin_amdgcn_readfirstlane(w[0]), hi = __builtin_amdgcn_readfirstlane(w[1]);
    typedef __attribute__((address_space(1))) const float* gptr_t;
    return (const float*)(gptr_t)(((unsigned long long)hi << 32) | lo);
}
__device__ __forceinline__ Params opq(const unsigned char* smem) {
    Params q;
    q.x = ldp(smem, 0); q.c = ldp(smem, 1); q.ctx = ldp(smem, 2); q.c_ctx = ldp(smem, 3); q.ada_w = ldp(smem, 4); q.ada_b = ldp(smem, 5); q.norm_g = ldp(smem, 6);
    q.ffn_up = ldp(smem, 7); q.ffn_down = ldp(smem, 8); q.w_in = ldp(smem, 9); q.qk_gain = ldp(smem, 10); q.da_lambda = ldp(smem, 11); q.da_subln = ldp(smem, 12);
    q.hy_conv_w = ldp(smem, 13); q.hy_conv_b = ldp(smem, 14); q.hy_w1 = ldp(smem, 15); q.hy_b1 = ldp(smem, 16); q.hy_w2 = ldp(smem, 17); q.hy_b2 = ldp(smem, 18);
    q.hy_freq = ldp(smem, 19); q.hy_w3 = ldp(smem, 20); q.hy_skip = ldp(smem, 21); q.sg_ln_g = ldp(smem, 22); q.sg_ln_b = ldp(smem, 23); q.sg_w = ldp(smem, 24);
    q.sg_b = ldp(smem, 25); q.gate_w = ldp(smem, 26); q.gate_b = ldp(smem, 27); q.w_br = ldp(smem, 28); q.w_o = ldp(smem, 29);
    q.out = (float*)ldp(smem, 30); q.ws = (unsigned char*)ldp(smem, 31);
    return q;
}


#define XB_TMO      128
#define XB_XCNT(j)  (256  + 64 * (j))
#define XB_XSUB(j)  (1280 + 64 * (j))
#define XB_XGEN(j)  (2304 + 64 * (j))
#define XB_TOP      3328
#define XB_TOPGEN   3392
#define XCD_BAR_WORDS 3456
#define XB_SPIN_CAP (1u << 22)
__device__ __forceinline__ unsigned xb_ld(unsigned* p)              { return __hip_atomic_load(p, __ATOMIC_RELAXED, __HIP_MEMORY_SCOPE_AGENT); }
__device__ __forceinline__ unsigned xb_add(unsigned* p, unsigned v) { return __hip_atomic_fetch_add(p, v, __ATOMIC_RELAXED, __HIP_MEMORY_SCOPE_AGENT); }
__device__ __forceinline__ unsigned xb_xcc_id() { return (unsigned)__builtin_amdgcn_s_getreg((3 << 11) | 20) & 0xFu; }
#define XB_SPIN(cond, bar) do { unsigned _sp = 0; while (cond) { __builtin_amdgcn_s_sleep(1); \
    if ((++_sp & 255u) == 0u) { if (xb_ld(&(bar)[XB_TMO])) break; if (_sp > XB_SPIN_CAP) { atomicAdd(&(bar)[XB_TMO], 1u); break; } } } } while (0)
__device__ __forceinline__ void xcd_barrier_complete(unsigned* bar, unsigned x, unsigned& nloc, unsigned& nx) {
    const unsigned G = gridDim.x * gridDim.y * gridDim.z;
    unsigned sum, cnt, mine, sp = 0u;
    for (;;) {
        sum = 0u; cnt = 0u; mine = 0u;
#pragma unroll
        for (unsigned j = 0; j < 16; ++j) { const unsigned c = xb_ld(&bar[XB_XCNT(j)]); sum += c; cnt += (c > 0u) ? 1u : 0u; mine = (j == x) ? c : mine; }
        if (sum == G) break;
        __builtin_amdgcn_s_sleep(1);
        if ((++sp & 255u) == 0u) { if (xb_ld(&bar[XB_TMO])) break; if (sp > XB_SPIN_CAP) { atomicAdd(&bar[XB_TMO], 1u); break; } }
    }
    nloc = mine > 0u ? mine : 1u; nx = cnt > 0u ? cnt : 1u;
}
__device__ __forceinline__ void gsync(unsigned char* smem) {
    asm volatile("s_waitcnt vmcnt(0)" ::: "memory");
    __syncthreads();
    if (threadIdx.x == 0) {
        unsigned* bar = (unsigned*)((unsigned char*)ldp(smem, 31) + O_BAR);
        volatile unsigned* st = (volatile unsigned*)(smem + POFF + 256);
        const unsigned x = xb_xcc_id();
        __builtin_amdgcn_s_waitcnt(0);
        unsigned nloc = st[0], nx = st[1];
        if (nloc == 0u) { xcd_barrier_complete(bar, x, nloc, nx); st[0] = nloc; st[1] = nx; }
        const unsigned old = xb_add(&bar[XB_XSUB(x)], 1u);
        const unsigned gen = old / nloc;
        if (old + 1u == (gen + 1u) * nloc) {
            __builtin_amdgcn_fence(__ATOMIC_RELEASE, "agent");
            asm volatile("s_waitcnt vmcnt(0)" ::: "memory");
            const unsigned og = xb_add(&bar[XB_TOP], 1u);
            const unsigned tg = og / nx;
            if (og + 1u == (tg + 1u) * nx) xb_add(&bar[XB_TOPGEN], 1u);
            else XB_SPIN(xb_ld(&bar[XB_TOPGEN]) == tg, bar);
            __builtin_amdgcn_fence(__ATOMIC_ACQUIRE, "agent");
            xb_add(&bar[XB_XGEN(x)], 1u);
            asm volatile("s_waitcnt vmcnt(0)" ::: "memory");
        } else {
            XB_SPIN(xb_ld(&bar[XB_XGEN(x)]) == gen, bar);
            __builtin_amdgcn_fence(__ATOMIC_ACQUIRE, "agent");
            asm volatile("s_waitcnt vmcnt(0)" ::: "memory");
        }
    }
    __syncthreads();
}

__device__ __forceinline__ unsigned pk2(float a, float b) { f32x2 v = {a, b}; bf16v2 r = __builtin_convertvector(v, bf16v2); return __builtin_bit_cast(unsigned, r); }
__device__ __forceinline__ bf16_t f2bf(float a) { return (bf16_t)(pk2(a, 0.f) & 0xffffu); }
__device__ __forceinline__ float bf2f(bf16_t h) { return __uint_as_float((unsigned)h << 16); }
__device__ __forceinline__ float bflo(unsigned w) { return __uint_as_float(w << 16); }
__device__ __forceinline__ float bfhi(unsigned w) { return __uint_as_float(w & 0xffff0000u); }
__device__ __forceinline__ void row_bk(int r, int& b, int& kidx) { if (r < TL) { b = r >> 12; kidx = 256 + (r & 4095); } else { const int rc = r - TL; b = rc >> 8; kidx = rc & 255; } }
__device__ __forceinline__ float wave_sum(float v) {
#pragma unroll
    for (int o = 32; o > 0; o >>= 1) v += __shfl_xor(v, o);
    return v;
}
__device__ __forceinline__ float sigmoidf_(float v) { return __builtin_amdgcn_rcpf(1.0f + __builtin_amdgcn_exp2f(v * -1.4426950408889634f)); }

namespace pg8 {
constexpr int BM = 256, BK = 64, HALF = 128, HTB = HALF * BK * 2, STAGE_BYTES = 8 * HTB, NXCD = 8, WGM = 8;
__device__ __forceinline__ int lds_byte(int r, int c) { const int st = (r >> 4) * 2 + (c >> 5), rr = r & 15, cc = c & 31, ob = rr * 64 + cc * 2; return st * 1024 + (ob ^ (((ob >> 9) & 1) << 5)); }
__device__ __forceinline__ void stage_rc(int b, int& R, int& C) { const int st = b / 1024, sb = b % 1024, swz = sb ^ (((sb >> 9) & 1) << 5); R = (st >> 1) * 16 + swz / 64; C = (st & 1) * 32 + (swz % 64) / 2; }
__device__ __forceinline__ int perm32(int rho) { const int n = rho >> 4, i = rho & 15; return 8 * (i >> 2) + 4 * n + (i & 3); }
struct Unit { int pm, pn, k0, nt, split; };
struct Gemm { const bf16_t* A; const bf16_t* Bt; int M, N, K; };
struct StaticOrder {
    int nM, nN, nwg, G, c, ntk, ntail;
    __device__ void init(int M, int N, int K, int G_, int c_, bool split_tail) {
        nM = M / BM; nN = N / BM; G = G_; c = c_; ntk = K / BK; ntail = 0;
        if (split_tail) { nM -= 8; ntail = 128; }
        nwg = nM * nN;
    }
    __device__ __forceinline__ bool next(int i, Unit& u) const {
        const long L = (long)i * G + c; if (L >= nwg + ntail) return false;
        int pm, pn, k0 = 0, nt = ntk, split = 0;
        if (L >= nwg) {
            const int j = (int)L - nwg, cu = j >> 2, part = j & 3;
            pm = nM + (cu >> 2); pn = cu & 3; split = 1 + part;
            const int q = (ntk / 4) & ~1, big = (ntk - 4 * q) / 2;
            nt = q + ((part < big) ? 2 : 0);
            k0 = part * q + 2 * (part < big ? part : big);
        } else {
            int wgid = (int)L; { const int q = nwg / NXCD, r = nwg % NXCD, xcd = wgid % NXCD, off = wgid / NXCD; wgid = (xcd < r ? xcd * (q + 1) : r * (q + 1) + (xcd - r) * q) + off; }
            const int nig = WGM * nN, gid = wgid / nig, fm = gid * WGM, gsz = (nM - fm) < WGM ? (nM - fm) : WGM;
            pm = fm + ((wgid % nig) % gsz); pn = (wgid % nig) / gsz;
        }
        u.pm = pm; u.pn = pn; u.k0 = k0; u.nt = nt; u.split = split;
        return true;
    }
};

template <class Epi>
__device__ __forceinline__ void gemm_phase(LAS unsigned char* lds, const Gemm g, const StaticOrder& S, const Epi& E) {
    const int tid = TID(), wid = __builtin_amdgcn_readfirstlane(tid >> 6), lane = tid & 63, wr = wid >> 2, wc = wid & 3, fr = lane & 15, fq = lane >> 4;
    const int K = g.K;
    unsigned voffA[2], voffB[2];
#pragma unroll
    for (int i = 0; i < 2; ++i) { int R, C; stage_rc(tid * 16 + i * 8192, R, C); const int Rb = Epi::PERM ? ((R & ~31) + perm32(R & 31)) : R;
        voffA[i] = (unsigned)(R * K + C) * 2u; voffB[i] = (unsigned)(Rb * K + C) * 2u; }
    const size_t kstep = (size_t)(BK * 2);
    const size_t hstep = (size_t)HALF * K * 2;
    const size_t tstep = 2 * hstep;
    const unsigned ldsw = (unsigned)wid * 1024u;
    const int aoff = lds_byte(wr * 64 + fr, fq * 8), boff = lds_byte(wc * 32 + fr, fq * 8);
#define PG8_SA(b, h) (((b) * 2 + (h)) * HTB)
#define PG8_SB(b, h) ((4 + (b) * 2 + (h)) * HTB)
#define PG8_STAGE(bufoff, gbase, voff) do { _Pragma("unroll") for (int _i = 0; _i < 2; ++_i) \
        __builtin_amdgcn_global_load_lds((const unsigned*)((const char*)(gbase) + (voff)[_i]), (LAS unsigned*)(lds + (bufoff) + ldsw + _i * 8192), 16, 0, 0); } while (0)
#define PG8_LDA(dst, b, h) do { _Pragma("unroll") for (int m = 0; m < 4; ++m) _Pragma("unroll") for (int k = 0; k < 2; ++k) dst[m][k] = *(const LAS bf16x8*)(lds + PG8_SA(b, h) + aoff + m * 2048 + k * 1024); } while (0)
#define PG8_LDB(dst, b, h) do { _Pragma("unroll") for (int n = 0; n < 2; ++n) _Pragma("unroll") for (int k = 0; k < 2; ++k) dst[n][k] = *(const LAS bf16x8*)(lds + PG8_SB(b, h) + boff + n * 2048 + k * 1024); } while (0)
#define PG8_MMA(ai, bj, At, Bt) do { __builtin_amdgcn_s_setprio(1); _Pragma("unroll") for (int m = 0; m < 4; ++m) _Pragma("unroll") for (int n = 0; n < 2; ++n) _Pragma("unroll") for (int k = 0; k < 2; ++k) \
        acc[ai][bj][m][n] = __builtin_amdgcn_mfma_f32_16x16x32_bf16(Bt[n][k], At[m][k], acc[ai][bj][m][n], 0, 0, 0); __builtin_amdgcn_s_setprio(0); } while (0)
#define PG8_WAIT_V(n) asm volatile("s_waitcnt vmcnt(" #n ")" ::: "memory")
#define PG8_WAIT_L(n) asm volatile("s_waitcnt lgkmcnt(" #n ")" ::: "memory")
#define PG8_BAR __builtin_amdgcn_s_barrier()
#define PG8_SCHED __builtin_amdgcn_sched_barrier(0)
    Unit cur, nxt; int ui = 0;
    if (!S.next(0, cur)) return;
    f32x4 acc[2][2][4][2];
#pragma unroll
    for (int a = 0; a < 2; ++a)
#pragma unroll
        for (int b = 0; b < 2; ++b)
#pragma unroll
            for (int m = 0; m < 4; ++m)
#pragma unroll
                for (int n = 0; n < 2; ++n) acc[a][b][m][n] = (f32x4){0.f, 0.f, 0.f, 0.f};
    bf16x8 At[4][2], B0[2][2], B1[2][2];
    const char* cA = (const char*)g.A + (size_t)cur.pm * tstep + (size_t)cur.k0 * kstep; const char* cB = (const char*)g.Bt + (size_t)cur.pn * tstep + (size_t)cur.k0 * kstep;
    PG8_STAGE(PG8_SB(0, 0), cB, voffB); PG8_STAGE(PG8_SA(0, 0), cA, voffA); PG8_STAGE(PG8_SB(0, 1), cB + hstep, voffB); PG8_STAGE(PG8_SA(0, 1), cA + hstep, voffA);
    if (wr == 1) PG8_BAR;
    PG8_WAIT_V(4); PG8_BAR;
    PG8_STAGE(PG8_SB(1, 0), cB + kstep, voffB); PG8_STAGE(PG8_SA(1, 0), cA + kstep, voffA); PG8_STAGE(PG8_SB(1, 1), cB + hstep + kstep, voffB);
    PG8_WAIT_V(6); PG8_BAR;
    for (;;) {
        const bool has_next = S.next(ui + 1, nxt);
        const char* nA = has_next ? (const char*)g.A + (size_t)nxt.pm * tstep + (size_t)nxt.k0 * kstep : cA; const char* nB = has_next ? (const char*)g.Bt + (size_t)nxt.pn * tstep + (size_t)nxt.k0 * kstep : cB;
        const int nt = cur.nt;
        for (int t = 0; t < nt; t += 2) {
            const bool last = (t == nt - 2);
            const char* a1 = cA + (size_t)(t + 1) * kstep;
            const char* a2 = last ? nA : cA + (size_t)(t + 2) * kstep; const char* b2 = last ? nB : cB + (size_t)(t + 2) * kstep;
            const char* a3 = a2 + kstep; const char* b3 = b2 + kstep;
            if constexpr (Epi::RESCALE) { if (t == 8 || t == 12) E.rescale(acc, cur, t == 8 ? 0 : 1, wr, wc, fr, fq); }
            PG8_LDB(B0, 0, 0); PG8_SCHED; PG8_LDA(At, 0, 0); PG8_STAGE(PG8_SA(1, 1), a1 + hstep, voffA);
            PG8_WAIT_L(8); PG8_BAR; PG8_WAIT_L(0); PG8_MMA(0, 0, At, B0); PG8_BAR; PG8_SCHED;
            PG8_LDB(B1, 0, 1); PG8_STAGE(PG8_SB(0, 0), b2, voffB);
            PG8_BAR; PG8_WAIT_L(0); PG8_MMA(0, 1, At, B1); PG8_BAR;
            PG8_LDA(At, 0, 1); PG8_STAGE(PG8_SA(0, 0), a2, voffA);
            PG8_BAR; PG8_WAIT_L(0); PG8_MMA(1, 0, At, B0); PG8_BAR; PG8_SCHED;
            PG8_STAGE(PG8_SB(0, 1), b2 + hstep, voffB);
            PG8_WAIT_V(6); PG8_BAR; PG8_MMA(1, 1, At, B1); PG8_BAR;
            PG8_LDB(B0, 1, 0); PG8_SCHED; PG8_LDA(At, 1, 0); PG8_STAGE(PG8_SA(0, 1), a2 + hstep, voffA);
            PG8_WAIT_L(8); PG8_BAR; PG8_WAIT_L(0); PG8_MMA(0, 0, At, B0); PG8_BAR; PG8_SCHED;
            PG8_LDB(B1, 1, 1); PG8_STAGE(PG8_SB(1, 0), b3, voffB);
            PG8_BAR; PG8_WAIT_L(0); PG8_MMA(0, 1, At, B1); PG8_BAR;
            PG8_LDA(At, 1, 1); PG8_STAGE(PG8_SA(1, 0), a3, voffA);
            PG8_BAR; PG8_WAIT_L(0); PG8_MMA(1, 0, At, B0); PG8_BAR; PG8_SCHED;
            PG8_STAGE(PG8_SB(1, 1), b3 + hstep, voffB);
            PG8_WAIT_V(6); PG8_BAR; PG8_MMA(1, 1, At, B1); PG8_BAR;
        }
        E(acc, cur, wr, wc, fr, fq);
        if (!has_next) break;
#pragma unroll
        for (int a = 0; a < 2; ++a)
#pragma unroll
            for (int b = 0; b < 2; ++b)
#pragma unroll
                for (int m = 0; m < 4; ++m)
#pragma unroll
                    for (int n = 0; n < 2; ++n) acc[a][b][m][n] = (f32x4){0.f, 0.f, 0.f, 0.f};
        cur = nxt; cA = nA; cB = nB; ++ui;
    }
    PG8_WAIT_V(0);
    if (wr == 0) PG8_BAR;
    PG8_BAR;
#undef PG8_SA
#undef PG8_SB
#undef PG8_STAGE
#undef PG8_LDA
#undef PG8_LDB
#undef PG8_MMA
#undef PG8_WAIT_V
#undef PG8_WAIT_L
#undef PG8_BAR
#undef PG8_SCHED
}
}
using pg8::Unit;
typedef f32x4 AccT[2][2][4][2];

struct EpiSwiglu {
    static constexpr bool PERM = true, RESCALE = false;
    bf16_t* G;
    __device__ __forceinline__ void operator()(const AccT& acc, const Unit& u, int wr, int wc, int fr, int fq) const {
        const int row0 = u.pm * 256 + wr * 64 + fr, col0 = u.pn * 128 + wc * 32 + 8 * fq;
#pragma unroll
        for (int ai = 0; ai < 2; ++ai)
#pragma unroll
            for (int m = 0; m < 4; ++m) {
                float gv[8];
#pragma unroll
                for (int n = 0; n < 2; ++n)
#pragma unroll
                    for (int j = 0; j < 4; ++j) { const float a = acc[ai][0][m][n][j], b = acc[ai][1][m][n][j]; gv[n * 4 + j] = a * b * __builtin_amdgcn_rcpf(1.0f + __builtin_amdgcn_exp2f(a * -1.4426950408889634f)); }
                u32x4 w; w.x = pk2(gv[0], gv[1]); w.y = pk2(gv[2], gv[3]); w.z = pk2(gv[4], gv[5]); w.w = pk2(gv[6], gv[7]);
                *(u32x4*)(G + (size_t)(row0 + ai * 128 + m * 16) * FFH + col0) = w;
            }
    }
};
struct EpiResid {
    static constexpr bool PERM = true, RESCALE = false;
    const bf16_t* xin; bf16_t* xout; float* fout; float* xc; float* part; const float* mod; int gofs; float coef;
    __device__ __forceinline__ void operator()(const AccT& acc, const Unit& u, int wr, int wc, int fr, int fq) const {
        const int row0 = u.pm * 256 + wr * 64 + fr, col0 = u.pn * 256 + wc * 32 + 8 * fq;
        const bool lat = u.pm < 128;
        const int mr = lat ? (u.pm >> 4) : 8;
        const float* gp = mod + (size_t)mr * 9216 + gofs + col0;
#pragma unroll
        for (int bj = 0; bj < 2; ++bj) {
            const f32x4 g0 = *(const f32x4*)(gp + bj * 128) * coef, g1 = *(const f32x4*)(gp + bj * 128 + 4) * coef;
            if (lat) {
                u32x4 xw[8];
#pragma unroll
                for (int am = 0; am < 8; ++am) xw[am] = *(const u32x4*)(xin + (size_t)(row0 + (am >> 2) * 128 + (am & 3) * 16) * 1024 + col0 + bj * 128);
#pragma unroll
                for (int am = 0; am < 8; ++am) {
                    const int ai = am >> 2, m = am & 3;
                    const size_t o = (size_t)(row0 + ai * 128 + m * 16) * 1024 + col0 + bj * 128;
                    f32x4 v0 = {bflo(xw[am].x), bfhi(xw[am].x), bflo(xw[am].y), bfhi(xw[am].y)}, v1 = {bflo(xw[am].z), bfhi(xw[am].z), bflo(xw[am].w), bfhi(xw[am].w)};
                    v0 += g0 * acc[ai][bj][m][0]; v1 += g1 * acc[ai][bj][m][1];
                    if (fout) { *(f32x4*)(fout + o) = v0; *(f32x4*)(fout + o + 4) = v1; }
                    else { u32x4 w; w.x = pk2(v0[0], v0[1]); w.y = pk2(v0[2], v0[3]); w.z = pk2(v1[0], v1[1]); w.w = pk2(v1[2], v1[3]); *(u32x4*)(xout + o) = w; }
                }
            } else {
#pragma unroll
                for (int am = 0; am < 8; ++am) {
                    const int ai = am >> 2, m = am & 3;
                    const size_t o = (size_t)(row0 + ai * 128 + m * 16 - TL) * 1024 + col0 + bj * 128;
                    const f32x4 d0 = g0 * acc[ai][bj][m][0], d1 = g1 * acc[ai][bj][m][1];
                    if (u.split) { float* pp = part + (size_t)(u.split - 1) * 2048 * 1024 + o; *(f32x4*)pp = d0; *(f32x4*)(pp + 4) = d1; }
                    else { float* xp = xc + o; *(f32x4*)xp = *(const f32x4*)xp + d0; *(f32x4*)(xp + 4) = *(const f32x4*)(xp + 4) + d1; }
                }
            }
        }
    }
};
struct EpiIn {
    static constexpr bool PERM = true, RESCALE = false;
    bf16_t *qn, *kn, *vraw, *hyraw, *sgraw;
    __device__ __forceinline__ void operator()(const AccT& acc, const Unit& u, int wr, int wc, int fr, int fq) const {
        const int row0 = u.pm * 256 + wr * 64 + fr, pn = u.pn;
#pragma unroll
        for (int ai = 0; ai < 2; ++ai)
#pragma unroll
            for (int m = 0; m < 4; ++m) {
                const int r = row0 + ai * 128 + m * 16;
#pragma unroll
                for (int bj = 0; bj < 2; ++bj) {
                    const f32x4 v0 = acc[ai][bj][m][0], v1 = acc[ai][bj][m][1];
                    u32x4 w; w.x = pk2(v0[0], v0[1]); w.y = pk2(v0[2], v0[3]); w.z = pk2(v1[0], v1[1]); w.w = pk2(v1[2], v1[3]);
                    const int cl = bj * 128 + wc * 32 + 8 * fq;
                    bf16_t* dst;
                    if (pn < 4) {
                        int b, kidx; row_bk(r, b, kidx);
                        const int cc = (pn & 1) * 256 + cl, head = cc >> 7, comp = (cc >> 6) & 1, d = cc & 63;
                        dst = (pn < 2 ? qn : kn) + ((size_t)((b * 4 + head) * 2 + comp) * NK + kidx) * 64 + d;
                    } else if (pn < 6) dst = vraw + (size_t)r * 512 + (pn - 4) * 256 + cl;
                    else if (pn < 9) dst = hyraw + (size_t)r * 768 + (pn - 6) * 256 + cl;
                    else dst = sgraw + (size_t)r * 512 + (pn - 9) * 256 + cl;
                    *(u32x4*)dst = w;
                }
            }
    }
};
struct EpiGate3 {
    static constexpr bool PERM = true, RESCALE = false;
    bf16_t* g3; const float* bias;
    __device__ __forceinline__ void operator()(const AccT& acc, const Unit& u, int wr, int wc, int fr, int fq) const {
        const int row0 = u.pm * 256 + wr * 64 + fr, col0 = u.pn * 256 + wc * 32 + 8 * fq;
#pragma unroll
        for (int bj = 0; bj < 2; ++bj) {
            const f32x4 b0 = *(const f32x4*)(bias + col0 + bj * 128), b1 = *(const f32x4*)(bias + col0 + bj * 128 + 4);
#pragma unroll
            for (int ai = 0; ai < 2; ++ai)
#pragma unroll
                for (int m = 0; m < 4; ++m) {
                    const f32x4 v0 = acc[ai][bj][m][0] + b0, v1 = acc[ai][bj][m][1] + b1;
                    float gv[8];
#pragma unroll
                    for (int j = 0; j < 4; ++j) { gv[j] = fmaxf(sigmoidf_(v0[j]), 1e-5f); gv[4 + j] = fmaxf(sigmoidf_(v1[j]), 1e-5f); }
                    u32x4 w; w.x = pk2(gv[0], gv[1]); w.y = pk2(gv[2], gv[3]); w.z = pk2(gv[4], gv[5]); w.w = pk2(gv[6], gv[7]);
                    *(u32x4*)(g3 + (size_t)(row0 + ai * 128 + m * 16) * 3072 + col0 + bj * 128) = w;
                }
        }
    }
};
struct EpiMergeR {
    static constexpr bool PERM = true, RESCALE = true;
    const bf16_t* g3; bf16_t* mb;
    __device__ __forceinline__ void rescale(AccT& acc, const Unit& u, int which, int wr, int wc, int fr, int fq) const {
        const int row0 = u.pm * 256 + wr * 64 + fr, col0 = u.pn * 256 + wc * 32 + 8 * fq;
        const bf16_t* gb = g3 + (size_t)row0 * 3072 + which * 1024 + col0;
#pragma unroll
        for (int ai = 0; ai < 2; ++ai)
#pragma unroll
            for (int mh = 0; mh < 2; ++mh) {
                u32x4 nw[2][2], dw[2][2];
#pragma unroll
                for (int mm = 0; mm < 2; ++mm)
#pragma unroll
                    for (int bj = 0; bj < 2; ++bj) { const bf16_t* gp = gb + (size_t)(ai * 128 + (mh * 2 + mm) * 16) * 3072 + bj * 128; nw[mm][bj] = *(const u32x4*)gp; dw[mm][bj] = *(const u32x4*)(gp + 1024); }
#pragma unroll
                for (int mm = 0; mm < 2; ++mm)
#pragma unroll
                    for (int bj = 0; bj < 2; ++bj) {
                        const u32x4 n4 = nw[mm][bj], d4 = dw[mm][bj];
                        const f32x4 r0 = {bflo(n4.x) * __builtin_amdgcn_rcpf(bflo(d4.x)), bfhi(n4.x) * __builtin_amdgcn_rcpf(bfhi(d4.x)), bflo(n4.y) * __builtin_amdgcn_rcpf(bflo(d4.y)), bfhi(n4.y) * __builtin_amdgcn_rcpf(bfhi(d4.y))};
                        const f32x4 r1 = {bflo(n4.z) * __builtin_amdgcn_rcpf(bflo(d4.z)), bfhi(n4.z) * __builtin_amdgcn_rcpf(bfhi(d4.z)), bflo(n4.w) * __builtin_amdgcn_rcpf(bflo(d4.w)), bfhi(n4.w) * __builtin_amdgcn_rcpf(bfhi(d4.w))};
                        acc[ai][bj][mh * 2 + mm][0] *= r0; acc[ai][bj][mh * 2 + mm][1] *= r1;
                    }
                __builtin_amdgcn_sched_barrier(0);
            }
    }
    __device__ __forceinline__ void operator()(const AccT& acc, const Unit& u, int wr, int wc, int fr, int fq) const {
        const int row0 = u.pm * 256 + wr * 64 + fr, col0 = u.pn * 256 + wc * 32 + 8 * fq;
#pragma unroll
        for (int bj = 0; bj < 2; ++bj) {
            u32x4 gw[8];
#pragma unroll
            for (int am = 0; am < 8; ++am) gw[am] = *(const u32x4*)(g3 + (size_t)(row0 + (am >> 2) * 128 + (am & 3) * 16) * 3072 + 2048 + col0 + bj * 128);
#pragma unroll
            for (int am = 0; am < 8; ++am) {
                const int ai = am >> 2, m = am & 3;
                const f32x4 v0 = acc[ai][bj][m][0], v1 = acc[ai][bj][m][1];
                u32x4 w; w.x = pk2(v0[0] * bflo(gw[am].x), v0[1] * bfhi(gw[am].x)); w.y = pk2(v0[2] * bflo(gw[am].y), v0[3] * bfhi(gw[am].y));
                w.z = pk2(v1[0] * bflo(gw[am].z), v1[1] * bfhi(gw[am].z)); w.w = pk2(v1[2] * bflo(gw[am].w), v1[3] * bfhi(gw[am].w));
                *(u32x4*)(mb + (size_t)(row0 + ai * 128 + m * 16) * 1024 + col0 + bj * 128) = w;
            }
        }
    }
};

template <class Epi>
__device__ __forceinline__ void run_gemm(unsigned char* smem, const bf16_t* A, const bf16_t* Bt, int M, int N, int K, const Epi& E, bool split_tail = false) {
    asm volatile("" : "+s"(M), "+s"(N), "+s"(K));
    pg8::Gemm g; g.A = A; g.Bt = Bt; g.M = M; g.N = N; g.K = K;
    pg8::StaticOrder S; S.init(M, N, K, gridDim.x, blockIdx.x, split_tail);
    pg8::gemm_phase<Epi>((LAS unsigned char*)smem, g, S, E);
}

__device__ __forceinline__ void mod_item(const Params& p, unsigned char* smem, int m) {
    float* s = (float*)smem;
    float* red = s + 9 * 1024;
    const int tid = TID(), l = m / 144, cb = m % 144;
    __syncthreads();
    for (int i = tid; i < 9216; i += NT) { const float v = (i < 8192) ? p.c[i] : p.c_ctx[i - 8192]; s[i] = v / (1.0f + __expf(-v)); }
    __syncthreads();
    const int kg = tid >> 6, cn = tid & 63, col = cb * 64 + cn;
    const float* w = p.ada_w + (size_t)l * 1024 * 9216 + col;
    float a0 = 0, a1 = 0, a2 = 0, a3 = 0, a4 = 0, a5 = 0, a6 = 0, a7 = 0, a8 = 0;
    for (int k = kg * 128; k < kg * 128 + 128; ++k) {
        const float wv = w[(size_t)k * 9216];
        a0 += s[k] * wv; a1 += s[1024 + k] * wv; a2 += s[2048 + k] * wv; a3 += s[3072 + k] * wv; a4 += s[4096 + k] * wv;
        a5 += s[5120 + k] * wv; a6 += s[6144 + k] * wv; a7 += s[7168 + k] * wv; a8 += s[8192 + k] * wv;
    }
    float* rp = red + kg * 576 + cn;
    rp[0] = a0; rp[64] = a1; rp[128] = a2; rp[192] = a3; rp[256] = a4; rp[320] = a5; rp[384] = a6; rp[448] = a7; rp[512] = a8;
    __syncthreads();
    float* MOD = (float*)(p.ws + O_MOD);
    for (int i = tid; i < 576; i += NT) {
        float v = 0; for (int q = 0; q < 8; ++q) v += red[q * 576 + i];
        const int r = i >> 6, c2 = cb * 64 + (i & 63);
        MOD[((size_t)l * 9 + r) * 9216 + c2] = v + p.ada_b[(size_t)l * 9216 + c2];
    }
}

__device__ __forceinline__ void filt_item(const Params& p, unsigned char* smem, int l, int n, int item, float* filt, float* l1p) {
    float* z = (float*)smem;
    float* h1 = z + 16 * 36;
    float* h2 = h1 + 16 * 64;
    float* stage = h2 + 16 * 64;
    const int tid = TID(), t0 = item * 16;
    __syncthreads();
    for (int i = tid; i < 16 * 33; i += NT) {
        const int tt = i / 33, e = i % 33, t = t0 + tt; float v;
        if (e == 0) v = (float)t / (float)(n - 1);
        else { const int bi = (e - 1) & 15; const float band = 1e-4f + (float)bi * ((15.0f - 1e-4f) / 15.0f); const float wv = (6.283185307179586f / (float)n) * (float)t;
            v = (e <= 16) ? cosf(band * wv) : -sinf(band * wv); }
        z[tt * 36 + e] = v;
    }
    __syncthreads();
    for (int i = tid; i < 16 * 64; i += NT) {
        const int tt = i >> 6, j = i & 63; float a = p.hy_b1[l * 64 + j];
        for (int e = 0; e < 33; ++e) a += z[tt * 36 + e] * p.hy_w1[((size_t)l * 33 + e) * 64 + j];
        h1[i] = sinf(p.hy_freq[l * 64 + j] * a);
    }
    __syncthreads();
    for (int i = tid; i < 16 * 64; i += NT) {
        const int tt = i >> 6, j = i & 63; float a = p.hy_b2[l * 64 + j];
        for (int e = 0; e < 64; ++e) a += h1[tt * 64 + e] * p.hy_w2[((size_t)l * 64 + e) * 64 + j];
        h2[i] = sinf(p.hy_freq[l * 64 + j] * a);
    }
    __syncthreads();
    const float min_decay = -3.0701134573253945f, max_decay = -15.350567286626973f;
#pragma unroll 1
    for (int cc = 0; cc < 2; ++cc) {
        const int col = tid + cc * 512;
        float acc[16];
#pragma unroll
        for (int tt = 0; tt < 16; ++tt) acc[tt] = 0.f;
        for (int e = 0; e < 64; ++e) {
            const float wv = p.hy_w3[((size_t)l * 64 + e) * 1024 + col];
#pragma unroll
            for (int tt = 0; tt < 16; ++tt) acc[tt] += h2[tt * 64 + e] * wv;
        }
        const int oc = col & 511, dir = col >> 9;
        const float ad = fabsf(min_decay + (float)oc * ((max_decay - min_decay) / 511.0f));
        float l1 = 0.f;
#pragma unroll
        for (int tt = 0; tt < 16; ++tt) {
            const int t = t0 + tt; const float tn = (float)t / (float)(n - 1);
            float v = acc[tt] * __expf(-tn * ad);
            if (dir == 1 && t == 0) v = 0.f;
            stage[col * 17 + tt] = v;
            l1 += fabsf(v);
        }
        l1p[(size_t)item * 1024 + col] = l1;
    }
    __syncthreads();
#pragma unroll 4
    for (int k = 0; k < 32; ++k) {
        const int e = tid + k * NT, col = e >> 4, tt = e & 15, t = t0 + tt;
        const int oc = col & 511, dir = col >> 9;
        const int pos = (dir == 0) ? t : ((t == 0) ? n : 2 * n - t);
        filt[(size_t)oc * (2 * n) + pos] = stage[col * 17 + tt];
    }
}

struct WDesc { const float* src; bf16_t* dst; int ld, K; };
__device__ __forceinline__ WDesc wdesc(const Params& p, int l, int ti) {
    WDesc d; int K, nrb, mapsw = 0; const float* src; bf16_t* dst; int ld;
    const size_t L = (size_t)l;
    if (ti < 1408) { src = p.ffn_up + (L * 2 + 0) * 1024 * 5632; ld = 5632; K = 1024; dst = (bf16_t*)(p.ws + O_WUP0); mapsw = 1; }
    else if ((ti -= 1408) < 1408) { src = p.ffn_up + (L * 2 + 1) * 1024 * 5632; ld = 5632; K = 1024; dst = (bf16_t*)(p.ws + O_WUP1); mapsw = 1; }
    else if ((ti -= 1408) < 704) { src = p.ffn_down + (L * 2 + 0) * 2816 * 1024; ld = 1024; K = 2816; dst = (bf16_t*)(p.ws + O_WDN0); }
    else if ((ti -= 704) < 704) { src = p.ffn_down + (L * 2 + 1) * 2816 * 1024; ld = 1024; K = 2816; dst = (bf16_t*)(p.ws + O_WDN1); }
    else if ((ti -= 704) < 704) { src = p.w_in + L * 1024 * 2816; ld = 2816; K = 1024; dst = (bf16_t*)(p.ws + O_WIN); }
    else if ((ti -= 704) < 768) { src = p.gate_w + L * 1024 * 3072; ld = 3072; K = 1024; dst = (bf16_t*)(p.ws + O_WG); }
    else if ((ti -= 768) < 256) { src = p.w_br + L * 1024 * 1024; ld = 1024; K = 1024; dst = (bf16_t*)(p.ws + O_WBR); }
    else { ti -= 256; src = p.w_o + L * 1024 * 1024; ld = 1024; K = 1024; dst = (bf16_t*)(p.ws + O_WO); }
    nrb = K / 64;
    const int nb = ti / nrb, kb = ti % nrb, n0 = nb * 64, k0 = kb * 64;
    int scol = n0;
    if (mapsw) { const int pn = n0 >> 8, half = (n0 >> 7) & 1; scol = half * 2816 + pn * 128 + (n0 & 127); }
    d.src = src + (size_t)k0 * ld + scol; d.dst = dst + (size_t)n0 * K + k0; d.ld = ld; d.K = K;
    return d;
}
__device__ __forceinline__ void wconv_tiles(const Params& p, unsigned char* smem, int l, int nw) {
    float* tile = (float*)smem;
    const int tid = TID(), kk0 = tid >> 6, nn0 = tid & 63, nn = tid >> 3, ks = tid & 7;
    int ti = blockIdx.x;
    if (ti >= nw) return;
    WDesc d = wdesc(p, l, ti);
    float v[8];
#pragma unroll
    for (int i = 0; i < 8; ++i) v[i] = d.src[(size_t)(kk0 + 8 * i) * d.ld + nn0];
    for (;;) {
        const int tn = ti + gridDim.x; const bool more = tn < nw;
        WDesc dn = d; float vn[8];
        if (more) { dn = wdesc(p, l, tn);
#pragma unroll
            for (int i = 0; i < 8; ++i) vn[i] = dn.src[(size_t)(kk0 + 8 * i) * dn.ld + nn0]; }
        __syncthreads();
#pragma unroll
        for (int i = 0; i < 8; ++i) tile[(kk0 + 8 * i) * 65 + nn0] = v[i];
        __syncthreads();
        float o[8];
#pragma unroll
        for (int j = 0; j < 8; ++j) o[j] = tile[(ks * 8 + j) * 65 + nn];
        u32x4 w; w.x = pk2(o[0], o[1]); w.y = pk2(o[2], o[3]); w.z = pk2(o[4], o[5]); w.w = pk2(o[6], o[7]);
        *(u32x4*)(d.dst + (size_t)nn * d.K + ks * 8) = w;
        if (!more) break;
        d = dn; ti = tn;
#pragma unroll
        for (int i = 0; i < 8; ++i) v[i] = vn[i];
    }
}

__device__ __forceinline__ void aux_phase(const Params& p, unsigned char* smem, int l) {
    const int nmod = (l == 0) ? 288 : 0, nf = 256, nfc = (l == 0) ? 16 : 0, nw = 6208;
    const int total = nmod + nf + nfc;
    for (int rep = 0; rep < REP_AUX; ++rep) {
        for (int it = blockIdx.x; it < total; it += gridDim.x) {
            int i = it;
            if (i < nmod) { mod_item(p, smem, i); continue; }
            i -= nmod;
            if (i < nf) { filt_item(p, smem, l, 4096, i, (float*)(p.ws + O_FILT), (float*)(p.ws + O_L1P)); continue; }
            i -= nf;
            filt_item(p, smem, l, 256, i, (float*)(p.ws + O_FILTC), (float*)(p.ws + O_L1PC));
        }
        wconv_tiles(p, smem, l, nw);
    }
}

__device__ __forceinline__ void norm_phase(const Params& p, int l, int sub, int M, bool first, const bf16_t* xl) {
    const float* PART = (const float*)(p.ws + O_PART);
    const int tid = TID(), lane = tid & 63, wv = tid >> 6;
    const float* MOD = (const float*)(p.ws + O_MOD) + (size_t)l * 9 * 9216;
    const float* gn = p.norm_g + ((size_t)l * 3 + sub) * 1024;
    float* XC = (float*)(p.ws + O_XC);
    bf16_t* H = (bf16_t*)(p.ws + O_H);
    const int rstep = gridDim.x * 8;
    for (int rep = 0; rep < REP_NORM; ++rep)
    for (int r0 = blockIdx.x * 8 + wv; r0 < M; r0 += 4 * rstep) {
        f32x4 v[4][4]; float ss[4];
#pragma unroll
        for (int k = 0; k < 4; ++k) {
            const int r = r0 + k * rstep; ss[k] = 0.f;
            if (r >= M) { continue; }
            if (r >= TL) {
                const float* src = (first ? p.ctx : XC) + (size_t)(r - TL) * 1024;
#pragma unroll
                for (int i = 0; i < 4; ++i) { const size_t o = (size_t)(r - TL) * 1024 + i * 256 + lane * 4; v[k][i] = *(const f32x4*)(src + i * 256 + lane * 4);
                    if (!first) { v[k][i] += *(const f32x4*)(PART + o); v[k][i] += *(const f32x4*)(PART + 2048 * 1024 + o); v[k][i] += *(const f32x4*)(PART + 2 * 2048 * 1024 + o); v[k][i] += *(const f32x4*)(PART + 3 * 2048 * 1024 + o); } }
            } else if (first) {
                const float* src = p.x + (size_t)r * 1024;
#pragma unroll
                for (int i = 0; i < 4; ++i) v[k][i] = *(const f32x4*)(src + i * 256 + lane * 4);
            } else {
                const bf16_t* src = xl + (size_t)r * 1024;
#pragma unroll
                for (int i = 0; i < 4; ++i) { const u32x2 w = *(const u32x2*)(src + i * 256 + lane * 4); v[k][i] = (f32x4){bflo(w.x), bfhi(w.x), bflo(w.y), bfhi(w.y)}; }
            }
        }
#pragma unroll
        for (int k = 0; k < 4; ++k) {
            const int r = r0 + k * rstep;
            if (r >= M) continue;
            if (r >= TL) {
#pragma unroll
                for (int i = 0; i < 4; ++i) *(f32x4*)(XC + (size_t)(r - TL) * 1024 + i * 256 + lane * 4) = v[k][i];
            } else if (first) {
                bf16_t* dstx = (bf16_t*)p.out + (size_t)r * 1024;
#pragma unroll
                for (int i = 0; i < 4; ++i) { u32x2 w; w.x = pk2(v[k][i][0], v[k][i][1]); w.y = pk2(v[k][i][2], v[k][i][3]); *(u32x2*)(dstx + i * 256 + lane * 4) = w; v[k][i] = (f32x4){bflo(w.x), bfhi(w.x), bflo(w.y), bfhi(w.y)}; }
            }
            float s2 = 0.f;
#pragma unroll
            for (int i = 0; i < 4; ++i) s2 += v[k][i][0] * v[k][i][0] + v[k][i][1] * v[k][i][1] + v[k][i][2] * v[k][i][2] + v[k][i][3] * v[k][i][3];
            s2 = wave_sum(s2);
            const float rinv = rsqrtf(s2 * (1.0f / 1024.0f) + 1e-6f);
            const int mr = r < TL ? (r >> 12) : 8;
            const float* sh = MOD + (size_t)mr * 9216 + (3 * sub) * 1024;
            const float* sc = sh + 1024;
#pragma unroll
            for (int i = 0; i < 4; ++i) {
                const int c = i * 256 + lane * 4;
                const f32x4 g4 = *(const f32x4*)(gn + c), s4 = *(const f32x4*)(sc + c), h4 = *(const f32x4*)(sh + c);
                const f32x4 y = v[k][i] * rinv * g4 * (s4 + 1.0f) + h4;
                u32x2 w; w.x = pk2(y[0], y[1]); w.y = pk2(y[2], y[3]);
                *(u32x2*)(H + (size_t)r * 1024 + c) = w;
            }
        }
    }
}

#define ZI(i) ((i) + ((i) >> 4))
__device__ __forceinline__ f32x2 cmul(f32x2 a, f32x2 b) { return (f32x2){a.x * b.x - a.y * b.y, a.x * b.y + a.y * b.x}; }
__device__ __forceinline__ f32x2 cmulc(f32x2 a, f32x2 b) { return (f32x2){a.x * b.x + a.y * b.y, a.y * b.x - a.x * b.y}; }
__device__ __forceinline__ void dif8(f32x2 (&x)[8]) {
    const float C = 0.70710678118654752f;
    { f32x2 t;
      t = x[0] - x[4]; x[0] += x[4]; x[4] = t;
      t = x[1] - x[5]; x[1] += x[5]; x[5] = (f32x2){C * (t.x + t.y), C * (t.y - t.x)};
      t = x[2] - x[6]; x[2] += x[6]; x[6] = (f32x2){t.y, -t.x};
      t = x[3] - x[7]; x[3] += x[7]; x[7] = (f32x2){C * (t.y - t.x), -C * (t.x + t.y)}; }
#pragma unroll
    for (int b = 0; b < 8; b += 4) { f32x2 t;
      t = x[b] - x[b + 2]; x[b] += x[b + 2]; x[b + 2] = t;
      t = x[b + 1] - x[b + 3]; x[b + 1] += x[b + 3]; x[b + 3] = (f32x2){t.y, -t.x}; }
#pragma unroll
    for (int b = 0; b < 8; b += 2) { const f32x2 t = x[b] - x[b + 1]; x[b] += x[b + 1]; x[b + 1] = t; }
}
__device__ __forceinline__ void idif8(f32x2 (&x)[8]) {
    const float C = 0.70710678118654752f;
#pragma unroll
    for (int b = 0; b < 8; b += 2) { const f32x2 t = x[b] - x[b + 1]; x[b] += x[b + 1]; x[b + 1] = t; }
#pragma unroll
    for (int b = 0; b < 8; b += 4) { f32x2 v, u;
      v = x[b + 2]; u = x[b]; x[b] = u + v; x[b + 2] = u - v;
      v = (f32x2){-x[b + 3].y, x[b + 3].x}; u = x[b + 1]; x[b + 1] = u + v; x[b + 3] = u - v; }
    { f32x2 v, u, t;
      v = x[4]; u = x[0]; x[0] = u + v; x[4] = u - v;
      t = x[5]; v = (f32x2){C * (t.x - t.y), C * (t.x + t.y)}; u = x[1]; x[1] = u + v; x[5] = u - v;
      t = x[6]; v = (f32x2){-t.y, t.x}; u = x[2]; x[2] = u + v; x[6] = u - v;
      t = x[7]; v = (f32x2){-C * (t.x + t.y), C * (t.x - t.y)}; u = x[3]; x[3] = u + v; x[7] = u - v; }
}
__device__ __forceinline__ void twid8(f32x2 (&x)[8], int pidx, int L, bool conj) {
    const float rev = -(float)pidx / (float)L;
    const float s = __builtin_amdgcn_sinf(rev), c = __builtin_amdgcn_cosf(rev);
    const f32x2 w1 = {c, s}; const f32x2 w2 = cmul(w1, w1), w3 = cmul(w2, w1), w4 = cmul(w2, w2), w5 = cmul(w4, w1), w6 = cmul(w3, w3), w7 = cmul(w4, w3);
    if (!conj) { x[1] = cmul(x[1], w4); x[2] = cmul(x[2], w2); x[3] = cmul(x[3], w6); x[4] = cmul(x[4], w1); x[5] = cmul(x[5], w5); x[6] = cmul(x[6], w3); x[7] = cmul(x[7], w7); }
    else { x[1] = cmulc(x[1], w4); x[2] = cmulc(x[2], w2); x[3] = cmulc(x[3], w6); x[4] = cmulc(x[4], w1); x[5] = cmulc(x[5], w5); x[6] = cmulc(x[6], w3); x[7] = cmulc(x[7], w7); }
}
__device__ __forceinline__ void fft_fwd(f32x2* z) {
    const int tid = TID();
#pragma unroll 1
    for (int L = 8192; L >= 16; L >>= 3) {
        const int S = L >> 3;
#pragma unroll
        for (int qq = 0; qq < 2; ++qq) { const int q = tid + qq * NT;
            const int pidx = q & (S - 1), B = (q / S) * L + pidx;
            f32x2 x[8];
#pragma unroll
            for (int j = 0; j < 8; ++j) x[j] = z[ZI(B + j * S)];
            dif8(x); twid8(x, pidx, L, false);
#pragma unroll
            for (int j = 0; j < 8; ++j) z[ZI(B + j * S)] = x[j];
        }
        __syncthreads();
    }
#pragma unroll 4
    for (int q = tid; q < 4096; q += NT) { const f32x2 a = z[ZI(2 * q)], b = z[ZI(2 * q + 1)]; z[ZI(2 * q)] = a + b; z[ZI(2 * q + 1)] = a - b; }
    __syncthreads();
}
__device__ __forceinline__ void fft_inv(f32x2* z) {
    const int tid = TID();
#pragma unroll 4
    for (int q = tid; q < 4096; q += NT) { const f32x2 a = z[ZI(2 * q)], b = z[ZI(2 * q + 1)]; z[ZI(2 * q)] = a + b; z[ZI(2 * q + 1)] = a - b; }
    __syncthreads();
#pragma unroll 1
    for (int L = 16; L <= 8192; L <<= 3) {
        const int S = L >> 3;
#pragma unroll
        for (int qq = 0; qq < 2; ++qq) { const int q = tid + qq * NT;
            const int pidx = q & (S - 1), B = (q / S) * L + pidx;
            f32x2 x[8];
#pragma unroll
            for (int j = 0; j < 8; ++j) x[j] = z[ZI(B + j * S)];
            twid8(x, pidx, L, true); idif8(x);
#pragma unroll
            for (int j = 0; j < 8; ++j) z[ZI(B + j * S)] = x[j];
        }
        __syncthreads();
    }
}

__device__ __forceinline__ void fft_fwd_h(f32x2* z, int lt) {
#pragma unroll 1
    for (int L = 8192; L >= 16; L >>= 3) {
        const int S = L >> 3;
#pragma unroll 2
        for (int qq = 0; qq < 4; ++qq) { const int q = lt + qq * 256;
            const int pidx = q & (S - 1), B = (q / S) * L + pidx;
            f32x2 x[8];
#pragma unroll
            for (int j = 0; j < 8; ++j) x[j] = z[ZI(B + j * S)];
            dif8(x); twid8(x, pidx, L, false);
#pragma unroll
            for (int j = 0; j < 8; ++j) z[ZI(B + j * S)] = x[j];
        }
        __syncthreads();
    }
#pragma unroll 4
    for (int q = lt; q < 4096; q += 256) { const f32x2 a = z[ZI(2 * q)], b = z[ZI(2 * q + 1)]; z[ZI(2 * q)] = a + b; z[ZI(2 * q + 1)] = a - b; }
    __syncthreads();
}
__device__ __forceinline__ void fft_inv_h(f32x2* z, int lt) {
#pragma unroll 4
    for (int q = lt; q < 4096; q += 256) { const f32x2 a = z[ZI(2 * q)], b = z[ZI(2 * q + 1)]; z[ZI(2 * q)] = a + b; z[ZI(2 * q + 1)] = a - b; }
    __syncthreads();
#pragma unroll 1
    for (int L = 16; L <= 8192; L <<= 3) {
        const int S = L >> 3;
#pragma unroll 2
        for (int qq = 0; qq < 4; ++qq) { const int q = lt + qq * 256;
            const int pidx = q & (S - 1), B = (q / S) * L + pidx;
            f32x2 x[8];
#pragma unroll
            for (int j = 0; j < 8; ++j) x[j] = z[ZI(B + j * S)];
            twid8(x, pidx, L, true); idif8(x);
#pragma unroll
            for (int j = 0; j < 8; ++j) z[ZI(B + j * S)] = x[j];
        }
        __syncthreads();
    }
}

__device__ __forceinline__ void filtfft_item(const Params& p, unsigned char* smem, int oc) {
    f32x2* z = (f32x2*)smem;
    float* red = (float*)(smem + 8704 * 8);
    const int tid = TID();
    const float* filt = (const float*)(p.ws + O_FILT) + (size_t)oc * 8192;
    const float* l1p = (const float*)(p.ws + O_L1P);
    __syncthreads();
#pragma unroll 4
    for (int i = tid; i < 8192; i += NT) z[ZI(i)] = (f32x2){filt[i], 0.f};
    if (tid < 256) red[tid] = l1p[(size_t)tid * 1024 + oc] + l1p[(size_t)tid * 1024 + 512 + oc];
    __syncthreads();
    if (tid < 64) { float v = red[tid] + red[tid + 64] + red[tid + 128] + red[tid + 192]; v = wave_sum(v); if (tid == 0) red[256] = v; }
    fft_fwd(z);
    const float sc = 1.0f / (red[256] * 8192.0f);
    f32x2* fh = (f32x2*)(p.ws + O_FH) + (size_t)oc * 8192;
#pragma unroll 4
    for (int i = tid; i < 8192; i += NT) fh[i] = z[ZI(i)] * sc;
}

__device__ __forceinline__ void hyfft_item(const Params& p, unsigned char* smem, int l, int ch, int bp) {
    f32x2* z = (f32x2*)smem;
    f32x2* zz = (f32x2*)(smem + 8704 * 8);
    const int tid = TID();
    const bf16_t* HV = (const bf16_t*)(p.ws + O_HV);
    const bf16_t* v0 = HV + ((size_t)(2 * bp) * 768 + ch) * 4096; const bf16_t* v1 = v0 + (size_t)768 * 4096;
    const f32x2* fh0 = (const f32x2*)(p.ws + O_FH) + (size_t)ch * 8192; const f32x2* fh1 = fh0 + (size_t)256 * 8192;
    const float sk0 = p.hy_skip[(size_t)l * 512 + ch], sk1 = p.hy_skip[(size_t)l * 512 + 256 + ch];
    bf16_t a0[8], a1[8];
#pragma unroll
    for (int k = 0; k < 8; ++k) { a0[k] = v0[tid + k * NT]; a1[k] = v1[tid + k * NT]; }
    f32x2 fr[16];
#pragma unroll
    for (int k = 0; k < 16; ++k) fr[k] = fh0[tid + k * NT];
    __syncthreads();
#pragma unroll
    for (int k = 0; k < 8; ++k) { const int t = tid + k * NT; z[ZI(t)] = (f32x2){bf2f(a0[k]), bf2f(a1[k])}; z[ZI(4096 + t)] = (f32x2){0.f, 0.f}; }
    __syncthreads();
    fft_fwd(z);
#pragma unroll
    for (int k = 0; k < 16; ++k) { const int i = tid + k * NT; z[ZI(i)] = cmul(z[ZI(i)], fr[k]); }
    bf16_t x0[8], x1[8];
#pragma unroll
    for (int k = 0; k < 8; ++k) { x0[k] = v0[(size_t)256 * 4096 + tid + k * NT]; x1[k] = v1[(size_t)256 * 4096 + tid + k * NT]; }
#pragma unroll
    for (int k = 0; k < 16; ++k) fr[k] = fh1[tid + k * NT];
    __syncthreads();
    fft_inv(z);
#pragma unroll
    for (int k = 0; k < 8; ++k) {
        const int t = tid + k * NT;
        f32x2 y = z[ZI(t)];
        y.x += bf2f(a0[k]) * sk0; y.y += bf2f(a1[k]) * sk0;
        const f32x2 zv = {bf2f(x0[k]) * y.x, bf2f(x1[k]) * y.y};
        zz[t] = zv; z[ZI(t)] = zv; z[ZI(4096 + t)] = (f32x2){0.f, 0.f};
    }
    __syncthreads();
    fft_fwd(z);
#pragma unroll
    for (int k = 0; k < 16; ++k) { const int i = tid + k * NT; z[ZI(i)] = cmul(z[ZI(i)], fr[k]); }
#pragma unroll
    for (int k = 0; k < 8; ++k) { x0[k] = v0[(size_t)512 * 4096 + tid + k * NT]; x1[k] = v1[(size_t)512 * 4096 + tid + k * NT]; }
    __syncthreads();
    fft_inv(z);
    bf16_t* YBT = (bf16_t*)(p.ws + O_YBT);
    bf16_t* o0 = YBT + ((size_t)(2 * bp) * 256 + ch) * 4096; bf16_t* o1 = o0 + (size_t)256 * 4096;
#pragma unroll
    for (int k = 0; k < 8; ++k) {
        const int t = tid + k * NT;
        const f32x2 y = z[ZI(t)] + zz[t] * sk1;
        o0[t] = f2bf(bf2f(x0[k]) * y.x); o1[t] = f2bf(bf2f(x1[k]) * y.y);
    }
}

__device__ __forceinline__ void hyfft_pair(const Params& p, unsigned char* smem, int l, int ch, int pp) {
    const int tid = TID(), hf = __builtin_amdgcn_readfirstlane(tid >> 8), lt = tid & 255, bp = 2 * pp + hf;
    f32x2* z = (f32x2*)(smem + (size_t)hf * 8704 * 8);
    const bf16_t* HV = (const bf16_t*)(p.ws + O_HV);
    const bf16_t* v0 = HV + ((size_t)(2 * bp) * 768 + ch) * 4096; const bf16_t* v1 = v0 + (size_t)768 * 4096;
    const f32x2* fh0 = (const f32x2*)(p.ws + O_FH) + (size_t)ch * 8192; const f32x2* fh1 = fh0 + (size_t)256 * 8192;
    const float sk0 = p.hy_skip[(size_t)l * 512 + ch], sk1 = p.hy_skip[(size_t)l * 512 + 256 + ch];
    unsigned av[16];
#pragma unroll
    for (int k = 0; k < 16; ++k) av[k] = (unsigned)v0[lt + k * 256] | ((unsigned)v1[lt + k * 256] << 16);
    f32x2 fr[32];
#pragma unroll
    for (int k = 0; k < 32; ++k) fr[k] = fh0[lt + k * 256];
    __syncthreads();
#pragma unroll
    for (int k = 0; k < 16; ++k) { const int t = lt + k * 256; z[ZI(t)] = (f32x2){bflo(av[k]), bfhi(av[k])}; z[ZI(4096 + t)] = (f32x2){0.f, 0.f}; }
    __syncthreads();
    fft_fwd_h(z, lt);
#pragma unroll
    for (int k = 0; k < 32; ++k) { const int i = lt + k * 256; z[ZI(i)] = cmul(z[ZI(i)], fr[k]); }
    unsigned xv[16];
#pragma unroll
    for (int k = 0; k < 16; ++k) xv[k] = (unsigned)v0[(size_t)256 * 4096 + lt + k * 256] | ((unsigned)v1[(size_t)256 * 4096 + lt + k * 256] << 16);
#pragma unroll
    for (int k = 0; k < 32; ++k) fr[k] = fh1[lt + k * 256];
    __syncthreads();
    fft_inv_h(z, lt);
    f32x2 zz[16];
#pragma unroll
    for (int k = 0; k < 16; ++k) {
        const int t = lt + k * 256;
        f32x2 y = z[ZI(t)];
        y.x += bflo(av[k]) * sk0; y.y += bfhi(av[k]) * sk0;
        const f32x2 zv = {bflo(xv[k]) * y.x, bfhi(xv[k]) * y.y};
        zz[k] = zv; z[ZI(t)] = zv; z[ZI(4096 + t)] = (f32x2){0.f, 0.f};
    }
    __syncthreads();
    fft_fwd_h(z, lt);
#pragma unroll
    for (int k = 0; k < 32; ++k) { const int i = lt + k * 256; z[ZI(i)] = cmul(z[ZI(i)], fr[k]); }
#pragma unroll
    for (int k = 0; k < 16; ++k) xv[k] = (unsigned)v0[(size_t)512 * 4096 + lt + k * 256] | ((unsigned)v1[(size_t)512 * 4096 + lt + k * 256] << 16);
    __syncthreads();
    fft_inv_h(z, lt);
    bf16_t* YBT = (bf16_t*)(p.ws + O_YBT);
    bf16_t* o0 = YBT + ((size_t)(2 * bp) * 256 + ch) * 4096; bf16_t* o1 = o0 + (size_t)256 * 4096;
#pragma unroll
    for (int k = 0; k < 16; ++k) {
        const int t = lt + k * 256;
        const f32x2 y = z[ZI(t)] + zz[k] * sk1;
        o0[t] = f2bf(bflo(xv[k]) * y.x); o1[t] = f2bf(bfhi(xv[k]) * y.y);
    }
}

__device__ __forceinline__ void hyctx_item(const Params& p, unsigned char* smem, int l, int b, int cp) {
    float* f1 = (float*)smem;
    float* f2 = f1 + 1024;
    float* vv = f2 + 1024;
    float* zc = vv + 512;
    float* red = zc + 512;
    const int tid = TID(), hf = tid >> 8, t = tid & 255, ch = cp * 2 + hf;
    const float* FC = (const float*)(p.ws + O_FILTC); const float* l1p = (const float*)(p.ws + O_L1PC);
    const bf16_t* HVC = (const bf16_t*)(p.ws + O_HVC) + ((size_t)b * 768 + ch) * 256;
    __syncthreads();
    f1[hf * 512 + t] = FC[(size_t)ch * 512 + t]; f1[hf * 512 + 256 + t] = FC[(size_t)ch * 512 + 256 + t];
    f2[hf * 512 + t] = FC[(size_t)(256 + ch) * 512 + t]; f2[hf * 512 + 256 + t] = FC[(size_t)(256 + ch) * 512 + 256 + t];
    const float vt = bf2f(HVC[t]); vv[hf * 256 + t] = vt;
    if (t < 2) { float s = 0.f; for (int it = 0; it < 16; ++it) s += l1p[(size_t)it * 1024 + t * 256 + ch] + l1p[(size_t)it * 1024 + 512 + t * 256 + ch]; red[hf * 2 + t] = s; }
    __syncthreads();
    float a = 0.f;
    for (int s = 0; s < 256; ++s) a += f1[hf * 512 + ((t - s) & 511)] * vv[hf * 256 + s];
    const float y1 = a / red[hf * 2 + 0] + vt * p.hy_skip[(size_t)l * 512 + ch];
    const float zt = bf2f(HVC[(size_t)256 * 256 + t]) * y1; zc[hf * 256 + t] = zt;
    __syncthreads();
    float a2 = 0.f;
    for (int s = 0; s < 256; ++s) a2 += f2[hf * 512 + ((t - s) & 511)] * zc[hf * 256 + s];
    const float y2 = a2 / red[hf * 2 + 1] + zt * p.hy_skip[(size_t)l * 512 + 256 + ch];
    bf16_t* YBTC = (bf16_t*)(p.ws + O_YBTC);
    YBTC[((size_t)b * 256 + ch) * 256 + t] = f2bf(bf2f(HVC[(size_t)512 * 256 + t]) * y2);
}

__device__ __forceinline__ void qk_item(const Params& p, int l, int item, bool dry = false) {
    const int tid = TID(), seg = tid & 7, vsub = tid >> 3;
    const int which = (item >= 544) ? 1 : 0;
    const int vbase = (item - which * 544) * 512;
    bf16_t* base = (bf16_t*)(p.ws + (which ? O_KN : O_QN));
    u32x4 raw[8];
#pragma unroll
    for (int it = 0; it < 8; ++it) raw[it] = *(const u32x4*)(base + (size_t)(vbase + it * 64 + vsub) * 64 + seg * 8);
    const float* gp = p.qk_gain + (size_t)l * 128 + which * 64 + seg * 8;
    const f32x4 g0 = *(const f32x4*)gp, g1 = *(const f32x4*)(gp + 4);
    const float gn[8] = {g0[0], g0[1], g0[2], g0[3], g1[0], g1[1], g1[2], g1[3]};
    const float qs = which ? 1.0f : (0.125f * 1.4426950408889634f);
    const int axis = seg >> 2, role = (seg >> 1) & 1, qb = (seg & 1) * 8;
    float inv[8];
#pragma unroll
    for (int e = 0; e < 8; ++e) inv[e] = exp2f(-(float)(qb + e) * (13.287712379549449f / 16.0f));
#pragma unroll
    for (int it = 0; it < 8; ++it) {
        const int rem = vbase + it * 64 + vsub, kidx = rem % NK;
        const u32x4 w = raw[it];
        float v[8] = {bflo(w.x), bfhi(w.x), bflo(w.y), bfhi(w.y), bflo(w.z), bfhi(w.z), bflo(w.w), bfhi(w.w)};
        float ss = 0.f;
#pragma unroll
        for (int e = 0; e < 8; ++e) ss += v[e] * v[e];
        ss += __shfl_xor(ss, 1); ss += __shfl_xor(ss, 2); ss += __shfl_xor(ss, 4);
        const float rinv = rsqrtf(ss * (1.0f / 64.0f) + 1e-6f) * qs;
#pragma unroll
        for (int e = 0; e < 8; ++e) v[e] = v[e] * rinv * gn[e];
        const int t = kidx - 256;
        const float pos = (float)(axis ? (t & 63) : (t >> 6));
        float o[8];
#pragma unroll
        for (int e = 0; e < 8; ++e) {
            const float pe = __shfl_xor(v[e], 2);
            float sn, cs; __sincosf(pos * inv[e], &sn, &cs);
            const float r = role ? (pe * sn + v[e] * cs) : (v[e] * cs - pe * sn);
            o[e] = (kidx >= 256) ? r : v[e];
        }
        u32x4 ow = {pk2(o[0], o[1]), pk2(o[2], o[3]), pk2(o[4], o[5]), pk2(o[6], o[7])};
        if (dry) ow = w;
        *(u32x4*)(base + (size_t)rem * 64 + seg * 8) = ow;
    }
}

__device__ __forceinline__ void vt_item(const Params& p, unsigned char* smem, int tb) {
    bf16_t* tile = (bf16_t*)smem;
    const int tid = TID(), r0 = tb * 64;
    const bf16_t* src = (const bf16_t*)(p.ws + O_VRAW) + (size_t)r0 * 512;
    __syncthreads();
#pragma unroll
    for (int i = 0; i < 8; ++i) { const int e = tid + i * NT, rr = e >> 6, sg = e & 63; *(u32x4*)(tile + rr * 520 + sg * 8) = *(const u32x4*)(src + (size_t)rr * 512 + sg * 8); }
    __syncthreads();
    int b, kidx0; row_bk(r0, b, kidx0);
    bf16_t* tr = tile + 64 * 520;
#pragma unroll
    for (int s = 0; s < 8; ++s) {
        unsigned w[4];
#pragma unroll
        for (int j = 0; j < 4; ++j) w[j] = (unsigned)tile[(s * 8 + 2 * j) * 520 + tid] | ((unsigned)tile[(s * 8 + 2 * j + 1) * 520 + tid] << 16);
        *(u32x4*)(tr + tid * 72 + s * 8) = (u32x4){w[0], w[1], w[2], w[3]};
    }
    __syncthreads();
    bf16_t* dst = (bf16_t*)(p.ws + O_VT) + (size_t)b * 512 * NK + kidx0;
#pragma unroll
    for (int ps = 0; ps < 8; ++ps) {
        const int c = (tid >> 3) + 64 * ps, sg = tid & 7;
        *(u32x4*)(dst + (size_t)c * NK + sg * 8) = *(const u32x4*)(tr + c * 72 + sg * 8);
    }
}

__device__ __forceinline__ void hyconv_item(const Params& p, unsigned char* smem, int l, int tb) {
    bf16_t* tile = (bf16_t*)smem;
    const int tid = TID(), r0 = tb * 64;
    const bool lat = r0 < TL;
    const int n = lat ? 4096 : 256, rb = lat ? r0 : r0 - TL, b = rb / n, t0 = rb % n;
    const bf16_t* src = (const bf16_t*)(p.ws + O_HYRAW);
    __syncthreads();
    {
        u32x4 wv[13];
#pragma unroll
        for (int k = 0; k < 13; ++k) {
            const int e = tid + k * NT, rr = e / 96, sg = e % 96, t = t0 - 1 + rr;
            wv[k] = (u32x4){0u, 0u, 0u, 0u};
            if (e < 66 * 96 && t >= 0 && t < n) wv[k] = *(const u32x4*)(src + (size_t)(r0 - 1 + rr) * 768 + sg * 8);
        }
#pragma unroll
        for (int k = 0; k < 13; ++k) { const int e = tid + k * NT, rr = e / 96, sg = e % 96; if (e < 66 * 96) *(u32x4*)(tile + rr * 776 + sg * 8) = wv[k]; }
    }
    __syncthreads();
    const float* cw = p.hy_conv_w + (size_t)l * 3 * 768; const float* cb = p.hy_conv_b + (size_t)l * 768;
    for (int c = tid; c < 768; c += NT) {
        const float w0 = cw[c], w1 = cw[768 + c], w2 = cw[1536 + c], bb = cb[c];
        bf16_t* dst = lat ? (bf16_t*)(p.ws + O_HV) + ((size_t)b * 768 + c) * 4096 + t0 : (bf16_t*)(p.ws + O_HVC) + ((size_t)b * 768 + c) * 256 + t0;
        float pm = bf2f(tile[c]), pc = bf2f(tile[776 + c]);
#pragma unroll
        for (int s = 0; s < 8; ++s) {
            float o[8];
#pragma unroll
            for (int j = 0; j < 8; ++j) { const float pn = bf2f(tile[(s * 8 + j + 2) * 776 + c]); o[j] = pm * w0 + pc * w1 + pn * w2 + bb; pm = pc; pc = pn; }
            *(u32x4*)(dst + s * 8) = (u32x4){pk2(o[0], o[1]), pk2(o[2], o[3]), pk2(o[4], o[5]), pk2(o[6], o[7])};
        }
    }
}

__device__ __forceinline__ float gelu_exact(float v) { return 0.5f * v * (1.0f + erff(v * 0.70710678118654752f)); }
__device__ __forceinline__ void sgu_item(const Params& p, unsigned char* smem, int l, int ci) {
    bf16_t* vt = (bf16_t*)smem;
    const int tid = TID(), lane = tid & 63, wv = __builtin_amdgcn_readfirstlane(tid >> 6), r0 = ci * 128;
    const bf16_t* src = (const bf16_t*)(p.ws + O_SGRAW) + (size_t)r0 * 512;
    const float* lg = p.sg_ln_g + (size_t)l * 256; const float* lb = p.sg_ln_b + (size_t)l * 256;
    __syncthreads();
    {
        const f32x4 g4 = *(const f32x4*)(lg + lane * 4), b4 = *(const f32x4*)(lb + lane * 4);
        u32x2 wr_[16];
#pragma unroll
        for (int k = 0; k < 16; ++k) wr_[k] = *(const u32x2*)(src + (size_t)(wv + 8 * k) * 512 + 256 + lane * 4);
#pragma unroll
        for (int k = 0; k < 16; ++k) {
            const int rr = wv + 8 * k; const u32x2 w = wr_[k];
            float a[4] = {gelu_exact(bflo(w.x)), gelu_exact(bfhi(w.x)), gelu_exact(bflo(w.y)), gelu_exact(bfhi(w.y))};
            const float mu = wave_sum(a[0] + a[1] + a[2] + a[3]) * (1.0f / 256.0f);
            float d[4]; float sq = 0.f;
#pragma unroll
            for (int j = 0; j < 4; ++j) { d[j] = a[j] - mu; sq += d[j] * d[j]; }
            const float rstd = rsqrtf(wave_sum(sq) * (1.0f / 256.0f) + 1e-6f);
#pragma unroll
            for (int j = 0; j < 4; ++j) vt[(lane * 4 + j) * 136 + rr] = f2bf(d[j] * rstd * g4[j] + b4[j]);
        }
    }
    __syncthreads();
    const int g = wv & 3, ih = wv >> 2, l32 = lane & 31, kg = lane >> 5;
    const float* wsb = p.sg_w + ((size_t)l * 4 + g) * 128 * 128;
    const float* bsb = p.sg_b + ((size_t)l * 4 + g) * 128;
    bf16_t* yc = (bf16_t*)(p.ws + O_YCAT) + 768;
#pragma unroll 1
    for (int ib = 0; ib < 2; ++ib) {
        const int i0 = ih * 64 + ib * 32;
        f32x16 acc0, acc1;
#pragma unroll
        for (int r = 0; r < 16; ++r) { acc0[r] = 0.f; acc1[r] = 0.f; }
        const float* wrow = wsb + (size_t)(i0 + l32) * 128 + 8 * kg;
#pragma unroll
        for (int ks = 0; ks < 8; ++ks) {
            const f32x4 w0 = *(const f32x4*)(wrow + 16 * ks), w1 = *(const f32x4*)(wrow + 16 * ks + 4);
            const u32x4 aw = {pk2(w0[0], w0[1]), pk2(w0[2], w0[3]), pk2(w1[0], w1[1]), pk2(w1[2], w1[3])};
            const bf16x8 af = __builtin_bit_cast(bf16x8, aw);
            const bf16x8 b0 = *(const bf16x8*)(vt + (g * 64 + l32) * 136 + 16 * ks + 8 * kg);
            const bf16x8 b1 = *(const bf16x8*)(vt + (g * 64 + 32 + l32) * 136 + 16 * ks + 8 * kg);
            acc0 = __builtin_amdgcn_mfma_f32_32x32x16_bf16(af, b0, acc0, 0, 0, 0);
            acc1 = __builtin_amdgcn_mfma_f32_32x32x16_bf16(af, b1, acc1, 0, 0, 0);
        }
#pragma unroll
        for (int r = 0; r < 16; ++r) {
            const int i = i0 + 8 * (r >> 2) + 4 * kg + (r & 3);
            const float bi = bsb[i];
            const int c0 = g * 64 + l32, c1 = c0 + 32;
            const float u0 = gelu_exact(bf2f(src[(size_t)i * 512 + c0])), u1 = gelu_exact(bf2f(src[(size_t)i * 512 + c1]));
            yc[(size_t)(r0 + i) * 1024 + c0] = f2bf(u0 * (acc0[r] + bi));
            yc[(size_t)(r0 + i) * 1024 + c1] = f2bf(u1 * (acc1[r] + bi));
        }
    }
}

__device__ __forceinline__ void prep_phase(const Params& p, unsigned char* smem, int l) {
    const int n_sg = 0, n_hy = 544, n_vt = 544, n_qk = 1088;
    const int total = n_sg + n_hy + n_vt + n_qk;
    for (int it = blockIdx.x; it < total; it += gridDim.x) {
        int i = it;
        if (i < n_sg) { for (int rep = 0; rep < REP_SGU; ++rep) sgu_item(p, smem, l, i); continue; }
        i -= n_sg;
        if (i < n_hy) { for (int rep = 0; rep < REP_PREP; ++rep) hyconv_item(p, smem, l, i); continue; }
        i -= n_hy;
        if (i < n_vt) { for (int rep = 0; rep < REP_PREP; ++rep) vt_item(p, smem, i); continue; }
        i -= n_vt;
#if REP_QK > 1
        qk_item(p, l, i, true);
#endif
        qk_item(p, l, i);
    }
}

__device__ __forceinline__ void attn_item(const Params& p, unsigned char* smem, int b, int h, int comp, int q0, int rowbase, int nkt) {
    constexpr int ABUF = 64 * 72 + 128 * 72;
    bf16_t* Ks = (bf16_t*)smem;
    bf16_t* Vs = Ks + 64 * 72;
    const int tid = TID(), lane = tid & 63, w = tid >> 6, l32 = lane & 31, g = lane >> 5;
    const size_t hc = (size_t)((b * 4 + h) * 2 + comp);
    const bf16_t* Qb = (const bf16_t*)(p.ws + O_QN) + (hc * NK + q0 + 32 * w + l32) * 64;
    const bf16_t* Kb = (const bf16_t*)(p.ws + O_KN) + hc * NK * 64;
    const bf16_t* Vb = (const bf16_t*)(p.ws + O_VT) + (size_t)((b * 4 + h) * 128) * NK;
    bf16x8 qf[4];
#pragma unroll
    for (int ks = 0; ks < 4; ++ks) qf[ks] = *(const bf16x8*)(Qb + 16 * ks + 8 * g);
    f32x16 O[4];
#pragma unroll
    for (int d = 0; d < 4; ++d)
#pragma unroll
        for (int i = 0; i < 16; ++i) O[d][i] = 0.f;
    float lsum = 0.f;
    const int kkey = tid >> 3, kseg = tid & 7, vdv = tid >> 2, vseg = tid & 3;
    const bf16_t* kg = Kb + (size_t)kkey * 64 + kseg * 8;
    const bf16_t* vg = Vb + (size_t)vdv * NK + vseg * 16;
    u32x4 kreg = *(const u32x4*)kg, vr0 = *(const u32x4*)vg, vr1 = *(const u32x4*)(vg + 8);
    const int pr = (l32 & ~12) | ((l32 & 4) << 1) | ((l32 & 8) >> 1);
    __syncthreads();
    *(u32x4*)(Ks + kkey * 72 + kseg * 8) = kreg; *(u32x4*)(Vs + vdv * 72 + vseg * 16) = vr0; *(u32x4*)(Vs + vdv * 72 + vseg * 16 + 8) = vr1;
    if (nkt > 1) { kreg = *(const u32x4*)(kg + (size_t)64 * 64); vr0 = *(const u32x4*)(vg + 64); vr1 = *(const u32x4*)(vg + 64 + 8); }
    __syncthreads();
    for (int kt = 0; kt < nkt; ++kt) {
        const bf16_t* Kc = Ks + (kt & 1) * ABUF; const bf16_t* Vc = Vs + (kt & 1) * ABUF;
        if (kt + 1 < nkt) {
            bf16_t* Kn = Ks + ((kt + 1) & 1) * ABUF; bf16_t* Vn = Vs + ((kt + 1) & 1) * ABUF;
            *(u32x4*)(Kn + kkey * 72 + kseg * 8) = kreg; *(u32x4*)(Vn + vdv * 72 + vseg * 16) = vr0; *(u32x4*)(Vn + vdv * 72 + vseg * 16 + 8) = vr1;
            if (kt + 2 < nkt) { kreg = *(const u32x4*)(kg + (size_t)(kt + 2) * 64 * 64); vr0 = *(const u32x4*)(vg + (kt + 2) * 64); vr1 = *(const u32x4*)(vg + (kt + 2) * 64 + 8); }
        }
        f32x16 S0, S1;
#pragma unroll
        for (int i = 0; i < 16; ++i) { S0[i] = 0.f; S1[i] = 0.f; }
#pragma unroll
        for (int ks = 0; ks < 4; ++ks) {
            const bf16x8 ka = *(const bf16x8*)(Kc + pr * 72 + 16 * ks + 8 * g);
            const bf16x8 kb = *(const bf16x8*)(Kc + (32 + pr) * 72 + 16 * ks + 8 * g);
            S0 = __builtin_amdgcn_mfma_f32_32x32x16_bf16(ka, qf[ks], S0, 0, 0, 0);
            S1 = __builtin_amdgcn_mfma_f32_32x32x16_bf16(kb, qf[ks], S1, 0, 0, 0);
        }
#pragma unroll
        for (int i = 0; i < 16; ++i) { S0[i] = __builtin_amdgcn_exp2f(S0[i]); S1[i] = __builtin_amdgcn_exp2f(S1[i]); lsum += S0[i] + S1[i]; }
#pragma unroll
        for (int kb2 = 0; kb2 < 2; ++kb2)
#pragma unroll
            for (int s = 0; s < 2; ++s) {
                u32x4 pw;
                if (kb2 == 0) { pw.x = pk2(S0[8 * s], S0[8 * s + 1]); pw.y = pk2(S0[8 * s + 2], S0[8 * s + 3]); pw.z = pk2(S0[8 * s + 4], S0[8 * s + 5]); pw.w = pk2(S0[8 * s + 6], S0[8 * s + 7]); }
                else { pw.x = pk2(S1[8 * s], S1[8 * s + 1]); pw.y = pk2(S1[8 * s + 2], S1[8 * s + 3]); pw.z = pk2(S1[8 * s + 4], S1[8 * s + 5]); pw.w = pk2(S1[8 * s + 6], S1[8 * s + 7]); }
                const bf16x8 pf = __builtin_bit_cast(bf16x8, pw);
#pragma unroll
                for (int d = 0; d < 4; ++d) {
                    const bf16x8 va = *(const bf16x8*)(Vc + (d * 32 + l32) * 72 + kb2 * 32 + 16 * s + 8 * g);
                    O[d] = __builtin_amdgcn_mfma_f32_32x32x16_bf16(va, pf, O[d], 0, 0, 0);
                }
            }
        __syncthreads();
    }
    lsum += __shfl_xor(lsum, 32);
    const float inv = 1.0f / lsum;
    bf16_t* stg = (bf16_t*)(smem + 4 * ABUF) + (size_t)(32 * w) * 136;
#pragma unroll
    for (int d = 0; d < 4; ++d)
#pragma unroll
        for (int i4 = 0; i4 < 4; ++i4) {
            u32x2 o; o.x = pk2(O[d][4 * i4] * inv, O[d][4 * i4 + 1] * inv); o.y = pk2(O[d][4 * i4 + 2] * inv, O[d][4 * i4 + 3] * inv);
            *(u32x2*)(stg + l32 * 136 + d * 32 + 8 * i4 + 4 * g) = o;
        }
    bf16_t* ob = (bf16_t*)(p.ws + O_OC) + ((size_t)(rowbase + 32 * w) * 8 + h * 2 + comp) * 128;
#pragma unroll
    for (int k = 0; k < 8; ++k) {
        const int rr = 4 * k + (lane >> 4), pc = lane & 15;
        *(u32x4*)(ob + (size_t)rr * 1024 + pc * 8) = *(const u32x4*)(stg + rr * 136 + pc * 8);
    }
}

__device__ __forceinline__ void mix_phase(const Params& p, unsigned char* smem, int l) {
    const int n_al = 1024, n_ac = (l == 0) ? 64 : 0, n_hf = 512, n_hc = (l == 0) ? 1024 : 0;
    const int total = n_al + n_ac + n_hf + n_hc;
    for (int it = blockIdx.x; it < total; it += gridDim.x) {
        int i = it;
        if (i < n_al) { const int comp = i & 1, h = (i >> 1) & 3, qt = (i >> 3) & 15, b = i >> 7; for (int rep = 0; rep < REP_ATT; ++rep) attn_item(p, smem, b, h, comp, 256 + qt * 256, b * 4096 + qt * 256, 68); continue; }
        i -= n_al;
        if (i < n_ac) { const int comp = i & 1, h = (i >> 1) & 3, b = i >> 3; attn_item(p, smem, b, h, comp, 0, TL + b * 256, 4); continue; }
        i -= n_ac;
        if (i < n_hf) { for (int rep = 0; rep < REP_HY; ++rep) hyfft_pair(p, smem, l, i >> 1, i & 1); continue; }
        i -= n_hf;
        for (int rep = 0; rep < REP_MISC; ++rep) hyctx_item(p, smem, l, i >> 7, i & 127);
    }
}

__device__ __forceinline__ void ybt_item(const Params& p, unsigned char* smem, int tb) {
    bf16_t* tile = (bf16_t*)smem;
    const int tid = TID(), r0 = tb * 64;
    const bool lat = r0 < TL;
    const int n = lat ? 4096 : 256, rb = lat ? r0 : r0 - TL, b = rb / n, t0 = rb % n;
    const bf16_t* src = (lat ? (const bf16_t*)(p.ws + O_YBT) : (const bf16_t*)(p.ws + O_YBTC)) + (size_t)b * 256 * n + t0;
    __syncthreads();
#pragma unroll
    for (int i = 0; i < 4; ++i) { const int e = tid + i * NT, ch = e >> 3, sg = e & 7; *(u32x4*)(tile + ch * 72 + sg * 8) = *(const u32x4*)(src + (size_t)ch * n + sg * 8); }
    __syncthreads();
    bf16_t* yb = (bf16_t*)(p.ws + O_YCAT) + 512;
#pragma unroll
    for (int i = 0; i < 4; ++i) {
        const int e = tid + i * NT, rr = e >> 5, sg = e & 31;
        unsigned w[4];
#pragma unroll
        for (int j = 0; j < 4; ++j) w[j] = (unsigned)tile[(sg * 8 + 2 * j) * 72 + rr] | ((unsigned)tile[(sg * 8 + 2 * j + 1) * 72 + rr] << 16);
        *(u32x4*)(yb + (size_t)(r0 + rr) * 1024 + sg * 8) = (u32x4){w[0], w[1], w[2], w[3]};
    }
}
__device__ __forceinline__ void post_phase(const Params& p, unsigned char* smem, int l, int M) {
    const int n_sg = M / 128, nb = M / 64;
    for (int it = blockIdx.x; it < n_sg + nb; it += gridDim.x) {
        if (it < n_sg) { for (int rep = 0; rep < REP_SGU; ++rep) sgu_item(p, smem, l, it); }
        else ybt_item(p, smem, it - n_sg);
    }
    const int tid = TID(), lane = tid & 63, wv = tid >> 6;
    const float* lv = p.da_lambda + (size_t)l * 256;
    const float d01 = wave_sum(lv[lane] * lv[64 + lane]), d23 = wave_sum(lv[128 + lane] * lv[192 + lane]);
    const float lam_init = 0.8f - 0.6f * expf(-0.3f * (float)l);
    const float lam = expf(d01) - expf(d23) + lam_init;
    const float* sub = p.da_subln + (size_t)l * 128;
    const float s0 = sub[2 * lane] * (1.0f - lam_init), s1 = sub[2 * lane + 1] * (1.0f - lam_init);
    const bf16_t* OC = (const bf16_t*)(p.ws + O_OC);
    bf16_t* YA = (bf16_t*)(p.ws + O_YCAT);
    const int vstep = gridDim.x * 8;
    for (int v0i = blockIdx.x * 8 + wv; v0i < M * 4; v0i += 4 * vstep) {
        unsigned aw[4], bw[4];
#pragma unroll
        for (int k = 0; k < 4; ++k) { const int vi = v0i + k * vstep; aw[k] = 0u; bw[k] = 0u;
            if (vi < M * 4) { const bf16_t* o0 = OC + (size_t)vi * 256; aw[k] = *(const unsigned*)(o0 + 2 * lane); bw[k] = *(const unsigned*)(o0 + 128 + 2 * lane); } }
#pragma unroll
        for (int k = 0; k < 4; ++k) { const int vi = v0i + k * vstep;
            if (vi < M * 4) {
                const float x0 = bflo(aw[k]) - lam * bflo(bw[k]), x1 = bfhi(aw[k]) - lam * bfhi(bw[k]);
                const float rinv = rsqrtf(wave_sum(x0 * x0 + x1 * x1) * (1.0f / 128.0f) + 1e-6f);
                *(unsigned*)(YA + (size_t)(vi >> 2) * 1024 + (vi & 3) * 128 + 2 * lane) = pk2(x0 * rinv * s0, x1 * rinv * s1);
            } }
    }
}

template <int l> __device__ __forceinline__ void layer_body(unsigned char* smem) {
        const int Mfull = TT, Mpost = (l == 0) ? TT : TL;
        { const Params q = opq(smem); norm_phase(q, l, 0, Mfull, l == 0, (const bf16_t*)q.out); if (l == 1) aux_phase(q, smem, 1); }
        gsync(smem);
        for (int rep = 0; rep < REP_UP; ++rep) { const Params q = opq(smem); EpiSwiglu E; E.G = (bf16_t*)(q.ws + O_GH); run_gemm(smem, (const bf16_t*)(q.ws + O_H), (const bf16_t*)(q.ws + O_WUP0), Mfull, 5632, 1024, E); }
        gsync(smem);
        { const Params q = opq(smem); EpiResid E; E.xin = (const bf16_t*)q.out; E.xout = (bf16_t*)q.out; E.fout = nullptr; E.xc = (float*)(q.ws + O_XC); E.part = (float*)(q.ws + O_PART); E.mod = (const float*)(q.ws + O_MOD) + (size_t)l * 9 * 9216; E.gofs = 2 * 1024; E.coef = 0.5f;
          run_gemm(smem, (const bf16_t*)(q.ws + O_GH), (const bf16_t*)(q.ws + O_WDN0), Mfull, 1024, 2816, E, true);
          for (int rep = 1; rep < REP_DN; ++rep) { E.coef = 0.f; run_gemm(smem, (const bf16_t*)(q.ws + O_GH), (const bf16_t*)(q.ws + O_WDN0), Mfull, 1024, 2816, E); } }
        gsync(smem);
        { const Params q = opq(smem); norm_phase(q, l, 1, Mfull, false, (const bf16_t*)q.out); for (int rep = 0; rep < REP_MISC; ++rep) for (int it = blockIdx.x; it < 512; it += gridDim.x) filtfft_item(q, smem, it); }
        gsync(smem);
        for (int rep = 0; rep < REP_G3; ++rep) { const Params q = opq(smem); EpiIn E; E.qn = (bf16_t*)(q.ws + O_QN); E.kn = (bf16_t*)(q.ws + O_KN); E.vraw = (bf16_t*)(q.ws + O_VRAW); E.hyraw = (bf16_t*)(q.ws + O_HYRAW); E.sgraw = (bf16_t*)(q.ws + O_SGRAW);
          run_gemm(smem, (const bf16_t*)(q.ws + O_H), (const bf16_t*)(q.ws + O_WIN), Mfull, 2816, 1024, E); }
        gsync(smem);
        { const Params q = opq(smem); prep_phase(q, smem, l); }
        gsync(smem);
        { const Params q = opq(smem); mix_phase(q, smem, l); }
        gsync(smem);
        for (int rep = 0; rep < REP_MISC; ++rep) { const Params q = opq(smem); post_phase(q, smem, l, Mpost); }
        gsync(smem);
#pragma unroll 1
        for (int rep9 = 0; rep9 < REP_P9; ++rep9) {
            { const Params q = opq(smem); EpiGate3 E; E.g3 = (bf16_t*)(q.ws + O_G3); E.bias = q.gate_b + (size_t)l * 3072;
              run_gemm(smem, (const bf16_t*)(q.ws + O_H), (const bf16_t*)(q.ws + O_WG), Mpost, 3072, 1024, E); }
            gsync(smem);
            { const Params q = opq(smem); EpiMergeR E; E.g3 = (const bf16_t*)(q.ws + O_G3); E.mb = (bf16_t*)(q.ws + O_MB);
              run_gemm(smem, (const bf16_t*)(q.ws + O_YCAT), (const bf16_t*)(q.ws + O_WBR), Mpost, 1024, 1024, E); }
        }
        gsync(smem);
        { const Params q = opq(smem); EpiResid E; E.xin = (const bf16_t*)q.out; E.xout = (l == 1) ? (bf16_t*)(q.ws + O_XALT) : (bf16_t*)q.out; E.fout = nullptr; E.xc = (float*)(q.ws + O_XC); E.part = (float*)(q.ws + O_PART); E.mod = (const float*)(q.ws + O_MOD) + (size_t)l * 9 * 9216; E.gofs = 5 * 1024; E.coef = 1.0f;
          run_gemm(smem, (const bf16_t*)(q.ws + O_MB), (const bf16_t*)(q.ws + O_WO), Mpost, 1024, 1024, E, l == 0);
          for (int rep = 1; rep < REP_G3; ++rep) { E.coef = 0.f; run_gemm(smem, (const bf16_t*)(q.ws + O_MB), (const bf16_t*)(q.ws + O_WO), Mpost, 1024, 1024, E); } }
        gsync(smem);
        { const Params q = opq(smem); norm_phase(q, l, 2, Mpost, false, (l == 1) ? (const bf16_t*)(q.ws + O_XALT) : (const bf16_t*)q.out); }
        gsync(smem);
        for (int rep = 0; rep < REP_UP; ++rep) { const Params q = opq(smem); EpiSwiglu E; E.G = (bf16_t*)(q.ws + O_GH); run_gemm(smem, (const bf16_t*)(q.ws + O_H), (const bf16_t*)(q.ws + O_WUP1), Mpost, 5632, 1024, E); }
        gsync(smem);
        { const Params q = opq(smem); EpiResid E; E.xin = (l == 1) ? (const bf16_t*)(q.ws + O_XALT) : (const bf16_t*)q.out; E.xout = (bf16_t*)q.out; E.fout = (l == 1) ? q.out : nullptr; E.xc = (float*)(q.ws + O_XC); E.part = (float*)(q.ws + O_PART); E.mod = (const float*)(q.ws + O_MOD) + (size_t)l * 9 * 9216; E.gofs = 8 * 1024; E.coef = 0.5f;
          run_gemm(smem, (const bf16_t*)(q.ws + O_GH), (const bf16_t*)(q.ws + O_WDN1), Mpost, 1024, 2816, E, l == 0); }
}

__global__ void __launch_bounds__(512, 2) fwd_megakernel(Params p) {
    extern __shared__ __attribute__((aligned(16))) unsigned char smem[];
    cg::grid_group grid = cg::this_grid();
    if (threadIdx.x == 0) {
        *(Params*)(smem + POFF) = p;
        volatile unsigned* st = (volatile unsigned*)(smem + POFF + 256); st[0] = 0u; st[1] = 0u;
        xb_add(&((unsigned*)(p.ws + O_BAR))[XB_XCNT(xb_xcc_id())], 1u);
    }
    __syncthreads();
    { const Params q = opq(smem); aux_phase(q, smem, 0); }
    grid.sync();
    layer_body<0>(smem);
    gsync(smem);
    layer_body<1>(smem);
}

extern "C" void kernel_launch(void* const* d_in, const int* in_sizes, int n_in, void* d_out, int out_size, void* d_ws, size_t ws_size, hipStream_t stream) {
    if (ws_size < WS_NEED) { fprintf(stderr, "workspace too small: need %zu have %zu\n", (size_t)WS_NEED, ws_size); return; }
    static int grid_blocks = 0;
    if (!grid_blocks) {
        hipFuncSetAttribute((const void*)fwd_megakernel, hipFuncAttributeMaxDynamicSharedMemorySize, LDS_BYTES);
        int dev = 0, cus = 0, per_cu = 0;
        hipGetDevice(&dev);
        hipDeviceGetAttribute(&cus, hipDeviceAttributeMultiprocessorCount, dev);
        hipOccupancyMaxActiveBlocksPerMultiprocessor(&per_cu, fwd_megakernel, NT, LDS_BYTES);
        if (per_cu < 1) per_cu = 1;
        grid_blocks = cus;
    }
    Params p{};
    const float** pp = (const float**)&p;
    for (int i = 0; i < 30; ++i) pp[i] = (const float*)d_in[i];
    p.out = (float*)d_out;
    p.ws = (unsigned char*)d_ws;
    hipMemsetAsync((unsigned char*)d_ws + O_BAR, 0, 16384, stream);
    void* args[] = {&p};
    hipError_t e = hipLaunchCooperativeKernel((void*)fwd_megakernel, dim3(grid_blocks), dim3(NT), args, LDS_BYTES, stream);
    if (e != hipSuccess) fprintf(stderr, "cooperative launch failed: %s (grid %d)\n", hipGetErrorString(e), grid_blocks);
}
```

```cpp
#include <hip/hip_runtime.h>
#include <hip/hip_cooperative_groups.h>
#include <cstdio>
namespace cg = cooperative_groups;

#define LAS __attribute__((address_space(3)))
typedef unsigned short bf16_t;
typedef short bf16x8 __attribute__((ext_vector_type(8)));
typedef float f32x2 __attribute__((ext_vector_type(2)));
typedef float f32x4 __attribute__((ext_vector_type(4)));
typedef float f32x16 __attribute__((ext_vector_type(16)));
typedef unsigned u32x2 __attribute__((ext_vector_type(2)));
typedef unsigned u32x4 __attribute__((ext_vector_type(4)));
typedef __bf16 bf16v2 __attribute__((ext_vector_type(2)));

constexpr int NT = 512;
#ifndef REP_ATT
#define REP_ATT 1
#endif
#ifndef REP_HY
#define REP_HY 1
#endif
#ifndef REP_AUX
#define REP_AUX 1
#endif
#ifndef REP_MISC
#define REP_MISC 1
#endif
#ifndef REP_PREP
#define REP_PREP 1
#endif
#ifndef REP_UP
#define REP_UP 1
#endif
#ifndef REP_DN
#define REP_DN 1
#endif
#ifndef REP_G3
#define REP_G3 1
#endif
#ifndef REP_P9
#define REP_P9 1
#endif
#ifndef REP_QK
#define REP_QK 1
#endif
#ifndef REP_NORM
#define REP_NORM 1
#endif
#ifndef REP_SGU
#define REP_SGU 1
#endif
constexpr int TL = 32768, TCX = 2048, TT = 34816, DM = 1024, FFH = 2816, SEQ = 4096, CTXL = 256, NK = 4352;
constexpr int LDS_BYTES = 147456;

constexpr size_t AL(size_t x) { return (x + 255) & ~(size_t)255; }
constexpr size_t O_WUP0 = 0;
constexpr size_t O_WUP1 = O_WUP0 + (size_t)5632 * 1024 * 2;
constexpr size_t O_WDN0 = O_WUP1 + (size_t)5632 * 1024 * 2;
constexpr size_t O_WDN1 = O_WDN0 + (size_t)1024 * 2816 * 2;
constexpr size_t O_WIN = O_WDN1 + (size_t)1024 * 2816 * 2;
constexpr size_t O_WG = O_WIN + (size_t)2816 * 1024 * 2;
constexpr size_t O_WBR = O_WG + (size_t)3072 * 1024 * 2;
constexpr size_t O_WO = O_WBR + (size_t)1024 * 1024 * 2;
constexpr size_t O_XC = O_WO + (size_t)1024 * 1024 * 2;
constexpr size_t O_MOD = O_XC + (size_t)TCX * 1024 * 4;
constexpr size_t O_L1P = O_MOD + AL((size_t)2 * 9 * 9216 * 4);
constexpr size_t O_L1PC = O_L1P + (size_t)256 * 1024 * 4;
constexpr size_t O_FILTC = O_L1PC + (size_t)16 * 1024 * 4;
constexpr size_t O_BAR = O_FILTC + (size_t)2 * 256 * 512 * 4;
constexpr size_t O_H = O_BAR + 16384;
constexpr size_t O_AR = O_H + (size_t)TT * 1024 * 2;
constexpr size_t O_GH = O_AR;
constexpr size_t O_VRAW = O_AR;
constexpr size_t O_HYRAW = O_VRAW + (size_t)TT * 512 * 2;
constexpr size_t O_SGRAW = O_HYRAW + (size_t)TT * 768 * 2;
constexpr size_t O_XALT = O_AR + (size_t)TT * 2816 * 2;
constexpr size_t O_PART = O_XALT;
constexpr size_t O_OC = O_AR;
constexpr size_t O_YBT = O_OC + (size_t)TT * 1024 * 2;
constexpr size_t O_YBTC = O_YBT + (size_t)8 * 256 * 4096 * 2;
static_assert(O_YBTC + (size_t)8 * 256 * 256 * 2 <= O_SGRAW, "OC/YBT must not touch SGRAW (read in the post phase)");
constexpr size_t O_G3 = O_AR;
constexpr size_t O_YCAT = O_G3 + (size_t)TT * 3072 * 2;
constexpr size_t O_MB = O_YCAT + (size_t)TT * 1024 * 2;
constexpr size_t SZ_B = (size_t)TT * 1024 * 4 + (size_t)8 * 256 * 4096 * 2 + (size_t)8 * 256 * 256 * 2;
constexpr size_t O_QN = O_AR + AL(SZ_B);
constexpr size_t O_KN = O_QN + (size_t)64 * NK * 64 * 2;
constexpr size_t O_VT = O_KN + (size_t)64 * NK * 64 * 2;
constexpr size_t O_HV = O_VT + (size_t)32 * 128 * NK * 2;
constexpr size_t O_HVC = O_HV + (size_t)8 * 768 * 4096 * 2;
constexpr size_t O_FH = O_HVC + (size_t)8 * 768 * 256 * 2;
constexpr size_t O_FILT = O_HV;
constexpr size_t SZ_C1 = (size_t)8 * 768 * 4096 * 2 + (size_t)8 * 768 * 256 * 2 + (size_t)2 * 256 * 8192 * 8;
constexpr size_t END1 = O_HV + SZ_C1, END2 = O_MB + (size_t)TT * 1024 * 2;
static_assert(O_YCAT >= O_SGRAW + (size_t)TT * 512 * 2, "YCAT is written while OC/YBT/SGRAW are read");
constexpr size_t WS_NEED = AL(END1 > END2 ? END1 : END2);
static_assert(O_GH + (size_t)TT * 2816 * 2 <= O_HV, "Gh must stay inside regions B'+A");
static_assert(O_XALT + (size_t)TL * 1024 * 2 <= O_MB, "X_alt is written while MB is read");
static_assert(O_PART + (size_t)4 * 2048 * 1024 * 4 <= O_HV, "partials must not touch FILT/FH");
static_assert(O_SGRAW + (size_t)TT * 512 * 2 <= O_QN, "raws fit region B'");

struct Params {
    const float *x, *c, *ctx, *c_ctx, *ada_w, *ada_b, *norm_g, *ffn_up, *ffn_down, *w_in, *qk_gain, *da_lambda, *da_subln,
        *hy_conv_w, *hy_conv_b, *hy_w1, *hy_b1, *hy_w2, *hy_b2, *hy_freq, *hy_w3, *hy_skip, *sg_ln_g, *sg_ln_b, *sg_w, *sg_b,
        *gate_w, *gate_b, *w_br, *w_o;
    float* out;
    unsigned char* ws;
};


__device__ __forceinline__ int TID() { int t = threadIdx.x; asm volatile("" : "+v"(t)); return t; }
constexpr int POFF = 147456 - 512;
__device__ __forceinline__ const float* ldp(const unsigned char* smem, int idx) {
    const volatile unsigned* w = (const volatile unsigned*)(smem + POFF + idx * 8);
    const unsigned lo = __builtin_amdgcn_readfirstlane(w[0]), hi = __builtin_amdgcn_readfirstlane(w[1]);
    typedef __attribute__((address_space(1))) const float* gptr_t;
    return (const float*)(gptr_t)(((unsigned long long)hi << 32) | lo);
}
__device__ __forceinline__ Params opq(const unsigned char* smem) {
    Params q;
    q.x = ldp(smem, 0); q.c = ldp(smem, 1); q.ctx = ldp(smem, 2); q.c_ctx = ldp(smem, 3); q.ada_w = ldp(smem, 4); q.ada_b = ldp(smem, 5); q.norm_g = ldp(smem, 6);
    q.ffn_up = ldp(smem, 7); q.ffn_down = ldp(smem, 8); q.w_in = ldp(smem, 9); q.qk_gain = ldp(smem, 10); q.da_lambda = ldp(smem, 11); q.da_subln = ldp(smem, 12);
    q.hy_conv_w = ldp(smem, 13); q.hy_conv_b = ldp(smem, 14); q.hy_w1 = ldp(smem, 15); q.hy_b1 = ldp(smem, 16); q.hy_w2 = ldp(smem, 17); q.hy_b2 = ldp(smem, 18);
    q.hy_freq = ldp(smem, 19); q.hy_w3 = ldp(smem, 20); q.hy_skip = ldp(smem, 21); q.sg_ln_g = ldp(smem, 22); q.sg_ln_b = ldp(smem, 23); q.sg_w = ldp(smem, 24);
    q.sg_b = ldp(smem, 25); q.gate_w = ldp(smem, 26); q.gate_b = ldp(smem, 27); q.w_br = ldp(smem, 28); q.w_o = ldp(smem, 29);
    q.out = (float*)ldp(smem, 30); q.ws = (unsigned char*)ldp(smem, 31);
    return q;
}


#define XB_TMO      128
#define XB_XCNT(j)  (256  + 64 * (j))
#define XB_XSUB(j)  (1280 + 64 * (j))
#define XB_XGEN(j)  (2304 + 64 * (j))
#define XB_TOP      3328
#define XB_TOPGEN   3392
#define XCD_BAR_WORDS 3456
#define XB_SPIN_CAP (1u << 22)
__device__ __forceinline__ unsigned xb_ld(unsigned* p)              { return __hip_atomic_load(p, __ATOMIC_RELAXED, __HIP_MEMORY_SCOPE_AGENT); }
__device__ __forceinline__ unsigned xb_add(unsigned* p, unsigned v) { return __hip_atomic_fetch_add(p, v, __ATOMIC_RELAXED, __HIP_MEMORY_SCOPE_AGENT); }
__device__ __forceinline__ unsigned xb_xcc_id() { return (unsigned)__builtin_amdgcn_s_getreg((3 << 11) | 20) & 0xFu; }
#define XB_SPIN(cond, bar) do { unsigned _sp = 0; while (cond) { __builtin_amdgcn_s_sleep(1); \
    if ((++_sp & 255u) == 0u) { if (xb_ld(&(bar)[XB_TMO])) break; if (_sp > XB_SPIN_CAP) { atomicAdd(&(bar)[XB_TMO], 1u); break; } } } } while (0)
__device__ __forceinline__ void xcd_barrier_complete(unsigned* bar, unsigned x, unsigned& nloc, unsigned& nx) {
    const unsigned G = gridDim.x * gridDim.y * gridDim.z;
    unsigned sum, cnt, mine, sp = 0u;
    for (;;) {
        sum = 0u; cnt = 0u; mine = 0u;
#pragma unroll
        for (unsigned j = 0; j < 16; ++j) { const unsigned c = xb_ld(&bar[XB_XCNT(j)]); sum += c; cnt += (c > 0u) ? 1u : 0u; mine = (j == x) ? c : mine; }
        if (sum == G) break;
        __builtin_amdgcn_s_sleep(1);
        if ((++sp & 255u) == 0u) { if (xb_ld(&bar[XB_TMO])) break; if (sp > XB_SPIN_CAP) { atomicAdd(&bar[XB_TMO], 1u); break; } }
    }
    nloc = mine > 0u ? mine : 1u; nx = cnt > 0u ? cnt : 1u;
}
__device__ __forceinline__ void gsync(unsigned char* smem) {
    asm volatile("s_waitcnt vmcnt(0)" ::: "memory");
    __syncthreads();
    if (threadIdx.x == 0) {
        unsigned* bar = (unsigned*)((unsigned char*)ldp(smem, 31) + O_BAR);
        volatile unsigned* st = (volatile unsigned*)(smem + POFF + 256);
        const unsigned x = xb_xcc_id();
        __builtin_amdgcn_s_waitcnt(0);
        unsigned nloc = st[0], nx = st[1];
        if (nloc == 0u) { xcd_barrier_complete(bar, x, nloc, nx); st[0] = nloc; st[1] = nx; }
        const unsigned old = xb_add(&bar[XB_XSUB(x)], 1u);
        const unsigned gen = old / nloc;
        if (old + 1u == (gen + 1u) * nloc) {
            __builtin_amdgcn_fence(__ATOMIC_RELEASE, "agent");
            asm volatile("s_waitcnt vmcnt(0)" ::: "memory");
            const unsigned og = xb_add(&bar[XB_TOP], 1u);
            const unsigned tg = og / nx;
            if (og + 1u == (tg + 1u) * nx) xb_add(&bar[XB_TOPGEN], 1u);
            else XB_SPIN(xb_ld(&bar[XB_TOPGEN]) == tg, bar);
            __builtin_amdgcn_fence(__ATOMIC_ACQUIRE, "agent");
            xb_add(&bar[XB_XGEN(x)], 1u);
            asm volatile("s_waitcnt vmcnt(0)" ::: "memory");
        } else {
            XB_SPIN(xb_ld(&bar[XB_XGEN(x)]) == gen, bar);
            __builtin_amdgcn_fence(__ATOMIC_ACQUIRE, "agent");
            asm volatile("s_waitcnt vmcnt(0)" ::: "memory");
        }
    }
    __syncthreads();
}

__device__ __forceinline__ unsigned pk2(float a, float b) { f32x2 v = {a, b}; bf16v2 r = __builtin_convertvector(v, bf16v2); return __builtin_bit_cast(unsigned, r); }
__device__ __forceinline__ bf16_t f2bf(float a) { return (bf16_t)(pk2(a, 0.f) & 0xffffu); }
__device__ __forceinline__ float bf2f(bf16_t h) { return __uint_as_float((unsigned)h << 16); }
__device__ __forceinline__ float bflo(unsigned w) { return __uint_as_float(w << 16); }
__device__ __forceinline__ float bfhi(unsigned w) { return __uint_as_float(w & 0xffff0000u); }
__device__ __forceinline__ void row_bk(int r, int& b, int& kidx) { if (r < TL) { b = r >> 12; kidx = 256 + (r & 4095); } else { const int rc = r - TL; b = rc >> 8; kidx = rc & 255; } }
__device__ __forceinline__ float wave_sum(float v) {
#pragma unroll
    for (int o = 32; o > 0; o >>= 1) v += __shfl_xor(v, o);
    return v;
}
__device__ __forceinline__ float sigmoidf_(float v) { return __builtin_amdgcn_rcpf(1.0f + __builtin_amdgcn_exp2f(v * -1.4426950408889634f)); }

namespace pg8 {
constexpr int BM = 256, BK = 64, HALF = 128, HTB = HALF * BK * 2, STAGE_BYTES = 8 * HTB, NXCD = 8, WGM = 8;
__device__ __forceinline__ int lds_byte(int r, int c) { const int st = (r >> 4) * 2 + (c >> 5), rr = r & 15, cc = c & 31, ob = rr * 64 + cc * 2; return st * 1024 + (ob ^ (((ob >> 9) & 1) << 5)); }
__device__ __forceinline__ void stage_rc(int b, int& R, int& C) { const int st = b / 1024, sb = b % 1024, swz = sb ^ (((sb >> 9) & 1) << 5); R = (st >> 1) * 16 + swz / 64; C = (st & 1) * 32 + (swz % 64) / 2; }
__device__ __forceinline__ int perm32(int rho) { const int n = rho >> 4, i = rho & 15; return 8 * (i >> 2) + 4 * n + (i & 3); }
struct Unit { int pm, pn, k0, nt, split; };
struct Gemm { const bf16_t* A; const bf16_t* Bt; int M, N, K; };
struct StaticOrder {
    int nM, nN, nwg, G, c, ntk, ntail;
    __device__ void init(int M, int N, int K, int G_, int c_, bool split_tail) {
        nM = M / BM; nN = N / BM; G = G_; c = c_; ntk = K / BK; ntail = 0;
        if (split_tail) { nM -= 8; ntail = 128; }
        nwg = nM * nN;
    }
    __device__ __forceinline__ bool next(int i, Unit& u) const {
        const long L = (long)i * G + c; if (L >= nwg + ntail) return false;
        int pm, pn, k0 = 0, nt = ntk, split = 0;
        if (L >= nwg) {
            const int j = (int)L - nwg, cu = j >> 2, part = j & 3;
            pm = nM + (cu >> 2); pn = cu & 3; split = 1 + part;
            const int q = (ntk / 4) & ~1, big = (ntk - 4 * q) / 2;
            nt = q + ((part < big) ? 2 : 0);
            k0 = part * q + 2 * (part < big ? part : big);
        } else {
            int wgid = (int)L; { const int q = nwg / NXCD, r = nwg % NXCD, xcd = wgid % NXCD, off = wgid / NXCD; wgid = (xcd < r ? xcd * (q + 1) : r * (q + 1) + (xcd - r) * q) + off; }
            const int nig = WGM * nN, gid = wgid / nig, fm = gid * WGM, gsz = (nM - fm) < WGM ? (nM - fm) : WGM;
            pm = fm + ((wgid % nig) % gsz); pn = (wgid % nig) / gsz;
        }
        u.pm = pm; u.pn = pn; u.k0 = k0; u.nt = nt; u.split = split;
        return true;
    }
};

template <class Epi>
__device__ __forceinline__ void gemm_phase(LAS unsigned char* lds, const Gemm g, const StaticOrder& S, const Epi& E) {
    const int tid = TID(), wid = __builtin_amdgcn_readfirstlane(tid >> 6), lane = tid & 63, wr = wid >> 2, wc = wid & 3, fr = lane & 15, fq = lane >> 4;
    const int K = g.K;
    unsigned voffA[2], voffB[2];
#pragma unroll
    for (int i = 0; i < 2; ++i) { int R, C; stage_rc(tid * 16 + i * 8192, R, C); const int Rb = Epi::PERM ? ((R & ~31) + perm32(R & 31)) : R;
        voffA[i] = (unsigned)(R * K + C) * 2u; voffB[i] = (unsigned)(Rb * K + C) * 2u; }
    const size_t kstep = (size_t)(BK * 2);
    const size_t hstep = (size_t)HALF * K * 2;
    const size_t tstep = 2 * hstep;
    const unsigned ldsw = (unsigned)wid * 1024u;
    const int aoff = lds_byte(wr * 64 + fr, fq * 8), boff = lds_byte(wc * 32 + fr, fq * 8);
#define PG8_SA(b, h) (((b) * 2 + (h)) * HTB)
#define PG8_SB(b, h) ((4 + (b) * 2 + (h)) * HTB)
#define PG8_STAGE(bufoff, gbase, voff) do { _Pragma("unroll") for (int _i = 0; _i < 2; ++_i) \
        __builtin_amdgcn_global_load_lds((const unsigned*)((const char*)(gbase) + (voff)[_i]), (LAS unsigned*)(lds + (bufoff) + ldsw + _i * 8192), 16, 0, 0); } while (0)
#define PG8_LDA(dst, b, h) do { _Pragma("unroll") for (int m = 0; m < 4; ++m) _Pragma("unroll") for (int k = 0; k < 2; ++k) dst[m][k] = *(const LAS bf16x8*)(lds + PG8_SA(b, h) + aoff + m * 2048 + k * 1024); } while (0)
#define PG8_LDB(dst, b, h) do { _Pragma("unroll") for (int n = 0; n < 2; ++n) _Pragma("unroll") for (int k = 0; k < 2; ++k) dst[n][k] = *(const LAS bf16x8*)(lds + PG8_SB(b, h) + boff + n * 2048 + k * 1024); } while (0)
#define PG8_MMA(ai, bj, At, Bt) do { __builtin_amdgcn_s_setprio(1); _Pragma("unroll") for (int m = 0; m < 4; ++m) _Pragma("unroll") for (int n = 0; n < 2; ++n) _Pragma("unroll") for (int k = 0; k < 2; ++k) \
        acc[ai][bj][m][n] = __builtin_amdgcn_mfma_f32_16x16x32_bf16(Bt[n][k], At[m][k], acc[ai][bj][m][n], 0, 0, 0); __builtin_amdgcn_s_setprio(0); } while (0)
#define PG8_WAIT_V(n) asm volatile("s_waitcnt vmcnt(" #n ")" ::: "memory")
#define PG8_WAIT_L(n) asm volatile("s_waitcnt lgkmcnt(" #n ")" ::: "memory")
#define PG8_BAR __builtin_amdgcn_s_barrier()
#define PG8_SCHED __builtin_amdgcn_sched_barrier(0)
    Unit cur, nxt; int ui = 0;
    if (!S.next(0, cur)) return;
    f32x4 acc[2][2][4][2];
#pragma unroll
    for (int a = 0; a < 2; ++a)
#pragma unroll
        for (int b = 0; b < 2; ++b)
#pragma unroll
            for (int m = 0; m < 4; ++m)
#pragma unroll
                for (int n = 0; n < 2; ++n) acc[a][b][m][n] = (f32x4){0.f, 0.f, 0.f, 0.f};
    bf16x8 At[4][2], B0[2][2], B1[2][2];
    const char* cA = (const char*)g.A + (size_t)cur.pm * tstep + (size_t)cur.k0 * kstep; const char* cB = (const char*)g.Bt + (size_t)cur.pn * tstep + (size_t)cur.k0 * kstep;
    PG8_STAGE(PG8_SB(0, 0), cB, voffB); PG8_STAGE(PG8_SA(0, 0), cA, voffA); PG8_STAGE(PG8_SB(0, 1), cB + hstep, voffB); PG8_STAGE(PG8_SA(0, 1), cA + hstep, voffA);
    if (wr == 1) PG8_BAR;
    PG8_WAIT_V(4); PG8_BAR;
    PG8_STAGE(PG8_SB(1, 0), cB + kstep, voffB); PG8_STAGE(PG8_SA(1, 0), cA + kstep, voffA); PG8_STAGE(PG8_SB(1, 1), cB + hstep + kstep, voffB);
    PG8_WAIT_V(6); PG8_BAR;
    for (;;) {
        const bool has_next = S.next(ui + 1, nxt);
        const char* nA = has_next ? (const char*)g.A + (size_t)nxt.pm * tstep + (size_t)nxt.k0 * kstep : cA; const char* nB = has_next ? (const char*)g.Bt + (size_t)nxt.pn * tstep + (size_t)nxt.k0 * kstep : cB;
        const int nt = cur.nt;
        for (int t = 0; t < nt; t += 2) {
            const bool last = (t == nt - 2);
            const char* a1 = cA + (size_t)(t + 1) * kstep;
            const char* a2 = last ? nA : cA + (size_t)(t + 2) * kstep; const char* b2 = last ? nB : cB + (size_t)(t + 2) * kstep;
            const char* a3 = a2 + kstep; const char* b3 = b2 + kstep;
            if constexpr (Epi::RESCALE) { if (t == 8 || t == 12) E.rescale(acc, cur, t == 8 ? 0 : 1, wr, wc, fr, fq); }
            PG8_LDB(B0, 0, 0); PG8_SCHED; PG8_LDA(At, 0, 0); PG8_STAGE(PG8_SA(1, 1), a1 + hstep, voffA);
            PG8_WAIT_L(8); PG8_BAR; PG8_WAIT_L(0); PG8_MMA(0, 0, At, B0); PG8_BAR; PG8_SCHED;
            PG8_LDB(B1, 0, 1); PG8_STAGE(PG8_SB(0, 0), b2, voffB);
            PG8_BAR; PG8_WAIT_L(0); PG8_MMA(0, 1, At, B1); PG8_BAR;
            PG8_LDA(At, 0, 1); PG8_STAGE(PG8_SA(0, 0), a2, voffA);
            PG8_BAR; PG8_WAIT_L(0); PG8_MMA(1, 0, At, B0); PG8_BAR; PG8_SCHED;
            PG8_STAGE(PG8_SB(0, 1), b2 + hstep, voffB);
            PG8_WAIT_V(6); PG8_BAR; PG8_MMA(1, 1, At, B1); PG8_BAR;
            PG8_LDB(B0, 1, 0); PG8_SCHED; PG8_LDA(At, 1, 0); PG8_STAGE(PG8_SA(0, 1), a2 + hstep, voffA);
            PG8_WAIT_L(8); PG8_BAR; PG8_WAIT_L(0); PG8_MMA(0, 0, At, B0); PG8_BAR; PG8_SCHED;
            PG8_LDB(B1, 1, 1); PG8_STAGE(PG8_SB(1, 0), b3, voffB);
            PG8_BAR; PG8_WAIT_L(0); PG8_MMA(0, 1, At, B1); PG8_BAR;
            PG8_LDA(At, 1, 1); PG8_STAGE(PG8_SA(1, 0), a3, voffA);
            PG8_BAR; PG8_WAIT_L(0); PG8_MMA(1, 0, At, B0); PG8_BAR; PG8_SCHED;
            PG8_STAGE(PG8_SB(1, 1), b3 + hstep, voffB);
            PG8_WAIT_V(6); PG8_BAR; PG8_MMA(1, 1, At, B1); PG8_BAR;
        }
        E(acc, cur, wr, wc, fr, fq);
        if (!has_next) break;
#pragma unroll
        for (int a = 0; a < 2; ++a)
#pragma unroll
            for (int b = 0; b < 2; ++b)
#pragma unroll
                for (int m = 0; m < 4; ++m)
#pragma unroll
                    for (int n = 0; n < 2; ++n) acc[a][b][m][n] = (f32x4){0.f, 0.f, 0.f, 0.f};
        cur = nxt; cA = nA; cB = nB; ++ui;
    }
    PG8_WAIT_V(0);
    if (wr == 0) PG8_BAR;
    PG8_BAR;
#undef PG8_SA
#undef PG8_SB
#undef PG8_STAGE
#undef PG8_LDA
#undef PG8_LDB
#undef PG8_MMA
#undef PG8_WAIT_V
#undef PG8_WAIT_L
#undef PG8_BAR
#undef PG8_SCHED
}
}
using pg8::Unit;
typedef f32x4 AccT[2][2][4][2];

struct EpiSwiglu {
    static constexpr bool PERM = true, RESCALE = false;
    bf16_t* G;
    __device__ __forceinline__ void operator()(const AccT& acc, const Unit& u, int wr, int wc, int fr, int fq) const {
        const int row0 = u.pm * 256 + wr * 64 + fr, col0 = u.pn * 128 + wc * 32 + 8 * fq;
#pragma unroll
        for (int ai = 0; ai < 2; ++ai)
#pragma unroll
            for (int m = 0; m < 4; ++m) {
                float gv[8];
#pragma unroll
                for (int n = 0; n < 2; ++n)
#pragma unroll
                    for (int j = 0; j < 4; ++j) { const float a = acc[ai][0][m][n][j], b = acc[ai][1][m][n][j]; gv[n * 4 + j] = a * b * __builtin_amdgcn_rcpf(1.0f + __builtin_amdgcn_exp2f(a * -1.4426950408889634f)); }
                u32x4 w; w.x = pk2(gv[0], gv[1]); w.y = pk2(gv[2], gv[3]); w.z = pk2(gv[4], gv[5]); w.w = pk2(gv[6], gv[7]);
                *(u32x4*)(G + (size_t)(row0 + ai * 128 + m * 16) * FFH + col0) = w;
            }
    }
};
struct EpiResid {
    static constexpr bool PERM = true, RESCALE = false;
    const bf16_t* xin; bf16_t* xout; float* fout; float* xc; float* part; const float* mod; int gofs; float coef;
    __device__ __forceinline__ void operator()(const AccT& acc, const Unit& u, int wr, int wc, int fr, int fq) const {
        const int row0 = u.pm * 256 + wr * 64 + fr, col0 = u.pn * 256 + wc * 32 + 8 * fq;
        const bool lat = u.pm < 128;
        const int mr = lat ? (u.pm >> 4) : 8;
        const float* gp = mod + (size_t)mr * 9216 + gofs + col0;
#pragma unroll
        for (int bj = 0; bj < 2; ++bj) {
            const f32x4 g0 = *(const f32x4*)(gp + bj * 128) * coef, g1 = *(const f32x4*)(gp + bj * 128 + 4) * coef;
            if (lat) {
                u32x4 xw[8];
#pragma unroll
                for (int am = 0; am < 8; ++am) xw[am] = *(const u32x4*)(xin + (size_t)(row0 + (am >> 2) * 128 + (am & 3) * 16) * 1024 + col0 + bj * 128);
#pragma unroll
                for (int am = 0; am < 8; ++am) {
                    const int ai = am >> 2, m = am & 3;
                    const size_t o = (size_t)(row0 + ai * 128 + m * 16) * 1024 + col0 + bj * 128;
                    f32x4 v0 = {bflo(xw[am].x), bfhi(xw[am].x), bflo(xw[am].y), bfhi(xw[am].y)}, v1 = {bflo(xw[am].z), bfhi(xw[am].z), bflo(xw[am].w), bfhi(xw[am].w)};
                    v0 += g0 * acc[ai][bj][m][0]; v1 += g1 * acc[ai][bj][m][1];
                    if (fout) { *(f32x4*)(fout + o) = v0; *(f32x4*)(fout + o + 4) = v1; }
                    else { u32x4 w; w.x = pk2(v0[0], v0[1]); w.y = pk2(v0[2], v0[3]); w.z = pk2(v1[0], v1[1]); w.w = pk2(v1[2], v1[3]); *(u32x4*)(xout + o) = w; }
                }
            } else {
#pragma unroll
                for (int am = 0; am < 8; ++am) {
                    const int ai = am >> 2, m = am & 3;
                    const size_t o = (size_t)(row0 + ai * 128 + m * 16 - TL) * 1024 + col0 + bj * 128;
                    const f32x4 d0 = g0 * acc[ai][bj][m][0], d1 = g1 * acc[ai][bj][m][1];
                    if (u.split) { float* pp = part + (size_t)(u.split - 1) * 2048 * 1024 + o; *(f32x4*)pp = d0; *(f32x4*)(pp + 4) = d1; }
                    else { float* xp = xc + o; *(f32x4*)xp = *(const f32x4*)xp + d0; *(f32x4*)(xp + 4) = *(const f32x4*)(xp + 4) + d1; }
                }
            }
        }
    }
};
struct EpiIn {
    static constexpr bool PERM = true, RESCALE = false;
    bf16_t *qn, *kn, *vraw, *hyraw, *sgraw;
    __device__ __forceinline__ void operator()(const AccT& acc, const Unit& u, int wr, int wc, int fr, int fq) const {
        const int row0 = u.pm * 256 + wr * 64 + fr, pn = u.pn;
#pragma unroll
        for (int ai = 0; ai < 2; ++ai)
#pragma unroll
            for (int m = 0; m < 4; ++m) {
                const int r = row0 + ai * 128 + m * 16;
#pragma unroll
                for (int bj = 0; bj < 2; ++bj) {
                    const f32x4 v0 = acc[ai][bj][m][0], v1 = acc[ai][bj][m][1];
                    u32x4 w; w.x = pk2(v0[0], v0[1]); w.y = pk2(v0[2], v0[3]); w.z = pk2(v1[0], v1[1]); w.w = pk2(v1[2], v1[3]);
                    const int cl = bj * 128 + wc * 32 + 8 * fq;
                    bf16_t* dst;
                    if (pn < 4) {
                        int b, kidx; row_bk(r, b, kidx);
                        const int cc = (pn & 1) * 256 + cl, head = cc >> 7, comp = (cc >> 6) & 1, d = cc & 63;
                        dst = (pn < 2 ? qn : kn) + ((size_t)((b * 4 + head) * 2 + comp) * NK + kidx) * 64 + d;
                    } else if (pn < 6) dst = vraw + (size_t)r * 512 + (pn - 4) * 256 + cl;
                    else if (pn < 9) dst = hyraw + (size_t)r * 768 + (pn - 6) * 256 + cl;
                    else dst = sgraw + (size_t)r * 512 + (pn - 9) * 256 + cl;
                    *(u32x4*)dst = w;
                }
            }
    }
};
struct EpiGate3 {
    static constexpr bool PERM = true, RESCALE = false;
    bf16_t* g3; const float* bias;
    __device__ __forceinline__ void operator()(const AccT& acc, const Unit& u, int wr, int wc, int fr, int fq) const {
        const int row0 = u.pm * 256 + wr * 64 + fr, col0 = u.pn * 256 + wc * 32 + 8 * fq;
#pragma unroll
        for (int bj = 0; bj < 2; ++bj) {
            const f32x4 b0 = *(const f32x4*)(bias + col0 + bj * 128), b1 = *(const f32x4*)(bias + col0 + bj * 128 + 4);
#pragma unroll
            for (int ai = 0; ai < 2; ++ai)
#pragma unroll
                for (int m = 0; m < 4; ++m) {
                    const f32x4 v0 = acc[ai][bj][m][0] + b0, v1 = acc[ai][bj][m][1] + b1;
                    float gv[8];
#pragma unroll
                    for (int j = 0; j < 4; ++j) { gv[j] = fmaxf(sigmoidf_(v0[j]), 1e-5f); gv[4 + j] = fmaxf(sigmoidf_(v1[j]), 1e-5f); }
                    u32x4 w; w.x = pk2(gv[0], gv[1]); w.y = pk2(gv[2], gv[3]); w.z = pk2(gv[4], gv[5]); w.w = pk2(gv[6], gv[7]);
                    *(u32x4*)(g3 + (size_t)(row0 + ai * 128 + m * 16) * 3072 + col0 + bj * 128) = w;
                }
        }
    }
};
struct EpiMergeR {
    static constexpr bool PERM = true, RESCALE = true;
    const bf16_t* g3; bf16_t* mb;
    __device__ __forceinline__ void rescale(AccT& acc, const Unit& u, int which, int wr, int wc, int fr, int fq) const {
        const int row0 = u.pm * 256 + wr * 64 + fr, col0 = u.pn * 256 + wc * 32 + 8 * fq;
        const bf16_t* gb = g3 + (size_t)row0 * 3072 + which * 1024 + col0;
#pragma unroll
        for (int ai = 0; ai < 2; ++ai)
#pragma unroll
            for (int mh = 0; mh < 2; ++mh) {
                u32x4 nw[2][2], dw[2][2];
#pragma unroll
                for (int mm = 0; mm < 2; ++mm)
#pragma unroll
                    for (int bj = 0; bj < 2; ++bj) { const bf16_t* gp = gb + (size_t)(ai * 128 + (mh * 2 + mm) * 16) * 3072 + bj * 128; nw[mm][bj] = *(const u32x4*)gp; dw[mm][bj] = *(const u32x4*)(gp + 1024); }
#pragma unroll
                for (int mm = 0; mm < 2; ++mm)
#pragma unroll
                    for (int bj = 0; bj < 2; ++bj) {
                        const u32x4 n4 = nw[mm][bj], d4 = dw[mm][bj];
                        const f32x4 r0 = {bflo(n4.x) * __builtin_amdgcn_rcpf(bflo(d4.x)), bfhi(n4.x) * __builtin_amdgcn_rcpf(bfhi(d4.x)), bflo(n4.y) * __builtin_amdgcn_rcpf(bflo(d4.y)), bfhi(n4.y) * __builtin_amdgcn_rcpf(bfhi(d4.y))};
                        const f32x4 r1 = {bflo(n4.z) * __builtin_amdgcn_rcpf(bflo(d4.z)), bfhi(n4.z) * __builtin_amdgcn_rcpf(bfhi(d4.z)), bflo(n4.w) * __builtin_amdgcn_rcpf(bflo(d4.w)), bfhi(n4.w) * __builtin_amdgcn_rcpf(bfhi(d4.w))};
                        acc[ai][bj][mh * 2 + mm][0] *= r0; acc[ai][bj][mh * 2 + mm][1] *= r1;
                    }
                __builtin_amdgcn_sched_barrier(0);
            }
    }
    __device__ __forceinline__ void operator()(const AccT& acc, const Unit& u, int wr, int wc, int fr, int fq) const {
        const int row0 = u.pm * 256 + wr * 64 + fr, col0 = u.pn * 256 + wc * 32 + 8 * fq;
#pragma unroll
        for (int bj = 0; bj < 2; ++bj) {
            u32x4 gw[8];
#pragma unroll
            for (int am = 0; am < 8; ++am) gw[am] = *(const u32x4*)(g3 + (size_t)(row0 + (am >> 2) * 128 + (am & 3) * 16) * 3072 + 2048 + col0 + bj * 128);
#pragma unroll
            for (int am = 0; am < 8; ++am) {
                const int ai = am >> 2, m = am & 3;
                const f32x4 v0 = acc[ai][bj][m][0], v1 = acc[ai][bj][m][1];
                u32x4 w; w.x = pk2(v0[0] * bflo(gw[am].x), v0[1] * bfhi(gw[am].x)); w.y = pk2(v0[2] * bflo(gw[am].y), v0[3] * bfhi(gw[am].y));
                w.z = pk2(v1[0] * bflo(gw[am].z), v1[1] * bfhi(gw[am].z)); w.w = pk2(v1[2] * bflo(gw[am].w), v1[3] * bfhi(gw[am].w));
                *(u32x4*)(mb + (size_t)(row0 + ai * 128 + m * 16) * 1024 + col0 + bj * 128) = w;
            }
        }
    }
};

template <class Epi>
__device__ __forceinline__ void run_gemm(unsigned char* smem, const bf16_t* A, const bf16_t* Bt, int M, int N, int K, const Epi& E, bool split_tail = false) {
    asm volatile("" : "+s"(M), "+s"(N), "+s"(K));
    pg8::Gemm g; g.A = A; g.Bt = Bt; g.M = M; g.N = N; g.K = K;
    pg8::StaticOrder S; S.init(M, N, K, gridDim.x, blockIdx.x, split_tail);
    pg8::gemm_phase<Epi>((LAS unsigned char*)smem, g, S, E);
}

__device__ __forceinline__ void mod_item(const Params& p, unsigned char* smem, int m) {
    float* s = (float*)smem;
    float* red = s + 9 * 1024;
    const int tid = TID(), l = m / 144, cb = m % 144;
    __syncthreads();
    for (int i = tid; i < 9216; i += NT) { const float v = (i < 8192) ? p.c[i] : p.c_ctx[i - 8192]; s[i] = v / (1.0f + __expf(-v)); }
    __syncthreads();
    const int kg = tid >> 6, cn = tid & 63, col = cb * 64 + cn;
    const float* w = p.ada_w + (size_t)l * 1024 * 9216 + col;
    float a0 = 0, a1 = 0, a2 = 0, a3 = 0, a4 = 0, a5 = 0, a6 = 0, a7 = 0, a8 = 0;
    for (int k = kg * 128; k < kg * 128 + 128; ++k) {
        const float wv = w[(size_t)k * 9216];
        a0 += s[k] * wv; a1 += s[1024 + k] * wv; a2 += s[2048 + k] * wv; a3 += s[3072 + k] * wv; a4 += s[4096 + k] * wv;
        a5 += s[5120 + k] * wv; a6 += s[6144 + k] * wv; a7 += s[7168 + k] * wv; a8 += s[8192 + k] * wv;
    }
    float* rp = red + kg * 576 + cn;
    rp[0] = a0; rp[64] = a1; rp[128] = a2; rp[192] = a3; rp[256] = a4; rp[320] = a5; rp[384] = a6; rp[448] = a7; rp[512] = a8;
    __syncthreads();
    float* MOD = (float*)(p.ws + O_MOD);
    for (int i = tid; i < 576; i += NT) {
        float v = 0; for (int q = 0; q < 8; ++q) v += red[q * 576 + i];
        const int r = i >> 6, c2 = cb * 64 + (i & 63);
        MOD[((size_t)l * 9 + r) * 9216 + c2] = v + p.ada_b[(size_t)l * 9216 + c2];
    }
}

__device__ __forceinline__ void filt_item(const Params& p, unsigned char* smem, int l, int n, int item, float* filt, float* l1p) {
    float* z = (float*)smem;
    float* h1 = z + 16 * 36;
    float* h2 = h1 + 16 * 64;
    float* stage = h2 + 16 * 64;
    const int tid = TID(), t0 = item * 16;
    __syncthreads();
    for (int i = tid; i < 16 * 33; i += NT) {
        const int tt = i / 33, e = i % 33, t = t0 + tt; float v;
        if (e == 0) v = (float)t / (float)(n - 1);
        else { const int bi = (e - 1) & 15; const float band = 1e-4f + (float)bi * ((15.0f - 1e-4f) / 15.0f); const float wv = (6.283185307179586f / (float)n) * (float)t;
            v = (e <= 16) ? cosf(band * wv) : -sinf(band * wv); }
        z[tt * 36 + e] = v;
    }
    __syncthreads();
    for (int i = tid; i < 16 * 64; i += NT) {
        const int tt = i >> 6, j = i & 63; float a = p.hy_b1[l * 64 + j];
        for (int e = 0; e < 33; ++e) a += z[tt * 36 + e] * p.hy_w1[((size_t)l * 33 + e) * 64 + j];
        h1[i] = sinf(p.hy_freq[l * 64 + j] * a);
    }
    __syncthreads();
    for (int i = tid; i < 16 * 64; i += NT) {
        const int tt = i >> 6, j = i & 63; float a = p.hy_b2[l * 64 + j];
        for (int e = 0; e < 64; ++e) a += h1[tt * 64 + e] * p.hy_w2[((size_t)l * 64 + e) * 64 + j];
        h2[i] = sinf(p.hy_freq[l * 64 + j] * a);
    }
    __syncthreads();
    const float min_decay = -3.0701134573253945f, max_decay = -15.350567286626973f;
#pragma unroll 1
    for (int cc = 0; cc < 2; ++cc) {
        const int col = tid + cc * 512;
        float acc[16];
#pragma unroll
        for (int tt = 0; tt < 16; ++tt) acc[tt] = 0.f;
        for (int e = 0; e < 64; ++e) {
            const float wv = p.hy_w3[((size_t)l * 64 + e) * 1024 + col];
#pragma unroll
            for (int tt = 0; tt < 16; ++tt) acc[tt] += h2[tt * 64 + e] * wv;
        }
        const int oc = col & 511, dir = col >> 9;
        const float ad = fabsf(min_decay + (float)oc * ((max_decay - min_decay) / 511.0f));
        float l1 = 0.f;
#pragma unroll
        for (int tt = 0; tt < 16; ++tt) {
            const int t = t0 + tt; const float tn = (float)t / (float)(n - 1);
            float v = acc[tt] * __expf(-tn * ad);
            if (dir == 1 && t == 0) v = 0.f;
            stage[col * 17 + tt] = v;
            l1 += fabsf(v);
        }
        l1p[(size_t)item * 1024 + col] = l1;
    }
    __syncthreads();
#pragma unroll 4
    for (int k = 0; k < 32; ++k) {
        const int e = tid + k * NT, col = e >> 4, tt = e & 15, t = t0 + tt;
        const int oc = col & 511, dir = col >> 9;
        const int pos = (dir == 0) ? t : ((t == 0) ? n : 2 * n - t);
        filt[(size_t)oc * (2 * n) + pos] = stage[col * 17 + tt];
    }
}

struct WDesc { const float* src; bf16_t* dst; int ld, K; };
__device__ __forceinline__ WDesc wdesc(const Params& p, int l, int ti) {
    WDesc d; int K, nrb, mapsw = 0; const float* src; bf16_t* dst; int ld;
    const size_t L = (size_t)l;
    if (ti < 1408) { src = p.ffn_up + (L * 2 + 0) * 1024 * 5632; ld = 5632; K = 1024; dst = (bf16_t*)(p.ws + O_WUP0); mapsw = 1; }
    else if ((ti -= 1408) < 1408) { src = p.ffn_up + (L * 2 + 1) * 1024 * 5632; ld = 5632; K = 1024; dst = (bf16_t*)(p.ws + O_WUP1); mapsw = 1; }
    else if ((ti -= 1408) < 704) { src = p.ffn_down + (L * 2 + 0) * 2816 * 1024; ld = 1024; K = 2816; dst = (bf16_t*)(p.ws + O_WDN0); }
    else if ((ti -= 704) < 704) { src = p.ffn_down + (L * 2 + 1) * 2816 * 1024; ld = 1024; K = 2816; dst = (bf16_t*)(p.ws + O_WDN1); }
    else if ((ti -= 704) < 704) { src = p.w_in + L * 1024 * 2816; ld = 2816; K = 1024; dst = (bf16_t*)(p.ws + O_WIN); }
    else if ((ti -= 704) < 768) { src = p.gate_w + L * 1024 * 3072; ld = 3072; K = 1024; dst = (bf16_t*)(p.ws + O_WG); }
    else if ((ti -= 768) < 256) { src = p.w_br + L * 1024 * 1024; ld = 1024; K = 1024; dst = (bf16_t*)(p.ws + O_WBR); }
    else { ti -= 256; src = p.w_o + L * 1024 * 1024; ld = 1024; K = 1024; dst = (bf16_t*)(p.ws + O_WO); }
    nrb = K / 64;
    const int nb = ti / nrb, kb = ti % nrb, n0 = nb * 64, k0 = kb * 64;
    int scol = n0;
    if (mapsw) { const int pn = n0 >> 8, half = (n0 >> 7) & 1; scol = half * 2816 + pn * 128 + (n0 & 127); }
    d.src = src + (size_t)k0 * ld + scol; d.dst = dst + (size_t)n0 * K + k0; d.ld = ld; d.K = K;
    return d;
}
__device__ __forceinline__ void wconv_tiles(const Params& p, unsigned char* smem, int l, int nw) {
    float* tile = (float*)smem;
    const int tid = TID(), kk0 = tid >> 6, nn0 = tid & 63, nn = tid >> 3, ks = tid & 7;
    int ti = blockIdx.x;
    if (ti >= nw) return;
    WDesc d = wdesc(p, l, ti);
    float v[8];
#pragma unroll
    for (int i = 0; i < 8; ++i) v[i] = d.src[(size_t)(kk0 + 8 * i) * d.ld + nn0];
    for (;;) {
        const int tn = ti + gridDim.x; const bool more = tn < nw;
        WDesc dn = d; float vn[8];
        if (more) { dn = wdesc(p, l, tn);
#pragma unroll
            for (int i = 0; i < 8; ++i) vn[i] = dn.src[(size_t)(kk0 + 8 * i) * dn.ld + nn0]; }
        __syncthreads();
#pragma unroll
        for (int i = 0; i < 8; ++i) tile[(kk0 + 8 * i) * 65 + nn0] = v[i];
        __syncthreads();
        float o[8];
#pragma unroll
        for (int j = 0; j < 8; ++j) o[j] = tile[(ks * 8 + j) * 65 + nn];
        u32x4 w; w.x = pk2(o[0], o[1]); w.y = pk2(o[2], o[3]); w.z = pk2(o[4], o[5]); w.w = pk2(o[6], o[7]);
        *(u32x4*)(d.dst + (size_t)nn * d.K + ks * 8) = w;
        if (!more) break;
        d = dn; ti = tn;
#pragma unroll
        for (int i = 0; i < 8; ++i) v[i] = vn[i];
    }
}

__device__ __forceinline__ void aux_phase(const Params& p, unsigned char* smem, int l) {
    const int nmod = (l == 0) ? 288 : 0, nf = 256, nfc = (l == 0) ? 16 : 0, nw = 6208;
    const int total = nmod + nf + nfc;
    for (int rep = 0; rep < REP_AUX; ++rep) {
        for (int it = blockIdx.x; it < total; it += gridDim.x) {
            int i = it;
            if (i < nmod) { mod_item(p, smem, i); continue; }
            i -= nmod;
            if (i < nf) { filt_item(p, smem, l, 4096, i, (float*)(p.ws + O_FILT), (float*)(p.ws + O_L1P)); continue; }
            i -= nf;
            filt_item(p, smem, l, 256, i, (float*)(p.ws + O_FILTC), (float*)(p.ws + O_L1PC));
        }
        wconv_tiles(p, smem, l, nw);
    }
}

__device__ __forceinline__ void norm_phase(const Params& p, int l, int sub, int M, bool first, const bf16_t* xl) {
    const float* PART = (const float*)(p.ws + O_PART);
    const int tid = TID(), lane = tid & 63, wv = tid >> 6;
    const float* MOD = (const float*)(p.ws + O_MOD) + (size_t)l * 9 * 9216;
    const float* gn = p.norm_g + ((size_t)l * 3 + sub) * 1024;
    float* XC = (float*)(p.ws + O_XC);
    bf16_t* H = (bf16_t*)(p.ws + O_H);
    const int rstep = gridDim.x * 8;
    for (int rep = 0; rep < REP_NORM; ++rep)
    for (int r0 = blockIdx.x * 8 + wv; r0 < M; r0 += 4 * rstep) {
        f32x4 v[4][4]; float ss[4];
#pragma unroll
        for (int k = 0; k < 4; ++k) {
            const int r = r0 + k * rstep; ss[k] = 0.f;
            if (r >= M) { continue; }
            if (r >= TL) {
                const float* src = (first ? p.ctx : XC) + (size_t)(r - TL) * 1024;
#pragma unroll
                for (int i = 0; i < 4; ++i) { const size_t o = (size_t)(r - TL) * 1024 + i * 256 + lane * 4; v[k][i] = *(const f32x4*)(src + i * 256 + lane * 4);
                    if (!first) { v[k][i] += *(const f32x4*)(PART + o); v[k][i] += *(const f32x4*)(PART + 2048 * 1024 + o); v[k][i] += *(const f32x4*)(PART + 2 * 2048 * 1024 + o); v[k][i] += *(const f32x4*)(PART + 3 * 2048 * 1024 + o); } }
            } else if (first) {
                const float* src = p.x + (size_t)r * 1024;
#pragma unroll
                for (int i = 0; i < 4; ++i) v[k][i] = *(const f32x4*)(src + i * 256 + lane * 4);
            } else {
                const bf16_t* src = xl + (size_t)r * 1024;
#pragma unroll
                for (int i = 0; i < 4; ++i) { const u32x2 w = *(const u32x2*)(src + i * 256 + lane * 4); v[k][i] = (f32x4){bflo(w.x), bfhi(w.x), bflo(w.y), bfhi(w.y)}; }
            }
        }
#pragma unroll
        for (int k = 0; k < 4; ++k) {
            const int r = r0 + k * rstep;
            if (r >= M) continue;
            if (r >= TL) {
#pragma unroll
                for (int i = 0; i < 4; ++i) *(f32x4*)(XC + (size_t)(r - TL) * 1024 + i * 256 + lane * 4) = v[k][i];
            } else if (first) {
                bf16_t* dstx = (bf16_t*)p.out + (size_t)r * 1024;
#pragma unroll
                for (int i = 0; i < 4; ++i) { u32x2 w; w.x = pk2(v[k][i][0], v[k][i][1]); w.y = pk2(v[k][i][2], v[k][i][3]); *(u32x2*)(dstx + i * 256 + lane * 4) = w; v[k][i] = (f32x4){bflo(w.x), bfhi(w.x), bflo(w.y), bfhi(w.y)}; }
            }
            float s2 = 0.f;
#pragma unroll
            for (int i = 0; i < 4; ++i) s2 += v[k][i][0] * v[k][i][0] + v[k][i][1] * v[k][i][1] + v[k][i][2] * v[k][i][2] + v[k][i][3] * v[k][i][3];
            s2 = wave_sum(s2);
            const float rinv = rsqrtf(s2 * (1.0f / 1024.0f) + 1e-6f);
            const int mr = r < TL ? (r >> 12) : 8;
            const float* sh = MOD + (size_t)mr * 9216 + (3 * sub) * 1024;
            const float* sc = sh + 1024;
#pragma unroll
            for (int i = 0; i < 4; ++i) {
                const int c = i * 256 + lane * 4;
                const f32x4 g4 = *(const f32x4*)(gn + c), s4 = *(const f32x4*)(sc + c), h4 = *(const f32x4*)(sh + c);
                const f32x4 y = v[k][i] * rinv * g4 * (s4 + 1.0f) + h4;
                u32x2 w; w.x = pk2(y[0], y[1]); w.y = pk2(y[2], y[3]);
                *(u32x2*)(H + (size_t)r * 1024 + c) = w;
            }
        }
    }
}

#define ZI(i) ((i) + ((i) >> 4))
__device__ __forceinline__ f32x2 cmul(f32x2 a, f32x2 b) { return (f32x2){a.x * b.x - a.y * b.y, a.x * b.y + a.y * b.x}; }
__device__ __forceinline__ f32x2 cmulc(f32x2 a, f32x2 b) { return (f32x2){a.x * b.x + a.y * b.y, a.y * b.x - a.x * b.y}; }
__device__ __forceinline__ void dif8(f32x2 (&x)[8]) {
    const float C = 0.70710678118654752f;
    { f32x2 t;
      t = x[0] - x[4]; x[0] += x[4]; x[4] = t;
      t = x[1] - x[5]; x[1] += x[5]; x[5] = (f32x2){C * (t.x + t.y), C * (t.y - t.x)};
      t = x[2] - x[6]; x[2] += x[6]; x[6] = (f32x2){t.y, -t.x};
      t = x[3] - x[7]; x[3] += x[7]; x[7] = (f32x2){C * (t.y - t.x), -C * (t.x + t.y)}; }
#pragma unroll
    for (int b = 0; b < 8; b += 4) { f32x2 t;
      t = x[b] - x[b + 2]; x[b] += x[b + 2]; x[b + 2] = t;
      t = x[b + 1] - x[b + 3]; x[b + 1] += x[b + 3]; x[b + 3] = (f32x2){t.y, -t.x}; }
#pragma unroll
    for (int b = 0; b < 8; b += 2) { const f32x2 t = x[b] - x[b + 1]; x[b] += x[b + 1]; x[b + 1] = t; }
}
__device__ __forceinline__ void idif8(f32x2 (&x)[8]) {
    const float C = 0.70710678118654752f;
#pragma unroll
    for (int b = 0; b < 8; b += 2) { const f32x2 t = x[b] - x[b + 1]; x[b] += x[b + 1]; x[b + 1] = t; }
#pragma unroll
    for (int b = 0; b < 8; b += 4) { f32x2 v, u;
      v = x[b + 2]; u = x[b]; x[b] = u + v; x[b + 2] = u - v;
      v = (f32x2){-x[b + 3].y, x[b + 3].x}; u = x[b + 1]; x[b + 1] = u + v; x[b + 3] = u - v; }
    { f32x2 v, u, t;
      v = x[4]; u = x[0]; x[0] = u + v; x[4] = u - v;
      t = x[5]; v = (f32x2){C * (t.x - t.y), C * (t.x + t.y)}; u = x[1]; x[1] = u + v; x[5] = u - v;
      t = x[6]; v = (f32x2){-t.y, t.x}; u = x[2]; x[2] = u + v; x[6] = u - v;
      t = x[7]; v = (f32x2){-C * (t.x + t.y), C * (t.x - t.y)}; u = x[3]; x[3] = u + v; x[7] = u - v; }
}
__device__ __forceinline__ void twid8(f32x2 (&x)[8], int pidx, int L, bool conj) {
    const float rev = -(float)pidx / (float)L;
    const float s = __builtin_amdgcn_sinf(rev), c = __builtin_amdgcn_cosf(rev);
    const f32x2 w1 = {c, s}; const f32x2 w2 = cmul(w1, w1), w3 = cmul(w2, w1), w4 = cmul(w2, w2), w5 = cmul(w4, w1), w6 = cmul(w3, w3), w7 = cmul(w4, w3);
    if (!conj) { x[1] = cmul(x[1], w4); x[2] = cmul(x[2], w2); x[3] = cmul(x[3], w6); x[4] = cmul(x[4], w1); x[5] = cmul(x[5], w5); x[6] = cmul(x[6], w3); x[7] = cmul(x[7], w7); }
    else { x[1] = cmulc(x[1], w4); x[2] = cmulc(x[2], w2); x[3] = cmulc(x[3], w6); x[4] = cmulc(x[4], w1); x[5] = cmulc(x[5], w5); x[6] = cmulc(x[6], w3); x[7] = cmulc(x[7], w7); }
}
__device__ __forceinline__ void fft_fwd(f32x2* z) {
    const int tid = TID();
#pragma unroll 1
    for (int L = 8192; L >= 16; L >>= 3) {
        const int S = L >> 3;
#pragma unroll
        for (int qq = 0; qq < 2; ++qq) { const int q = tid + qq * NT;
            const int pidx = q & (S - 1), B = (q / S) * L + pidx;
            f32x2 x[8];
#pragma unroll
            for (int j = 0; j < 8; ++j) x[j] = z[ZI(B + j * S)];
            dif8(x); twid8(x, pidx, L, false);
#pragma unroll
            for (int j = 0; j < 8; ++j) z[ZI(B + j * S)] = x[j];
        }
        __syncthreads();
    }
#pragma unroll 4
    for (int q = tid; q < 4096; q += NT) { const f32x2 a = z[ZI(2 * q)], b = z[ZI(2 * q + 1)]; z[ZI(2 * q)] = a + b; z[ZI(2 * q + 1)] = a - b; }
    __syncthreads();
}
__device__ __forceinline__ void fft_inv(f32x2* z) {
    const int tid = TID();
#pragma unroll 4
    for (int q = tid; q < 4096; q += NT) { const f32x2 a = z[ZI(2 * q)], b = z[ZI(2 * q + 1)]; z[ZI(2 * q)] = a + b; z[ZI(2 * q + 1)] = a - b; }
    __syncthreads();
#pragma unroll 1
    for (int L = 16; L <= 8192; L <<= 3) {
        const int S = L >> 3;
#pragma unroll
        for (int qq = 0; qq < 2; ++qq) { const int q = tid + qq * NT;
            const int pidx = q & (S - 1), B = (q / S) * L + pidx;
            f32x2 x[8];
#pragma unroll
            for (int j = 0; j < 8; ++j) x[j] = z[ZI(B + j * S)];
            twid8(x, pidx, L, true); idif8(x);
#pragma unroll
            for (int j = 0; j < 8; ++j) z[ZI(B + j * S)] = x[j];
        }
        __syncthreads();
    }
}

__device__ __forceinline__ void fft_fwd_h(f32x2* z, int lt) {
#pragma unroll 1
    for (int L = 8192; L >= 16; L >>= 3) {
        const int S = L >> 3;
#pragma unroll 2
        for (int qq = 0; qq < 4; ++qq) { const int q = lt + qq * 256;
            const int pidx = q & (S - 1), B = (q / S) * L + pidx;
            f32x2 x[8];
#pragma unroll
            for (int j = 0; j < 8; ++j) x[j] = z[ZI(B + j * S)];
            dif8(x); twid8(x, pidx, L, false);
#pragma unroll
            for (int j = 0; j < 8; ++j) z[ZI(B + j * S)] = x[j];
        }
        __syncthreads();
    }
#pragma unroll 4
    for (int q = lt; q < 4096; q += 256) { const f32x2 a = z[ZI(2 * q)], b = z[ZI(2 * q + 1)]; z[ZI(2 * q)] = a + b; z[ZI(2 * q + 1)] = a - b; }
    __syncthreads();
}
__device__ __forceinline__ void fft_inv_h(f32x2* z, int lt) {
#pragma unroll 4
    for (int q = lt; q < 4096; q += 256) { const f32x2 a = z[ZI(2 * q)], b = z[ZI(2 * q + 1)]; z[ZI(2 * q)] = a + b; z[ZI(2 * q + 1)] = a - b; }
    __syncthreads();
#pragma unroll 1
    for (int L = 16; L <= 8192; L <<= 3) {
        const int S = L >> 3;
#pragma unroll 2
        for (int qq = 0; qq < 4; ++qq) { const int q = lt + qq * 256;
            const int pidx = q & (S - 1), B = (q / S) * L + pidx;
            f32x2 x[8];
#pragma unroll
            for (int j = 0; j < 8; ++j) x[j] = z[ZI(B + j * S)];
            twid8(x, pidx, L, true); idif8(x);
#pragma unroll
            for (int j = 0; j < 8; ++j) z[ZI(B + j * S)] = x[j];
        }
        __syncthreads();
    }
}

__device__ __forceinline__ void filtfft_item(const Params& p, unsigned char* smem, int oc) {
    f32x2* z = (f32x2*)smem;
    float* red = (float*)(smem + 8704 * 8);
    const int tid = TID();
    const float* filt = (const float*)(p.ws + O_FILT) + (size_t)oc * 8192;
    const float* l1p = (const float*)(p.ws + O_L1P);
    __syncthreads();
#pragma unroll 4
    for (int i = tid; i < 8192; i += NT) z[ZI(i)] = (f32x2){filt[i], 0.f};
    if (tid < 256) red[tid] = l1p[(size_t)tid * 1024 + oc] + l1p[(size_t)tid * 1024 + 512 + oc];
    __syncthreads();
    if (tid < 64) { float v = red[tid] + red[tid + 64] + red[tid + 128] + red[tid + 192]; v = wave_sum(v); if (tid == 0) red[256] = v; }
    fft_fwd(z);
    const float sc = 1.0f / (red[256] * 8192.0f);
    f32x2* fh = (f32x2*)(p.ws + O_FH) + (size_t)oc * 8192;
#pragma unroll 4
    for (int i = tid; i < 8192; i += NT) fh[i] = z[ZI(i)] * sc;
}

__device__ __forceinline__ void hyfft_item(const Params& p, unsigned char* smem, int l, int ch, int bp) {
    f32x2* z = (f32x2*)smem;
    f32x2* zz = (f32x2*)(smem + 8704 * 8);
    const int tid = TID();
    const bf16_t* HV = (const bf16_t*)(p.ws + O_HV);
    const bf16_t* v0 = HV + ((size_t)(2 * bp) * 768 + ch) * 4096; const bf16_t* v1 = v0 + (size_t)768 * 4096;
    const f32x2* fh0 = (const f32x2*)(p.ws + O_FH) + (size_t)ch * 8192; const f32x2* fh1 = fh0 + (size_t)256 * 8192;
    const float sk0 = p.hy_skip[(size_t)l * 512 + ch], sk1 = p.hy_skip[(size_t)l * 512 + 256 + ch];
    bf16_t a0[8], a1[8];
#pragma unroll
    for (int k = 0; k < 8; ++k) { a0[k] = v0[tid + k * NT]; a1[k] = v1[tid + k * NT]; }
    f32x2 fr[16];
#pragma unroll
    for (int k = 0; k < 16; ++k) fr[k] = fh0[tid + k * NT];
    __syncthreads();
#pragma unroll
    for (int k = 0; k < 8; ++k) { const int t = tid + k * NT; z[ZI(t)] = (f32x2){bf2f(a0[k]), bf2f(a1[k])}; z[ZI(4096 + t)] = (f32x2){0.f, 0.f}; }
    __syncthreads();
    fft_fwd(z);
#pragma unroll
    for (int k = 0; k < 16; ++k) { const int i = tid + k * NT; z[ZI(i)] = cmul(z[ZI(i)], fr[k]); }
    bf16_t x0[8], x1[8];
#pragma unroll
    for (int k = 0; k < 8; ++k) { x0[k] = v0[(size_t)256 * 4096 + tid + k * NT]; x1[k] = v1[(size_t)256 * 4096 + tid + k * NT]; }
#pragma unroll
    for (int k = 0; k < 16; ++k) fr[k] = fh1[tid + k * NT];
    __syncthreads();
    fft_inv(z);
#pragma unroll
    for (int k = 0; k < 8; ++k) {
        const int t = tid + k * NT;
        f32x2 y = z[ZI(t)];
        y.x += bf2f(a0[k]) * sk0; y.y += bf2f(a1[k]) * sk0;
        const f32x2 zv = {bf2f(x0[k]) * y.x, bf2f(x1[k]) * y.y};
        zz[t] = zv; z[ZI(t)] = zv; z[ZI(4096 + t)] = (f32x2){0.f, 0.f};
    }
    __syncthreads();
    fft_fwd(z);
#pragma unroll
    for (int k = 0; k < 16; ++k) { const int i = tid + k * NT; z[ZI(i)] = cmul(z[ZI(i)], fr[k]); }
#pragma unroll
    for (int k = 0; k < 8; ++k) { x0[k] = v0[(size_t)512 * 4096 + tid + k * NT]; x1[k] = v1[(size_t)512 * 4096 + tid + k * NT]; }
    __syncthreads();
    fft_inv(z);
    bf16_t* YBT = (bf16_t*)(p.ws + O_YBT);
    bf16_t* o0 = YBT + ((size_t)(2 * bp) * 256 + ch) * 4096; bf16_t* o1 = o0 + (size_t)256 * 4096;
#pragma unroll
    for (int k = 0; k < 8; ++k) {
        const int t = tid + k * NT;
        const f32x2 y = z[ZI(t)] + zz[t] * sk1;
        o0[t] = f2bf(bf2f(x0[k]) * y.x); o1[t] = f2bf(bf2f(x1[k]) * y.y);
    }
}

__device__ __forceinline__ void hyfft_pair(const Params& p, unsigned char* smem, int l, int ch, int pp) {
    const int tid = TID(), hf = __builtin_amdgcn_readfirstlane(tid >> 8), lt = tid & 255, bp = 2 * pp + hf;
    f32x2* z = (f32x2*)(smem + (size_t)hf * 8704 * 8);
    const bf16_t* HV = (const bf16_t*)(p.ws + O_HV);
    const bf16_t* v0 = HV + ((size_t)(2 * bp) * 768 + ch) * 4096; const bf16_t* v1 = v0 + (size_t)768 * 4096;
    const f32x2* fh0 = (const f32x2*)(p.ws + O_FH) + (size_t)ch * 8192; const f32x2* fh1 = fh0 + (size_t)256 * 8192;
    const float sk0 = p.hy_skip[(size_t)l * 512 + ch], sk1 = p.hy_skip[(size_t)l * 512 + 256 + ch];
    unsigned av[16];
#pragma unroll
    for (int k = 0; k < 16; ++k) av[k] = (unsigned)v0[lt + k * 256] | ((unsigned)v1[lt + k * 256] << 16);
    f32x2 fr[32];
#pragma unroll
    for (int k = 0; k < 32; ++k) fr[k] = fh0[lt + k * 256];
    __syncthreads();
#pragma unroll
    for (int k = 0; k < 16; ++k) { const int t = lt + k * 256; z[ZI(t)] = (f32x2){bflo(av[k]), bfhi(av[k])}; z[ZI(4096 + t)] = (f32x2){0.f, 0.f}; }
    __syncthreads();
    fft_fwd_h(z, lt);
#pragma unroll
    for (int k = 0; k < 32; ++k) { const int i = lt + k * 256; z[ZI(i)] = cmul(z[ZI(i)], fr[k]); }
    unsigned xv[16];
#pragma unroll
    for (int k = 0; k < 16; ++k) xv[k] = (unsigned)v0[(size_t)256 * 4096 + lt + k * 256] | ((unsigned)v1[(size_t)256 * 4096 + lt + k * 256] << 16);
#pragma unroll
    for (int k = 0; k < 32; ++k) fr[k] = fh1[lt + k * 256];
    __syncthreads();
    fft_inv_h(z, lt);
    f32x2 zz[16];
#pragma unroll
    for (int k = 0; k < 16; ++k) {
        const int t = lt + k * 256;
        f32x2 y = z[ZI(t)];
        y.x += bflo(av[k]) * sk0; y.y += bfhi(av[k]) * sk0;
        const f32x2 zv = {bflo(xv[k]) * y.x, bfhi(xv[k]) * y.y};
        zz[k] = zv; z[ZI(t)] = zv; z[ZI(4096 + t)] = (f32x2){0.f, 0.f};
    }
    __syncthreads();
    fft_fwd_h(z, lt);
#pragma unroll
    for (int k = 0; k < 32; ++k) { const int i = lt + k * 256; z[ZI(i)] = cmul(z[ZI(i)], fr[k]); }
#pragma unroll
    for (int k = 0; k < 16; ++k) xv[k] = (unsigned)v0[(size_t)512 * 4096 + lt + k * 256] | ((unsigned)v1[(size_t)512 * 4096 + lt + k * 256] << 16);
    __syncthreads();
    fft_inv_h(z, lt);
    bf16_t* YBT = (bf16_t*)(p.ws + O_YBT);
    bf16_t* o0 = YBT + ((size_t)(2 * bp) * 256 + ch) * 4096; bf16_t* o1 = o0 + (size_t)256 * 4096;
#pragma unroll
    for (int k = 0; k < 16; ++k) {
        const int t = lt + k * 256;
        const f32x2 y = z[ZI(t)] + zz[k] * sk1;
        o0[t] = f2bf(bflo(xv[k]) * y.x); o1[t] = f2bf(bfhi(xv[k]) * y.y);
    }
}

__device__ __forceinline__ void hyctx_item(const Params& p, unsigned char* smem, int l, int b, int cp) {
    float* f1 = (float*)smem;
    float* f2 = f1 + 1024;
    float* vv = f2 + 1024;
    float* zc = vv + 512;
    float* red = zc + 512;
    const int tid = TID(), hf = tid >> 8, t = tid & 255, ch = cp * 2 + hf;
    const float* FC = (const float*)(p.ws + O_FILTC); const float* l1p = (const float*)(p.ws + O_L1PC);
    const bf16_t* HVC = (const bf16_t*)(p.ws + O_HVC) + ((size_t)b * 768 + ch) * 256;
    __syncthreads();
    f1[hf * 512 + t] = FC[(size_t)ch * 512 + t]; f1[hf * 512 + 256 + t] = FC[(size_t)ch * 512 + 256 + t];
    f2[hf * 512 + t] = FC[(size_t)(256 + ch) * 512 + t]; f2[hf * 512 + 256 + t] = FC[(size_t)(256 + ch) * 512 + 256 + t];
    const float vt = bf2f(HVC[t]); vv[hf * 256 + t] = vt;
    if (t < 2) { float s = 0.f; for (int it = 0; it < 16; ++it) s += l1p[(size_t)it * 1024 + t * 256 + ch] + l1p[(size_t)it * 1024 + 512 + t * 256 + ch]; red[hf * 2 + t] = s; }
    __syncthreads();
    float a = 0.f;
    for (int s = 0; s < 256; ++s) a += f1[hf * 512 + ((t - s) & 511)] * vv[hf * 256 + s];
    const float y1 = a / red[hf * 2 + 0] + vt * p.hy_skip[(size_t)l * 512 + ch];
    const float zt = bf2f(HVC[(size_t)256 * 256 + t]) * y1; zc[hf * 256 + t] = zt;
    __syncthreads();
    float a2 = 0.f;
    for (int s = 0; s < 256; ++s) a2 += f2[hf * 512 + ((t - s) & 511)] * zc[hf * 256 + s];
    const float y2 = a2 / red[hf * 2 + 1] + zt * p.hy_skip[(size_t)l * 512 + 256 + ch];
    bf16_t* YBTC = (bf16_t*)(p.ws + O_YBTC);
    YBTC[((size_t)b * 256 + ch) * 256 + t] = f2bf(bf2f(HVC[(size_t)512 * 256 + t]) * y2);
}

__device__ __forceinline__ void qk_item(const Params& p, int l, int item, bool dry = false) {
    const int tid = TID(), seg = tid & 7, vsub = tid >> 3;
    const int which = (item >= 544) ? 1 : 0;
    const int vbase = (item - which * 544) * 512;
    bf16_t* base = (bf16_t*)(p.ws + (which ? O_KN : O_QN));
    u32x4 raw[8];
#pragma unroll
    for (int it = 0; it < 8; ++it) raw[it] = *(const u32x4*)(base + (size_t)(vbase + it * 64 + vsub) * 64 + seg * 8);
    const float* gp = p.qk_gain + (size_t)l * 128 + which * 64 + seg * 8;
    const f32x4 g0 = *(const f32x4*)gp, g1 = *(const f32x4*)(gp + 4);
    const float gn[8] = {g0[0], g0[1], g0[2], g0[3], g1[0], g1[1], g1[2], g1[3]};
    const float qs = which ? 1.0f : (0.125f * 1.4426950408889634f);
    const int axis = seg >> 2, role = (seg >> 1) & 1, qb = (seg & 1) * 8;
    float inv[8];
#pragma unroll
    for (int e = 0; e < 8; ++e) inv[e] = exp2f(-(float)(qb + e) * (13.287712379549449f / 16.0f));
#pragma unroll
    for (int it = 0; it < 8; ++it) {
        const int rem = vbase + it * 64 + vsub, kidx = rem % NK;
        const u32x4 w = raw[it];
        float v[8] = {bflo(w.x), bfhi(w.x), bflo(w.y), bfhi(w.y), bflo(w.z), bfhi(w.z), bflo(w.w), bfhi(w.w)};
        float ss = 0.f;
#pragma unroll
        for (int e = 0; e < 8; ++e) ss += v[e] * v[e];
        ss += __shfl_xor(ss, 1); ss += __shfl_xor(ss, 2); ss += __shfl_xor(ss, 4);
        const float rinv = rsqrtf(ss * (1.0f / 64.0f) + 1e-6f) * qs;
#pragma unroll
        for (int e = 0; e < 8; ++e) v[e] = v[e] * rinv * gn[e];
        const int t = kidx - 256;
        const float pos = (float)(axis ? (t & 63) : (t >> 6));
        float o[8];
#pragma unroll
        for (int e = 0; e < 8; ++e) {
            const float pe = __shfl_xor(v[e], 2);
            float sn, cs; __sincosf(pos * inv[e], &sn, &cs);
            const float r = role ? (pe * sn + v[e] * cs) : (v[e] * cs - pe * sn);
            o[e] = (kidx >= 256) ? r : v[e];
        }
        u32x4 ow = {pk2(o[0], o[1]), pk2(o[2], o[3]), pk2(o[4], o[5]), pk2(o[6], o[7])};
        if (dry) ow = w;
        *(u32x4*)(base + (size_t)rem * 64 + seg * 8) = ow;
    }
}

__device__ __forceinline__ void vt_item(const Params& p, unsigned char* smem, int tb) {
    bf16_t* tile = (bf16_t*)smem;
    const int tid = TID(), r0 = tb * 64;
    const bf16_t* src = (const bf16_t*)(p.ws + O_VRAW) + (size_t)r0 * 512;
    __syncthreads();
#pragma unroll
    for (int i = 0; i < 8; ++i) { const int e = tid + i * NT, rr = e >> 6, sg = e & 63; *(u32x4*)(tile + rr * 520 + sg * 8) = *(const u32x4*)(src + (size_t)rr * 512 + sg * 8); }
    __syncthreads();
    int b, kidx0; row_bk(r0, b, kidx0);
    bf16_t* tr = tile + 64 * 520;
#pragma unroll
    for (int s = 0; s < 8; ++s) {
        unsigned w[4];
#pragma unroll
        for (int j = 0; j < 4; ++j) w[j] = (unsigned)tile[(s * 8 + 2 * j) * 520 + tid] | ((unsigned)tile[(s * 8 + 2 * j + 1) * 520 + tid] << 16);
        *(u32x4*)(tr + tid * 72 + s * 8) = (u32x4){w[0], w[1], w[2], w[3]};
    }
    __syncthreads();
    bf16_t* dst = (bf16_t*)(p.ws + O_VT) + (size_t)b * 512 * NK + kidx0;
#pragma unroll
    for (int ps = 0; ps < 8; ++ps) {
        const int c = (tid >> 3) + 64 * ps, sg = tid & 7;
        *(u32x4*)(dst + (size_t)c * NK + sg * 8) = *(const u32x4*)(tr + c * 72 + sg * 8);
    }
}

__device__ __forceinline__ void hyconv_item(const Params& p, unsigned char* smem, int l, int tb) {
    bf16_t* tile = (bf16_t*)smem;
    const int tid = TID(), r0 = tb * 64;
    const bool lat = r0 < TL;
    const int n = lat ? 4096 : 256, rb = lat ? r0 : r0 - TL, b = rb / n, t0 = rb % n;
    const bf16_t* src = (const bf16_t*)(p.ws + O_HYRAW);
    __syncthreads();
    {
        u32x4 wv[13];
#pragma unroll
        for (int k = 0; k < 13; ++k) {
            const int e = tid + k * NT, rr = e / 96, sg = e % 96, t = t0 - 1 + rr;
            wv[k] = (u32x4){0u, 0u, 0u, 0u};
            if (e < 66 * 96 && t >= 0 && t < n) wv[k] = *(const u32x4*)(src + (size_t)(r0 - 1 + rr) * 768 + sg * 8);
        }
#pragma unroll
        for (int k = 0; k < 13; ++k) { const int e = tid + k * NT, rr = e / 96, sg = e % 96; if (e < 66 * 96) *(u32x4*)(tile + rr * 776 + sg * 8) = wv[k]; }
    }
    __syncthreads();
    const float* cw = p.hy_conv_w + (size_t)l * 3 * 768; const float* cb = p.hy_conv_b + (size_t)l * 768;
    bf16_t* img = tile + 66 * 776;
    const int cl = tid & 255, hh = tid >> 8;
#pragma unroll 1
    for (int third = 0; third < 3; ++third) {
        const int c = third * 256 + cl;
        const float w0 = cw[c], w1 = cw[768 + c], w2 = cw[1536 + c], bb = cb[c];
        float pm = bf2f(tile[(hh * 32) * 776 + c]), pc = bf2f(tile[(hh * 32 + 1) * 776 + c]);
#pragma unroll
        for (int s4 = 0; s4 < 4; ++s4) {
            float o[8];
#pragma unroll
            for (int j = 0; j < 8; ++j) { const float pn = bf2f(tile[(hh * 32 + s4 * 8 + j + 2) * 776 + c]); o[j] = pm * w0 + pc * w1 + pn * w2 + bb; pm = pc; pc = pn; }
            *(u32x4*)(img + cl * 72 + hh * 32 + s4 * 8) = (u32x4){pk2(o[0], o[1]), pk2(o[2], o[3]), pk2(o[4], o[5]), pk2(o[6], o[7])};
        }
        __syncthreads();
#pragma unroll
        for (int k = 0; k < 4; ++k) {
            const int e = tid + k * NT, cr = e >> 3, sg = e & 7, cg = third * 256 + cr;
            bf16_t* dst = lat ? (bf16_t*)(p.ws + O_HV) + ((size_t)b * 768 + cg) * 4096 + t0 : (bf16_t*)(p.ws + O_HVC) + ((size_t)b * 768 + cg) * 256 + t0;
            *(u32x4*)(dst + sg * 8) = *(const u32x4*)(img + cr * 72 + sg * 8);
        }
        __syncthreads();
    }
}

__device__ __forceinline__ float gelu_exact(float v) { return 0.5f * v * (1.0f + erff(v * 0.70710678118654752f)); }
__device__ __forceinline__ void sgu_item(const Params& p, unsigned char* smem, int l, int ci) {
    bf16_t* vt = (bf16_t*)smem;
    const int tid = TID(), lane = tid & 63, wv = __builtin_amdgcn_readfirstlane(tid >> 6), r0 = ci * 128;
    const bf16_t* src = (const bf16_t*)(p.ws + O_SGRAW) + (size_t)r0 * 512;
    const float* lg = p.sg_ln_g + (size_t)l * 256; const float* lb = p.sg_ln_b + (size_t)l * 256;
    __syncthreads();
    {
        const f32x4 g4 = *(const f32x4*)(lg + lane * 4), b4 = *(const f32x4*)(lb + lane * 4);
        u32x2 wr_[16];
#pragma unroll
        for (int k = 0; k < 16; ++k) wr_[k] = *(const u32x2*)(src + (size_t)(wv + 8 * k) * 512 + 256 + lane * 4);
#pragma unroll
        for (int k = 0; k < 16; ++k) {
            const int rr = wv + 8 * k; const u32x2 w = wr_[k];
            float a[4] = {gelu_exact(bflo(w.x)), gelu_exact(bfhi(w.x)), gelu_exact(bflo(w.y)), gelu_exact(bfhi(w.y))};
            const float mu = wave_sum(a[0] + a[1] + a[2] + a[3]) * (1.0f / 256.0f);
            float d[4]; float sq = 0.f;
#pragma unroll
            for (int j = 0; j < 4; ++j) { d[j] = a[j] - mu; sq += d[j] * d[j]; }
            const float rstd = rsqrtf(wave_sum(sq) * (1.0f / 256.0f) + 1e-6f);
#pragma unroll
            for (int j = 0; j < 4; ++j) vt[(lane * 4 + j) * 136 + rr] = f2bf(d[j] * rstd * g4[j] + b4[j]);
        }
    }
    __syncthreads();
    const int g = wv & 3, ih = wv >> 2, l32 = lane & 31, kg = lane >> 5;
    const float* wsb = p.sg_w + ((size_t)l * 4 + g) * 128 * 128;
    const float* bsb = p.sg_b + ((size_t)l * 4 + g) * 128;
    bf16_t* yc = (bf16_t*)(p.ws + O_YCAT) + 768;
#pragma unroll 1
    for (int ib = 0; ib < 2; ++ib) {
        const int i0 = ih * 64 + ib * 32;
        f32x16 acc0, acc1;
#pragma unroll
        for (int r = 0; r < 16; ++r) { acc0[r] = 0.f; acc1[r] = 0.f; }
        const float* wrow = wsb + (size_t)(i0 + l32) * 128 + 8 * kg;
#pragma unroll
        for (int ks = 0; ks < 8; ++ks) {
            const f32x4 w0 = *(const f32x4*)(wrow + 16 * ks), w1 = *(const f32x4*)(wrow + 16 * ks + 4);
            const u32x4 aw = {pk2(w0[0], w0[1]), pk2(w0[2], w0[3]), pk2(w1[0], w1[1]), pk2(w1[2], w1[3])};
            const bf16x8 af = __builtin_bit_cast(bf16x8, aw);
            const bf16x8 b0 = *(const bf16x8*)(vt + (g * 64 + l32) * 136 + 16 * ks + 8 * kg);
            const bf16x8 b1 = *(const bf16x8*)(vt + (g * 64 + 32 + l32) * 136 + 16 * ks + 8 * kg);
            acc0 = __builtin_amdgcn_mfma_f32_32x32x16_bf16(af, b0, acc0, 0, 0, 0);
            acc1 = __builtin_amdgcn_mfma_f32_32x32x16_bf16(af, b1, acc1, 0, 0, 0);
        }
#pragma unroll
        for (int r = 0; r < 16; ++r) {
            const int i = i0 + 8 * (r >> 2) + 4 * kg + (r & 3);
            const float bi = bsb[i];
            const int c0 = g * 64 + l32, c1 = c0 + 32;
            const float u0 = gelu_exact(bf2f(src[(size_t)i * 512 + c0])), u1 = gelu_exact(bf2f(src[(size_t)i * 512 + c1]));
            yc[(size_t)(r0 + i) * 1024 + c0] = f2bf(u0 * (acc0[r] + bi));
            yc[(size_t)(r0 + i) * 1024 + c1] = f2bf(u1 * (acc1[r] + bi));
        }
    }
}

__device__ __forceinline__ void prep_phase(const Params& p, unsigned char* smem, int l) {
    const int n_sg = 0, n_hy = 544, n_vt = 544, n_qk = 1088;
    const int total = n_sg + n_hy + n_vt + n_qk;
    for (int it = blockIdx.x; it < total; it += gridDim.x) {
        int i = it;
        if (i < n_sg) { for (int rep = 0; rep < REP_SGU; ++rep) sgu_item(p, smem, l, i); continue; }
        i -= n_sg;
        if (i < n_hy) { for (int rep = 0; rep < REP_PREP; ++rep) hyconv_item(p, smem, l, i); continue; }
        i -= n_hy;
        if (i < n_vt) { for (int rep = 0; rep < REP_PREP; ++rep) vt_item(p, smem, i); continue; }
        i -= n_vt;
#if REP_QK > 1
        qk_item(p, l, i, true);
#endif
        qk_item(p, l, i);
    }
}

__device__ __forceinline__ void attn_item(const Params& p, unsigned char* smem, int b, int h, int comp, int q0, int rowbase, int nkt) {
    constexpr int ABUF = 64 * 72 + 128 * 72;
    bf16_t* Ks = (bf16_t*)smem;
    bf16_t* Vs = Ks + 64 * 72;
    const int tid = TID(), lane = tid & 63, w = tid >> 6, l32 = lane & 31, g = lane >> 5;
    const size_t hc = (size_t)((b * 4 + h) * 2 + comp);
    const bf16_t* Qb = (const bf16_t*)(p.ws + O_QN) + (hc * NK + q0 + 32 * w + l32) * 64;
    const bf16_t* Kb = (const bf16_t*)(p.ws + O_KN) + hc * NK * 64;
    const bf16_t* Vb = (const bf16_t*)(p.ws + O_VT) + (size_t)((b * 4 + h) * 128) * NK;
    bf16x8 qf[4];
#pragma unroll
    for (int ks = 0; ks < 4; ++ks) qf[ks] = *(const bf16x8*)(Qb + 16 * ks + 8 * g);
    f32x16 O[4];
#pragma unroll
    for (int d = 0; d < 4; ++d)
#pragma unroll
        for (int i = 0; i < 16; ++i) O[d][i] = 0.f;
    float lsum = 0.f;
    const int kkey = tid >> 3, kseg = tid & 7, vdv = tid >> 2, vseg = tid & 3;
    const bf16_t* kg = Kb + (size_t)kkey * 64 + kseg * 8;
    const bf16_t* vg = Vb + (size_t)vdv * NK + vseg * 16;
    u32x4 kreg = *(const u32x4*)kg, vr0 = *(const u32x4*)vg, vr1 = *(const u32x4*)(vg + 8);
    const int pr = (l32 & ~12) | ((l32 & 4) << 1) | ((l32 & 8) >> 1);
    __syncthreads();
    *(u32x4*)(Ks + kkey * 72 + kseg * 8) = kreg; *(u32x4*)(Vs + vdv * 72 + vseg * 16) = vr0; *(u32x4*)(Vs + vdv * 72 + vseg * 16 + 8) = vr1;
    if (nkt > 1) { kreg = *(const u32x4*)(kg + (size_t)64 * 64); vr0 = *(const u32x4*)(vg + 64); vr1 = *(const u32x4*)(vg + 64 + 8); }
    __syncthreads();
    for (int kt = 0; kt < nkt; ++kt) {
        const bf16_t* Kc = Ks + (kt & 1) * ABUF; const bf16_t* Vc = Vs + (kt & 1) * ABUF;
        if (kt + 1 < nkt) {
            bf16_t* Kn = Ks + ((kt + 1) & 1) * ABUF; bf16_t* Vn = Vs + ((kt + 1) & 1) * ABUF;
            *(u32x4*)(Kn + kkey * 72 + kseg * 8) = kreg; *(u32x4*)(Vn + vdv * 72 + vseg * 16) = vr0; *(u32x4*)(Vn + vdv * 72 + vseg * 16 + 8) = vr1;
            if (kt + 2 < nkt) { kreg = *(const u32x4*)(kg + (size_t)(kt + 2) * 64 * 64); vr0 = *(const u32x4*)(vg + (kt + 2) * 64); vr1 = *(const u32x4*)(vg + (kt + 2) * 64 + 8); }
        }
        f32x16 S0, S1;
#pragma unroll
        for (int i = 0; i < 16; ++i) { S0[i] = 0.f; S1[i] = 0.f; }
#pragma unroll
        for (int ks = 0; ks < 4; ++ks) {
            const bf16x8 ka = *(const bf16x8*)(Kc + pr * 72 + 16 * ks + 8 * g);
            const bf16x8 kb = *(const bf16x8*)(Kc + (32 + pr) * 72 + 16 * ks + 8 * g);
            S0 = __builtin_amdgcn_mfma_f32_32x32x16_bf16(ka, qf[ks], S0, 0, 0, 0);
            S1 = __builtin_amdgcn_mfma_f32_32x32x16_bf16(kb, qf[ks], S1, 0, 0, 0);
        }
#pragma unroll
        for (int i = 0; i < 16; ++i) { S0[i] = __builtin_amdgcn_exp2f(S0[i]); S1[i] = __builtin_amdgcn_exp2f(S1[i]); lsum += S0[i] + S1[i]; }
#pragma unroll
        for (int kb2 = 0; kb2 < 2; ++kb2)
#pragma unroll
            for (int s = 0; s < 2; ++s) {
                u32x4 pw;
                if (kb2 == 0) { pw.x = pk2(S0[8 * s], S0[8 * s + 1]); pw.y = pk2(S0[8 * s + 2], S0[8 * s + 3]); pw.z = pk2(S0[8 * s + 4], S0[8 * s + 5]); pw.w = pk2(S0[8 * s + 6], S0[8 * s + 7]); }
                else { pw.x = pk2(S1[8 * s], S1[8 * s + 1]); pw.y = pk2(S1[8 * s + 2], S1[8 * s + 3]); pw.z = pk2(S1[8 * s + 4], S1[8 * s + 5]); pw.w = pk2(S1[8 * s + 6], S1[8 * s + 7]); }
                const bf16x8 pf = __builtin_bit_cast(bf16x8, pw);
#pragma unroll
                for (int d = 0; d < 4; ++d) {
                    const bf16x8 va = *(const bf16x8*)(Vc + (d * 32 + l32) * 72 + kb2 * 32 + 16 * s + 8 * g);
                    O[d] = __builtin_amdgcn_mfma_f32_32x32x16_bf16(va, pf, O[d], 0, 0, 0);
                }
            }
        __syncthreads();
    }
    lsum += __shfl_xor(lsum, 32);
    const float inv = 1.0f / lsum;
    bf16_t* stg = (bf16_t*)(smem + 4 * ABUF) + (size_t)(32 * w) * 136;
#pragma unroll
    for (int d = 0; d < 4; ++d)
#pragma unroll
        for (int i4 = 0; i4 < 4; ++i4) {
            u32x2 o; o.x = pk2(O[d][4 * i4] * inv, O[d][4 * i4 + 1] * inv); o.y = pk2(O[d][4 * i4 + 2] * inv, O[d][4 * i4 + 3] * inv);
            *(u32x2*)(stg + l32 * 136 + d * 32 + 8 * i4 + 4 * g) = o;
        }
    bf16_t* ob = (bf16_t*)(p.ws + O_OC) + ((size_t)(rowbase + 32 * w) * 8 + h * 2 + comp) * 128;
#pragma unroll
    for (int k = 0; k < 8; ++k) {
        const int rr = 4 * k + (lane >> 4), pc = lane & 15;
        *(u32x4*)(ob + (size_t)rr * 1024 + pc * 8) = *(const u32x4*)(stg + rr * 136 + pc * 8);
    }
}

__device__ __forceinline__ void mix_phase(const Params& p, unsigned char* smem, int l) {
    const int n_al = 1024, n_ac = (l == 0) ? 64 : 0, n_hf = 512, n_hc = (l == 0) ? 1024 : 0;
    const int total = n_al + n_ac + n_hf + n_hc;
    for (int it = blockIdx.x; it < total; it += gridDim.x) {
        int i = it;
        if (i < n_al) { const int comp = i & 1, h = (i >> 1) & 3, qt = (i >> 3) & 15, b = i >> 7; for (int rep = 0; rep < REP_ATT; ++rep) attn_item(p, smem, b, h, comp, 256 + qt * 256, b * 4096 + qt * 256, 68); continue; }
        i -= n_al;
        if (i < n_ac) { const int comp = i & 1, h = (i >> 1) & 3, b = i >> 3; attn_item(p, smem, b, h, comp, 0, TL + b * 256, 4); continue; }
        i -= n_ac;
        if (i < n_hf) { for (int rep = 0; rep < REP_HY; ++rep) hyfft_pair(p, smem, l, i >> 1, i & 1); continue; }
        i -= n_hf;
        for (int rep = 0; rep < REP_MISC; ++rep) hyctx_item(p, smem, l, i >> 7, i & 127);
    }
}

__device__ __forceinline__ void ybt_item(const Params& p, unsigned char* smem, int tb) {
    bf16_t* tile = (bf16_t*)smem;
    const int tid = TID(), r0 = tb * 64;
    const bool lat = r0 < TL;
    const int n = lat ? 4096 : 256, rb = lat ? r0 : r0 - TL, b = rb / n, t0 = rb % n;
    const bf16_t* src = (lat ? (const bf16_t*)(p.ws + O_YBT) : (const bf16_t*)(p.ws + O_YBTC)) + (size_t)b * 256 * n + t0;
    __syncthreads();
#pragma unroll
    for (int i = 0; i < 4; ++i) { const int e = tid + i * NT, ch = e >> 3, sg = e & 7; *(u32x4*)(tile + ch * 72 + sg * 8) = *(const u32x4*)(src + (size_t)ch * n + sg * 8); }
    __syncthreads();
    bf16_t* yb = (bf16_t*)(p.ws + O_YCAT) + 512;
#pragma unroll
    for (int i = 0; i < 4; ++i) {
        const int e = tid + i * NT, rr = e >> 5, sg = e & 31;
        unsigned w[4];
#pragma unroll
        for (int j = 0; j < 4; ++j) w[j] = (unsigned)tile[(sg * 8 + 2 * j) * 72 + rr] | ((unsigned)tile[(sg * 8 + 2 * j + 1) * 72 + rr] << 16);
        *(u32x4*)(yb + (size_t)(r0 + rr) * 1024 + sg * 8) = (u32x4){w[0], w[1], w[2], w[3]};
    }
}
__device__ __forceinline__ void post_phase(const Params& p, unsigned char* smem, int l, int M) {
    const int n_sg = M / 128, nb = M / 64;
    for (int it = blockIdx.x; it < n_sg + nb; it += gridDim.x) {
        if (it < n_sg) { for (int rep = 0; rep < REP_SGU; ++rep) sgu_item(p, smem, l, it); }
        else ybt_item(p, smem, it - n_sg);
    }
    const int tid = TID(), lane = tid & 63, wv = tid >> 6;
    const float* lv = p.da_lambda + (size_t)l * 256;
    const float d01 = wave_sum(lv[lane] * lv[64 + lane]), d23 = wave_sum(lv[128 + lane] * lv[192 + lane]);
    const float lam_init = 0.8f - 0.6f * expf(-0.3f * (float)l);
    const float lam = expf(d01) - expf(d23) + lam_init;
    const float* sub = p.da_subln + (size_t)l * 128;
    const float s0 = sub[2 * lane] * (1.0f - lam_init), s1 = sub[2 * lane + 1] * (1.0f - lam_init);
    const bf16_t* OC = (const bf16_t*)(p.ws + O_OC);
    bf16_t* YA = (bf16_t*)(p.ws + O_YCAT);
    const int vstep = gridDim.x * 8;
    for (int v0i = blockIdx.x * 8 + wv; v0i < M * 4; v0i += 4 * vstep) {
        unsigned aw[4], bw[4];
#pragma unroll
        for (int k = 0; k < 4; ++k) { const int vi = v0i + k * vstep; aw[k] = 0u; bw[k] = 0u;
            if (vi < M * 4) { const bf16_t* o0 = OC + (size_t)vi * 256; aw[k] = *(const unsigned*)(o0 + 2 * lane); bw[k] = *(const unsigned*)(o0 + 128 + 2 * lane); } }
#pragma unroll
        for (int k = 0; k < 4; ++k) { const int vi = v0i + k * vstep;
            if (vi < M * 4) {
                const float x0 = bflo(aw[k]) - lam * bflo(bw[k]), x1 = bfhi(aw[k]) - lam * bfhi(bw[k]);
                const float rinv = rsqrtf(wave_sum(x0 * x0 + x1 * x1) * (1.0f / 128.0f) + 1e-6f);
                *(unsigned*)(YA + (size_t)(vi >> 2) * 1024 + (vi & 3) * 128 + 2 * lane) = pk2(x0 * rinv * s0, x1 * rinv * s1);
            } }
    }
}

template <int l> __device__ __forceinline__ void layer_body(unsigned char* smem) {
        const int Mfull = TT, Mpost = (l == 0) ? TT : TL;
        { const Params q = opq(smem); norm_phase(q, l, 0, Mfull, l == 0, (const bf16_t*)q.out); if (l == 1) aux_phase(q, smem, 1); }
        gsync(smem);
        for (int rep = 0; rep < REP_UP; ++rep) { const Params q = opq(smem); EpiSwiglu E; E.G = (bf16_t*)(q.ws + O_GH); run_gemm(smem, (const bf16_t*)(q.ws + O_H), (const bf16_t*)(q.ws + O_WUP0), Mfull, 5632, 1024, E); }
        gsync(smem);
        { const Params q = opq(smem); EpiResid E; E.xin = (const bf16_t*)q.out; E.xout = (bf16_t*)q.out; E.fout = nullptr; E.xc = (float*)(q.ws + O_XC); E.part = (float*)(q.ws + O_PART); E.mod = (const float*)(q.ws + O_MOD) + (size_t)l * 9 * 9216; E.gofs = 2 * 1024; E.coef = 0.5f;
          run_gemm(smem, (const bf16_t*)(q.ws + O_GH), (const bf16_t*)(q.ws + O_WDN0), Mfull, 1024, 2816, E, true);
          for (int rep = 1; rep < REP_DN; ++rep) { E.coef = 0.f; run_gemm(smem, (const bf16_t*)(q.ws + O_GH), (const bf16_t*)(q.ws + O_WDN0), Mfull, 1024, 2816, E); } }
        gsync(smem);
        { const Params q = opq(smem); norm_phase(q, l, 1, Mfull, false, (const bf16_t*)q.out); for (int rep = 0; rep < REP_MISC; ++rep) for (int it = blockIdx.x; it < 512; it += gridDim.x) filtfft_item(q, smem, it); }
        gsync(smem);
        for (int rep = 0; rep < REP_G3; ++rep) { const Params q = opq(smem); EpiIn E; E.qn = (bf16_t*)(q.ws + O_QN); E.kn = (bf16_t*)(q.ws + O_KN); E.vraw = (bf16_t*)(q.ws + O_VRAW); E.hyraw = (bf16_t*)(q.ws + O_HYRAW); E.sgraw = (bf16_t*)(q.ws + O_SGRAW);
          run_gemm(smem, (const bf16_t*)(q.ws + O_H), (const bf16_t*)(q.ws + O_WIN), Mfull, 2816, 1024, E); }
        gsync(smem);
        { const Params q = opq(smem); prep_phase(q, smem, l); }
        gsync(smem);
        { const Params q = opq(smem); mix_phase(q, smem, l); }
        gsync(smem);
        for (int rep = 0; rep < REP_MISC; ++rep) { const Params q = opq(smem); post_phase(q, smem, l, Mpost); }
        gsync(smem);
#pragma unroll 1
        for (int rep9 = 0; rep9 < REP_P9; ++rep9) {
            { const Params q = opq(smem); EpiGate3 E; E.g3 = (bf16_t*)(q.ws + O_G3); E.bias = q.gate_b + (size_t)l * 3072;
              run_gemm(smem, (const bf16_t*)(q.ws + O_H), (const bf16_t*)(q.ws + O_WG), Mpost, 3072, 1024, E); }
            gsync(smem);
            { const Params q = opq(smem); EpiMergeR E; E.g3 = (const bf16_t*)(q.ws + O_G3); E.mb = (bf16_t*)(q.ws + O_MB);
              run_gemm(smem, (const bf16_t*)(q.ws + O_YCAT), (const bf16_t*)(q.ws + O_WBR), Mpost, 1024, 1024, E); }
        }
        gsync(smem);
        { const Params q = opq(smem); EpiResid E; E.xin = (const bf16_t*)q.out; E.xout = (l == 1) ? (bf16_t*)(q.ws + O_XALT) : (bf16_t*)q.out; E.fout = nullptr; E.xc = (float*)(q.ws + O_XC); E.part = (float*)(q.ws + O_PART); E.mod = (const float*)(q.ws + O_MOD) + (size_t)l * 9 * 9216; E.gofs = 5 * 1024; E.coef = 1.0f;
          run_gemm(smem, (const bf16_t*)(q.ws + O_MB), (const bf16_t*)(q.ws + O_WO), Mpost, 1024, 1024, E, l == 0);
          for (int rep = 1; rep < REP_G3; ++rep) { E.coef = 0.f; run_gemm(smem, (const bf16_t*)(q.ws + O_MB), (const bf16_t*)(q.ws + O_WO), Mpost, 1024, 1024, E); } }
        gsync(smem);
        { const Params q = opq(smem); norm_phase(q, l, 2, Mpost, false, (l == 1) ? (const bf16_t*)(q.ws + O_XALT) : (const bf16_t*)q.out); }
        gsync(smem);
        for (int rep = 0; rep < REP_UP; ++rep) { const Params q = opq(smem); EpiSwiglu E; E.G = (bf16_t*)(q.ws + O_GH); run_gemm(smem, (const bf16_t*)(q.ws + O_H), (const bf16_t*)(q.ws + O_WUP1), Mpost, 5632, 1024, E); }
        gsync(smem);
        { const Params q = opq(smem); EpiResid E; E.xin = (l == 1) ? (const bf16_t*)(q.ws + O_XALT) : (const bf16_t*)q.out; E.xout = (bf16_t*)q.out; E.fout = (l == 1) ? q.out : nullptr; E.xc = (float*)(q.ws + O_XC); E.part = (float*)(q.ws + O_PART); E.mod = (const float*)(q.ws + O_MOD) + (size_t)l * 9 * 9216; E.gofs = 8 * 1024; E.coef = 0.5f;
          run_gemm(smem, (const bf16_t*)(q.ws + O_GH), (const bf16_t*)(q.ws + O_WDN1), Mpost, 1024, 2816, E, l == 0); }
}

__global__ void __launch_bounds__(512, 2) fwd_megakernel(Params p) {
    extern __shared__ __attribute__((aligned(16))) unsigned char smem[];
    cg::grid_group grid = cg::this_grid();
    if (threadIdx.x == 0) {
        *(Params*)(smem + POFF) = p;
        volatile unsigned* st = (volatile unsigned*)(smem + POFF + 256); st[0] = 0u; st[1] = 0u;
        xb_add(&((unsigned*)(p.ws + O_BAR))[XB_XCNT(xb_xcc_id())], 1u);
    }
    __syncthreads();
    { const Params q = opq(smem); aux_phase(q, smem, 0); }
    grid.sync();
    layer_body<0>(smem);
    gsync(smem);
    layer_body<1>(smem);
}

extern "C" void kernel_launch(void* const* d_in, const int* in_sizes, int n_in, void* d_out, int out_size, void* d_ws, size_t ws_size, hipStream_t stream) {
    if (ws_size < WS_NEED) { fprintf(stderr, "workspace too small: need %zu have %zu\n", (size_t)WS_NEED, ws_size); return; }
    static int grid_blocks = 0;
    if (!grid_blocks) {
        hipFuncSetAttribute((const void*)fwd_megakernel, hipFuncAttributeMaxDynamicSharedMemorySize, LDS_BYTES);
        int dev = 0, cus = 0, per_cu = 0;
        hipGetDevice(&dev);
        hipDeviceGetAttribute(&cus, hipDeviceAttributeMultiprocessorCount, dev);
        hipOccupancyMaxActiveBlocksPerMultiprocessor(&per_cu, fwd_megakernel, NT, LDS_BYTES);
        if (per_cu < 1) per_cu = 1;
        grid_blocks = cus;
    }
    Params p{};
    const float** pp = (const float**)&p;
    for (int i = 0; i < 30; ++i) pp[i] = (const float*)d_in[i];
    p.out = (float*)d_out;
    p.ws = (unsigned char*)d_ws;
    hipMemsetAsync((unsigned char*)d_ws + O_BAR, 0, 16384, stream);
    void* args[] = {&p};
    hipError_t e = hipLaunchCooperativeKernel((void*)fwd_megakernel, dim3(grid_blocks), dim3(NT), args, LDS_BYTES, stream);
    if (e != hipSuccess) fprintf(stderr, "cooperative launch failed: %s (grid %d)\n", hipGetErrorString(e), grid_blocks);
}
```

```cpp
#include <hip/hip_runtime.h>
#include <hip/hip_cooperative_groups.h>
#include <cstdio>
namespace cg = cooperative_groups;

#define LAS __attribute__((address_space(3)))
typedef unsigned short bf16_t;
typedef short bf16x8 __attribute__((ext_vector_type(8)));
typedef float f32x2 __attribute__((ext_vector_type(2)));
typedef float f32x4 __attribute__((ext_vector_type(4)));
typedef float f32x16 __attribute__((ext_vector_type(16)));
typedef unsigned u32x2 __attribute__((ext_vector_type(2)));
typedef unsigned u32x4 __attribute__((ext_vector_type(4)));
typedef __bf16 bf16v2 __attribute__((ext_vector_type(2)));

constexpr int NT = 512;
#ifndef REP_ATT
#define REP_ATT 1
#endif
#ifndef REP_HY
#define REP_HY 1
#endif
#ifndef REP_AUX
#define REP_AUX 1
#endif
#ifndef REP_MISC
#define REP_MISC 1
#endif
#ifndef REP_PREP
#define REP_PREP 1
#endif
#ifndef REP_UP
#define REP_UP 1
#endif
#ifndef REP_DN
#define REP_DN 1
#endif
#ifndef REP_G3
#define REP_G3 1
#endif
#ifndef REP_P9
#define REP_P9 1
#endif
#ifndef REP_QK
#define REP_QK 1
#endif
#ifndef REP_NORM
#define REP_NORM 1
#endif
#ifndef REP_SGU
#define REP_SGU 1
#endif
constexpr int TL = 32768, TCX = 2048, TT = 34816, DM = 1024, FFH = 2816, SEQ = 4096, CTXL = 256, NK = 4352;
constexpr int LDS_BYTES = 147456;

constexpr size_t AL(size_t x) { return (x + 255) & ~(size_t)255; }
constexpr size_t O_WUP0 = 0;
constexpr size_t O_WUP1 = O_WUP0 + (size_t)5632 * 1024 * 2;
constexpr size_t O_WDN0 = O_WUP1 + (size_t)5632 * 1024 * 2;
constexpr size_t O_WDN1 = O_WDN0 + (size_t)1024 * 2816 * 2;
constexpr size_t O_WIN = O_WDN1 + (size_t)1024 * 2816 * 2;
constexpr size_t O_WG = O_WIN + (size_t)2816 * 1024 * 2;
constexpr size_t O_WBR = O_WG + (size_t)3072 * 1024 * 2;
constexpr size_t O_WO = O_WBR + (size_t)1024 * 1024 * 2;
constexpr size_t O_XC = O_WO + (size_t)1024 * 1024 * 2;
constexpr size_t O_MOD = O_XC + (size_t)TCX * 1024 * 4;
constexpr size_t O_L1P = O_MOD + AL((size_t)2 * 9 * 9216 * 4);
constexpr size_t O_L1PC = O_L1P + (size_t)256 * 1024 * 4;
constexpr size_t O_FILTC = O_L1PC + (size_t)16 * 1024 * 4;
constexpr size_t O_BAR = O_FILTC + (size_t)2 * 256 * 512 * 4;
constexpr size_t O_H = O_BAR + 16384;
constexpr size_t O_AR = O_H + (size_t)TT * 1024 * 2;
constexpr size_t O_GH = O_AR;
constexpr size_t O_VRAW = O_AR;
constexpr size_t O_HYRAW = O_VRAW + (size_t)TT * 512 * 2;
constexpr size_t O_SGRAW = O_HYRAW + (size_t)TT * 768 * 2;
constexpr size_t O_XALT = O_AR + (size_t)TT * 2816 * 2;
constexpr size_t O_PART = O_XALT;
constexpr size_t O_OC = O_AR;
constexpr size_t O_YBT = O_OC + (size_t)TT * 1024 * 2;
constexpr size_t O_YBTC = O_YBT + (size_t)8 * 256 * 4096 * 2;
static_assert(O_YBTC + (size_t)8 * 256 * 256 * 2 <= O_SGRAW, "OC/YBT must not touch SGRAW (read in the post phase)");
constexpr size_t O_G3 = O_AR;
constexpr size_t O_YCAT = O_G3 + (size_t)TT * 3072 * 2;
constexpr size_t O_MB = O_YCAT + (size_t)TT * 1024 * 2;
constexpr size_t SZ_B = (size_t)TT * 1024 * 4 + (size_t)8 * 256 * 4096 * 2 + (size_t)8 * 256 * 256 * 2;
constexpr size_t O_QN = O_AR + AL(SZ_B);
constexpr size_t O_KN = O_QN + (size_t)64 * NK * 64 * 2;
constexpr size_t O_VT = O_KN + (size_t)64 * NK * 64 * 2;
constexpr size_t O_HV = O_VT + (size_t)32 * 128 * NK * 2;
constexpr size_t O_HVC = O_HV + (size_t)8 * 768 * 4096 * 2;
constexpr size_t O_FH = O_HVC + (size_t)8 * 768 * 256 * 2;
constexpr size_t O_FILT = O_HV;
constexpr size_t SZ_C1 = (size_t)8 * 768 * 4096 * 2 + (size_t)8 * 768 * 256 * 2 + (size_t)2 * 256 * 8192 * 8;
constexpr size_t END1 = O_HV + SZ_C1, END2 = O_MB + (size_t)TT * 1024 * 2;
static_assert(O_YCAT >= O_SGRAW + (size_t)TT * 512 * 2, "YCAT is written while OC/YBT/SGRAW are read");
constexpr size_t WS_NEED = AL(END1 > END2 ? END1 : END2);
static_assert(O_GH + (size_t)TT * 2816 * 2 <= O_HV, "Gh must stay inside regions B'+A");
static_assert(O_XALT + (size_t)TL * 1024 * 2 <= O_MB, "X_alt is written while MB is read");
static_assert(O_PART + (size_t)4 * 2048 * 1024 * 4 <= O_HV, "partials must not touch FILT/FH");
static_assert(O_SGRAW + (size_t)TT * 512 * 2 <= O_QN, "raws fit region B'");

struct Params {
    const float *x, *c, *ctx, *c_ctx, *ada_w, *ada_b, *norm_g, *ffn_up, *ffn_down, *w_in, *qk_gain, *da_lambda, *da_subln,
        *hy_conv_w, *hy_conv_b, *hy_w1, *hy_b1, *hy_w2, *hy_b2, *hy_freq, *hy_w3, *hy_skip, *sg_ln_g, *sg_ln_b, *sg_w, *sg_b,
        *gate_w, *gate_b, *w_br, *w_o;
    float* out;
    unsigned char* ws;
};


__device__ __forceinline__ int TID() { int t = threadIdx.x; asm volatile("" : "+v"(t)); return t; }
constexpr int POFF = 147456 - 512;
__device__ __forceinline__ const float* ldp(const unsigned char* smem, int idx) {
    const volatile unsigned* w = (const volatile unsigned*)(smem + POFF + idx * 8);
    const unsigned lo = __builtin_amdgcn_readfirstlane(w[0]), hi = __builtin_amdgcn_readfirstlane(w[1]);
    typedef __attribute__((address_space(1))) const float* gptr_t;
    return (const float*)(gptr_t)(((unsigned long long)hi << 32) | lo);
}
__device__ __forceinline__ Params opq(const unsigned char* smem) {
    Params q;
    q.x = ldp(smem, 0); q.c = ldp(smem, 1); q.ctx = ldp(smem, 2); q.c_ctx = ldp(smem, 3); q.ada_w = ldp(smem, 4); q.ada_b = ldp(smem, 5); q.norm_g = ldp(smem, 6);
    q.ffn_up = ldp(smem, 7); q.ffn_down = ldp(smem, 8); q.w_in = ldp(smem, 9); q.qk_gain = ldp(smem, 10); q.da_lambda = ldp(smem, 11); q.da_subln = ldp(smem, 12);
    q.hy_conv_w = ldp(smem, 13); q.hy_conv_b = ldp(smem, 14); q.hy_w1 = ldp(smem, 15); q.hy_b1 = ldp(smem, 16); q.hy_w2 = ldp(smem, 17); q.hy_b2 = ldp(smem, 18);
    q.hy_freq = ldp(smem, 19); q.hy_w3 = ldp(smem, 20); q.hy_skip = ldp(smem, 21); q.sg_ln_g = ldp(smem, 22); q.sg_ln_b = ldp(smem, 23); q.sg_w = ldp(smem, 24);
    q.sg_b = ldp(smem, 25); q.gate_w = ldp(smem, 26); q.gate_b = ldp(smem, 27); q.w_br = ldp(smem, 28); q.w_o = ldp(smem, 29);
    q.out = (float*)ldp(smem, 30); q.ws = (unsigned char*)ldp(smem, 31);
    return q;
}


#define XB_TMO      128
#define XB_XCNT(j)  (256  + 64 * (j))
#define XB_XSUB(j)  (1280 + 64 * (j))
#define XB_XGEN(j)  (2304 + 64 * (j))
#define XB_TOP      3328
#define XB_TOPGEN   3392
#define XCD_BAR_WORDS 3456
#define XB_SPIN_CAP (1u << 22)
__device__ __forceinline__ unsigned xb_ld(unsigned* p)              { return __hip_atomic_load(p, __ATOMIC_RELAXED, __HIP_MEMORY_SCOPE_AGENT); }
__device__ __forceinline__ unsigned xb_add(unsigned* p, unsigned v) { return __hip_atomic_fetch_add(p, v, __ATOMIC_RELAXED, __HIP_MEMORY_SCOPE_AGENT); }
__device__ __forceinline__ unsigned xb_xcc_id() { return (unsigned)__builtin_amdgcn_s_getreg((3 << 11) | 20) & 0xFu; }
#define XB_SPIN(cond, bar) do { unsigned _sp = 0; while (cond) { __builtin_amdgcn_s_sleep(1); \
    if ((++_sp & 255u) == 0u) { if (xb_ld(&(bar)[XB_TMO])) break; if (_sp > XB_SPIN_CAP) { atomicAdd(&(bar)[XB_TMO], 1u); break; } } } } while (0)
__device__ __forceinline__ void xcd_barrier_complete(unsigned* bar, unsigned x, unsigned& nloc, unsigned& nx) {
    const unsigned G = gridDim.x * gridDim.y * gridDim.z;
    unsigned sum, cnt, mine, sp = 0u;
    for (;;) {
        sum = 0u; cnt = 0u; mine = 0u;
#pragma unroll
        for (unsigned j = 0; j < 16; ++j) { const unsigned c = xb_ld(&bar[XB_XCNT(j)]); sum += c; cnt += (c > 0u) ? 1u : 0u; mine = (j == x) ? c : mine; }
        if (sum == G) break;
        __builtin_amdgcn_s_sleep(1);
        if ((++sp & 255u) == 0u) { if (xb_ld(&bar[XB_TMO])) break; if (sp > XB_SPIN_CAP) { atomicAdd(&bar[XB_TMO], 1u); break; } }
    }
    nloc = mine > 0u ? mine : 1u; nx = cnt > 0u ? cnt : 1u;
}
__device__ __forceinline__ void gsync(unsigned char* smem) {
    asm volatile("s_waitcnt vmcnt(0)" ::: "memory");
    __syncthreads();
    if (threadIdx.x == 0) {
        unsigned* bar = (unsigned*)((unsigned char*)ldp(smem, 31) + O_BAR);
        volatile unsigned* st = (volatile unsigned*)(smem + POFF + 256);
        const unsigned x = xb_xcc_id();
        __builtin_amdgcn_s_waitcnt(0);
        unsigned nloc = st[0], nx = st[1];
        if (nloc == 0u) { xcd_barrier_complete(bar, x, nloc, nx); st[0] = nloc; st[1] = nx; }
        const unsigned old = xb_add(&bar[XB_XSUB(x)], 1u);
        const unsigned gen = old / nloc;
        if (old + 1u == (gen + 1u) * nloc) {
            __builtin_amdgcn_fence(__ATOMIC_RELEASE, "agent");
            asm volatile("s_waitcnt vmcnt(0)" ::: "memory");
            const unsigned og = xb_add(&bar[XB_TOP], 1u);
            const unsigned tg = og / nx;
            if (og + 1u == (tg + 1u) * nx) xb_add(&bar[XB_TOPGEN], 1u);
            else XB_SPIN(xb_ld(&bar[XB_TOPGEN]) == tg, bar);
            __builtin_amdgcn_fence(__ATOMIC_ACQUIRE, "agent");
            xb_add(&bar[XB_XGEN(x)], 1u);
            asm volatile("s_waitcnt vmcnt(0)" ::: "memory");
        } else {
            XB_SPIN(xb_ld(&bar[XB_XGEN(x)]) == gen, bar);
            __builtin_amdgcn_fence(__ATOMIC_ACQUIRE, "agent");
            asm volatile("s_waitcnt vmcnt(0)" ::: "memory");
        }
    }
    __syncthreads();
}

__device__ __forceinline__ unsigned pk2(float a, float b) { f32x2 v = {a, b}; bf16v2 r = __builtin_convertvector(v, bf16v2); return __builtin_bit_cast(unsigned, r); }
__device__ __forceinline__ bf16_t f2bf(float a) { return (bf16_t)(pk2(a, 0.f) & 0xffffu); }
__device__ __forceinline__ float bf2f(bf16_t h) { return __uint_as_float((unsigned)h << 16); }
__device__ __forceinline__ float bflo(unsigned w) { return __uint_as_float(w << 16); }
__device__ __forceinline__ float bfhi(unsigned w) { return __uint_as_float(w & 0xffff0000u); }
__device__ __forceinline__ void row_bk(int r, int& b, int& kidx) { if (r < TL) { b = r >> 12; kidx = 256 + (r & 4095); } else { const int rc = r - TL; b = rc >> 8; kidx = rc & 255; } }
__device__ __forceinline__ float wave_sum(float v) {
#pragma unroll
    for (int o = 32; o > 0; o >>= 1) v += __shfl_xor(v, o);
    return v;
}
__device__ __forceinline__ float sigmoidf_(float v) { return __builtin_amdgcn_rcpf(1.0f + __builtin_amdgcn_exp2f(v * -1.4426950408889634f)); }

namespace pg8 {
constexpr int BM = 256, BK = 64, HALF = 128, HTB = HALF * BK * 2, STAGE_BYTES = 8 * HTB, NXCD = 8, WGM = 8;
__device__ __forceinline__ int lds_byte(int r, int c) { const int st = (r >> 4) * 2 + (c >> 5), rr = r & 15, cc = c & 31, ob = rr * 64 + cc * 2; return st * 1024 + (ob ^ (((ob >> 9) & 1) << 5)); }
__device__ __forceinline__ void stage_rc(int b, int& R, int& C) { const int st = b / 1024, sb = b % 1024, swz = sb ^ (((sb >> 9) & 1) << 5); R = (st >> 1) * 16 + swz / 64; C = (st & 1) * 32 + (swz % 64) / 2; }
__device__ __forceinline__ int perm32(int rho) { const int n = rho >> 4, i = rho & 15; return 8 * (i >> 2) + 4 * n + (i & 3); }
struct Unit { int pm, pn, k0, nt, split; };
struct Gemm { const bf16_t* A; const bf16_t* Bt; int M, N, K; };
struct StaticOrder {
    int nM, nN, nwg, G, c, ntk, ntail;
    __device__ void init(int M, int N, int K, int G_, int c_, bool split_tail) {
        nM = M / BM; nN = N / BM; G = G_; c = c_; ntk = K / BK; ntail = 0;
        if (split_tail) { nM -= 8; ntail = 128; }
        nwg = nM * nN;
    }
    __device__ __forceinline__ bool next(int i, Unit& u) const {
        const long L = (long)i * G + c; if (L >= nwg + ntail) return false;
        int pm, pn, k0 = 0, nt = ntk, split = 0;
        if (L >= nwg) {
            const int j = (int)L - nwg, cu = j >> 2, part = j & 3;
            pm = nM + (cu >> 2); pn = cu & 3; split = 1 + part;
            const int q = (ntk / 4) & ~1, big = (ntk - 4 * q) / 2;
            nt = q + ((part < big) ? 2 : 0);
            k0 = part * q + 2 * (part < big ? part : big);
        } else {
            int wgid = (int)L; { const int q = nwg / NXCD, r = nwg % NXCD, xcd = wgid % NXCD, off = wgid / NXCD; wgid = (xcd < r ? xcd * (q + 1) : r * (q + 1) + (xcd - r) * q) + off; }
            const int nig = WGM * nN, gid = wgid / nig, fm = gid * WGM, gsz = (nM - fm) < WGM ? (nM - fm) : WGM;
            pm = fm + ((wgid % nig) % gsz); pn = (wgid % nig) / gsz;
        }
        u.pm = pm; u.pn = pn; u.k0 = k0; u.nt = nt; u.split = split;
        return true;
    }
};

template <class Epi>
__device__ __forceinline__ void gemm_phase(LAS unsigned char* lds, const Gemm g, const StaticOrder& S, const Epi& E) {
    const int tid = TID(), wid = __builtin_amdgcn_readfirstlane(tid >> 6), lane = tid & 63, wr = wid >> 2, wc = wid & 3, fr = lane & 15, fq = lane >> 4;
    const int K = g.K;
    unsigned voffA[2], voffB[2];
#pragma unroll
    for (int i = 0; i < 2; ++i) { int R, C; stage_rc(tid * 16 + i * 8192, R, C); const int Rb = Epi::PERM ? ((R & ~31) + perm32(R & 31)) : R;
        voffA[i] = (unsigned)(R * K + C) * 2u; voffB[i] = (unsigned)(Rb * K + C) * 2u; }
    const size_t kstep = (size_t)(BK * 2);
    const size_t hstep = (size_t)HALF * K * 2;
    const size_t tstep = 2 * hstep;
    const unsigned ldsw = (unsigned)wid * 1024u;
    const int aoff = lds_byte(wr * 64 + fr, fq * 8), boff = lds_byte(wc * 32 + fr, fq * 8);
#define PG8_SA(b, h) (((b) * 2 + (h)) * HTB)
#define PG8_SB(b, h) ((4 + (b) * 2 + (h)) * HTB)
#define PG8_STAGE(bufoff, gbase, voff) do { _Pragma("unroll") for (int _i = 0; _i < 2; ++_i) \
        __builtin_amdgcn_global_load_lds((const unsigned*)((const char*)(gbase) + (voff)[_i]), (LAS unsigned*)(lds + (bufoff) + ldsw + _i * 8192), 16, 0, 0); } while (0)
#define PG8_LDA(dst, b, h) do { _Pragma("unroll") for (int m = 0; m < 4; ++m) _Pragma("unroll") for (int k = 0; k < 2; ++k) dst[m][k] = *(const LAS bf16x8*)(lds + PG8_SA(b, h) + aoff + m * 2048 + k * 1024); } while (0)
#define PG8_LDB(dst, b, h) do { _Pragma("unroll") for (int n = 0; n < 2; ++n) _Pragma("unroll") for (int k = 0; k < 2; ++k) dst[n][k] = *(const LAS bf16x8*)(lds + PG8_SB(b, h) + boff + n * 2048 + k * 1024); } while (0)
#define PG8_MMA(ai, bj, At, Bt) do { __builtin_amdgcn_s_setprio(1); _Pragma("unroll") for (int m = 0; m < 4; ++m) _Pragma("unroll") for (int n = 0; n < 2; ++n) _Pragma("unroll") for (int k = 0; k < 2; ++k) \
        acc[ai][bj][m][n] = __builtin_amdgcn_mfma_f32_16x16x32_bf16(Bt[n][k], At[m][k], acc[ai][bj][m][n], 0, 0, 0); __builtin_amdgcn_s_setprio(0); } while (0)
#define PG8_WAIT_V(n) asm volatile("s_waitcnt vmcnt(" #n ")" ::: "memory")
#define PG8_WAIT_L(n) asm volatile("s_waitcnt lgkmcnt(" #n ")" ::: "memory")
#define PG8_BAR __builtin_amdgcn_s_barrier()
#define PG8_SCHED __builtin_amdgcn_sched_barrier(0)
    Unit cur, nxt; int ui = 0;
    if (!S.next(0, cur)) return;
    f32x4 acc[2][2][4][2];
#pragma unroll
    for (int a = 0; a < 2; ++a)
#pragma unroll
        for (int b = 0; b < 2; ++b)
#pragma unroll
            for (int m = 0; m < 4; ++m)
#pragma unroll
                for (int n = 0; n < 2; ++n) acc[a][b][m][n] = (f32x4){0.f, 0.f, 0.f, 0.f};
    bf16x8 At[4][2], B0[2][2], B1[2][2];
    const char* cA = (const char*)g.A + (size_t)cur.pm * tstep + (size_t)cur.k0 * kstep; const char* cB = (const char*)g.Bt + (size_t)cur.pn * tstep + (size_t)cur.k0 * kstep;
    PG8_STAGE(PG8_SB(0, 0), cB, voffB); PG8_STAGE(PG8_SA(0, 0), cA, voffA); PG8_STAGE(PG8_SB(0, 1), cB + hstep, voffB); PG8_STAGE(PG8_SA(0, 1), cA + hstep, voffA);
    if (wr == 1) PG8_BAR;
    PG8_WAIT_V(4); PG8_BAR;
    PG8_STAGE(PG8_SB(1, 0), cB + kstep, voffB); PG8_STAGE(PG8_SA(1, 0), cA + kstep, voffA); PG8_STAGE(PG8_SB(1, 1), cB + hstep + kstep, voffB);
    PG8_WAIT_V(6); PG8_BAR;
    for (;;) {
        const bool has_next = S.next(ui + 1, nxt);
        const char* nA = has_next ? (const char*)g.A + (size_t)nxt.pm * tstep + (size_t)nxt.k0 * kstep : cA; const char* nB = has_next ? (const char*)g.Bt + (size_t)nxt.pn * tstep + (size_t)nxt.k0 * kstep : cB;
        const int nt = cur.nt;
        for (int t = 0; t < nt; t += 2) {
            const bool last = (t == nt - 2);
            const char* a1 = cA + (size_t)(t + 1) * kstep;
            const char* a2 = last ? nA : cA + (size_t)(t + 2) * kstep; const char* b2 = last ? nB : cB + (size_t)(t + 2) * kstep;
            const char* a3 = a2 + kstep; const char* b3 = b2 + kstep;
            if constexpr (Epi::RESCALE) { if (t == 8 || t == 12) E.rescale(acc, cur, t == 8 ? 0 : 1, wr, wc, fr, fq); }
            PG8_LDB(B0, 0, 0); PG8_SCHED; PG8_LDA(At, 0, 0); PG8_STAGE(PG8_SA(1, 1), a1 + hstep, voffA);
            PG8_WAIT_L(8); PG8_BAR; PG8_WAIT_L(0); PG8_MMA(0, 0, At, B0); PG8_BAR; PG8_SCHED;
            PG8_LDB(B1, 0, 1); PG8_STAGE(PG8_SB(0, 0), b2, voffB);
            PG8_BAR; PG8_WAIT_L(0); PG8_MMA(0, 1, At, B1); PG8_BAR;
            PG8_LDA(At, 0, 1); PG8_STAGE(PG8_SA(0, 0), a2, voffA);
            PG8_BAR; PG8_WAIT_L(0); PG8_MMA(1, 0, At, B0); PG8_BAR; PG8_SCHED;
            PG8_STAGE(PG8_SB(0, 1), b2 + hstep, voffB);
            PG8_WAIT_V(6); PG8_BAR; PG8_MMA(1, 1, At, B1); PG8_BAR;
            PG8_LDB(B0, 1, 0); PG8_SCHED; PG8_LDA(At, 1, 0); PG8_STAGE(PG8_SA(0, 1), a2 + hstep, voffA);
            PG8_WAIT_L(8); PG8_BAR; PG8_WAIT_L(0); PG8_MMA(0, 0, At, B0); PG8_BAR; PG8_SCHED;
            PG8_LDB(B1, 1, 1); PG8_STAGE(PG8_SB(1, 0), b3, voffB);
            PG8_BAR; PG8_WAIT_L(0); PG8_MMA(0, 1, At, B1); PG8_BAR;
            PG8_LDA(At, 1, 1); PG8_STAGE(PG8_SA(1, 0), a3, voffA);
            PG8_BAR; PG8_WAIT_L(0); PG8_MMA(1, 0, At, B0); PG8_BAR; PG8_SCHED;
            PG8_STAGE(PG8_SB(1, 1), b3 + hstep, voffB);
            PG8_WAIT_V(6); PG8_BAR; PG8_MMA(1, 1, At, B1); PG8_BAR;
        }
        E(acc, cur, wr, wc, fr, fq);
        if (!has_next) break;
#pragma unroll
        for (int a = 0; a < 2; ++a)
#pragma unroll
            for (int b = 0; b < 2; ++b)
#pragma unroll
                for (int m = 0; m < 4; ++m)
#pragma unroll
                    for (int n = 0; n < 2; ++n) acc[a][b][m][n] = (f32x4){0.f, 0.f, 0.f, 0.f};
        cur = nxt; cA = nA; cB = nB; ++ui;
    }
    PG8_WAIT_V(0);
    if (wr == 0) PG8_BAR;
    PG8_BAR;
#undef PG8_SA
#undef PG8_SB
#undef PG8_STAGE
#undef PG8_LDA
#undef PG8_LDB
#undef PG8_MMA
#undef PG8_WAIT_V
#undef PG8_WAIT_L
#undef PG8_BAR
#undef PG8_SCHED
}
}
using pg8::Unit;
typedef f32x4 AccT[2][2][4][2];

struct EpiSwiglu {
    static constexpr bool PERM = true, RESCALE = false;
    bf16_t* G;
    __device__ __forceinline__ void operator()(const AccT& acc, const Unit& u, int wr, int wc, int fr, int fq) const {
        const int row0 = u.pm * 256 + wr * 64 + fr, col0 = u.pn * 128 + wc * 32 + 8 * fq;
#pragma unroll
        for (int ai = 0; ai < 2; ++ai)
#pragma unroll
            for (int m = 0; m < 4; ++m) {
                float gv[8];
#pragma unroll
                for (int n = 0; n < 2; ++n)
#pragma unroll
                    for (int j = 0; j < 4; ++j) { const float a = acc[ai][0][m][n][j], b = acc[ai][1][m][n][j]; gv[n * 4 + j] = a * b * __builtin_amdgcn_rcpf(1.0f + __builtin_amdgcn_exp2f(a * -1.4426950408889634f)); }
                u32x4 w; w.x = pk2(gv[0], gv[1]); w.y = pk2(gv[2], gv[3]); w.z = pk2(gv[4], gv[5]); w.w = pk2(gv[6], gv[7]);
                *(u32x4*)(G + (size_t)(row0 + ai * 128 + m * 16) * FFH + col0) = w;
            }
    }
};
struct EpiResid {
    static constexpr bool PERM = true, RESCALE = false;
    const bf16_t* xin; bf16_t* xout; float* fout; float* xc; float* part; const float* mod; int gofs; float coef;
    __device__ __forceinline__ void operator()(const AccT& acc, const Unit& u, int wr, int wc, int fr, int fq) const {
        const int row0 = u.pm * 256 + wr * 64 + fr, col0 = u.pn * 256 + wc * 32 + 8 * fq;
        const bool lat = u.pm < 128;
        const int mr = lat ? (u.pm >> 4) : 8;
        const float* gp = mod + (size_t)mr * 9216 + gofs + col0;
#pragma unroll
        for (int bj = 0; bj < 2; ++bj) {
            const f32x4 g0 = *(const f32x4*)(gp + bj * 128) * coef, g1 = *(const f32x4*)(gp + bj * 128 + 4) * coef;
            if (lat) {
                u32x4 xw[8];
#pragma unroll
                for (int am = 0; am < 8; ++am) xw[am] = *(const u32x4*)(xin + (size_t)(row0 + (am >> 2) * 128 + (am & 3) * 16) * 1024 + col0 + bj * 128);
#pragma unroll
                for (int am = 0; am < 8; ++am) {
                    const int ai = am >> 2, m = am & 3;
                    const size_t o = (size_t)(row0 + ai * 128 + m * 16) * 1024 + col0 + bj * 128;
                    f32x4 v0 = {bflo(xw[am].x), bfhi(xw[am].x), bflo(xw[am].y), bfhi(xw[am].y)}, v1 = {bflo(xw[am].z), bfhi(xw[am].z), bflo(xw[am].w), bfhi(xw[am].w)};
                    v0 += g0 * acc[ai][bj][m][0]; v1 += g1 * acc[ai][bj][m][1];
                    if (fout) { *(f32x4*)(fout + o) = v0; *(f32x4*)(fout + o + 4) = v1; }
                    else { u32x4 w; w.x = pk2(v0[0], v0[1]); w.y = pk2(v0[2], v0[3]); w.z = pk2(v1[0], v1[1]); w.w = pk2(v1[2], v1[3]); *(u32x4*)(xout + o) = w; }
                }
            } else {
#pragma unroll
                for (int am = 0; am < 8; ++am) {
                    const int ai = am >> 2, m = am & 3;
                    const size_t o = (size_t)(row0 + ai * 128 + m * 16 - TL) * 1024 + col0 + bj * 128;
                    const f32x4 d0 = g0 * acc[ai][bj][m][0], d1 = g1 * acc[ai][bj][m][1];
                    if (u.split) { float* pp = part + (size_t)(u.split - 1) * 2048 * 1024 + o; *(f32x4*)pp = d0; *(f32x4*)(pp + 4) = d1; }
                    else { float* xp = xc + o; *(f32x4*)xp = *(const f32x4*)xp + d0; *(f32x4*)(xp + 4) = *(const f32x4*)(xp + 4) + d1; }
                }
            }
        }
    }
};
struct EpiIn {
    static constexpr bool PERM = true, RESCALE = false;
    bf16_t *qn, *kn, *vraw, *hyraw, *sgraw;
    __device__ __forceinline__ void operator()(const AccT& acc, const Unit& u, int wr, int wc, int fr, int fq) const {
        const int row0 = u.pm * 256 + wr * 64 + fr, pn = u.pn;
#pragma unroll
        for (int ai = 0; ai < 2; ++ai)
#pragma unroll
            for (int m = 0; m < 4; ++m) {
                const int r = row0 + ai * 128 + m * 16;
#pragma unroll
                for (int bj = 0; bj < 2; ++bj) {
                    const f32x4 v0 = acc[ai][bj][m][0], v1 = acc[ai][bj][m][1];
                    u32x4 w; w.x = pk2(v0[0], v0[1]); w.y = pk2(v0[2], v0[3]); w.z = pk2(v1[0], v1[1]); w.w = pk2(v1[2], v1[3]);
                    const int cl = bj * 128 + wc * 32 + 8 * fq;
                    bf16_t* dst;
                    if (pn < 4) {
                        int b, kidx; row_bk(r, b, kidx);
                        const int cc = (pn & 1) * 256 + cl, head = cc >> 7, comp = (cc >> 6) & 1, d = cc & 63;
                        dst = (pn < 2 ? qn : kn) + ((size_t)((b * 4 + head) * 2 + comp) * NK + kidx) * 64 + d;
                    } else if (pn < 6) dst = vraw + (size_t)r * 512 + (pn - 4) * 256 + cl;
                    else if (pn < 9) dst = hyraw + (size_t)r * 768 + (pn - 6) * 256 + cl;
                    else dst = sgraw + (size_t)r * 512 + (pn - 9) * 256 + cl;
                    *(u32x4*)dst = w;
                }
            }
    }
};
struct EpiGate3 {
    static constexpr bool PERM = true, RESCALE = false;
    bf16_t* g3; const float* bias;
    __device__ __forceinline__ void operator()(const AccT& acc, const Unit& u, int wr, int wc, int fr, int fq) const {
        const int row0 = u.pm * 256 + wr * 64 + fr, col0 = u.pn * 256 + wc * 32 + 8 * fq;
#pragma unroll
        for (int bj = 0; bj < 2; ++bj) {
            const f32x4 b0 = *(const f32x4*)(bias + col0 + bj * 128), b1 = *(const f32x4*)(bias + col0 + bj * 128 + 4);
#pragma unroll
            for (int ai = 0; ai < 2; ++ai)
#pragma unroll
                for (int m = 0; m < 4; ++m) {
                    const f32x4 v0 = acc[ai][bj][m][0] + b0, v1 = acc[ai][bj][m][1] + b1;
                    float gv[8];
#pragma unroll
                    for (int j = 0; j < 4; ++j) { gv[j] = fmaxf(sigmoidf_(v0[j]), 1e-5f); gv[4 + j] = fmaxf(sigmoidf_(v1[j]), 1e-5f); }
                    u32x4 w; w.x = pk2(gv[0], gv[1]); w.y = pk2(gv[2], gv[3]); w.z = pk2(gv[4], gv[5]); w.w = pk2(gv[6], gv[7]);
                    *(u32x4*)(g3 + (size_t)(row0 + ai * 128 + m * 16) * 3072 + col0 + bj * 128) = w;
                }
        }
    }
};
struct EpiMergeR {
    static constexpr bool PERM = true, RESCALE = true;
    const bf16_t* g3; bf16_t* mb;
    __device__ __forceinline__ void rescale(AccT& acc, const Unit& u, int which, int wr, int wc, int fr, int fq) const {
        const int row0 = u.pm * 256 + wr * 64 + fr, col0 = u.pn * 256 + wc * 32 + 8 * fq;
        const bf16_t* gb = g3 + (size_t)row0 * 3072 + which * 1024 + col0;
#pragma unroll
        for (int ai = 0; ai < 2; ++ai)
#pragma unroll
            for (int mh = 0; mh < 2; ++mh) {
                u32x4 nw[2][2], dw[2][2];
#pragma unroll
                for (int mm = 0; mm < 2; ++mm)
#pragma unroll
                    for (int bj = 0; bj < 2; ++bj) { const bf16_t* gp = gb + (size_t)(ai * 128 + (mh * 2 + mm) * 16) * 3072 + bj * 128; nw[mm][bj] = *(const u32x4*)gp; dw[mm][bj] = *(const u32x4*)(gp + 1024); }
#pragma unroll
                for (int mm = 0; mm < 2; ++mm)
#pragma unroll
                    for (int bj = 0; bj < 2; ++bj) {
                        const u32x4 n4 = nw[mm][bj], d4 = dw[mm][bj];
                        const f32x4 r0 = {bflo(n4.x) * __builtin_amdgcn_rcpf(bflo(d4.x)), bfhi(n4.x) * __builtin_amdgcn_rcpf(bfhi(d4.x)), bflo(n4.y) * __builtin_amdgcn_rcpf(bflo(d4.y)), bfhi(n4.y) * __builtin_amdgcn_rcpf(bfhi(d4.y))};
                        const f32x4 r1 = {bflo(n4.z) * __builtin_amdgcn_rcpf(bflo(d4.z)), bfhi(n4.z) * __builtin_amdgcn_rcpf(bfhi(d4.z)), bflo(n4.w) * __builtin_amdgcn_rcpf(bflo(d4.w)), bfhi(n4.w) * __builtin_amdgcn_rcpf(bfhi(d4.w))};
                        acc[ai][bj][mh * 2 + mm][0] *= r0; acc[ai][bj][mh * 2 + mm][1] *= r1;
                    }
                __builtin_amdgcn_sched_barrier(0);
            }
    }
    __device__ __forceinline__ void operator()(const AccT& acc, const Unit& u, int wr, int wc, int fr, int fq) const {
        const int row0 = u.pm * 256 + wr * 64 + fr, col0 = u.pn * 256 + wc * 32 + 8 * fq;
#pragma unroll
        for (int bj = 0; bj < 2; ++bj) {
            u32x4 gw[8];
#pragma unroll
            for (int am = 0; am < 8; ++am) gw[am] = *(const u32x4*)(g3 + (size_t)(row0 + (am >> 2) * 128 + (am & 3) * 16) * 3072 + 2048 + col0 + bj * 128);
#pragma unroll
            for (int am = 0; am < 8; ++am) {
                const int ai = am >> 2, m = am & 3;
                const f32x4 v0 = acc[ai][bj][m][0], v1 = acc[ai][bj][m][1];
                u32x4 w; w.x = pk2(v0[0] * bflo(gw[am].x), v0[1] * bfhi(gw[am].x)); w.y = pk2(v0[2] * bflo(gw[am].y), v0[3] * bfhi(gw[am].y));
                w.z = pk2(v1[0] * bflo(gw[am].z), v1[1] * bfhi(gw[am].z)); w.w = pk2(v1[2] * bflo(gw[am].w), v1[3] * bfhi(gw[am].w));
                *(u32x4*)(mb + (size_t)(row0 + ai * 128 + m * 16) * 1024 + col0 + bj * 128) = w;
            }
        }
    }
};

template <class Epi>
__device__ __forceinline__ void run_gemm(unsigned char* smem, const bf16_t* A, const bf16_t* Bt, int M, int N, int K, const Epi& E, bool split_tail = false) {
    asm volatile("" : "+s"(M), "+s"(N), "+s"(K));
    pg8::Gemm g; g.A = A; g.Bt = Bt; g.M = M; g.N = N; g.K = K;
    pg8::StaticOrder S; S.init(M, N, K, gridDim.x, blockIdx.x, split_tail);
    pg8::gemm_phase<Epi>((LAS unsigned char*)smem, g, S, E);
}

__device__ __forceinline__ void mod_item(const Params& p, unsigned char* smem, int m) {
    float* s = (float*)smem;
    float* red = s + 9 * 1024;
    const int tid = TID(), l = m / 144, cb = m % 144;
    __syncthreads();
    for (int i = tid; i < 9216; i += NT) { const float v = (i < 8192) ? p.c[i] : p.c_ctx[i - 8192]; s[i] = v / (1.0f + __expf(-v)); }
    __syncthreads();
    const int kg = tid >> 6, cn = tid & 63, col = cb * 64 + cn;
    const float* w = p.ada_w + (size_t)l * 1024 * 9216 + col;
    float a0 = 0, a1 = 0, a2 = 0, a3 = 0, a4 = 0, a5 = 0, a6 = 0, a7 = 0, a8 = 0;
    for (int k = kg * 128; k < kg * 128 + 128; ++k) {
        const float wv = w[(size_t)k * 9216];
        a0 += s[k] * wv; a1 += s[1024 + k] * wv; a2 += s[2048 + k] * wv; a3 += s[3072 + k] * wv; a4 += s[4096 + k] * wv;
        a5 += s[5120 + k] * wv; a6 += s[6144 + k] * wv; a7 += s[7168 + k] * wv; a8 += s[8192 + k] * wv;
    }
    float* rp = red + kg * 576 + cn;
    rp[0] = a0; rp[64] = a1; rp[128] = a2; rp[192] = a3; rp[256] = a4; rp[320] = a5; rp[384] = a6; rp[448] = a7; rp[512] = a8;
    __syncthreads();
    float* MOD = (float*)(p.ws + O_MOD);
    for (int i = tid; i < 576; i += NT) {
        float v = 0; for (int q = 0; q < 8; ++q) v += red[q * 576 + i];
        const int r = i >> 6, c2 = cb * 64 + (i & 63);
        MOD[((size_t)l * 9 + r) * 9216 + c2] = v + p.ada_b[(size_t)l * 9216 + c2];
    }
}

__device__ __forceinline__ void filt_item(const Params& p, unsigned char* smem, int l, int n, int item, float* filt, float* l1p) {
    float* z = (float*)smem;
    float* h1 = z + 16 * 36;
    float* h2 = h1 + 16 * 64;
    float* stage = h2 + 16 * 64;
    const int tid = TID(), t0 = item * 16;
    __syncthreads();
    for (int i = tid; i < 16 * 33; i += NT) {
        const int tt = i / 33, e = i % 33, t = t0 + tt; float v;
        if (e == 0) v = (float)t / (float)(n - 1);
        else { const int bi = (e - 1) & 15; const float band = 1e-4f + (float)bi * ((15.0f - 1e-4f) / 15.0f); const float wv = (6.283185307179586f / (float)n) * (float)t;
            v = (e <= 16) ? cosf(band * wv) : -sinf(band * wv); }
        z[tt * 36 + e] = v;
    }
    __syncthreads();
    for (int i = tid; i < 16 * 64; i += NT) {
        const int tt = i >> 6, j = i & 63; float a = p.hy_b1[l * 64 + j];
        for (int e = 0; e < 33; ++e) a += z[tt * 36 + e] * p.hy_w1[((size_t)l * 33 + e) * 64 + j];
        h1[i] = sinf(p.hy_freq[l * 64 + j] * a);
    }
    __syncthreads();
    for (int i = tid; i < 16 * 64; i += NT) {
        const int tt = i >> 6, j = i & 63; float a = p.hy_b2[l * 64 + j];
        for (int e = 0; e < 64; ++e) a += h1[tt * 64 + e] * p.hy_w2[((size_t)l * 64 + e) * 64 + j];
        h2[i] = sinf(p.hy_freq[l * 64 + j] * a);
    }
    __syncthreads();
    const float min_decay = -3.0701134573253945f, max_decay = -15.350567286626973f;
#pragma unroll 1
    for (int cc = 0; cc < 2; ++cc) {
        const int col = tid + cc * 512;
        float acc[16];
#pragma unroll
        for (int tt = 0; tt < 16; ++tt) acc[tt] = 0.f;
        for (int e = 0; e < 64; ++e) {
            const float wv = p.hy_w3[((size_t)l * 64 + e) * 1024 + col];
#pragma unroll
            for (int tt = 0; tt < 16; ++tt) acc[tt] += h2[tt * 64 + e] * wv;
        }
        const int oc = col & 511, dir = col >> 9;
        const float ad = fabsf(min_decay + (float)oc * ((max_decay - min_decay) / 511.0f));
        float l1 = 0.f;
#pragma unroll
        for (int tt = 0; tt < 16; ++tt) {
            const int t = t0 + tt; const float tn = (float)t / (float)(n - 1);
            float v = acc[tt] * __expf(-tn * ad);
            if (dir == 1 && t == 0) v = 0.f;
            stage[col * 17 + tt] = v;
            l1 += fabsf(v);
        }
        l1p[(size_t)item * 1024 + col] = l1;
    }
    __syncthreads();
#pragma unroll 4
    for (int k = 0; k < 32; ++k) {
        const int e = tid + k * NT, col = e >> 4, tt = e & 15, t = t0 + tt;
        const int oc = col & 511, dir = col >> 9;
        const int pos = (dir == 0) ? t : ((t == 0) ? n : 2 * n - t);
        filt[(size_t)oc * (2 * n) + pos] = stage[col * 17 + tt];
    }
}

struct WDesc { const float* src; bf16_t* dst; int ld, K; };
__device__ __forceinline__ WDesc wdesc(const Params& p, int l, int ti) {
    WDesc d; int K, nrb, mapsw = 0; const float* src; bf16_t* dst; int ld;
    const size_t L = (size_t)l;
    if (ti < 1408) { src = p.ffn_up + (L * 2 + 0) * 1024 * 5632; ld = 5632; K = 1024; dst = (bf16_t*)(p.ws + O_WUP0); mapsw = 1; }
    else if ((ti -= 1408) < 1408) { src = p.ffn_up + (L * 2 + 1) * 1024 * 5632; ld = 5632; K = 1024; dst = (bf16_t*)(p.ws + O_WUP1); mapsw = 1; }
    else if ((ti -= 1408) < 704) { src = p.ffn_down + (L * 2 + 0) * 2816 * 1024; ld = 1024; K = 2816; dst = (bf16_t*)(p.ws + O_WDN0); }
    else if ((ti -= 704) < 704) { src = p.ffn_down + (L * 2 + 1) * 2816 * 1024; ld = 1024; K = 2816; dst = (bf16_t*)(p.ws + O_WDN1); }
    else if ((ti -= 704) < 704) { src = p.w_in + L * 1024 * 2816; ld = 2816; K = 1024; dst = (bf16_t*)(p.ws + O_WIN); }
    else if ((ti -= 704) < 768) { src = p.gate_w + L * 1024 * 3072; ld = 3072; K = 1024; dst = (bf16_t*)(p.ws + O_WG); }
    else if ((ti -= 768) < 256) { src = p.w_br + L * 1024 * 1024; ld = 1024; K = 1024; dst = (bf16_t*)(p.ws + O_WBR); }
    else { ti -= 256; src = p.w_o + L * 1024 * 1024; ld = 1024; K = 1024; dst = (bf16_t*)(p.ws + O_WO); }
    nrb = K / 64;
    const int nb = ti / nrb, kb = ti % nrb, n0 = nb * 64, k0 = kb * 64;
    int scol = n0;
    if (mapsw) { const int pn = n0 >> 8, half = (n0 >> 7) & 1; scol = half * 2816 + pn * 128 + (n0 & 127); }
    d.src = src + (size_t)k0 * ld + scol; d.dst = dst + (size_t)n0 * K + k0; d.ld = ld; d.K = K;
    return d;
}
__device__ __forceinline__ void wconv_tiles(const Params& p, unsigned char* smem, int l, int nw) {
    float* tile = (float*)smem;
    const int tid = TID(), kk0 = tid >> 6, nn0 = tid & 63, nn = tid >> 3, ks = tid & 7;
    int ti = blockIdx.x;
    if (ti >= nw) return;
    WDesc d = wdesc(p, l, ti);
    float v[8];
#pragma unroll
    for (int i = 0; i < 8; ++i) v[i] = d.src[(size_t)(kk0 + 8 * i) * d.ld + nn0];
    for (;;) {
        const int tn = ti + gridDim.x; const bool more = tn < nw;
        WDesc dn = d; float vn[8];
        if (more) { dn = wdesc(p, l, tn);
#pragma unroll
            for (int i = 0; i < 8; ++i) vn[i] = dn.src[(size_t)(kk0 + 8 * i) * dn.ld + nn0]; }
        __syncthreads();
#pragma unroll
        for (int i = 0; i < 8; ++i) tile[(kk0 + 8 * i) * 65 + nn0] = v[i];
        __syncthreads();
        float o[8];
#pragma unroll
        for (int j = 0; j < 8; ++j) o[j] = tile[(ks * 8 + j) * 65 + nn];
        u32x4 w; w.x = pk2(o[0], o[1]); w.y = pk2(o[2], o[3]); w.z = pk2(o[4], o[5]); w.w = pk2(o[6], o[7]);
        *(u32x4*)(d.dst + (size_t)nn * d.K + ks * 8) = w;
        if (!more) break;
        d = dn; ti = tn;
#pragma unroll
        for (int i = 0; i < 8; ++i) v[i] = vn[i];
    }
}

__device__ __forceinline__ void aux_phase(const Params& p, unsigned char* smem, int l) {
    const int nmod = (l == 0) ? 288 : 0, nf = 256, nfc = (l == 0) ? 16 : 0, nw = 6208;
    const int total = nmod + nf + nfc;
    for (int rep = 0; rep < REP_AUX; ++rep) {
        for (int it = blockIdx.x; it < total; it += gridDim.x) {
            int i = it;
            if (i < nmod) { mod_item(p, smem, i); continue; }
            i -= nmod;
            if (i < nf) { filt_item(p, smem, l, 4096, i, (float*)(p.ws + O_FILT), (float*)(p.ws + O_L1P)); continue; }
            i -= nf;
            filt_item(p, smem, l, 256, i, (float*)(p.ws + O_FILTC), (float*)(p.ws + O_L1PC));
        }
        wconv_tiles(p, smem, l, nw);
    }
}

__device__ __forceinline__ void norm_phase(const Params& p, int l, int sub, int M, bool first, const bf16_t* xl) {
    const float* PART = (const float*)(p.ws + O_PART);
    const int tid = TID(), lane = tid & 63, wv = tid >> 6;
    const float* MOD = (const float*)(p.ws + O_MOD) + (size_t)l * 9 * 9216;
    const float* gn = p.norm_g + ((size_t)l * 3 + sub) * 1024;
    float* XC = (float*)(p.ws + O_XC);
    bf16_t* H = (bf16_t*)(p.ws + O_H);
    const int rstep = gridDim.x * 8;
    for (int rep = 0; rep < REP_NORM; ++rep)
    for (int r0 = blockIdx.x * 8 + wv; r0 < M; r0 += 4 * rstep) {
        f32x4 v[4][4]; float ss[4];
#pragma unroll
        for (int k = 0; k < 4; ++k) {
            const int r = r0 + k * rstep; ss[k] = 0.f;
            if (r >= M) { continue; }
            if (r >= TL) {
                const float* src = (first ? p.ctx : XC) + (size_t)(r - TL) * 1024;
#pragma unroll
                for (int i = 0; i < 4; ++i) { const size_t o = (size_t)(r - TL) * 1024 + i * 256 + lane * 4; v[k][i] = *(const f32x4*)(src + i * 256 + lane * 4);
                    if (!first) { v[k][i] += *(const f32x4*)(PART + o); v[k][i] += *(const f32x4*)(PART + 2048 * 1024 + o); v[k][i] += *(const f32x4*)(PART + 2 * 2048 * 1024 + o); v[k][i] += *(const f32x4*)(PART + 3 * 2048 * 1024 + o); } }
            } else if (first) {
                const float* src = p.x + (size_t)r * 1024;
#pragma unroll
                for (int i = 0; i < 4; ++i) v[k][i] = *(const f32x4*)(src + i * 256 + lane * 4);
            } else {
                const bf16_t* src = xl + (size_t)r * 1024;
#pragma unroll
                for (int i = 0; i < 4; ++i) { const u32x2 w = *(const u32x2*)(src + i * 256 + lane * 4); v[k][i] = (f32x4){bflo(w.x), bfhi(w.x), bflo(w.y), bfhi(w.y)}; }
            }
        }
#pragma unroll
        for (int k = 0; k < 4; ++k) {
            const int r = r0 + k * rstep;
            if (r >= M) continue;
            if (r >= TL) {
#pragma unroll
                for (int i = 0; i < 4; ++i) *(f32x4*)(XC + (size_t)(r - TL) * 1024 + i * 256 + lane * 4) = v[k][i];
            } else if (first) {
                bf16_t* dstx = (bf16_t*)p.out + (size_t)r * 1024;
#pragma unroll
                for (int i = 0; i < 4; ++i) { u32x2 w; w.x = pk2(v[k][i][0], v[k][i][1]); w.y = pk2(v[k][i][2], v[k][i][3]); *(u32x2*)(dstx + i * 256 + lane * 4) = w; v[k][i] = (f32x4){bflo(w.x), bfhi(w.x), bflo(w.y), bfhi(w.y)}; }
            }
            float s2 = 0.f;
#pragma unroll
            for (int i = 0; i < 4; ++i) s2 += v[k][i][0] * v[k][i][0] + v[k][i][1] * v[k][i][1] + v[k][i][2] * v[k][i][2] + v[k][i][3] * v[k][i][3];
            s2 = wave_sum(s2);
            const float rinv = rsqrtf(s2 * (1.0f / 1024.0f) + 1e-6f);
            const int mr = r < TL ? (r >> 12) : 8;
            const float* sh = MOD + (size_t)mr * 9216 + (3 * sub) * 1024;
            const float* sc = sh + 1024;
#pragma unroll
            for (int i = 0; i < 4; ++i) {
                const int c = i * 256 + lane * 4;
                const f32x4 g4 = *(const f32x4*)(gn + c), s4 = *(const f32x4*)(sc + c), h4 = *(const f32x4*)(sh + c);
                const f32x4 y = v[k][i] * rinv * g4 * (s4 + 1.0f) + h4;
                u32x2 w; w.x = pk2(y[0], y[1]); w.y = pk2(y[2], y[3]);
                *(u32x2*)(H + (size_t)r * 1024 + c) = w;
            }
        }
    }
}

#define ZI(i) ((i) + ((i) >> 4))
__device__ __forceinline__ f32x2 cmul(f32x2 a, f32x2 b) { return (f32x2){a.x * b.x - a.y * b.y, a.x * b.y + a.y * b.x}; }
__device__ __forceinline__ f32x2 cmulc(f32x2 a, f32x2 b) { return (f32x2){a.x * b.x + a.y * b.y, a.y * b.x - a.x * b.y}; }
__device__ __forceinline__ void dif8(f32x2 (&x)[8]) {
    const float C = 0.70710678118654752f;
    { f32x2 t;
      t = x[0] - x[4]; x[0] += x[4]; x[4] = t;
      t = x[1] - x[5]; x[1] += x[5]; x[5] = (f32x2){C * (t.x + t.y), C * (t.y - t.x)};
      t = x[2] - x[6]; x[2] += x[6]; x[6] = (f32x2){t.y, -t.x};
      t = x[3] - x[7]; x[3] += x[7]; x[7] = (f32x2){C * (t.y - t.x), -C * (t.x + t.y)}; }
#pragma unroll
    for (int b = 0; b < 8; b += 4) { f32x2 t;
      t = x[b] - x[b + 2]; x[b] += x[b + 2]; x[b + 2] = t;
      t = x[b + 1] - x[b + 3]; x[b + 1] += x[b + 3]; x[b + 3] = (f32x2){t.y, -t.x}; }
#pragma unroll
    for (int b = 0; b < 8; b += 2) { const f32x2 t = x[b] - x[b + 1]; x[b] += x[b + 1]; x[b + 1] = t; }
}
__device__ __forceinline__ void idif8(f32x2 (&x)[8]) {
    const float C = 0.70710678118654752f;
#pragma unroll
    for (int b = 0; b < 8; b += 2) { const f32x2 t = x[b] - x[b + 1]; x[b] += x[b + 1]; x[b + 1] = t; }
#pragma unroll
    for (int b = 0; b < 8; b += 4) { f32x2 v, u;
      v = x[b + 2]; u = x[b]; x[b] = u + v; x[b + 2] = u - v;
      v = (f32x2){-x[b + 3].y, x[b + 3].x}; u = x[b + 1]; x[b + 1] = u + v; x[b + 3] = u - v; }
    { f32x2 v, u, t;
      v = x[4]; u = x[0]; x[0] = u + v; x[4] = u - v;
      t = x[5]; v = (f32x2){C * (t.x - t.y), C * (t.x + t.y)}; u = x[1]; x[1] = u + v; x[5] = u - v;
      t = x[6]; v = (f32x2){-t.y, t.x}; u = x[2]; x[2] = u + v; x[6] = u - v;
      t = x[7]; v = (f32x2){-C * (t.x + t.y), C * (t.x - t.y)}; u = x[3]; x[3] = u + v; x[7] = u - v; }
}
__device__ __forceinline__ void twid8(f32x2 (&x)[8], int pidx, int L, bool conj) {
    const float rev = -(float)pidx / (float)L;
    const float s = __builtin_amdgcn_sinf(rev), c = __builtin_amdgcn_cosf(rev);
    const f32x2 w1 = {c, s}; const f32x2 w2 = cmul(w1, w1), w3 = cmul(w2, w1), w4 = cmul(w2, w2), w5 = cmul(w4, w1), w6 = cmul(w3, w3), w7 = cmul(w4, w3);
    if (!conj) { x[1] = cmul(x[1], w4); x[2] = cmul(x[2], w2); x[3] = cmul(x[3], w6); x[4] = cmul(x[4], w1); x[5] = cmul(x[5], w5); x[6] = cmul(x[6], w3); x[7] = cmul(x[7], w7); }
    else { x[1] = cmulc(x[1], w4); x[2] = cmulc(x[2], w2); x[3] = cmulc(x[3], w6); x[4] = cmulc(x[4], w1); x[5] = cmulc(x[5], w5); x[6] = cmulc(x[6], w3); x[7] = cmulc(x[7], w7); }
}
__device__ __forceinline__ void fft_fwd(f32x2* z) {
    const int tid = TID();
#pragma unroll 1
    for (int L = 8192; L >= 16; L >>= 3) {
        const int S = L >> 3;
#pragma unroll
        for (int qq = 0; qq < 2; ++qq) { const int q = tid + qq * NT;
            const int pidx = q & (S - 1), B = (q / S) * L + pidx;
            f32x2 x[8];
#pragma unroll
            for (int j = 0; j < 8; ++j) x[j] = z[ZI(B + j * S)];
            dif8(x); twid8(x, pidx, L, false);
#pragma unroll
            for (int j = 0; j < 8; ++j) z[ZI(B + j * S)] = x[j];
        }
        __syncthreads();
    }
#pragma unroll 4
    for (int q = tid; q < 4096; q += NT) { const f32x2 a = z[ZI(2 * q)], b = z[ZI(2 * q + 1)]; z[ZI(2 * q)] = a + b; z[ZI(2 * q + 1)] = a - b; }
    __syncthreads();
}
__device__ __forceinline__ void fft_inv(f32x2* z) {
    const int tid = TID();
#pragma unroll 4
    for (int q = tid; q < 4096; q += NT) { const f32x2 a = z[ZI(2 * q)], b = z[ZI(2 * q + 1)]; z[ZI(2 * q)] = a + b; z[ZI(2 * q + 1)] = a - b; }
    __syncthreads();
#pragma unroll 1
    for (int L = 16; L <= 8192; L <<= 3) {
        const int S = L >> 3;
#pragma unroll
        for (int qq = 0; qq < 2; ++qq) { const int q = tid + qq * NT;
            const int pidx = q & (S - 1), B = (q / S) * L + pidx;
            f32x2 x[8];
#pragma unroll
            for (int j = 0; j < 8; ++j) x[j] = z[ZI(B + j * S)];
            twid8(x, pidx, L, true); idif8(x);
#pragma unroll
            for (int j = 0; j < 8; ++j) z[ZI(B + j * S)] = x[j];
        }
        __syncthreads();
    }
}

__device__ __forceinline__ void fft_fwd_h(f32x2* z, int lt) {
#pragma unroll 1
    for (int L = 8192; L >= 16; L >>= 3) {
        const int S = L >> 3;
#pragma unroll 2
        for (int qq = 0; qq < 4; ++qq) { const int q = lt + qq * 256;
            const int pidx = q & (S - 1), B = (q / S) * L + pidx;
            f32x2 x[8];
#pragma unroll
            for (int j = 0; j < 8; ++j) x[j] = z[ZI(B + j * S)];
            dif8(x); twid8(x, pidx, L, false);
#pragma unroll
            for (int j = 0; j < 8; ++j) z[ZI(B + j * S)] = x[j];
        }
        __syncthreads();
    }
#pragma unroll 4
    for (int q = lt; q < 4096; q += 256) { const f32x2 a = z[ZI(2 * q)], b = z[ZI(2 * q + 1)]; z[ZI(2 * q)] = a + b; z[ZI(2 * q + 1)] = a - b; }
    __syncthreads();
}
__device__ __forceinline__ void fft_inv_h(f32x2* z, int lt) {
#pragma unroll 4
    for (int q = lt; q < 4096; q += 256) { const f32x2 a = z[ZI(2 * q)], b = z[ZI(2 * q + 1)]; z[ZI(2 * q)] = a + b; z[ZI(2 * q + 1)] = a - b; }
    __syncthreads();
#pragma unroll 1
    for (int L = 16; L <= 8192; L <<= 3) {
        const int S = L >> 3;
#pragma unroll 2
        for (int qq = 0; qq < 4; ++qq) { const int q = lt + qq * 256;
            const int pidx = q & (S - 1), B = (q / S) * L + pidx;
            f32x2 x[8];
#pragma unroll
            for (int j = 0; j < 8; ++j) x[j] = z[ZI(B + j * S)];
            twid8(x, pidx, L, true); idif8(x);
#pragma unroll
            for (int j = 0; j < 8; ++j) z[ZI(B + j * S)] = x[j];
        }
        __syncthreads();
    }
}

__device__ __forceinline__ void filtfft_item(const Params& p, unsigned char* smem, int oc) {
    f32x2* z = (f32x2*)smem;
    float* red = (float*)(smem + 8704 * 8);
    const int tid = TID();
    const float* filt = (const float*)(p.ws + O_FILT) + (size_t)oc * 8192;
    const float* l1p = (const float*)(p.ws + O_L1P);
    __syncthreads();
#pragma unroll 4
    for (int i = tid; i < 8192; i += NT) z[ZI(i)] = (f32x2){filt[i], 0.f};
    if (tid < 256) red[tid] = l1p[(size_t)tid * 1024 + oc] + l1p[(size_t)tid * 1024 + 512 + oc];
    __syncthreads();
    if (tid < 64) { float v = red[tid] + red[tid + 64] + red[tid + 128] + red[tid + 192]; v = wave_sum(v); if (tid == 0) red[256] = v; }
    fft_fwd(z);
    const float sc = 1.0f / (red[256] * 8192.0f);
    f32x2* fh = (f32x2*)(p.ws + O_FH) + (size_t)oc * 8192;
#pragma unroll 4
    for (int i = tid; i < 8192; i += NT) fh[i] = z[ZI(i)] * sc;
}

__device__ __forceinline__ void hyfft_item(const Params& p, unsigned char* smem, int l, int ch, int bp) {
    f32x2* z = (f32x2*)smem;
    f32x2* zz = (f32x2*)(smem + 8704 * 8);
    const int tid = TID();
    const bf16_t* HV = (const bf16_t*)(p.ws + O_HV);
    const bf16_t* v0 = HV + ((size_t)(2 * bp) * 768 + ch) * 4096; const bf16_t* v1 = v0 + (size_t)768 * 4096;
    const f32x2* fh0 = (const f32x2*)(p.ws + O_FH) + (size_t)ch * 8192; const f32x2* fh1 = fh0 + (size_t)256 * 8192;
    const float sk0 = p.hy_skip[(size_t)l * 512 + ch], sk1 = p.hy_skip[(size_t)l * 512 + 256 + ch];
    bf16_t a0[8], a1[8];
#pragma unroll
    for (int k = 0; k < 8; ++k) { a0[k] = v0[tid + k * NT]; a1[k] = v1[tid + k * NT]; }
    f32x2 fr[16];
#pragma unroll
    for (int k = 0; k < 16; ++k) fr[k] = fh0[tid + k * NT];
    __syncthreads();
#pragma unroll
    for (int k = 0; k < 8; ++k) { const int t = tid + k * NT; z[ZI(t)] = (f32x2){bf2f(a0[k]), bf2f(a1[k])}; z[ZI(4096 + t)] = (f32x2){0.f, 0.f}; }
    __syncthreads();
    fft_fwd(z);
#pragma unroll
    for (int k = 0; k < 16; ++k) { const int i = tid + k * NT; z[ZI(i)] = cmul(z[ZI(i)], fr[k]); }
    bf16_t x0[8], x1[8];
#pragma unroll
    for (int k = 0; k < 8; ++k) { x0[k] = v0[(size_t)256 * 4096 + tid + k * NT]; x1[k] = v1[(size_t)256 * 4096 + tid + k * NT]; }
#pragma unroll
    for (int k = 0; k < 16; ++k) fr[k] = fh1[tid + k * NT];
    __syncthreads();
    fft_inv(z);
#pragma unroll
    for (int k = 0; k < 8; ++k) {
        const int t = tid + k * NT;
        f32x2 y = z[ZI(t)];
        y.x += bf2f(a0[k]) * sk0; y.y += bf2f(a1[k]) * sk0;
        const f32x2 zv = {bf2f(x0[k]) * y.x, bf2f(x1[k]) * y.y};
        zz[t] = zv; z[ZI(t)] = zv; z[ZI(4096 + t)] = (f32x2){0.f, 0.f};
    }
    __syncthreads();
    fft_fwd(z);
#pragma unroll
    for (int k = 0; k < 16; ++k) { const int i = tid + k * NT; z[ZI(i)] = cmul(z[ZI(i)], fr[k]); }
#pragma unroll
    for (int k = 0; k < 8; ++k) { x0[k] = v0[(size_t)512 * 4096 + tid + k * NT]; x1[k] = v1[(size_t)512 * 4096 + tid + k * NT]; }
    __syncthreads();
    fft_inv(z);
    bf16_t* YBT = (bf16_t*)(p.ws + O_YBT);
    bf16_t* o0 = YBT + ((size_t)(2 * bp) * 256 + ch) * 4096; bf16_t* o1 = o0 + (size_t)256 * 4096;
#pragma unroll
    for (int k = 0; k < 8; ++k) {
        const int t = tid + k * NT;
        const f32x2 y = z[ZI(t)] + zz[t] * sk1;
        o0[t] = f2bf(bf2f(x0[k]) * y.x); o1[t] = f2bf(bf2f(x1[k]) * y.y);
    }
}

__device__ __forceinline__ void hyfft_pair(const Params& p, unsigned char* smem, int l, int ch, int pp) {
    const int tid = TID(), hf = __builtin_amdgcn_readfirstlane(tid >> 8), lt = tid & 255, bp = 2 * pp + hf;
    f32x2* z = (f32x2*)(smem + (size_t)hf * 8704 * 8);
    const bf16_t* HV = (const bf16_t*)(p.ws + O_HV);
    const bf16_t* v0 = HV + ((size_t)(2 * bp) * 768 + ch) * 4096; const bf16_t* v1 = v0 + (size_t)768 * 4096;
    const f32x2* fh0 = (const f32x2*)(p.ws + O_FH) + (size_t)ch * 8192; const f32x2* fh1 = fh0 + (size_t)256 * 8192;
    const float sk0 = p.hy_skip[(size_t)l * 512 + ch], sk1 = p.hy_skip[(size_t)l * 512 + 256 + ch];
    unsigned av[16];
#pragma unroll
    for (int k = 0; k < 16; ++k) av[k] = (unsigned)v0[lt + k * 256] | ((unsigned)v1[lt + k * 256] << 16);
    f32x2 fr[32];
#pragma unroll
    for (int k = 0; k < 32; ++k) fr[k] = fh0[lt + k * 256];
    __syncthreads();
#pragma unroll
    for (int k = 0; k < 16; ++k) { const int t = lt + k * 256; z[ZI(t)] = (f32x2){bflo(av[k]), bfhi(av[k])}; z[ZI(4096 + t)] = (f32x2){0.f, 0.f}; }
    __syncthreads();
    fft_fwd_h(z, lt);
#pragma unroll
    for (int k = 0; k < 32; ++k) { const int i = lt + k * 256; z[ZI(i)] = cmul(z[ZI(i)], fr[k]); }
    unsigned xv[16];
#pragma unroll
    for (int k = 0; k < 16; ++k) xv[k] = (unsigned)v0[(size_t)256 * 4096 + lt + k * 256] | ((unsigned)v1[(size_t)256 * 4096 + lt + k * 256] << 16);
#pragma unroll
    for (int k = 0; k < 32; ++k) fr[k] = fh1[lt + k * 256];
    __syncthreads();
    fft_inv_h(z, lt);
    f32x2 zz[16];
#pragma unroll
    for (int k = 0; k < 16; ++k) {
        const int t = lt + k * 256;
        f32x2 y = z[ZI(t)];
        y.x += bflo(av[k]) * sk0; y.y += bfhi(av[k]) * sk0;
        const f32x2 zv = {bflo(xv[k]) * y.x, bfhi(xv[k]) * y.y};
        zz[k] = zv; z[ZI(t)] = zv; z[ZI(4096 + t)] = (f32x2){0.f, 0.f};
    }
    __syncthreads();
    fft_fwd_h(z, lt);
#pragma unroll
    for (int k = 0; k < 32; ++k) { const int i = lt + k * 256; z[ZI(i)] = cmul(z[ZI(i)], fr[k]); }
#pragma unroll
    for (int k = 0; k < 16; ++k) xv[k] = (unsigned)v0[(size_t)512 * 4096 + lt + k * 256] | ((unsigned)v1[(size_t)512 * 4096 + lt + k * 256] << 16);
    __syncthreads();
    fft_inv_h(z, lt);
    bf16_t* YBT = (bf16_t*)(p.ws + O_YBT);
    bf16_t* o0 = YBT + ((size_t)(2 * bp) * 256 + ch) * 4096; bf16_t* o1 = o0 + (size_t)256 * 4096;
#pragma unroll
    for (int k = 0; k < 16; ++k) {
        const int t = lt + k * 256;
        const f32x2 y = z[ZI(t)] + zz[k] * sk1;
        o0[t] = f2bf(bflo(xv[k]) * y.x); o1[t] = f2bf(bfhi(xv[k]) * y.y);
    }
}

__device__ __forceinline__ void hyctx_item(const Params& p, unsigned char* smem, int l, int b, int cp) {
    float* f1 = (float*)smem;
    float* f2 = f1 + 1024;
    float* vv = f2 + 1024;
    float* zc = vv + 512;
    float* red = zc + 512;
    const int tid = TID(), hf = tid >> 8, t = tid & 255, ch = cp * 2 + hf;
    const float* FC = (const float*)(p.ws + O_FILTC); const float* l1p = (const float*)(p.ws + O_L1PC);
    const bf16_t* HVC = (const bf16_t*)(p.ws + O_HVC) + ((size_t)b * 768 + ch) * 256;
    __syncthreads();
    f1[hf * 512 + t] = FC[(size_t)ch * 512 + t]; f1[hf * 512 + 256 + t] = FC[(size_t)ch * 512 + 256 + t];
    f2[hf * 512 + t] = FC[(size_t)(256 + ch) * 512 + t]; f2[hf * 512 + 256 + t] = FC[(size_t)(256 + ch) * 512 + 256 + t];
    const float vt = bf2f(HVC[t]); vv[hf * 256 + t] = vt;
    if (t < 2) { float s = 0.f; for (int it = 0; it < 16; ++it) s += l1p[(size_t)it * 1024 + t * 256 + ch] + l1p[(size_t)it * 1024 + 512 + t * 256 + ch]; red[hf * 2 + t] = s; }
    __syncthreads();
    float a = 0.f;
    for (int s = 0; s < 256; ++s) a += f1[hf * 512 + ((t - s) & 511)] * vv[hf * 256 + s];
    const float y1 = a / red[hf * 2 + 0] + vt * p.hy_skip[(size_t)l * 512 + ch];
    const float zt = bf2f(HVC[(size_t)256 * 256 + t]) * y1; zc[hf * 256 + t] = zt;
    __syncthreads();
    float a2 = 0.f;
    for (int s = 0; s < 256; ++s) a2 += f2[hf * 512 + ((t - s) & 511)] * zc[hf * 256 + s];
    const float y2 = a2 / red[hf * 2 + 1] + zt * p.hy_skip[(size_t)l * 512 + 256 + ch];
    bf16_t* YBTC = (bf16_t*)(p.ws + O_YBTC);
    YBTC[((size_t)b * 256 + ch) * 256 + t] = f2bf(bf2f(HVC[(size_t)512 * 256 + t]) * y2);
}

__device__ __forceinline__ void qk_item(const Params& p, int l, int item, bool dry = false) {
    const int tid = TID(), seg = tid & 7, vsub = tid >> 3;
    const int which = (item >= 544) ? 1 : 0;
    const int vbase = (item - which * 544) * 512;
    bf16_t* base = (bf16_t*)(p.ws + (which ? O_KN : O_QN));
    u32x4 raw[8];
#pragma unroll
    for (int it = 0; it < 8; ++it) raw[it] = *(const u32x4*)(base + (size_t)(vbase + it * 64 + vsub) * 64 + seg * 8);
    const float* gp = p.qk_gain + (size_t)l * 128 + which * 64 + seg * 8;
    const f32x4 g0 = *(const f32x4*)gp, g1 = *(const f32x4*)(gp + 4);
    const float gn[8] = {g0[0], g0[1], g0[2], g0[3], g1[0], g1[1], g1[2], g1[3]};
    const float qs = which ? 1.0f : (0.125f * 1.4426950408889634f);
    const int axis = seg >> 2, role = (seg >> 1) & 1, qb = (seg & 1) * 8;
    float inv[8];
#pragma unroll
    for (int e = 0; e < 8; ++e) inv[e] = exp2f(-(float)(qb + e) * (13.287712379549449f / 16.0f));
#pragma unroll
    for (int it = 0; it < 8; ++it) {
        const int rem = vbase + it * 64 + vsub, kidx = rem % NK;
        const u32x4 w = raw[it];
        float v[8] = {bflo(w.x), bfhi(w.x), bflo(w.y), bfhi(w.y), bflo(w.z), bfhi(w.z), bflo(w.w), bfhi(w.w)};
        float ss = 0.f;
#pragma unroll
        for (int e = 0; e < 8; ++e) ss += v[e] * v[e];
        ss += __shfl_xor(ss, 1); ss += __shfl_xor(ss, 2); ss += __shfl_xor(ss, 4);
        const float rinv = rsqrtf(ss * (1.0f / 64.0f) + 1e-6f) * qs;
#pragma unroll
        for (int e = 0; e < 8; ++e) v[e] = v[e] * rinv * gn[e];
        const int t = kidx - 256;
        const float pos = (float)(axis ? (t & 63) : (t >> 6));
        float o[8];
#pragma unroll
        for (int e = 0; e < 8; ++e) {
            const float pe = __shfl_xor(v[e], 2);
            float sn, cs; __sincosf(pos * inv[e], &sn, &cs);
            const float r = role ? (pe * sn + v[e] * cs) : (v[e] * cs - pe * sn);
            o[e] = (kidx >= 256) ? r : v[e];
        }
        u32x4 ow = {pk2(o[0], o[1]), pk2(o[2], o[3]), pk2(o[4], o[5]), pk2(o[6], o[7])};
        if (dry) ow = w;
        *(u32x4*)(base + (size_t)rem * 64 + seg * 8) = ow;
    }
}

__device__ __forceinline__ void vt_item(const Params& p, unsigned char* smem, int tb) {
    bf16_t* tile = (bf16_t*)smem;
    const int tid = TID(), r0 = tb * 64;
    const bf16_t* src = (const bf16_t*)(p.ws + O_VRAW) + (size_t)r0 * 512;
    __syncthreads();
#pragma unroll
    for (int i = 0; i < 8; ++i) { const int e = tid + i * NT, rr = e >> 6, sg = e & 63; *(u32x4*)(tile + rr * 520 + sg * 8) = *(const u32x4*)(src + (size_t)rr * 512 + sg * 8); }
    __syncthreads();
    int b, kidx0; row_bk(r0, b, kidx0);
    bf16_t* tr = tile + 64 * 520;
#pragma unroll
    for (int s = 0; s < 8; ++s) {
        unsigned w[4];
#pragma unroll
        for (int j = 0; j < 4; ++j) w[j] = (unsigned)tile[(s * 8 + 2 * j) * 520 + tid] | ((unsigned)tile[(s * 8 + 2 * j + 1) * 520 + tid] << 16);
        *(u32x4*)(tr + tid * 72 + s * 8) = (u32x4){w[0], w[1], w[2], w[3]};
    }
    __syncthreads();
    bf16_t* dst = (bf16_t*)(p.ws + O_VT) + (size_t)b * 512 * NK + kidx0;
#pragma unroll
    for (int ps = 0; ps < 8; ++ps) {
        const int c = (tid >> 3) + 64 * ps, sg = tid & 7;
        *(u32x4*)(dst + (size_t)c * NK + sg * 8) = *(const u32x4*)(tr + c * 72 + sg * 8);
    }
}

__device__ __forceinline__ void hyconv_item(const Params& p, unsigned char* smem, int l, int tb) {
    bf16_t* tile = (bf16_t*)smem;
    const int tid = TID(), r0 = tb * 64;
    const bool lat = r0 < TL;
    const int n = lat ? 4096 : 256, rb = lat ? r0 : r0 - TL, b = rb / n, t0 = rb % n;
    const bf16_t* src = (const bf16_t*)(p.ws + O_HYRAW);
    __syncthreads();
    {
        u32x4 wv[13];
#pragma unroll
        for (int k = 0; k < 13; ++k) {
            const int e = tid + k * NT, rr = e / 96, sg = e % 96, t = t0 - 1 + rr;
            wv[k] = (u32x4){0u, 0u, 0u, 0u};
            if (e < 66 * 96 && t >= 0 && t < n) wv[k] = *(const u32x4*)(src + (size_t)(r0 - 1 + rr) * 768 + sg * 8);
        }
#pragma unroll
        for (int k = 0; k < 13; ++k) { const int e = tid + k * NT, rr = e / 96, sg = e % 96; if (e < 66 * 96) *(u32x4*)(tile + rr * 776 + sg * 8) = wv[k]; }
    }
    __syncthreads();
    const float* cw = p.hy_conv_w + (size_t)l * 3 * 768; const float* cb = p.hy_conv_b + (size_t)l * 768;
    bf16_t* img = tile + 66 * 776;
    const int cl = tid & 255, hh = tid >> 8;
#pragma unroll 1
    for (int third = 0; third < 3; ++third) {
        const int c = third * 256 + cl;
        const float w0 = cw[c], w1 = cw[768 + c], w2 = cw[1536 + c], bb = cb[c];
        float pm = bf2f(tile[(hh * 32) * 776 + c]), pc = bf2f(tile[(hh * 32 + 1) * 776 + c]);
#pragma unroll
        for (int s4 = 0; s4 < 4; ++s4) {
            float o[8];
#pragma unroll
            for (int j = 0; j < 8; ++j) { const float pn = bf2f(tile[(hh * 32 + s4 * 8 + j + 2) * 776 + c]); o[j] = pm * w0 + pc * w1 + pn * w2 + bb; pm = pc; pc = pn; }
            *(u32x4*)(img + cl * 72 + hh * 32 + s4 * 8) = (u32x4){pk2(o[0], o[1]), pk2(o[2], o[3]), pk2(o[4], o[5]), pk2(o[6], o[7])};
        }
        __syncthreads();
#pragma unroll
        for (int k = 0; k < 4; ++k) {
            const int e = tid + k * NT, cr = e >> 3, sg = e & 7, cg = third * 256 + cr;
            bf16_t* dst = lat ? (bf16_t*)(p.ws + O_HV) + ((size_t)b * 768 + cg) * 4096 + t0 : (bf16_t*)(p.ws + O_HVC) + ((size_t)b * 768 + cg) * 256 + t0;
            *(u32x4*)(dst + sg * 8) = *(const u32x4*)(img + cr * 72 + sg * 8);
        }
        __syncthreads();
    }
}

__device__ __forceinline__ float gelu_exact(float v) { return 0.5f * v * (1.0f + erff(v * 0.70710678118654752f)); }
__device__ __forceinline__ void sgu_item(const Params& p, unsigned char* smem, int l, int ci) {
    bf16_t* vt = (bf16_t*)smem;
    const int tid = TID(), lane = tid & 63, wv = __builtin_amdgcn_readfirstlane(tid >> 6), r0 = ci * 128;
    const bf16_t* src = (const bf16_t*)(p.ws + O_SGRAW) + (size_t)r0 * 512;
    const float* lg = p.sg_ln_g + (size_t)l * 256; const float* lb = p.sg_ln_b + (size_t)l * 256;
    __syncthreads();
    {
        const f32x4 g4 = *(const f32x4*)(lg + lane * 4), b4 = *(const f32x4*)(lb + lane * 4);
        u32x2 wr_[16];
#pragma unroll
        for (int k = 0; k < 16; ++k) wr_[k] = *(const u32x2*)(src + (size_t)(wv + 8 * k) * 512 + 256 + lane * 4);
#pragma unroll
        for (int k = 0; k < 16; ++k) {
            const int rr = wv + 8 * k; const u32x2 w = wr_[k];
            float a[4] = {gelu_exact(bflo(w.x)), gelu_exact(bfhi(w.x)), gelu_exact(bflo(w.y)), gelu_exact(bfhi(w.y))};
            const float mu = wave_sum(a[0] + a[1] + a[2] + a[3]) * (1.0f / 256.0f);
            float d[4]; float sq = 0.f;
#pragma unroll
            for (int j = 0; j < 4; ++j) { d[j] = a[j] - mu; sq += d[j] * d[j]; }
            const float rstd = rsqrtf(wave_sum(sq) * (1.0f / 256.0f) + 1e-6f);
#pragma unroll
            for (int j = 0; j < 4; ++j) vt[(lane * 4 + j) * 136 + rr] = f2bf(d[j] * rstd * g4[j] + b4[j]);
        }
    }
    __syncthreads();
    const int g = wv & 3, ih = wv >> 2, l32 = lane & 31, kg = lane >> 5;
    const float* wsb = p.sg_w + ((size_t)l * 4 + g) * 128 * 128;
    const float* bsb = p.sg_b + ((size_t)l * 4 + g) * 128;
    bf16_t* yc = (bf16_t*)(p.ws + O_YCAT) + 768;
#pragma unroll 1
    for (int ib = 0; ib < 2; ++ib) {
        const int i0 = ih * 64 + ib * 32;
        f32x16 acc0, acc1;
#pragma unroll
        for (int r = 0; r < 16; ++r) { acc0[r] = 0.f; acc1[r] = 0.f; }
        const float* wrow = wsb + (size_t)(i0 + l32) * 128 + 8 * kg;
#pragma unroll
        for (int ks = 0; ks < 8; ++ks) {
            const f32x4 w0 = *(const f32x4*)(wrow + 16 * ks), w1 = *(const f32x4*)(wrow + 16 * ks + 4);
            const u32x4 aw = {pk2(w0[0], w0[1]), pk2(w0[2], w0[3]), pk2(w1[0], w1[1]), pk2(w1[2], w1[3])};
            const bf16x8 af = __builtin_bit_cast(bf16x8, aw);
            const bf16x8 b0 = *(const bf16x8*)(vt + (g * 64 + 2 * l32) * 136 + 16 * ks + 8 * kg);
            const bf16x8 b1 = *(const bf16x8*)(vt + (g * 64 + 2 * l32 + 1) * 136 + 16 * ks + 8 * kg);
            acc0 = __builtin_amdgcn_mfma_f32_32x32x16_bf16(af, b0, acc0, 0, 0, 0);
            acc1 = __builtin_amdgcn_mfma_f32_32x32x16_bf16(af, b1, acc1, 0, 0, 0);
        }
        const int c0 = g * 64 + 2 * l32;
        unsigned uw[16]; float bia[16];
#pragma unroll
        for (int r = 0; r < 16; ++r) {
            const int i = i0 + 8 * (r >> 2) + 4 * kg + (r & 3);
            uw[r] = *(const unsigned*)(src + (size_t)i * 512 + c0); bia[r] = bsb[i];
        }
#pragma unroll
        for (int r = 0; r < 16; ++r) {
            const int i = i0 + 8 * (r >> 2) + 4 * kg + (r & 3);
            const float u0 = gelu_exact(bflo(uw[r])), u1 = gelu_exact(bfhi(uw[r]));
            *(unsigned*)(yc + (size_t)(r0 + i) * 1024 + c0) = pk2(u0 * (acc0[r] + bia[r]), u1 * (acc1[r] + bia[r]));
        }
    }
}

__device__ __forceinline__ void prep_phase(const Params& p, unsigned char* smem, int l) {
    const int n_sg = 0, n_hy = 544, n_vt = 544, n_qk = 1088;
    const int total = n_sg + n_hy + n_vt + n_qk;
    for (int it = blockIdx.x; it < total; it += gridDim.x) {
        int i = it;
        if (i < n_sg) { for (int rep = 0; rep < REP_SGU; ++rep) sgu_item(p, smem, l, i); continue; }
        i -= n_sg;
        if (i < n_hy) { for (int rep = 0; rep < REP_PREP; ++rep) hyconv_item(p, smem, l, i); continue; }
        i -= n_hy;
        if (i < n_vt) { for (int rep = 0; rep < REP_PREP; ++rep) vt_item(p, smem, i); continue; }
        i -= n_vt;
#if REP_QK > 1
        qk_item(p, l, i, true);
#endif
        qk_item(p, l, i);
    }
}

__device__ __forceinline__ void attn_item(const Params& p, unsigned char* smem, int b, int h, int comp, int q0, int rowbase, int nkt) {
    constexpr int ABUF = 64 * 72 + 128 * 72;
    bf16_t* Ks = (bf16_t*)smem;
    bf16_t* Vs = Ks + 64 * 72;
    const int tid = TID(), lane = tid & 63, w = tid >> 6, l32 = lane & 31, g = lane >> 5;
    const size_t hc = (size_t)((b * 4 + h) * 2 + comp);
    const bf16_t* Qb = (const bf16_t*)(p.ws + O_QN) + (hc * NK + q0 + 32 * w + l32) * 64;
    const bf16_t* Kb = (const bf16_t*)(p.ws + O_KN) + hc * NK * 64;
    const bf16_t* Vb = (const bf16_t*)(p.ws + O_VT) + (size_t)((b * 4 + h) * 128) * NK;
    bf16x8 qf[4];
#pragma unroll
    for (int ks = 0; ks < 4; ++ks) qf[ks] = *(const bf16x8*)(Qb + 16 * ks + 8 * g);
    f32x16 O[4];
#pragma unroll
    for (int d = 0; d < 4; ++d)
#pragma unroll
        for (int i = 0; i < 16; ++i) O[d][i] = 0.f;
    float lsum = 0.f;
    const int kkey = tid >> 3, kseg = tid & 7, vdv = tid >> 2, vseg = tid & 3;
    const bf16_t* kg = Kb + (size_t)kkey * 64 + kseg * 8;
    const bf16_t* vg = Vb + (size_t)vdv * NK + vseg * 16;
    u32x4 kreg = *(const u32x4*)kg, vr0 = *(const u32x4*)vg, vr1 = *(const u32x4*)(vg + 8);
    const int pr = (l32 & ~12) | ((l32 & 4) << 1) | ((l32 & 8) >> 1);
    __syncthreads();
    *(u32x4*)(Ks + kkey * 72 + kseg * 8) = kreg; *(u32x4*)(Vs + vdv * 72 + vseg * 16) = vr0; *(u32x4*)(Vs + vdv * 72 + vseg * 16 + 8) = vr1;
    if (nkt > 1) { kreg = *(const u32x4*)(kg + (size_t)64 * 64); vr0 = *(const u32x4*)(vg + 64); vr1 = *(const u32x4*)(vg + 64 + 8); }
    __syncthreads();
    for (int kt = 0; kt < nkt; ++kt) {
        const bf16_t* Kc = Ks + (kt & 1) * ABUF; const bf16_t* Vc = Vs + (kt & 1) * ABUF;
        if (kt + 1 < nkt) {
            bf16_t* Kn = Ks + ((kt + 1) & 1) * ABUF; bf16_t* Vn = Vs + ((kt + 1) & 1) * ABUF;
            *(u32x4*)(Kn + kkey * 72 + kseg * 8) = kreg; *(u32x4*)(Vn + vdv * 72 + vseg * 16) = vr0; *(u32x4*)(Vn + vdv * 72 + vseg * 16 + 8) = vr1;
            if (kt + 2 < nkt) { kreg = *(const u32x4*)(kg + (size_t)(kt + 2) * 64 * 64); vr0 = *(const u32x4*)(vg + (kt + 2) * 64); vr1 = *(const u32x4*)(vg + (kt + 2) * 64 + 8); }
        }
        f32x16 S0, S1;
#pragma unroll
        for (int i = 0; i < 16; ++i) { S0[i] = 0.f; S1[i] = 0.f; }
#pragma unroll
        for (int ks = 0; ks < 4; ++ks) {
            const bf16x8 ka = *(const bf16x8*)(Kc + pr * 72 + 16 * ks + 8 * g);
            const bf16x8 kb = *(const bf16x8*)(Kc + (32 + pr) * 72 + 16 * ks + 8 * g);
            S0 = __builtin_amdgcn_mfma_f32_32x32x16_bf16(ka, qf[ks], S0, 0, 0, 0);
            S1 = __builtin_amdgcn_mfma_f32_32x32x16_bf16(kb, qf[ks], S1, 0, 0, 0);
        }
#pragma unroll
        for (int i = 0; i < 16; ++i) { S0[i] = __builtin_amdgcn_exp2f(S0[i]); S1[i] = __builtin_amdgcn_exp2f(S1[i]); lsum += S0[i] + S1[i]; }
#pragma unroll
        for (int kb2 = 0; kb2 < 2; ++kb2)
#pragma unroll
            for (int s = 0; s < 2; ++s) {
                u32x4 pw;
                if (kb2 == 0) { pw.x = pk2(S0[8 * s], S0[8 * s + 1]); pw.y = pk2(S0[8 * s + 2], S0[8 * s + 3]); pw.z = pk2(S0[8 * s + 4], S0[8 * s + 5]); pw.w = pk2(S0[8 * s + 6], S0[8 * s + 7]); }
                else { pw.x = pk2(S1[8 * s], S1[8 * s + 1]); pw.y = pk2(S1[8 * s + 2], S1[8 * s + 3]); pw.z = pk2(S1[8 * s + 4], S1[8 * s + 5]); pw.w = pk2(S1[8 * s + 6], S1[8 * s + 7]); }
                const bf16x8 pf = __builtin_bit_cast(bf16x8, pw);
#pragma unroll
                for (int d = 0; d < 4; ++d) {
                    const bf16x8 va = *(const bf16x8*)(Vc + (d * 32 + l32) * 72 + kb2 * 32 + 16 * s + 8 * g);
                    O[d] = __builtin_amdgcn_mfma_f32_32x32x16_bf16(va, pf, O[d], 0, 0, 0);
                }
            }
        __syncthreads();
    }
    lsum += __shfl_xor(lsum, 32);
    const float inv = 1.0f / lsum;
    bf16_t* stg = (bf16_t*)(smem + 4 * ABUF) + (size_t)(32 * w) * 136;
#pragma unroll
    for (int d = 0; d < 4; ++d)
#pragma unroll
        for (int i4 = 0; i4 < 4; ++i4) {
            u32x2 o; o.x = pk2(O[d][4 * i4] * inv, O[d][4 * i4 + 1] * inv); o.y = pk2(O[d][4 * i4 + 2] * inv, O[d][4 * i4 + 3] * inv);
            *(u32x2*)(stg + l32 * 136 + d * 32 + 8 * i4 + 4 * g) = o;
        }
    bf16_t* ob = (bf16_t*)(p.ws + O_OC) + ((size_t)(rowbase + 32 * w) * 8 + h * 2 + comp) * 128;
#pragma unroll
    for (int k = 0; k < 8; ++k) {
        const int rr = 4 * k + (lane >> 4), pc = lane & 15;
        *(u32x4*)(ob + (size_t)rr * 1024 + pc * 8) = *(const u32x4*)(stg + rr * 136 + pc * 8);
    }
}

__device__ __forceinline__ void mix_phase(const Params& p, unsigned char* smem, int l) {
    const int n_al = 1024, n_ac = (l == 0) ? 64 : 0, n_hf = 512, n_hc = (l == 0) ? 1024 : 0;
    const int total = n_al + n_ac + n_hf + n_hc;
    for (int it = blockIdx.x; it < total; it += gridDim.x) {
        int i = it;
        if (i < n_al) { const int comp = i & 1, h = (i >> 1) & 3, qt = (i >> 3) & 15, b = i >> 7; for (int rep = 0; rep < REP_ATT; ++rep) attn_item(p, smem, b, h, comp, 256 + qt * 256, b * 4096 + qt * 256, 68); continue; }
        i -= n_al;
        if (i < n_ac) { const int comp = i & 1, h = (i >> 1) & 3, b = i >> 3; attn_item(p, smem, b, h, comp, 0, TL + b * 256, 4); continue; }
        i -= n_ac;
        if (i < n_hf) { for (int rep = 0; rep < REP_HY; ++rep) hyfft_pair(p, smem, l, i >> 1, i & 1); continue; }
        i -= n_hf;
        for (int rep = 0; rep < REP_MISC; ++rep) hyctx_item(p, smem, l, i >> 7, i & 127);
    }
}

__device__ __forceinline__ void ybt_item(const Params& p, unsigned char* smem, int tb) {
    bf16_t* tile = (bf16_t*)smem;
    const int tid = TID(), r0 = tb * 64;
    const bool lat = r0 < TL;
    const int n = lat ? 4096 : 256, rb = lat ? r0 : r0 - TL, b = rb / n, t0 = rb % n;
    const bf16_t* src = (lat ? (const bf16_t*)(p.ws + O_YBT) : (const bf16_t*)(p.ws + O_YBTC)) + (size_t)b * 256 * n + t0;
    __syncthreads();
#pragma unroll
    for (int i = 0; i < 4; ++i) { const int e = tid + i * NT, ch = e >> 3, sg = e & 7; *(u32x4*)(tile + ch * 72 + sg * 8) = *(const u32x4*)(src + (size_t)ch * n + sg * 8); }
    __syncthreads();
    bf16_t* yb = (bf16_t*)(p.ws + O_YCAT) + 512;
#pragma unroll
    for (int i = 0; i < 4; ++i) {
        const int e = tid + i * NT, rr = e >> 5, sg = e & 31;
        unsigned w[4];
#pragma unroll
        for (int j = 0; j < 4; ++j) w[j] = (unsigned)tile[(sg * 8 + 2 * j) * 72 + rr] | ((unsigned)tile[(sg * 8 + 2 * j + 1) * 72 + rr] << 16);
        *(u32x4*)(yb + (size_t)(r0 + rr) * 1024 + sg * 8) = (u32x4){w[0], w[1], w[2], w[3]};
    }
}
__device__ __forceinline__ void post_phase(const Params& p, unsigned char* smem, int l, int M) {
    const int n_sg = M / 128, nb = M / 64;
    for (int it = blockIdx.x; it < n_sg + nb; it += gridDim.x) {
        if (it < n_sg) { for (int rep = 0; rep < REP_SGU; ++rep) sgu_item(p, smem, l, it); }
        else ybt_item(p, smem, it - n_sg);
    }
    const int tid = TID(), lane = tid & 63, wv = tid >> 6;
    const float* lv = p.da_lambda + (size_t)l * 256;
    const float d01 = wave_sum(lv[lane] * lv[64 + lane]), d23 = wave_sum(lv[128 + lane] * lv[192 + lane]);
    const float lam_init = 0.8f - 0.6f * expf(-0.3f * (float)l);
    const float lam = expf(d01) - expf(d23) + lam_init;
    const float* sub = p.da_subln + (size_t)l * 128;
    const float s0 = sub[2 * lane] * (1.0f - lam_init), s1 = sub[2 * lane + 1] * (1.0f - lam_init);
    const bf16_t* OC = (const bf16_t*)(p.ws + O_OC);
    bf16_t* YA = (bf16_t*)(p.ws + O_YCAT);
    const int vstep = gridDim.x * 8;
    for (int v0i = blockIdx.x * 8 + wv; v0i < M * 4; v0i += 4 * vstep) {
        unsigned aw[4], bw[4];
#pragma unroll
        for (int k = 0; k < 4; ++k) { const int vi = v0i + k * vstep; aw[k] = 0u; bw[k] = 0u;
            if (vi < M * 4) { const bf16_t* o0 = OC + (size_t)vi * 256; aw[k] = *(const unsigned*)(o0 + 2 * lane); bw[k] = *(const unsigned*)(o0 + 128 + 2 * lane); } }
#pragma unroll
        for (int k = 0; k < 4; ++k) { const int vi = v0i + k * vstep;
            if (vi < M * 4) {
                const float x0 = bflo(aw[k]) - lam * bflo(bw[k]), x1 = bfhi(aw[k]) - lam * bfhi(bw[k]);
                const float rinv = rsqrtf(wave_sum(x0 * x0 + x1 * x1) * (1.0f / 128.0f) + 1e-6f);
                *(unsigned*)(YA + (size_t)(vi >> 2) * 1024 + (vi & 3) * 128 + 2 * lane) = pk2(x0 * rinv * s0, x1 * rinv * s1);
            } }
    }
}

template <int l> __device__ __forceinline__ void layer_body(unsigned char* smem) {
        const int Mfull = TT, Mpost = (l == 0) ? TT : TL;
        { const Params q = opq(smem); norm_phase(q, l, 0, Mfull, l == 0, (const bf16_t*)q.out); if (l == 1) aux_phase(q, smem, 1); }
        gsync(smem);
        for (int rep = 0; rep < REP_UP; ++rep) { const Params q = opq(smem); EpiSwiglu E; E.G = (bf16_t*)(q.ws + O_GH); run_gemm(smem, (const bf16_t*)(q.ws + O_H), (const bf16_t*)(q.ws + O_WUP0), Mfull, 5632, 1024, E); }
        gsync(smem);
        { const Params q = opq(smem); EpiResid E; E.xin = (const bf16_t*)q.out; E.xout = (bf16_t*)q.out; E.fout = nullptr; E.xc = (float*)(q.ws + O_XC); E.part = (float*)(q.ws + O_PART); E.mod = (const float*)(q.ws + O_MOD) + (size_t)l * 9 * 9216; E.gofs = 2 * 1024; E.coef = 0.5f;
          run_gemm(smem, (const bf16_t*)(q.ws + O_GH), (const bf16_t*)(q.ws + O_WDN0), Mfull, 1024, 2816, E, true);
          for (int rep = 1; rep < REP_DN; ++rep) { E.coef = 0.f; run_gemm(smem, (const bf16_t*)(q.ws + O_GH), (const bf16_t*)(q.ws + O_WDN0), Mfull, 1024, 2816, E); } }
        gsync(smem);
        { const Params q = opq(smem); norm_phase(q, l, 1, Mfull, false, (const bf16_t*)q.out); for (int rep = 0; rep < REP_MISC; ++rep) for (int it = blockIdx.x; it < 512; it += gridDim.x) filtfft_item(q, smem, it); }
        gsync(smem);
        for (int rep = 0; rep < REP_G3; ++rep) { const Params q = opq(smem); EpiIn E; E.qn = (bf16_t*)(q.ws + O_QN); E.kn = (bf16_t*)(q.ws + O_KN); E.vraw = (bf16_t*)(q.ws + O_VRAW); E.hyraw = (bf16_t*)(q.ws + O_HYRAW); E.sgraw = (bf16_t*)(q.ws + O_SGRAW);
          run_gemm(smem, (const bf16_t*)(q.ws + O_H), (const bf16_t*)(q.ws + O_WIN), Mfull, 2816, 1024, E); }
        gsync(smem);
        { const Params q = opq(smem); prep_phase(q, smem, l); }
        gsync(smem);
        { const Params q = opq(smem); mix_phase(q, smem, l); }
        gsync(smem);
        for (int rep = 0; rep < REP_MISC; ++rep) { const Params q = opq(smem); post_phase(q, smem, l, Mpost); }
        gsync(smem);
#pragma unroll 1
        for (int rep9 = 0; rep9 < REP_P9; ++rep9) {
            { const Params q = opq(smem); EpiGate3 E; E.g3 = (bf16_t*)(q.ws + O_G3); E.bias = q.gate_b + (size_t)l * 3072;
              run_gemm(smem, (const bf16_t*)(q.ws + O_H), (const bf16_t*)(q.ws + O_WG), Mpost, 3072, 1024, E); }
            gsync(smem);
            { const Params q = opq(smem); EpiMergeR E; E.g3 = (const bf16_t*)(q.ws + O_G3); E.mb = (bf16_t*)(q.ws + O_MB);
              run_gemm(smem, (const bf16_t*)(q.ws + O_YCAT), (const bf16_t*)(q.ws + O_WBR), Mpost, 1024, 1024, E); }
        }
        gsync(smem);
        { const Params q = opq(smem); EpiResid E; E.xin = (const bf16_t*)q.out; E.xout = (l == 1) ? (bf16_t*)(q.ws + O_XALT) : (bf16_t*)q.out; E.fout = nullptr; E.xc = (float*)(q.ws + O_XC); E.part = (float*)(q.ws + O_PART); E.mod = (const float*)(q.ws + O_MOD) + (size_t)l * 9 * 9216; E.gofs = 5 * 1024; E.coef = 1.0f;
          run_gemm(smem, (const bf16_t*)(q.ws + O_MB), (const bf16_t*)(q.ws + O_WO), Mpost, 1024, 1024, E, l == 0);
          for (int rep = 1; rep < REP_G3; ++rep) { E.coef = 0.f; run_gemm(smem, (const bf16_t*)(q.ws + O_MB), (const bf16_t*)(q.ws + O_WO), Mpost, 1024, 1024, E); } }
        gsync(smem);
        { const Params q = opq(smem); norm_phase(q, l, 2, Mpost, false, (l == 1) ? (const bf16_t*)(q.ws + O_XALT) : (const bf16_t*)q.out); }
        gsync(smem);
        for (int rep = 0; rep < REP_UP; ++rep) { const Params q = opq(smem); EpiSwiglu E; E.G = (bf16_t*)(q.ws + O_GH); run_gemm(smem, (const bf16_t*)(q.ws + O_H), (const bf16_t*)(q.ws + O_WUP1), Mpost, 5632, 1024, E); }
        gsync(smem);
        { const Params q = opq(smem); EpiResid E; E.xin = (l == 1) ? (const bf16_t*)(q.ws + O_XALT) : (const bf16_t*)q.out; E.xout = (bf16_t*)q.out; E.fout = (l == 1) ? q.out : nullptr; E.xc = (float*)(q.ws + O_XC); E.part = (float*)(q.ws + O_PART); E.mod = (const float*)(q.ws + O_MOD) + (size_t)l * 9 * 9216; E.gofs = 8 * 1024; E.coef = 0.5f;
          run_gemm(smem, (const bf16_t*)(q.ws + O_GH), (const bf16_t*)(q.ws + O_WDN1), Mpost, 1024, 2816, E, l == 0); }
}

__global__ void __launch_bounds__(512, 2) fwd_megakernel(Params p) {
    extern __shared__ __attribute__((aligned(16))) unsigned char smem[];
    cg::grid_group grid = cg::this_grid();
    if (threadIdx.x == 0) {
        *(Params*)(smem + POFF) = p;
        volatile unsigned* st = (volatile unsigned*)(smem + POFF + 256); st[0] = 0u; st[1] = 0u;
        xb_add(&((unsigned*)(p.ws + O_BAR))[XB_XCNT(xb_xcc_id())], 1u);
    }
    __syncthreads();
    { const Params q = opq(smem); aux_phase(q, smem, 0); }
    grid.sync();
    layer_body<0>(smem);
    gsync(smem);
    layer_body<1>(smem);
}

extern "C" void kernel_launch(void* const* d_in, const int* in_sizes, int n_in, void* d_out, int out_size, void* d_ws, size_t ws_size, hipStream_t stream) {
    if (ws_size < WS_NEED) { fprintf(stderr, "workspace too small: need %zu have %zu\n", (size_t)WS_NEED, ws_size); return; }
    static int grid_blocks = 0;
    if (!grid_blocks) {
        hipFuncSetAttribute((const void*)fwd_megakernel, hipFuncAttributeMaxDynamicSharedMemorySize, LDS_BYTES);
        int dev = 0, cus = 0, per_cu = 0;
        hipGetDevice(&dev);
        hipDeviceGetAttribute(&cus, hipDeviceAttributeMultiprocessorCount, dev);
        hipOccupancyMaxActiveBlocksPerMultiprocessor(&per_cu, fwd_megakernel, NT, LDS_BYTES);
        if (per_cu < 1) per_cu = 1;
        grid_blocks = cus;
    }
    Params p{};
    const float** pp = (const float**)&p;
    for (int i = 0; i < 30; ++i) pp[i] = (const float*)d_in[i];
    p.out = (float*)d_out;
    p.ws = (unsigned char*)d_ws;
    hipMemsetAsync((unsigned char*)d_ws + O_BAR, 0, 16384, stream);
    void* args[] = {&p};
    hipError_t e = hipLaunchCooperativeKernel((void*)fwd_megakernel, dim3(grid_blocks), dim3(NT), args, LDS_BYTES, stream);
    if (e != hipSuccess) fprintf(stderr, "cooperative launch failed: %s (grid %d)\n", hipGetErrorString(e), grid_blocks);
}
```
